# Optimizing an MI355X kernel written in HIP

```python
import jax, jax.numpy as jnp
from jax import lax
import numpy as np

D_MODEL = 1024
BATCH = 8
SEQ = 4096
DEPTH = 4

N_MIXERS = 3
GRID_W = 64
D_FF = 2816
NORM_EPS = 1e-6
HG_HEADS = 8
HG_DK = D_MODEL // HG_HEADS
HG_DV = D_MODEL // HG_HEADS
HG_CHUNK = 16
NA_HEADS = 16
NA_HEAD_DIM = D_MODEL // NA_HEADS
NA_WIN_R = 8
NA_WIN_C = 16
MLA_HEADS = 16
MLA_Q_LORA = 768
MLA_KV_LORA = 256
MLA_NOPE = 64
MLA_ROPE = 32
MLA_V = 64
ROPE_THETA = 10000.0
Q_BLOCK = 128
N_A = (DEPTH + 2) // 3
N_B = (DEPTH + 1) // 3
N_C = DEPTH // 3
NEG_INF = -1e30

kernel_name = 'hybrid_hgrn2_natten_mla_macaron_encoder'


def _rms_norm(x, g):
    xf = x.astype(jnp.float32)
    y = xf * lax.rsqrt(jnp.mean(xf * xf, axis=-1, keepdims=True) + NORM_EPS)
    return (y * g.astype(jnp.float32)).astype(x.dtype)


def _swiglu(x, w_gu, w_down):
    g, u = jnp.split(x @ w_gu, 2, axis=-1)
    return (jax.nn.silu(g) * u) @ w_down


def _rope(x, pos):
    half = x.shape[-1] // 2
    inv_freq = ROPE_THETA ** (-jnp.arange(half, dtype=jnp.float32) / half)
    ang = pos.astype(jnp.float32)[:, None] * inv_freq[None, :]
    cos = jnp.cos(ang)[:, None, :]
    sin = jnp.sin(ang)[:, None, :]
    xf = x.astype(jnp.float32)
    x1, x2 = xf[..., :half], xf[..., half:]
    return jnp.concatenate([x1 * cos - x2 * sin, x2 * cos + x1 * sin], axis=-1).astype(x.dtype)


def _gla_chunk_scan(q, k, v, logf):
    H, T, dk = q.shape
    dv = v.shape[-1]
    n = T // HG_CHUNK
    q = q.reshape(H, n, HG_CHUNK, dk)
    k = k.reshape(H, n, HG_CHUNK, dk)
    v = v.reshape(H, n, HG_CHUNK, dv)
    b = jnp.cumsum(logf.reshape(H, n, HG_CHUNK, dk), axis=2)
    tri = np.tril(np.ones((HG_CHUNK, HG_CHUNK), dtype=bool))[:, :, None]
    diff = b[:, :, :, None, :] - b[:, :, None, :, :]
    decay = jnp.where(tri, jnp.exp(jnp.where(tri, diff, 0.0)), 0.0)
    attn = jnp.einsum('hntd,hntsd,hnsd->hnts', q, decay, k)
    o_intra = jnp.einsum('hnts,hnsv->hntv', attn, v)
    b_last = b[:, :, -1, :]
    q_inter = q * jnp.exp(b)
    k_inter = k * jnp.exp(b_last[:, :, None, :] - b)
    chunk_kv = jnp.einsum('hncd,hncv->hndv', k_inter, v)

    def step(state, inp):
        q_c, dl, kv_c = inp
        o_c = jnp.einsum('hcd,hdv->hcv', q_c, state)
        state = jnp.exp(dl)[..., None] * state + kv_c
        return state, o_c

    s0 = jnp.zeros((H, dk, dv), q.dtype)
    _, o_inter = lax.scan(step, s0, (q_inter.transpose(1, 0, 2, 3), b_last.transpose(1, 0, 2), chunk_kv.transpose(1, 0, 2, 3)))
    o = o_intra + o_inter.transpose(1, 0, 2, 3)
    return o.reshape(H, T, dv)


def _hgrn2_mixer(h, w_in, g_norm, w_out, lb):
    B, T, _ = h.shape
    q, zf, zb, i, g = jnp.split(h @ w_in, 5, axis=-1)

    def to_heads(t, d):
        return t.reshape(B, T, HG_HEADS, d).transpose(0, 2, 1, 3).astype(jnp.float32)

    lbh = lb.astype(jnp.float32).reshape(HG_HEADS, 1, HG_DK)
    log_lb = jnp.log(lbh)
    log_1m_lb = jnp.log1p(-lbh)

    def forget(z):
        logf = jnp.logaddexp(log_lb, log_1m_lb + jax.nn.log_sigmoid(to_heads(z, HG_DK)))
        return 1.0 - jnp.exp(logf), logf

    k_f, logf_f = forget(zf)
    k_b, logf_b = forget(zb)
    qh = to_heads(q, HG_DK) * (HG_DK ** -0.5)
    vh = to_heads(i, HG_DV)

    def per_seq(a):
        q_s, kf_s, lf_s, kb_s, lbw_s, v_s = a
        fwd = _gla_chunk_scan(q_s, kf_s, v_s, lf_s)
        bwd = _gla_chunk_scan(q_s[:, ::-1], kb_s[:, ::-1], v_s[:, ::-1], lbw_s[:, ::-1])[:, ::-1]
        return fwd + bwd

    o = lax.map(per_seq, (qh, k_f, logf_f, k_b, logf_b, vh))
    o = o.transpose(0, 2, 1, 3)
    gh = g.reshape(B, T, HG_HEADS, HG_DV).astype(jnp.float32)
    o = _rms_norm(o, g_norm) * jax.nn.silu(gh)
    return o.reshape(B, T, D_MODEL).astype(h.dtype) @ w_out


def _na_mixer(h, w_in, q_norm, k_norm, rpb, w_out):
    B, T, _ = h.shape
    rows = T // GRID_W
    win_r = min(NA_WIN_R, rows)
    q, k, v = jnp.split(h @ w_in, 3, axis=-1)
    shp = (B, rows, GRID_W, NA_HEADS, NA_HEAD_DIM)
    q = _rms_norm(q.reshape(shp), q_norm)
    k = _rms_norm(k.reshape(shp), k_norm)
    v = v.reshape(shp)
    cols = np.arange(GRID_W)
    col_start = np.clip(cols - NA_WIN_C // 2, 0, GRID_W - NA_WIN_C)
    col_mask = (cols[None, :] >= col_start[:, None]) & (cols[None, :] < col_start[:, None] + NA_WIN_C)
    col_off = np.clip(cols[None, :] - cols[:, None] + NA_WIN_C - 1, 0, 2 * NA_WIN_C - 2)
    rpb_cols = rpb.astype(jnp.float32)[:, :, col_off]
    scale = NA_HEAD_DIM ** -0.5

    def attend_row(r):
        r0 = jnp.clip(r - win_r // 2, 0, rows - win_r)
        q_r = lax.dynamic_index_in_dim(q, r, axis=1, keepdims=False)
        k_blk = lax.dynamic_slice_in_dim(k, r0, win_r, axis=1)
        v_blk = lax.dynamic_slice_in_dim(v, r0, win_r, axis=1)
        s = jnp.einsum('bqhd,brkhd->bhqrk', q_r, k_blk).astype(jnp.float32) * scale
        row_off = r0 + jnp.arange(win_r) - r + NA_WIN_R - 1
        bias = jnp.take(rpb_cols, row_off, axis=1).transpose(0, 2, 1, 3)
        s = jnp.where(col_mask[:, None, :], s + bias, NEG_INF)
        p = jax.nn.softmax(s.reshape(B, NA_HEADS, GRID_W, win_r * GRID_W), axis=-1)
        p = p.reshape(B, NA_HEADS, GRID_W, win_r, GRID_W).astype(v.dtype)
        return jnp.einsum('bhqrk,brkhd->bqhd', p, v_blk)

    o = lax.map(attend_row, jnp.arange(rows))
    o = o.transpose(1, 0, 2, 3, 4).reshape(B, T, D_MODEL)
    return o @ w_out


def _dense_attention_blocks(q, k, v):
    B, T, H, dqk = q.shape
    n_blk = T // Q_BLOCK
    scale = dqk ** -0.5
    q_blocks = q.reshape(B, n_blk, Q_BLOCK, H, dqk).transpose(1, 0, 2, 3, 4)

    def attend(q_b):
        s = jnp.einsum('bqhd,bkhd->bhqk', q_b, k).astype(jnp.float32) * scale
        p = jax.nn.softmax(s, axis=-1).astype(v.dtype)
        return jnp.einsum('bhqk,bkhd->bqhd', p, v)

    o = lax.map(attend, q_blocks)
    return o.transpose(1, 0, 2, 3, 4).reshape(B, T, H * v.shape[-1])


def _mla_mixer(h, w_in, q_a_norm, w_uq, kv_a_norm, w_ukv, q_norm, k_norm, w_out):
    B, T, _ = h.shape
    c = h @ w_in
    c_q = c[..., :MLA_Q_LORA]
    c_kv = c[..., MLA_Q_LORA:MLA_Q_LORA + MLA_KV_LORA]
    k_rope = c[..., MLA_Q_LORA + MLA_KV_LORA:]
    q = (_rms_norm(c_q, q_a_norm) @ w_uq).reshape(B, T, MLA_HEADS, MLA_NOPE + MLA_ROPE)
    kv = (_rms_norm(c_kv, kv_a_norm) @ w_ukv).reshape(B, T, MLA_HEADS, MLA_NOPE + MLA_V)
    k_rope = jnp.broadcast_to(k_rope[:, :, None, :], (B, T, MLA_HEADS, MLA_ROPE))
    k = jnp.concatenate([kv[..., :MLA_NOPE], k_rope], axis=-1)
    v = kv[..., MLA_NOPE:]
    q = _rms_norm(q, q_norm)
    k = _rms_norm(k, k_norm)
    pos = jnp.arange(T)
    q = jnp.concatenate([q[..., :MLA_NOPE], _rope(q[..., MLA_NOPE:], pos)], axis=-1)
    k = jnp.concatenate([k[..., :MLA_NOPE], _rope(k[..., MLA_NOPE:], pos)], axis=-1)
    return _dense_attention_blocks(q, k, v) @ w_out


def setup_inputs(seed: int = 0) -> dict:
    key = jax.random.key(seed)
    ks = iter(jax.random.split(key, 32))

    def nrm(shape, scale):
        return jax.random.normal(next(ks), shape, jnp.float32) * scale

    def gain(shape):
        return 1.0 + nrm(shape, 0.02)

    D = D_MODEL
    qk_dim = MLA_NOPE + MLA_ROPE
    return {
        'x': nrm((BATCH, SEQ, D), 1.0),
        'ffn1_norm': gain((DEPTH, D)),
        'ffn1_w_gu': nrm((DEPTH, D, 2 * D_FF), D ** -0.5),
        'ffn1_w_down': nrm((DEPTH, D_FF, D), D_FF ** -0.5),
        'mix_norm': gain((DEPTH, D)),
        'ffn2_norm': gain((DEPTH, D)),
        'ffn2_w_gu': nrm((DEPTH, D, 2 * D_FF), D ** -0.5),
        'ffn2_w_down': nrm((DEPTH, D_FF, D), D_FF ** -0.5),
        'hg_lb_logits': nrm((DEPTH, HG_HEADS * HG_DK), 0.5),
        'hg_w_in': nrm((N_A, D, 5 * D), D ** -0.5),
        'hg_g_norm': gain((N_A, HG_DV)),
        'hg_w_out': nrm((N_A, D, D), D ** -0.5),
        'na_w_in': nrm((N_B, D, 3 * D), D ** -0.5),
        'na_q_norm': gain((N_B, NA_HEAD_DIM)),
        'na_k_norm': gain((N_B, NA_HEAD_DIM)),
        'na_rpb': nrm((N_B, NA_HEADS, 2 * NA_WIN_R - 1, 2 * NA_WIN_C - 1), 0.2),
        'na_w_out': nrm((N_B, D, D), D ** -0.5),
        'mla_w_in': nrm((N_C, D, MLA_Q_LORA + MLA_KV_LORA + MLA_ROPE), D ** -0.5),
        'mla_q_a_norm': gain((N_C, MLA_Q_LORA)),
        'mla_w_uq': nrm((N_C, MLA_Q_LORA, MLA_HEADS * qk_dim), MLA_Q_LORA ** -0.5),
        'mla_kv_a_norm': gain((N_C, MLA_KV_LORA)),
        'mla_w_ukv': nrm((N_C, MLA_KV_LORA, MLA_HEADS * (MLA_NOPE + MLA_V)), MLA_KV_LORA ** -0.5),
        'mla_q_norm': gain((N_C, qk_dim)),
        'mla_k_norm': gain((N_C, qk_dim)),
        'mla_w_out': nrm((N_C, MLA_HEADS * MLA_V, D), (MLA_HEADS * MLA_V) ** -0.5),
    }


def reference(x, ffn1_norm, ffn1_w_gu, ffn1_w_down, mix_norm, ffn2_norm, ffn2_w_gu, ffn2_w_down,
              hg_lb_logits, hg_w_in, hg_g_norm, hg_w_out,
              na_w_in, na_q_norm, na_k_norm, na_rpb, na_w_out,
              mla_w_in, mla_q_a_norm, mla_w_uq, mla_kv_a_norm, mla_w_ukv, mla_q_norm, mla_k_norm, mla_w_out):
    gam = jnp.cumsum(jax.nn.softmax(hg_lb_logits.astype(jnp.float32), axis=0), axis=0)
    lb_all = gam - gam[0:1]
    ia = ib = ic = 0
    for layer in range(DEPTH):
        x = x + 0.5 * _swiglu(_rms_norm(x, ffn1_norm[layer]), ffn1_w_gu[layer], ffn1_w_down[layer])
        h = _rms_norm(x, mix_norm[layer])
        kind = layer % N_MIXERS
        if kind == 0:
            y = _hgrn2_mixer(h, hg_w_in[ia], hg_g_norm[ia], hg_w_out[ia], lb_all[layer])
            ia += 1
        elif kind == 1:
            y = _na_mixer(h, na_w_in[ib], na_q_norm[ib], na_k_norm[ib], na_rpb[ib], na_w_out[ib])
            ib += 1
        else:
            y = _mla_mixer(h, mla_w_in[ic], mla_q_a_norm[ic], mla_w_uq[ic], mla_kv_a_norm[ic], mla_w_ukv[ic],
                           mla_q_norm[ic], mla_k_norm[ic], mla_w_out[ic])
            ic += 1
        x = x + y
        x = x + 0.5 * _swiglu(_rms_norm(x, ffn2_norm[layer]), ffn2_w_gu[layer], ffn2_w_down[layer])
    return x
```

```cpp
#include <hip/hip_runtime.h>
#include <hip/hip_cooperative_groups.h>
#include <cstdio>
#include <cstdint>
namespace cg = cooperative_groups;

#ifndef MULTI_LAUNCH
#define MULTI_LAUNCH 0
#endif

typedef unsigned short u16;
typedef unsigned int u32;
using bf16x8 = __attribute__((ext_vector_type(8))) short;
using bf16x4 = __attribute__((ext_vector_type(4))) short;
using f32x4 = __attribute__((ext_vector_type(4))) float;
using u32x2 = __attribute__((ext_vector_type(2))) unsigned int;
using u32x4 = __attribute__((ext_vector_type(4))) unsigned int;

#define DI __device__ __forceinline__
#define MFMA32(a, b, c) __builtin_amdgcn_mfma_f32_16x16x32_bf16((a), (b), (c), 0, 0, 0)

constexpr int MTOK = 32768;
constexpr float EPS = 1e-6f;
constexpr float LOG2E = 1.4426950408889634f;

constexpr size_t MiB = 1048576;
constexpr size_t OFF_WGU1 = 0;
constexpr size_t OFF_WDN1 = 11534336;
constexpr size_t OFF_WGU2 = 17301504;
constexpr size_t OFF_WDN2 = 28835840;
constexpr size_t OFF_WMIX = 34603008;
constexpr size_t OFF_TAB = 47185920;
constexpr size_t OFF_H = 46 * MiB;
constexpr size_t OFF_R = 110 * MiB;
constexpr size_t WS_NEED = 500 * MiB;

struct Params {
  const float* x; const float* ffn1_norm; const float* ffn1_w_gu; const float* ffn1_w_down;
  const float* mix_norm; const float* ffn2_norm; const float* ffn2_w_gu; const float* ffn2_w_down;
  const float* hg_lb_logits; const float* hg_w_in; const float* hg_g_norm; const float* hg_w_out;
  const float* na_w_in; const float* na_q_norm; const float* na_k_norm; const float* na_rpb; const float* na_w_out;
  const float* mla_w_in; const float* mla_q_a_norm; const float* mla_w_uq; const float* mla_kv_a_norm; const float* mla_w_ukv;
  const float* mla_q_norm; const float* mla_k_norm; const float* mla_w_out;
  float* X; char* ws; int lo; int hi;
};

DI u32 f2bf(float x) { u32 u = __float_as_uint(x); u += 0x7fffu + ((u >> 16) & 1u); return u >> 16; }
DI u32 pack2(float a, float b) { return f2bf(a) | (f2bf(b) << 16); }
DI float bflo(u32 w) { return __uint_as_float(w << 16); }
DI float bfhi(u32 w) { return __uint_as_float(w & 0xffff0000u); }
DI float bfget(const u32x4& v, int e) { u32 w = v[e >> 1]; return (e & 1) ? bfhi(w) : bflo(w); }
DI u32x2 pack4(const f32x4& v) { u32x2 r; r[0] = pack2(v[0], v[1]); r[1] = pack2(v[2], v[3]); return r; }
DI bf16x8 pack8(const f32x4& a, const f32x4& b) {
  u32x4 r; r[0] = pack2(a[0], a[1]); r[1] = pack2(a[2], a[3]); r[2] = pack2(b[0], b[1]); r[3] = pack2(b[2], b[3]);
  return __builtin_bit_cast(bf16x8, r);
}
DI bf16x8 cat4(const bf16x4& lo, const bf16x4& hi) { return __builtin_shufflevector(lo, hi, 0, 1, 2, 3, 4, 5, 6, 7); }
DI float wave_sum(float v) {
#pragma unroll
  for (int o = 32; o > 0; o >>= 1) v += __shfl_xor(v, o);
  return v;
}
DI float sigmoidf_(float z) { return 1.f / (1.f + __expf(-z)); }
DI float siluf_(float z) { return z / (1.f + __expf(-z)); }
DI int otid() { int t = threadIdx.x; asm volatile("" : "+v"(t)); return t; }
DI f32x4 zero4() { f32x4 z = {0.f, 0.f, 0.f, 0.f}; return z; }

DI void init_tables(const Params& p) {
  float* LB = (float*)(p.ws + OFF_TAB); float* RC = LB + 4096; float* RS = RC + 65536;
  const int gt = blockIdx.x * 256 + otid(), gs = gridDim.x * 256;
  for (int c = gt; c < 1024; c += gs) {
    float l0 = p.hg_lb_logits[c], l1 = p.hg_lb_logits[1024 + c], l2 = p.hg_lb_logits[2048 + c], l3 = p.hg_lb_logits[3072 + c];
    float mx = fmaxf(fmaxf(l0, l1), fmaxf(l2, l3));
    float e0 = expf(l0 - mx), e1 = expf(l1 - mx), e2 = expf(l2 - mx), e3 = expf(l3 - mx);
    float inv = 1.f / (e0 + e1 + e2 + e3);
    LB[c] = 0.f; LB[1024 + c] = e1 * inv; LB[2048 + c] = (e1 + e2) * inv; LB[3072 + c] = (e1 + e2 + e3) * inv;
  }
  for (int i = gt; i < 65536; i += gs) {
    int t = i >> 4, j = i & 15;
    float inv = exp2f(-(float)j * (13.287712379549449f / 16.f));
    float ang = (float)t * inv;
    double a = (double)ang;
    double k = rint(a * 0.15915494309189535);
    float r = (float)(a - k * 6.283185307179586);
    RC[i] = __cosf(r); RS[i] = __sinf(r);
  }
}

DI void cvt_tiles(const float* __restrict__ src, u16* __restrict__ dst, int K, int N, int Nd, int mode, char* smem) {
  float* tile = (float*)smem;
  const int tk = K >> 6, tn = Nd >> 6, tid = otid();
  for (int t = blockIdx.x; t < tk * tn; t += gridDim.x) {
    const int k0 = (t % tk) << 6, n0 = (t / tk) << 6;
    {
      const int nl = tid & 63, kq = tid >> 6;
      const int nd = n0 + nl;
      int col = nd;
      if (mode == 1) { int a = nd >> 5, r = nd & 31; col = a * 16 + (r & 15) + ((r >= 16) ? 2816 : 0); }
      const bool ok = col < N;
#pragma unroll
      for (int i = 0; i < 16; ++i) {
        int kl = kq + 4 * i;
        tile[kl * 65 + nl] = ok ? src[(size_t)(k0 + kl) * N + col] : 0.f;
      }
    }
    __syncthreads();
    {
      const int kp = (tid & 31) * 2, nq = tid >> 5;
#pragma unroll
      for (int i = 0; i < 8; ++i) {
        int n = nq + 8 * i;
        *(u32*)(dst + (size_t)(n0 + n) * K + k0 + kp) = pack2(tile[kp * 65 + n], tile[(kp + 1) * 65 + n]);
      }
    }
    __syncthreads();
  }
}

DI void cvt_layer(const Params& p, int layer, char* smem) {
  const int kind = layer % 3, mi = layer / 3;
  char* ws = p.ws;
  for (int task = 0; task < 8; ++task) {
    const float* src = nullptr; size_t off = 0; int K = 0, N = 0, Nd = 0, mode = 0;
    if (task == 0) { src = p.ffn1_w_gu + (size_t)layer * 1024 * 5632; off = OFF_WGU1; K = 1024; N = 5632; Nd = 5632; mode = 1; }
    else if (task == 1) { src = p.ffn1_w_down + (size_t)layer * 2816 * 1024; off = OFF_WDN1; K = 2816; N = 1024; Nd = 1024; }
    else if (task == 2) { src = p.ffn2_w_gu + (size_t)layer * 1024 * 5632; off = OFF_WGU2; K = 1024; N = 5632; Nd = 5632; mode = 1; }
    else if (task == 3) { src = p.ffn2_w_down + (size_t)layer * 2816 * 1024; off = OFF_WDN2; K = 2816; N = 1024; Nd = 1024; }
    else if (kind == 0) {
      if (task == 4) { src = p.hg_w_in + (size_t)mi * 1024 * 5120; off = OFF_WMIX; K = 1024; N = 5120; Nd = 5120; }
      else if (task == 5) { src = p.hg_w_out + (size_t)mi * 1024 * 1024; off = OFF_WMIX + 10485760; K = 1024; N = 1024; Nd = 1024; }
    } else if (kind == 1) {
      if (task == 4) { src = p.na_w_in + (size_t)mi * 1024 * 3072; off = OFF_WMIX; K = 1024; N = 3072; Nd = 3072; }
      else if (task == 5) { src = p.na_w_out + (size_t)mi * 1024 * 1024; off = OFF_WMIX + 6291456; K = 1024; N = 1024; Nd = 1024; }
    } else {
      if (task == 4) { src = p.mla_w_in + (size_t)mi * 1024 * 1056; off = OFF_WMIX; K = 1024; N = 1056; Nd = 1152; }
      else if (task == 5) { src = p.mla_w_uq + (size_t)mi * 768 * 1536; off = OFF_WMIX + 2359296; K = 768; N = 1536; Nd = 1536; }
      else if (task == 6) { src = p.mla_w_ukv + (size_t)mi * 256 * 2048; off = OFF_WMIX + 4718592; K = 256; N = 2048; Nd = 2048; }
      else if (task == 7) { src = p.mla_w_out + (size_t)mi * 1024 * 1024; off = OFF_WMIX + 5767168; K = 1024; N = 1024; Nd = 1024; }
    }
    if (src) cvt_tiles(src, (u16*)(ws + off), K, N, Nd, mode, smem);
  }
}

DI void norm_phase(const float* __restrict__ src, const float* __restrict__ gain, u16* __restrict__ dst, float* copy_dst, int rows) {
  const int lane = otid() & 63, wid = otid() >> 6;
  f32x4 g[4];
#pragma unroll
  for (int i = 0; i < 4; ++i) g[i] = *(const f32x4*)(gain + i * 256 + lane * 4);
  for (int row = blockIdx.x * 4 + wid; row < rows; row += gridDim.x * 4) {
    const float* s = src + (size_t)row * 1024;
    f32x4 v[4]; float ss = 0.f;
#pragma unroll
    for (int i = 0; i < 4; ++i) { v[i] = *(const f32x4*)(s + i * 256 + lane * 4); ss += v[i][0] * v[i][0] + v[i][1] * v[i][1] + v[i][2] * v[i][2] + v[i][3] * v[i][3]; }
    ss = wave_sum(ss);
    const float rstd = rsqrtf(ss * (1.f / 1024.f) + EPS);
#pragma unroll
    for (int i = 0; i < 4; ++i) {
      f32x4 y = v[i] * rstd * g[i];
      *(u32x2*)(dst + (size_t)row * 1024 + i * 256 + lane * 4) = pack4(y);
      if (copy_dst) *(f32x4*)(copy_dst + (size_t)row * 1024 + i * 256 + lane * 4) = v[i];
    }
  }
}

constexpr int LDS_ROW = 144;
constexpr int LDS_TILE = 128 * LDS_ROW;
constexpr int LDS_BUF = 2 * LDS_TILE;

template <class Epi>
DI void gemm_tile(const u16* __restrict__ A, int lda, const u16* __restrict__ W, int K, int m0, int n0, const Epi& epi, char* smem) {
  const int tid = otid(), lane = tid & 63, wid = tid >> 6;
  const int wm = wid >> 1, wn = wid & 1, fr = lane & 15, fq = lane >> 4;
  f32x4 acc[4][4];
#pragma unroll
  for (int i = 0; i < 4; ++i)
#pragma unroll
    for (int j = 0; j < 4; ++j) acc[i][j] = zero4();
  const int lrow = tid >> 3, lkc = tid & 7;
  const u16* ga = A + (size_t)lrow * lda + lkc * 8;
  const u16* gw = W + (size_t)lrow * K + lkc * 8;
  u32x4 ra[4], rw[4];
  const int soff = lrow * LDS_ROW + lkc * 16;
  const char* sa_rd = smem + (wm * 64 + fr) * LDS_ROW + fq * 16;
  const char* sw_rd = smem + LDS_TILE + (wn * 64 + fr) * LDS_ROW + fq * 16;
  const int nk = K >> 6;
#pragma unroll
  for (int i = 0; i < 4; ++i) { ra[i] = *(const u32x4*)(ga + (size_t)(32 * i) * lda); rw[i] = *(const u32x4*)(gw + (size_t)(32 * i) * K); }
#pragma unroll
  for (int i = 0; i < 4; ++i) { *(u32x4*)(smem + soff + i * 32 * LDS_ROW) = ra[i]; *(u32x4*)(smem + LDS_TILE + soff + i * 32 * LDS_ROW) = rw[i]; }
  __syncthreads();
  for (int t = 0; t < nk; ++t) {
    const int cur = (t & 1) * LDS_BUF, nxt = LDS_BUF - cur;
    if (t + 1 < nk) {
      const int k0 = (t + 1) << 6;
#pragma unroll
      for (int i = 0; i < 4; ++i) { ra[i] = *(const u32x4*)(ga + (size_t)(32 * i) * lda + k0); rw[i] = *(const u32x4*)(gw + (size_t)(32 * i) * K + k0); }
    }
#pragma unroll
    for (int ks = 0; ks < 2; ++ks) {
      bf16x8 af[4], wf[4];
#pragma unroll
      for (int i = 0; i < 4; ++i) {
        af[i] = *(const bf16x8*)(sa_rd + cur + i * 16 * LDS_ROW + ks * 64);
        wf[i] = *(const bf16x8*)(sw_rd + cur + i * 16 * LDS_ROW + ks * 64);
      }
#pragma unroll
      for (int nt = 0; nt < 4; ++nt)
#pragma unroll
        for (int mt = 0; mt < 4; ++mt) acc[nt][mt] = MFMA32(wf[nt], af[mt], acc[nt][mt]);
    }
    if (t + 1 < nk) {
#pragma unroll
      for (int i = 0; i < 4; ++i) { *(u32x4*)(smem + nxt + soff + i * 32 * LDS_ROW) = ra[i]; *(u32x4*)(smem + nxt + LDS_TILE + soff + i * 32 * LDS_ROW) = rw[i]; }
    }
    __syncthreads();
  }
  epi(acc, m0 + wm * 64, n0 + wn * 64, fr, fq);
}

template <class Epi>
DI void gemm_phase(const u16* A, int lda, const u16* W, int K, int Mrows, int Ncols, const Epi& epi, char* smem) {
  const int mtn = Mrows >> 7, ntn = Ncols >> 7;
  const int ntiles = mtn * ntn;
  constexpr int GM = 16;
  for (int tile = blockIdx.x; tile < ntiles; tile += gridDim.x) {
    const int group = tile / (GM * ntn), rem = tile % (GM * ntn);
    const int mt = group * GM + (rem % GM), nt = rem / GM;
    gemm_tile(A + (size_t)mt * 128 * lda, lda, W + (size_t)nt * 128 * K, K, mt * 128, nt * 128, epi, smem);
  }
}

struct EpiSwiglu {
  u16* act;
  DI void operator()(f32x4 (&acc)[4][4], int mb, int nb, int fr, int fq) const {
#pragma unroll
    for (int mt = 0; mt < 4; ++mt) {
      const int m = mb + mt * 16 + fr;
#pragma unroll
      for (int np = 0; np < 2; ++np) {
        const f32x4 g = acc[2 * np][mt], u = acc[2 * np + 1][mt];
        f32x4 r;
#pragma unroll
        for (int j = 0; j < 4; ++j) r[j] = siluf_(g[j]) * u[j];
        const int jc = (nb >> 1) + np * 16 + fq * 4;
        *(u32x2*)(act + (size_t)m * 2816 + jc) = pack4(r);
      }
    }
  }
};

struct EpiResid {
  float* X; float scale;
  DI void operator()(f32x4 (&acc)[4][4], int mb, int nb, int fr, int fq) const {
#pragma unroll
    for (int mt = 0; mt < 4; ++mt) {
      const int m = mb + mt * 16 + fr;
#pragma unroll
      for (int nt = 0; nt < 4; ++nt) {
        f32x4* ptr = (f32x4*)(X + (size_t)m * 1024 + nb + nt * 16 + fq * 4);
        f32x4 v = *ptr;
        v += acc[nt][mt] * scale;
        *ptr = v;
      }
    }
  }
};

struct EpiStore {
  u16* out; int ldo; int nmax;
  DI void operator()(f32x4 (&acc)[4][4], int mb, int nb, int fr, int fq) const {
#pragma unroll
    for (int mt = 0; mt < 4; ++mt) {
      const int m = mb + mt * 16 + fr;
#pragma unroll
      for (int nt = 0; nt < 4; ++nt) {
        const int n = nb + nt * 16 + fq * 4;
        if (n < nmax) *(u32x2*)(out + (size_t)m * ldo + n) = pack4(acc[nt][mt]);
      }
    }
  }
};

struct EpiHgIn {
  u16 *Q, *LFf, *LFb, *V, *G; const float* lb;
  DI void operator()(f32x4 (&acc)[4][4], int mb, int nb, int fr, int fq) const {
    const int seg = nb >> 10, c0 = nb & 1023;
    u16* dst = seg == 0 ? Q : seg == 1 ? LFf : seg == 2 ? LFb : seg == 3 ? V : G;
#pragma unroll
    for (int mt = 0; mt < 4; ++mt) {
      const int m = mb + mt * 16 + fr;
#pragma unroll
      for (int nt = 0; nt < 4; ++nt) {
        const int c = c0 + nt * 16 + fq * 4;
        f32x4 a = acc[nt][mt], r;
        if (seg == 0) r = a * 0.08838834764831845f;
        else if (seg == 3) r = a;
        else if (seg == 4) {
#pragma unroll
          for (int j = 0; j < 4; ++j) r[j] = siluf_(a[j]);
        } else {
          const f32x4 l4 = *(const f32x4*)(lb + c);
#pragma unroll
          for (int j = 0; j < 4; ++j) {
            float z = fminf(fmaxf(a[j], -30.f), 30.f);
            float f = l4[j] + (1.f - l4[j]) * sigmoidf_(z);
            r[j] = __logf(f);
          }
        }
        *(u32x2*)(dst + (size_t)m * 1024 + c) = pack4(r);
      }
    }
  }
};

struct EpiNaIn {
  u16 *Q, *K, *VT; const float *qn, *kn;
  DI void operator()(f32x4 (&acc)[4][4], int mb, int nb, int fr, int fq) const {
    const int seg = nb >> 10, h = (nb & 1023) >> 6;
    if (seg < 2) {
      u16* dst = seg == 0 ? Q : K;
      const float* gn = seg == 0 ? qn : kn;
      const float sc = seg == 0 ? 0.125f * LOG2E : 1.f;
#pragma unroll
      for (int mt = 0; mt < 4; ++mt) {
        const int m = mb + mt * 16 + fr;
        float ss = 0.f;
#pragma unroll
        for (int nt = 0; nt < 4; ++nt)
#pragma unroll
          for (int j = 0; j < 4; ++j) ss += acc[nt][mt][j] * acc[nt][mt][j];
        ss += __shfl_xor(ss, 16); ss += __shfl_xor(ss, 32);
        const float rstd = rsqrtf(ss * (1.f / 64.f) + EPS) * sc;
#pragma unroll
        for (int nt = 0; nt < 4; ++nt) {
          const int d = nt * 16 + fq * 4;
          const f32x4 g4 = *(const f32x4*)(gn + d);
          f32x4 r = acc[nt][mt] * rstd * g4;
          *(u32x2*)(dst + (size_t)m * 1024 + h * 64 + d) = pack4(r);
        }
      }
    } else {
#pragma unroll
      for (int mt = 0; mt < 4; ++mt) {
        const int m = mb + mt * 16 + fr;
        const int b = m >> 12, t = m & 4095;
#pragma unroll
        for (int nt = 0; nt < 4; ++nt)
#pragma unroll
          for (int j = 0; j < 4; ++j) {
            const int d = nt * 16 + fq * 4 + j;
            VT[((size_t)((b * 16 + h) * 64 + d)) * 4096 + t] = (u16)f2bf(acc[nt][mt][j]);
          }
      }
    }
  }
};

struct HgBufs {
  u16 *Q, *LFf, *LFb, *V, *G, *QIf, *QIb, *KITf, *KITb, *VTc, *OI, *OF, *OB, *Y;
  float *DECf, *DECb;
};

DI void hg_prep_item(const HgBufs& hb, int item, char* smem) {
  const int h = item & 7, n = (item >> 3) & 255, b = item >> 11;
  float* sq = (float*)smem; float* sbf = sq + 2112; float* sbb = sbf + 2112; float* skf = sbb + 2112;
  float* skb = skf + 2112; float* sv = skb + 2112; float* sA = sv + 2112;
  const int tid = otid();
  const int row = tid >> 4, c8 = (tid & 15) * 8;
  const size_t tok0 = (size_t)b * 4096 + n * 16;
  const size_t gidx = (tok0 + row) * 1024 + h * 128 + c8;
  {
    const u32x4 rq = *(const u32x4*)(hb.Q + gidx), rf = *(const u32x4*)(hb.LFf + gidx);
    const u32x4 rb = *(const u32x4*)(hb.LFb + gidx), rv = *(const u32x4*)(hb.V + gidx);
#pragma unroll
    for (int e = 0; e < 8; ++e) {
      const int o = row * 132 + c8 + e;
      const float lf = bfget(rf, e), lb_ = bfget(rb, e);
      sq[o] = bfget(rq, e); sbf[o] = lf; sbb[o] = lb_;
      skf[o] = 1.f - __expf(lf); skb[o] = 1.f - __expf(lb_); sv[o] = bfget(rv, e);
    }
  }
  __syncthreads();
  if (tid < 128) {
    const int d = tid; float a = 0.f;
#pragma unroll
    for (int t = 0; t < 16; ++t) { a += sbf[t * 132 + d]; sbf[t * 132 + d] = a; }
    hb.DECf[((size_t)b * 256 + n) * 1024 + h * 128 + d] = __expf(a);
  } else {
    const int d = tid - 128; float a = 0.f;
#pragma unroll
    for (int t = 15; t >= 0; --t) { a += sbb[t * 132 + d]; sbb[t * 132 + d] = a; }
    hb.DECb[((size_t)b * 256 + n) * 1024 + h * 128 + d] = __expf(a);
  }
  __syncthreads();
  {
    u32x4 of, ob;
#pragma unroll
    for (int e2 = 0; e2 < 4; ++e2) {
      const int o = row * 132 + c8 + 2 * e2;
      const float q0 = sq[o], q1 = sq[o + 1];
      of[e2] = pack2(q0 * __expf(sbf[o]), q1 * __expf(sbf[o + 1]));
      ob[e2] = pack2(q0 * __expf(sbb[o]), q1 * __expf(sbb[o + 1]));
    }
    *(u32x4*)(hb.QIf + gidx) = of; *(u32x4*)(hb.QIb + gidx) = ob;
  }
  {
    const int d = tid >> 1, t8 = (tid & 1) * 8;
    const float blf = sbf[15 * 132 + d], blb = sbb[d];
    u32x4 kf, kb, vv;
#pragma unroll
    for (int e2 = 0; e2 < 4; ++e2) {
      const int o0 = (t8 + 2 * e2) * 132 + d, o1 = o0 + 132;
      kf[e2] = pack2(skf[o0] * __expf(blf - sbf[o0]), skf[o1] * __expf(blf - sbf[o1]));
      kb[e2] = pack2(skb[o0] * __expf(blb - sbb[o0]), skb[o1] * __expf(blb - sbb[o1]));
      vv[e2] = pack2(sv[o0], sv[o1]);
    }
    const size_t cidx = (((size_t)(b * 8 + h) * 256 + n) * 128 + d) * 16 + t8;
    *(u32x4*)(hb.KITf + cidx) = kf; *(u32x4*)(hb.KITb + cidx) = kb; *(u32x4*)(hb.VTc + cidx) = vv;
  }
  {
    const int t = tid >> 4, s = tid & 15;
    if (s <= t) {
      float af = 0.f, ab = 0.f;
      for (int d4 = 0; d4 < 32; ++d4) {
        const f32x4 qt = *(const f32x4*)(sq + t * 132 + d4 * 4), qs = *(const f32x4*)(sq + s * 132 + d4 * 4);
        const f32x4 kfs = *(const f32x4*)(skf + s * 132 + d4 * 4), kbt = *(const f32x4*)(skb + t * 132 + d4 * 4);
        const f32x4 bft = *(const f32x4*)(sbf + t * 132 + d4 * 4), bfs = *(const f32x4*)(sbf + s * 132 + d4 * 4);
        const f32x4 bbs = *(const f32x4*)(sbb + s * 132 + d4 * 4), bbt = *(const f32x4*)(sbb + t * 132 + d4 * 4);
#pragma unroll
        for (int c = 0; c < 4; ++c) {
          af += qt[c] * kfs[c] * __expf(bft[c] - bfs[c]);
          ab += qs[c] * kbt[c] * __expf(bbs[c] - bbt[c]);
        }
      }
      if (s == t) sA[t * 17 + t] = af + ab;
      else { sA[t * 17 + s] = af; sA[s * 17 + t] = ab; }
    }
  }
  __syncthreads();
  {
    float o[8];
#pragma unroll
    for (int e = 0; e < 8; ++e) o[e] = 0.f;
#pragma unroll
    for (int s = 0; s < 16; ++s) {
      const float a = sA[row * 17 + s];
      const f32x4 v0 = *(const f32x4*)(sv + s * 132 + c8), v1 = *(const f32x4*)(sv + s * 132 + c8 + 4);
#pragma unroll
      for (int e = 0; e < 4; ++e) { o[e] += a * v0[e]; o[4 + e] += a * v1[e]; }
    }
    u32x4 r; r[0] = pack2(o[0], o[1]); r[1] = pack2(o[2], o[3]); r[2] = pack2(o[4], o[5]); r[3] = pack2(o[6], o[7]);
    *(u32x4*)(hb.OI + gidx) = r;
  }
  __syncthreads();
}

struct ScanOps { bf16x8 qa[4]; bf16x8 ka[8]; bf16x8 vb; f32x4 dc[8]; };

DI void scan_load(ScanOps& s, const u16* QI, const u16* KIT, const u16* VTc, const float* DEC, int b, int h, int vs, int n, int fr, int fq) {
  const size_t tok0 = (size_t)b * 4096 + n * 16;
  const u16* qp = QI + (tok0 + fr) * 1024 + h * 128 + fq * 4;
#pragma unroll
  for (int ks = 0; ks < 4; ++ks) s.qa[ks] = cat4(*(const bf16x4*)(qp + ks * 32), *(const bf16x4*)(qp + ks * 32 + 16));
  const size_t cb = ((size_t)(b * 8 + h) * 256 + n) * 2048;
  const int fo = (fq & 1) * 8;
#pragma unroll
  for (int dt = 0; dt < 8; ++dt) s.ka[dt] = *(const bf16x8*)(KIT + cb + (dt * 16 + fr) * 16 + fo);
  s.vb = *(const bf16x8*)(VTc + cb + (vs * 16 + fr) * 16 + fo);
  if (fq >= 2) {
    const bf16x8 z = {0, 0, 0, 0, 0, 0, 0, 0};
#pragma unroll
    for (int dt = 0; dt < 8; ++dt) s.ka[dt] = z;
    s.vb = z;
  }
  const float* dp = DEC + ((size_t)b * 256 + n) * 1024 + h * 128 + fq * 4;
#pragma unroll
  for (int dt = 0; dt < 8; ++dt) s.dc[dt] = *(const f32x4*)(dp + dt * 16);
}

DI void scan_step(f32x4 (&S)[8], const ScanOps& s, u16* Oout, int b, int h, int vs, int n, int fr, int fq) {
  f32x4 o = zero4();
#pragma unroll
  for (int ks = 0; ks < 4; ++ks) o = MFMA32(s.qa[ks], pack8(S[2 * ks], S[2 * ks + 1]), o);
  const size_t tok0 = (size_t)b * 4096 + n * 16;
#pragma unroll
  for (int j = 0; j < 4; ++j) Oout[(tok0 + fq * 4 + j) * 1024 + h * 128 + vs * 16 + fr] = (u16)f2bf(o[j]);
#pragma unroll
  for (int dt = 0; dt < 8; ++dt) { S[dt] = S[dt] * s.dc[dt]; S[dt] = MFMA32(s.ka[dt], s.vb, S[dt]); }
}

DI void hg_scan_phase(const HgBufs& hb) {
  const int lane = otid() & 63, wid = otid() >> 6, fr = lane & 15, fq = lane >> 4;
  for (int item = blockIdx.x * 4 + wid; item < 512; item += gridDim.x * 4) {
    const int vs = item & 7, dir = (item >> 3) & 1, h = (item >> 4) & 7, b = item >> 7;
    const u16* QI = dir ? hb.QIb : hb.QIf; const u16* KIT = dir ? hb.KITb : hb.KITf;
    const float* DEC = dir ? hb.DECb : hb.DECf; u16* Oout = dir ? hb.OB : hb.OF;
    f32x4 S[8];
#pragma unroll
    for (int i = 0; i < 8; ++i) S[i] = zero4();
    ScanOps s0, s1;
    scan_load(s0, QI, KIT, hb.VTc, DEC, b, h, vs, dir ? 255 : 0, fr, fq);
    for (int step = 0; step < 256; step += 2) {
      const int n0 = dir ? 255 - step : step, n1 = dir ? n0 - 1 : n0 + 1;
      scan_load(s1, QI, KIT, hb.VTc, DEC, b, h, vs, n1, fr, fq);
      scan_step(S, s0, Oout, b, h, vs, n0, fr, fq);
      if (step + 2 < 256) scan_load(s0, QI, KIT, hb.VTc, DEC, b, h, vs, dir ? n1 - 1 : n1 + 1, fr, fq);
      scan_step(S, s1, Oout, b, h, vs, n1, fr, fq);
    }
  }
}

DI void hg_combine_phase(const HgBufs& hb, const float* __restrict__ gnorm, int rows) {
  const int lane = otid() & 63, wid = otid() >> 6;
  const int h = lane >> 3, c16 = (lane & 7) * 16;
  for (int row = blockIdx.x * 4 + wid; row < rows; row += gridDim.x * 4) {
    const size_t g = (size_t)row * 1024 + h * 128 + c16;
    float o[16]; float ss = 0.f;
#pragma unroll
    for (int half = 0; half < 2; ++half) {
      const u32x4 a = *(const u32x4*)(hb.OI + g + half * 8), f = *(const u32x4*)(hb.OF + g + half * 8), bb = *(const u32x4*)(hb.OB + g + half * 8);
#pragma unroll
      for (int e = 0; e < 8; ++e) { float v = bfget(a, e) + bfget(f, e) + bfget(bb, e); o[half * 8 + e] = v; ss += v * v; }
    }
    ss += __shfl_xor(ss, 1); ss += __shfl_xor(ss, 2); ss += __shfl_xor(ss, 4);
    const float rstd = rsqrtf(ss * (1.f / 128.f) + EPS);
#pragma unroll
    for (int half = 0; half < 2; ++half) {
      const u32x4 gs = *(const u32x4*)(hb.G + g + half * 8);
      u32x4 r;
#pragma unroll
      for (int e2 = 0; e2 < 4; ++e2) {
        const int e = half * 8 + 2 * e2;
        r[e2] = pack2(o[e] * rstd * gnorm[c16 + e] * bfget(gs, 2 * e2), o[e + 1] * rstd * gnorm[c16 + e + 1] * bfget(gs, 2 * e2 + 1));
      }
      *(u32x4*)(hb.Y + g + half * 8) = r;
    }
  }
}

DI void na_attn_item(const u16* __restrict__ Q, const u16* __restrict__ K, const u16* __restrict__ VT, const float* __restrict__ rpb, u16* __restrict__ O, int item, int fr, int fq) {
  const int h = item & 15, qt = (item >> 4) & 3, r = (item >> 6) & 63, b = item >> 12;
  const int r0 = min(max(r - 4, 0), 56);
  const int cw0 = qt == 0 ? 0 : qt == 1 ? 8 : qt == 2 ? 24 : 32;
  const size_t tokq = (size_t)b * 4096 + r * 64 + qt * 16 + fr;
  bf16x8 qf[2];
#pragma unroll
  for (int ks = 0; ks < 2; ++ks) qf[ks] = *(const bf16x8*)(Q + tokq * 1024 + h * 64 + ks * 32 + fq * 8);
  f32x4 s[8][2];
#pragma unroll
  for (int kr = 0; kr < 8; ++kr)
#pragma unroll
    for (int hf = 0; hf < 2; ++hf) {
      const size_t tokk = (size_t)b * 4096 + (r0 + kr) * 64 + cw0 + hf * 16 + fr;
      const bf16x8 k0 = *(const bf16x8*)(K + tokk * 1024 + h * 64 + fq * 8);
      const bf16x8 k1 = *(const bf16x8*)(K + tokk * 1024 + h * 64 + 32 + fq * 8);
      f32x4 a = MFMA32(k0, qf[0], zero4());
      s[kr][hf] = MFMA32(k1, qf[1], a);
    }
  const int qc = qt * 16 + fr;
  const int cs = min(max(qc - 8, 0), 48);
  float mx = -1e30f;
#pragma unroll
  for (int kr = 0; kr < 8; ++kr) {
    const float* rp = rpb + (h * 15 + (r0 + kr - r + 7)) * 31;
#pragma unroll
    for (int hf = 0; hf < 2; ++hf)
#pragma unroll
      for (int j = 0; j < 4; ++j) {
        const int kc = cw0 + hf * 16 + fq * 4 + j;
        const bool valid = (kc >= cs) && (kc < cs + 16);
        const int ci = min(max(kc - qc + 15, 0), 30);
        const float v = valid ? s[kr][hf][j] + rp[ci] * LOG2E : -1e30f;
        s[kr][hf][j] = v; mx = fmaxf(mx, v);
      }
  }
  mx = fmaxf(mx, __shfl_xor(mx, 16)); mx = fmaxf(mx, __shfl_xor(mx, 32));
  float l = 0.f;
#pragma unroll
  for (int kr = 0; kr < 8; ++kr)
#pragma unroll
    for (int hf = 0; hf < 2; ++hf)
#pragma unroll
      for (int j = 0; j < 4; ++j) { const float pv = exp2f(s[kr][hf][j] - mx); s[kr][hf][j] = pv; l += pv; }
  l += __shfl_xor(l, 16); l += __shfl_xor(l, 32);
  f32x4 o[4];
#pragma unroll
  for (int dt = 0; dt < 4; ++dt) o[dt] = zero4();
#pragma unroll
  for (int kr = 0; kr < 8; ++kr) {
    const bf16x8 pp = pack8(s[kr][0], s[kr][1]);
#pragma unroll
    for (int dt = 0; dt < 4; ++dt) {
      const u16* vp = VT + ((size_t)((b * 16 + h) * 64 + dt * 16 + fr)) * 4096 + (r0 + kr) * 64 + cw0 + fq * 4;
      const bf16x8 vf = cat4(*(const bf16x4*)vp, *(const bf16x4*)(vp + 16));
      o[dt] = MFMA32(vf, pp, o[dt]);
    }
  }
  const float inv = 1.f / l;
#pragma unroll
  for (int dt = 0; dt < 4; ++dt) *(u32x2*)(O + tokq * 1024 + h * 64 + dt * 16 + fq * 4) = pack4(o[dt] * inv);
}

DI void mla_norm_phase(const u16* __restrict__ CRAW, const float* __restrict__ gq, const float* __restrict__ gkv, u16* __restrict__ CQN, u16* __restrict__ CKVN, float* __restrict__ KROPE) {
  const int lane = otid() & 63, wid = otid() >> 6;
  for (int row = blockIdx.x * 4 + wid; row < MTOK; row += gridDim.x * 4) {
    const u16* c = CRAW + (size_t)row * 1056;
    f32x4 v[3]; float ss = 0.f;
#pragma unroll
    for (int i = 0; i < 3; ++i) {
      const u32x2 w = *(const u32x2*)(c + i * 256 + lane * 4);
      v[i][0] = bflo(w[0]); v[i][1] = bfhi(w[0]); v[i][2] = bflo(w[1]); v[i][3] = bfhi(w[1]);
      ss += v[i][0] * v[i][0] + v[i][1] * v[i][1] + v[i][2] * v[i][2] + v[i][3] * v[i][3];
    }
    ss = wave_sum(ss);
    const float rq = rsqrtf(ss * (1.f / 768.f) + EPS);
#pragma unroll
    for (int i = 0; i < 3; ++i) {
      const f32x4 g4 = *(const f32x4*)(gq + i * 256 + lane * 4);
      *(u32x2*)(CQN + (size_t)row * 768 + i * 256 + lane * 4) = pack4(v[i] * rq * g4);
    }
    {
      const u32x2 w = *(const u32x2*)(c + 768 + lane * 4);
      f32x4 k; k[0] = bflo(w[0]); k[1] = bfhi(w[0]); k[2] = bflo(w[1]); k[3] = bfhi(w[1]);
      float s2 = wave_sum(k[0] * k[0] + k[1] * k[1] + k[2] * k[2] + k[3] * k[3]);
      const float rk = rsqrtf(s2 * (1.f / 256.f) + EPS);
      const f32x4 g4 = *(const f32x4*)(gkv + lane * 4);
      *(u32x2*)(CKVN + (size_t)row * 256 + lane * 4) = pack4(k * rk * g4);
    }
    if (lane < 8) {
      const u32x2 w = *(const u32x2*)(c + 1024 + lane * 4);
      f32x4 k; k[0] = bflo(w[0]); k[1] = bfhi(w[0]); k[2] = bflo(w[1]); k[3] = bfhi(w[1]);
      *(f32x4*)(KROPE + (size_t)row * 32 + lane * 4) = k;
    }
  }
}

DI void mla_prep_phase(u16* __restrict__ Q, const u16* __restrict__ KVRAW, const float* __restrict__ KROPE, u16* __restrict__ Kout,
                       const float* __restrict__ gq, const float* __restrict__ gk, const float* __restrict__ RC, const float* __restrict__ RS) {
  const int lane = otid() & 63, wid = otid() >> 6;
  const int h = lane >> 2, sub = lane & 3;
  const float QS = 0.10206207261596577f * LOG2E;
  for (int m = blockIdx.x * 4 + wid; m < MTOK; m += gridDim.x * 4) {
    const int t = m & 4095;
    const f32x4 cs = *(const f32x4*)(RC + t * 16 + sub * 4), sn = *(const f32x4*)(RS + t * 16 + sub * 4);
#pragma unroll
    for (int which = 0; which < 2; ++which) {
      float nope[16]; f32x4 ra, rb;
      u16* dstp = (which == 0 ? Q : Kout) + (size_t)m * 1536 + h * 96;
      const float* gn = which == 0 ? gq : gk;
      if (which == 0) {
        const u32x4 w0 = *(const u32x4*)(dstp + sub * 16), w1 = *(const u32x4*)(dstp + sub * 16 + 8);
#pragma unroll
        for (int e = 0; e < 8; ++e) { nope[e] = bfget(w0, e); nope[8 + e] = bfget(w1, e); }
        const u32x2 a2 = *(const u32x2*)(dstp + 64 + sub * 4), b2 = *(const u32x2*)(dstp + 80 + sub * 4);
        ra[0] = bflo(a2[0]); ra[1] = bfhi(a2[0]); ra[2] = bflo(a2[1]); ra[3] = bfhi(a2[1]);
        rb[0] = bflo(b2[0]); rb[1] = bfhi(b2[0]); rb[2] = bflo(b2[1]); rb[3] = bfhi(b2[1]);
      } else {
        const u16* kp = KVRAW + (size_t)m * 2048 + h * 128 + sub * 16;
        const u32x4 w0 = *(const u32x4*)kp, w1 = *(const u32x4*)(kp + 8);
#pragma unroll
        for (int e = 0; e < 8; ++e) { nope[e] = bfget(w0, e); nope[8 + e] = bfget(w1, e); }
        ra = *(const f32x4*)(KROPE + (size_t)m * 32 + sub * 4);
        rb = *(const f32x4*)(KROPE + (size_t)m * 32 + 16 + sub * 4);
      }
      float ss = 0.f;
#pragma unroll
      for (int e = 0; e < 16; ++e) ss += nope[e] * nope[e];
#pragma unroll
      for (int e = 0; e < 4; ++e) ss += ra[e] * ra[e] + rb[e] * rb[e];
      ss += __shfl_xor(ss, 1); ss += __shfl_xor(ss, 2);
      const float rstd = rsqrtf(ss * (1.f / 96.f) + EPS) * (which == 0 ? QS : 1.f);
      u32x4 o0, o1;
#pragma unroll
      for (int e2 = 0; e2 < 4; ++e2) {
        o0[e2] = pack2(nope[2 * e2] * rstd * gn[sub * 16 + 2 * e2], nope[2 * e2 + 1] * rstd * gn[sub * 16 + 2 * e2 + 1]);
        o1[e2] = pack2(nope[8 + 2 * e2] * rstd * gn[sub * 16 + 8 + 2 * e2], nope[9 + 2 * e2] * rstd * gn[sub * 16 + 9 + 2 * e2]);
      }
      f32x4 oa, ob;
#pragma unroll
      for (int e = 0; e < 4; ++e) {
        const float a = ra[e] * rstd * gn[64 + sub * 4 + e], bq = rb[e] * rstd * gn[80 + sub * 4 + e];
        oa[e] = a * cs[e] - bq * sn[e];
        ob[e] = bq * cs[e] + a * sn[e];
      }
      *(u32x4*)(dstp + sub * 16) = o0; *(u32x4*)(dstp + sub * 16 + 8) = o1;
      *(u32x2*)(dstp + 64 + sub * 4) = pack4(oa); *(u32x2*)(dstp + 80 + sub * 4) = pack4(ob);
    }
  }
}

DI void mla_vt_phase(const u16* __restrict__ KVRAW, u16* __restrict__ VT, char* smem) {
  u16* tile = (u16*)smem;
  const int tid = otid();
  for (int item = blockIdx.x; item < 8192; item += gridDim.x) {
    const int tt = item & 63, bh = item >> 6, b = bh >> 4, h = bh & 15;
    {
      const int row = tid >> 2, part = tid & 3;
      const u16* src = KVRAW + ((size_t)b * 4096 + tt * 64 + row) * 2048 + h * 128 + 64 + part * 16;
      const u32x4 w0 = *(const u32x4*)src, w1 = *(const u32x4*)(src + 8);
      u32* d32 = (u32*)(tile + row * 66 + part * 16);
#pragma unroll
      for (int e = 0; e < 4; ++e) { d32[e] = w0[e]; d32[4 + e] = w1[e]; }
    }
    __syncthreads();
    {
      const int d = tid >> 2, tp = (tid & 3) * 16;
      u32x4 o0, o1;
#pragma unroll
      for (int e2 = 0; e2 < 4; ++e2) {
        o0[e2] = (u32)tile[(tp + 2 * e2) * 66 + d] | ((u32)tile[(tp + 2 * e2 + 1) * 66 + d] << 16);
        o1[e2] = (u32)tile[(tp + 8 + 2 * e2) * 66 + d] | ((u32)tile[(tp + 9 + 2 * e2) * 66 + d] << 16);
      }
      u16* dst = VT + ((size_t)(bh * 64 + d)) * 4096 + tt * 64 + tp;
      *(u32x4*)dst = o0; *(u32x4*)(dst + 8) = o1;
    }
    __syncthreads();
  }
}

constexpr int FA_KROW = 208, FA_VROW = 144, FA_KT = 64 * FA_KROW, FA_BUF = FA_KT + 64 * FA_VROW;
DI void mla_attn_item(const u16* __restrict__ Q, const u16* __restrict__ Kb, const u16* __restrict__ VT, u16* __restrict__ O, int item, char* smem) {
  const int qb = item & 31, bh = item >> 5, b = bh >> 4, h = bh & 15;
  const int tid = otid(), lane = tid & 63, wid = tid >> 6, fr = lane & 15, fq = lane >> 4;
  bf16x8 qf[2][3];
#pragma unroll
  for (int qt = 0; qt < 2; ++qt) {
    const size_t tq = (size_t)b * 4096 + qb * 128 + wid * 32 + qt * 16 + fr;
#pragma unroll
    for (int ks = 0; ks < 3; ++ks) qf[qt][ks] = *(const bf16x8*)(Q + tq * 1536 + h * 96 + ks * 32 + fq * 8);
  }
  f32x4 o[4][2];
#pragma unroll
  for (int i = 0; i < 4; ++i) { o[i][0] = zero4(); o[i][1] = zero4(); }
  float mrun[2] = {-1e30f, -1e30f}, lrun[2] = {0.f, 0.f};
  const u16* kg[3]; int ks_off[3];
#pragma unroll
  for (int i = 0; i < 3; ++i) {
    const int c = tid + 256 * i, row = c / 12, kc = c % 12;
    kg[i] = Kb + ((size_t)b * 4096 + row) * 1536 + h * 96 + kc * 8;
    ks_off[i] = row * FA_KROW + kc * 16;
  }
  const u16* vg[2]; int vs_off[2];
#pragma unroll
  for (int i = 0; i < 2; ++i) {
    const int c = tid + 256 * i, d = c >> 3, kc = c & 7;
    vg[i] = VT + ((size_t)(bh * 64 + d)) * 4096 + kc * 8;
    vs_off[i] = FA_KT + d * FA_VROW + kc * 16;
  }
  u32x4 rk[3], rv[2];
#pragma unroll
  for (int i = 0; i < 3; ++i) rk[i] = *(const u32x4*)(kg[i]);
#pragma unroll
  for (int i = 0; i < 2; ++i) rv[i] = *(const u32x4*)(vg[i]);
#pragma unroll
  for (int i = 0; i < 3; ++i) *(u32x4*)(smem + ks_off[i]) = rk[i];
#pragma unroll
  for (int i = 0; i < 2; ++i) *(u32x4*)(smem + vs_off[i]) = rv[i];
  __syncthreads();
  for (int kt = 0; kt < 64; ++kt) {
    const int cur = (kt & 1) * FA_BUF, nxt = FA_BUF - cur;
    if (kt + 1 < 64) {
      const size_t key0 = (size_t)(kt + 1) * 64;
#pragma unroll
      for (int i = 0; i < 3; ++i) rk[i] = *(const u32x4*)(kg[i] + key0 * 1536);
#pragma unroll
      for (int i = 0; i < 2; ++i) rv[i] = *(const u32x4*)(vg[i] + key0);
    }
    f32x4 s[4][2];
#pragma unroll
    for (int k4 = 0; k4 < 4; ++k4) {
      s[k4][0] = zero4(); s[k4][1] = zero4();
#pragma unroll
      for (int ks = 0; ks < 3; ++ks) {
        const bf16x8 kf = *(const bf16x8*)(smem + cur + (k4 * 16 + fr) * FA_KROW + ks * 64 + fq * 16);
        s[k4][0] = MFMA32(kf, qf[0][ks], s[k4][0]);
        s[k4][1] = MFMA32(kf, qf[1][ks], s[k4][1]);
      }
    }
    bf16x8 pp[2][2];
#pragma unroll
    for (int qt = 0; qt < 2; ++qt) {
      float mx = -1e30f;
#pragma unroll
      for (int k4 = 0; k4 < 4; ++k4)
#pragma unroll
        for (int j = 0; j < 4; ++j) mx = fmaxf(mx, s[k4][qt][j]);
      mx = fmaxf(mx, __shfl_xor(mx, 16)); mx = fmaxf(mx, __shfl_xor(mx, 32));
      const float mnew = fmaxf(mrun[qt], mx);
      const float alpha = exp2f(mrun[qt] - mnew);
      mrun[qt] = mnew;
      float ps = 0.f;
#pragma unroll
      for (int k4 = 0; k4 < 4; ++k4)
#pragma unroll
        for (int j = 0; j < 4; ++j) { const float pv = exp2f(s[k4][qt][j] - mnew); s[k4][qt][j] = pv; ps += pv; }
      lrun[qt] = lrun[qt] * alpha + ps;
#pragma unroll
      for (int dt = 0; dt < 4; ++dt) o[dt][qt] = o[dt][qt] * alpha;
      pp[qt][0] = pack8(s[0][qt], s[1][qt]);
      pp[qt][1] = pack8(s[2][qt], s[3][qt]);
    }
#pragma unroll
    for (int dt = 0; dt < 4; ++dt)
#pragma unroll
      for (int a = 0; a < 2; ++a) {
        const char* vp = smem + cur + FA_KT + (dt * 16 + fr) * FA_VROW + (a * 32 + fq * 4) * 2;
        const bf16x8 vf = cat4(*(const bf16x4*)vp, *(const bf16x4*)(vp + 32));
        o[dt][0] = MFMA32(vf, pp[0][a], o[dt][0]);
        o[dt][1] = MFMA32(vf, pp[1][a], o[dt][1]);
      }
    if (kt + 1 < 64) {
#pragma unroll
      for (int i = 0; i < 3; ++i) *(u32x4*)(smem + nxt + ks_off[i]) = rk[i];
#pragma unroll
      for (int i = 0; i < 2; ++i) *(u32x4*)(smem + nxt + vs_off[i]) = rv[i];
    }
    __syncthreads();
  }
#pragma unroll
  for (int qt = 0; qt < 2; ++qt) {
    float l = lrun[qt];
    l += __shfl_xor(l, 16); l += __shfl_xor(l, 32);
    const float inv = 1.f / l;
    const size_t tq = (size_t)b * 4096 + qb * 128 + wid * 32 + qt * 16 + fr;
#pragma unroll
    for (int dt = 0; dt < 4; ++dt) *(u32x2*)(O + tq * 1024 + h * 64 + dt * 16 + fq * 4) = pack4(o[dt][qt] * inv);
  }
}

#ifndef ENMASK
#define ENMASK 0xffffffffu
#endif
#define EN(i) ((ENMASK >> (i)) & 1u)
#define PHASE_BEGIN(i) if (EN(i) && pc >= p.lo && pc < p.hi) {
#define PHASE_END } { if (pc >= p.lo && pc + 1 < p.hi) grid.sync(); ++pc; }

__global__ void __launch_bounds__(256, 2) mega(Params p) {
  __shared__ __attribute__((aligned(16))) char smem[73728];
  cg::grid_group grid = cg::this_grid();
  int pc = 0;
  char* ws = p.ws;
  u16* H = (u16*)(ws + OFF_H);
  char* R = ws + OFF_R;
  const float* LB = (const float*)(ws + OFF_TAB);
  const float* RC = LB + 4096; const float* RS = RC + 65536;
  for (int layer = 0; layer < 4; ++layer) {
    const int kind = layer % 3, mi = layer / 3;
    for (int stage = 0; stage < 3; ++stage) {
      if (stage != 1) {
        const float* ng = (stage == 0 ? p.ffn1_norm : p.ffn2_norm) + layer * 1024;
        const u16* wgu = (const u16*)(ws + (stage == 0 ? OFF_WGU1 : OFF_WGU2));
        const u16* wdn = (const u16*)(ws + (stage == 0 ? OFF_WDN1 : OFF_WDN2));
        u16* ACT = (u16*)R;
        PHASE_BEGIN(0)
          const bool first = (layer == 0 && stage == 0);
          if (stage == 0) { if (layer == 0) init_tables(p); cvt_layer(p, layer, smem); }
          norm_phase(first ? p.x : p.X, ng, H, first ? p.X : nullptr, MTOK);
        PHASE_END
        PHASE_BEGIN(1)
          gemm_phase(H, 1024, wgu, 1024, MTOK, 5632, EpiSwiglu{ACT}, smem);
        PHASE_END
        PHASE_BEGIN(2)
          gemm_phase(ACT, 2816, wdn, 2816, MTOK, 1024, EpiResid{p.X, 0.5f}, smem);
        PHASE_END
      } else {
        PHASE_BEGIN(3)
          norm_phase(p.X, p.mix_norm + layer * 1024, H, nullptr, MTOK);
        PHASE_END
        if (kind == 0) {
          constexpr size_t SZ = 32 * MiB;
          HgBufs hb;
          hb.Q = (u16*)(R + 0 * SZ); hb.LFf = (u16*)(R + 1 * SZ); hb.LFb = (u16*)(R + 2 * SZ); hb.V = (u16*)(R + 3 * SZ); hb.G = (u16*)(R + 4 * SZ);
          hb.QIf = (u16*)(R + 5 * SZ); hb.QIb = (u16*)(R + 6 * SZ); hb.KITf = (u16*)(R + 7 * SZ); hb.KITb = (u16*)(R + 8 * SZ);
          hb.VTc = (u16*)(R + 9 * SZ); hb.OI = (u16*)(R + 10 * SZ); hb.OF = hb.Q; hb.OB = hb.LFf; hb.Y = hb.LFb;
          hb.DECf = (float*)(R + 11 * SZ); hb.DECb = (float*)(R + 11 * SZ + 4 * MiB);
          const u16* w_in = (const u16*)(ws + OFF_WMIX); const u16* w_out = (const u16*)(ws + OFF_WMIX + 10485760);
          for (int half = 0; half < 2; ++half) {
            PHASE_BEGIN(4)
              gemm_phase(H + (size_t)half * 16384 * 1024, 1024, w_in, 1024, 16384, 5120, EpiHgIn{hb.Q, hb.LFf, hb.LFb, hb.V, hb.G, LB + layer * 1024}, smem);
            PHASE_END
            PHASE_BEGIN(5)
              for (int item = blockIdx.x; item < 8192; item += gridDim.x) hg_prep_item(hb, item, smem);
            PHASE_END
            PHASE_BEGIN(6)
              hg_scan_phase(hb);
            PHASE_END
            PHASE_BEGIN(7)
              hg_combine_phase(hb, p.hg_g_norm + mi * 128, 16384);
            PHASE_END
            PHASE_BEGIN(8)
              gemm_phase(hb.Y, 1024, w_out, 1024, 16384, 1024, EpiResid{p.X + (size_t)half * 16384 * 1024, 1.0f}, smem);
            PHASE_END
          }
        } else if (kind == 1) {
          u16* Qn = (u16*)R; u16* Kn = (u16*)(R + 64 * MiB); u16* VT = (u16*)(R + 128 * MiB); u16* On = (u16*)(R + 192 * MiB);
          const u16* w_in = (const u16*)(ws + OFF_WMIX); const u16* w_out = (const u16*)(ws + OFF_WMIX + 6291456);
          PHASE_BEGIN(9)
            gemm_phase(H, 1024, w_in, 1024, MTOK, 3072, EpiNaIn{Qn, Kn, VT, p.na_q_norm + mi * 64, p.na_k_norm + mi * 64}, smem);
          PHASE_END
          PHASE_BEGIN(10)
            const int tid_ = otid(), lane = tid_ & 63, wid = tid_ >> 6, fr = lane & 15, fq = lane >> 4;
            for (int item = blockIdx.x * 4 + wid; item < 32768; item += gridDim.x * 4)
              na_attn_item(Qn, Kn, VT, p.na_rpb + (size_t)mi * 16 * 15 * 31, On, item, fr, fq);
          PHASE_END
          PHASE_BEGIN(11)
            gemm_phase(On, 1024, w_out, 1024, MTOK, 1024, EpiResid{p.X, 1.0f}, smem);
          PHASE_END
        } else {
          u16* VT = H;
          u16* CRAW = (u16*)R; u16* On = (u16*)R;
          u16* CQN = (u16*)(R + 66 * MiB); u16* CKVN = (u16*)(R + 114 * MiB); u16* Kk = (u16*)(R + 66 * MiB);
          float* KROPE = (float*)(R + 162 * MiB);
          u16* Qq = (u16*)(R + 166 * MiB); u16* KVRAW = (u16*)(R + 262 * MiB);
          const u16* w_in = (const u16*)(ws + OFF_WMIX); const u16* w_uq = (const u16*)(ws + OFF_WMIX + 2359296);
          const u16* w_ukv = (const u16*)(ws + OFF_WMIX + 4718592); const u16* w_out = (const u16*)(ws + OFF_WMIX + 5767168);
          PHASE_BEGIN(12)
            gemm_phase(H, 1024, w_in, 1024, MTOK, 1152, EpiStore{CRAW, 1056, 1056}, smem);
          PHASE_END
          PHASE_BEGIN(13)
            mla_norm_phase(CRAW, p.mla_q_a_norm + mi * 768, p.mla_kv_a_norm + mi * 256, CQN, CKVN, KROPE);
          PHASE_END
          PHASE_BEGIN(14)
            gemm_phase(CQN, 768, w_uq, 768, MTOK, 1536, EpiStore{Qq, 1536, 1536}, smem);
            gemm_phase(CKVN, 256, w_ukv, 256, MTOK, 2048, EpiStore{KVRAW, 2048, 2048}, smem);
          PHASE_END
          PHASE_BEGIN(15)
            mla_prep_phase(Qq, KVRAW, KROPE, Kk, p.mla_q_norm + mi * 96, p.mla_k_norm + mi * 96, RC, RS);
            mla_vt_phase(KVRAW, VT, smem);
          PHASE_END
          PHASE_BEGIN(16)
            for (int item = blockIdx.x; item < 4096; item += gridDim.x) mla_attn_item(Qq, Kk, VT, On, item, smem);
          PHASE_END
          PHASE_BEGIN(17)
            gemm_phase(On, 1024, w_out, 1024, MTOK, 1024, EpiResid{p.X, 1.0f}, smem);
          PHASE_END
        }
      }
    }
  }
}

static int count_phases() {
  int n = 0;
  for (int layer = 0; layer < 4; ++layer) {
    int kind = layer % 3;
    n += 3 + 3 + 1;
    n += kind == 0 ? 10 : kind == 1 ? 3 : 6;
  }
  return n;
}

extern "C" void kernel_launch(void* const* d_in, const int* in_sizes, int n_in, void* d_out, int out_size, void* d_ws, size_t ws_size, hipStream_t stream) {
  if (ws_size < WS_NEED) { fprintf(stderr, "workspace too small: %zu < %zu\n", ws_size, WS_NEED); return; }
  static int grid_blocks = 0;
  if (!grid_blocks) {
    int dev = 0, cus = 0, per_cu = 0;
    hipGetDevice(&dev);
    hipDeviceGetAttribute(&cus, hipDeviceAttributeMultiprocessorCount, dev);
    hipOccupancyMaxActiveBlocksPerMultiprocessor(&per_cu, mega, 256, 0);
    if (per_cu > 2) per_cu = 2;
    grid_blocks = cus * per_cu;
  }
  Params p{};
  const float** pf = (const float**)&p;
  for (int i = 0; i < 25; ++i) pf[i] = (const float*)d_in[i];
  p.X = (float*)d_out; p.ws = (char*)d_ws;
  const int total = count_phases();
#if MULTI_LAUNCH
  for (int ph = 0; ph < total; ++ph) {
    p.lo = ph; p.hi = ph + 1;
    hipLaunchKernelGGL(mega, dim3(grid_blocks), dim3(256), 0, stream, p);
  }
#else
  p.lo = 0; p.hi = total;
  void* args[] = {&p};
  hipError_t e = hipLaunchCooperativeKernel((void*)mega, dim3(grid_blocks), dim3(256), args, 0, stream);
  if (e != hipSuccess) fprintf(stderr, "cooperative launch failed: %s (grid %d)\n", hipGetErrorString(e), grid_blocks);
#endif
}
```

```cpp
#include <hip/hip_runtime.h>
#include <hip/hip_cooperative_groups.h>
#include <cstdio>
#include <cstdint>
namespace cg = cooperative_groups;

#ifndef MULTI_LAUNCH
#define MULTI_LAUNCH 0
#endif

typedef unsigned short u16;
typedef unsigned int u32;
using bf16x8 = __attribute__((ext_vector_type(8))) short;
using bf16x4 = __attribute__((ext_vector_type(4))) short;
using f32x4 = __attribute__((ext_vector_type(4))) float;
using u32x2 = __attribute__((ext_vector_type(2))) unsigned int;
using u32x4 = __attribute__((ext_vector_type(4))) unsigned int;

#define DI __device__ __forceinline__
#define MFMA32(a, b, c) __builtin_amdgcn_mfma_f32_16x16x32_bf16((a), (b), (c), 0, 0, 0)

constexpr int MTOK = 32768;
constexpr float EPS = 1e-6f;
constexpr float LOG2E = 1.4426950408889634f;

constexpr size_t MiB = 1048576;
constexpr size_t OFF_WGU1 = 0;
constexpr size_t OFF_WDN1 = 11534336;
constexpr size_t OFF_WGU2 = 17301504;
constexpr size_t OFF_WDN2 = 28835840;
constexpr size_t OFF_WMIX = 34603008;
constexpr size_t OFF_TAB = 47185920;
constexpr size_t OFF_BAR = OFF_TAB + 786432;
constexpr size_t OFF_H = 46 * MiB;
constexpr size_t OFF_R = 110 * MiB;
constexpr size_t WS_NEED = 500 * MiB;

struct Params {
  const float* x; const float* ffn1_norm; const float* ffn1_w_gu; const float* ffn1_w_down;
  const float* mix_norm; const float* ffn2_norm; const float* ffn2_w_gu; const float* ffn2_w_down;
  const float* hg_lb_logits; const float* hg_w_in; const float* hg_g_norm; const float* hg_w_out;
  const float* na_w_in; const float* na_q_norm; const float* na_k_norm; const float* na_rpb; const float* na_w_out;
  const float* mla_w_in; const float* mla_q_a_norm; const float* mla_w_uq; const float* mla_kv_a_norm; const float* mla_w_ukv;
  const float* mla_q_norm; const float* mla_k_norm; const float* mla_w_out;
  float* X; char* ws; int lo; int hi;
};

DI u32 f2bf(float x) { u32 u = __float_as_uint(x); u += 0x7fffu + ((u >> 16) & 1u); return u >> 16; }
DI u32 pack2(float a, float b) { return f2bf(a) | (f2bf(b) << 16); }
DI float bflo(u32 w) { return __uint_as_float(w << 16); }
DI float bfhi(u32 w) { return __uint_as_float(w & 0xffff0000u); }
DI float bfget(const u32x4& v, int e) { u32 w = v[e >> 1]; return (e & 1) ? bfhi(w) : bflo(w); }
DI u32x2 pack4(const f32x4& v) { u32x2 r; r[0] = pack2(v[0], v[1]); r[1] = pack2(v[2], v[3]); return r; }
DI bf16x8 pack8(const f32x4& a, const f32x4& b) {
  u32x4 r; r[0] = pack2(a[0], a[1]); r[1] = pack2(a[2], a[3]); r[2] = pack2(b[0], b[1]); r[3] = pack2(b[2], b[3]);
  return __builtin_bit_cast(bf16x8, r);
}
DI bf16x8 cat4(const bf16x4& lo, const bf16x4& hi) { return __builtin_shufflevector(lo, hi, 0, 1, 2, 3, 4, 5, 6, 7); }
DI float wave_sum(float v) {
#pragma unroll
  for (int o = 32; o > 0; o >>= 1) v += __shfl_xor(v, o);
  return v;
}
DI float sigmoidf_(float z) { return 1.f / (1.f + __expf(-z)); }
DI float siluf_(float z) { return z / (1.f + __expf(-z)); }
DI int otid() { int t = threadIdx.x; asm volatile("" : "+v"(t)); return t; }
DI f32x4 zero4() { f32x4 z = {0.f, 0.f, 0.f, 0.f}; return z; }

DI void init_tables(const Params& p) {
  float* LB = (float*)(p.ws + OFF_TAB); float* RC = LB + 4096; float* RS = RC + 65536;
  const int gt = blockIdx.x * 256 + otid(), gs = gridDim.x * 256;
  for (int c = gt; c < 1024; c += gs) {
    float l0 = p.hg_lb_logits[c], l1 = p.hg_lb_logits[1024 + c], l2 = p.hg_lb_logits[2048 + c], l3 = p.hg_lb_logits[3072 + c];
    float mx = fmaxf(fmaxf(l0, l1), fmaxf(l2, l3));
    float e0 = expf(l0 - mx), e1 = expf(l1 - mx), e2 = expf(l2 - mx), e3 = expf(l3 - mx);
    float inv = 1.f / (e0 + e1 + e2 + e3);
    LB[c] = 0.f; LB[1024 + c] = e1 * inv; LB[2048 + c] = (e1 + e2) * inv; LB[3072 + c] = (e1 + e2 + e3) * inv;
  }
  for (int i = gt; i < 65536; i += gs) {
    int t = i >> 4, j = i & 15;
    float inv = exp2f(-(float)j * (13.287712379549449f / 16.f));
    float ang = (float)t * inv;
    double a = (double)ang;
    double k = rint(a * 0.15915494309189535);
    float r = (float)(a - k * 6.283185307179586);
    RC[i] = __cosf(r); RS[i] = __sinf(r);
  }
}

DI void cvt_tiles(const float* __restrict__ src, u16* __restrict__ dst, int K, int N, int Nd, int mode, char* smem) {
  float* tile = (float*)smem;
  const int tk = K >> 6, tn = Nd >> 6, tid = otid();
  for (int t = blockIdx.x; t < tk * tn; t += gridDim.x) {
    const int k0 = (t % tk) << 6, n0 = (t / tk) << 6;
    {
      const int nl = tid & 63, kq = tid >> 6;
      const int nd = n0 + nl;
      int col = nd;
      if (mode == 1) { int a = nd >> 5, r = nd & 31; col = a * 16 + (r & 15) + ((r >= 16) ? 2816 : 0); }
      const bool ok = col < N;
#pragma unroll
      for (int i = 0; i < 16; ++i) {
        int kl = kq + 4 * i;
        tile[kl * 65 + nl] = ok ? src[(size_t)(k0 + kl) * N + col] : 0.f;
      }
    }
    __syncthreads();
    {
      const int kp = (tid & 31) * 2, nq = tid >> 5;
#pragma unroll
      for (int i = 0; i < 8; ++i) {
        int n = nq + 8 * i;
        *(u32*)(dst + (size_t)(n0 + n) * K + k0 + kp) = pack2(tile[kp * 65 + n], tile[(kp + 1) * 65 + n]);
      }
    }
    __syncthreads();
  }
}

DI void cvt_layer(const Params& p, int layer, char* smem) {
  const int kind = layer % 3, mi = layer / 3;
  char* ws = p.ws;
  for (int task = 0; task < 8; ++task) {
    const float* src = nullptr; size_t off = 0; int K = 0, N = 0, Nd = 0, mode = 0;
    if (task == 0) { src = p.ffn1_w_gu + (size_t)layer * 1024 * 5632; off = OFF_WGU1; K = 1024; N = 5632; Nd = 5632; mode = 1; }
    else if (task == 1) { src = p.ffn1_w_down + (size_t)layer * 2816 * 1024; off = OFF_WDN1; K = 2816; N = 1024; Nd = 1024; }
    else if (task == 2) { src = p.ffn2_w_gu + (size_t)layer * 1024 * 5632; off = OFF_WGU2; K = 1024; N = 5632; Nd = 5632; mode = 1; }
    else if (task == 3) { src = p.ffn2_w_down + (size_t)layer * 2816 * 1024; off = OFF_WDN2; K = 2816; N = 1024; Nd = 1024; }
    else if (kind == 0) {
      if (task == 4) { src = p.hg_w_in + (size_t)mi * 1024 * 5120; off = OFF_WMIX; K = 1024; N = 5120; Nd = 5120; }
      else if (task == 5) { src = p.hg_w_out + (size_t)mi * 1024 * 1024; off = OFF_WMIX + 10485760; K = 1024; N = 1024; Nd = 1024; }
    } else if (kind == 1) {
      if (task == 4) { src = p.na_w_in + (size_t)mi * 1024 * 3072; off = OFF_WMIX; K = 1024; N = 3072; Nd = 3072; }
      else if (task == 5) { src = p.na_w_out + (size_t)mi * 1024 * 1024; off = OFF_WMIX + 6291456; K = 1024; N = 1024; Nd = 1024; }
    } else {
      if (task == 4) { src = p.mla_w_in + (size_t)mi * 1024 * 1056; off = OFF_WMIX; K = 1024; N = 1056; Nd = 1152; }
      else if (task == 5) { src = p.mla_w_uq + (size_t)mi * 768 * 1536; off = OFF_WMIX + 2359296; K = 768; N = 1536; Nd = 1536; }
      else if (task == 6) { src = p.mla_w_ukv + (size_t)mi * 256 * 2048; off = OFF_WMIX + 4718592; K = 256; N = 2048; Nd = 2048; }
      else if (task == 7) { src = p.mla_w_out + (size_t)mi * 1024 * 1024; off = OFF_WMIX + 5767168; K = 1024; N = 1024; Nd = 1024; }
    }
    if (src) cvt_tiles(src, (u16*)(ws + off), K, N, Nd, mode, smem);
  }
}

DI void norm_phase(const float* __restrict__ src, const float* __restrict__ gain, u16* __restrict__ dst, float* copy_dst, int rows) {
  const int lane = otid() & 63, wid = otid() >> 6;
  f32x4 g[4];
#pragma unroll
  for (int i = 0; i < 4; ++i) g[i] = *(const f32x4*)(gain + i * 256 + lane * 4);
  for (int row = blockIdx.x * 4 + wid; row < rows; row += gridDim.x * 4) {
    const float* s = src + (size_t)row * 1024;
    f32x4 v[4]; float ss = 0.f;
#pragma unroll
    for (int i = 0; i < 4; ++i) { v[i] = *(const f32x4*)(s + i * 256 + lane * 4); ss += v[i][0] * v[i][0] + v[i][1] * v[i][1] + v[i][2] * v[i][2] + v[i][3] * v[i][3]; }
    ss = wave_sum(ss);
    const float rstd = rsqrtf(ss * (1.f / 1024.f) + EPS);
#pragma unroll
    for (int i = 0; i < 4; ++i) {
      f32x4 y = v[i] * rstd * g[i];
      *(u32x2*)(dst + (size_t)row * 1024 + i * 256 + lane * 4) = pack4(y);
      if (copy_dst) *(f32x4*)(copy_dst + (size_t)row * 1024 + i * 256 + lane * 4) = v[i];
    }
  }
}

constexpr int LDS_TILE = 128 * 128;
constexpr int LDS_BUF = 2 * LDS_TILE;

#define GLDS16(gp, lp) __builtin_amdgcn_global_load_lds((const unsigned*)(gp), (unsigned*)(lp), 16, 0, 0)

template <class Epi>
DI void gemm_tile(const u16* __restrict__ A, int lda, const u16* __restrict__ W, int K, int m0, int n0, const Epi& epi, char* smem) {
  const int tid = otid(), lane = tid & 63, wid = tid >> 6;
  const int wm = wid >> 1, wn = wid & 1, fr = lane & 15, fq = lane >> 4;
  f32x4 acc[4][4];
#pragma unroll
  for (int i = 0; i < 4; ++i)
#pragma unroll
    for (int j = 0; j < 4; ++j) acc[i][j] = zero4();
  const int lrow = tid >> 3, lc = (tid & 7) ^ ((tid >> 4) & 7);
  const u16* ga = A + (size_t)lrow * lda + lc * 8;
  const u16* gw = W + (size_t)lrow * K + lc * 8;
  char* sdst = smem + tid * 16;
  const int sw = fr >> 1;
  const int ro0 = ((fq) ^ sw) * 16, ro1 = ((4 + fq) ^ sw) * 16;
  const char* sa_rd = smem + (wm * 64 + fr) * 128;
  const char* sw_rd = smem + LDS_TILE + (wn * 64 + fr) * 128;
  const int nk = K >> 6;
#pragma unroll
  for (int i = 0; i < 4; ++i) { GLDS16(ga + (size_t)(32 * i) * lda, sdst + i * 4096); GLDS16(gw + (size_t)(32 * i) * K, sdst + LDS_TILE + i * 4096); }
  asm volatile("s_waitcnt vmcnt(0)" ::: "memory");
  __syncthreads();
  for (int t = 0; t < nk; ++t) {
    const int cur = (t & 1) * LDS_BUF, nxt = LDS_BUF - cur;
    if (t + 1 < nk) {
      const int k0 = (t + 1) << 6;
#pragma unroll
      for (int i = 0; i < 4; ++i) { GLDS16(ga + (size_t)(32 * i) * lda + k0, sdst + nxt + i * 4096); GLDS16(gw + (size_t)(32 * i) * K + k0, sdst + nxt + LDS_TILE + i * 4096); }
    }
#pragma unroll
    for (int ks = 0; ks < 2; ++ks) {
      const int ro = ks ? ro1 : ro0;
      bf16x8 af[4], wf[4];
#pragma unroll
      for (int i = 0; i < 4; ++i) {
        af[i] = *(const bf16x8*)(sa_rd + cur + i * 2048 + ro);
        wf[i] = *(const bf16x8*)(sw_rd + cur + i * 2048 + ro);
      }
#pragma unroll
      for (int nt = 0; nt < 4; ++nt)
#pragma unroll
        for (int mt = 0; mt < 4; ++mt) acc[nt][mt] = MFMA32(wf[nt], af[mt], acc[nt][mt]);
    }
    asm volatile("s_waitcnt vmcnt(0)" ::: "memory");
    __syncthreads();
  }
  epi(acc, m0 + wm * 64, n0 + wn * 64, fr, fq);
}

template <class Epi>
DI void gemm_phase(const u16* A, int lda, const u16* W, int K, int Mrows, int Ncols, const Epi& epi, char* smem) {
  const int mtn = Mrows >> 7, ntn = Ncols >> 7;
  const int ntiles = mtn * ntn;
  constexpr int GM = 16;
  for (int tile = blockIdx.x; tile < ntiles; tile += gridDim.x) {
    const int group = tile / (GM * ntn), rem = tile % (GM * ntn);
    const int mt = group * GM + (rem % GM), nt = rem / GM;
    gemm_tile(A + (size_t)mt * 128 * lda, lda, W + (size_t)nt * 128 * K, K, mt * 128, nt * 128, epi, smem);
  }
}

struct EpiSwiglu {
  u16* act;
  DI void operator()(f32x4 (&acc)[4][4], int mb, int nb, int fr, int fq) const {
#pragma unroll
    for (int mt = 0; mt < 4; ++mt) {
      const int m = mb + mt * 16 + fr;
#pragma unroll
      for (int np = 0; np < 2; ++np) {
        const f32x4 g = acc[2 * np][mt], u = acc[2 * np + 1][mt];
        f32x4 r;
#pragma unroll
        for (int j = 0; j < 4; ++j) r[j] = siluf_(g[j]) * u[j];
        const int jc = (nb >> 1) + np * 16 + fq * 4;
        *(u32x2*)(act + (size_t)m * 2816 + jc) = pack4(r);
      }
    }
  }
};

struct EpiResid {
  float* X; float scale;
  DI void operator()(f32x4 (&acc)[4][4], int mb, int nb, int fr, int fq) const {
#pragma unroll
    for (int mt = 0; mt < 4; ++mt) {
      const int m = mb + mt * 16 + fr;
#pragma unroll
      for (int nt = 0; nt < 4; ++nt) {
        f32x4* ptr = (f32x4*)(X + (size_t)m * 1024 + nb + nt * 16 + fq * 4);
        f32x4 v = *ptr;
        v += acc[nt][mt] * scale;
        *ptr = v;
      }
    }
  }
};

struct EpiStore {
  u16* out; int ldo; int nmax;
  DI void operator()(f32x4 (&acc)[4][4], int mb, int nb, int fr, int fq) const {
#pragma unroll
    for (int mt = 0; mt < 4; ++mt) {
      const int m = mb + mt * 16 + fr;
#pragma unroll
      for (int nt = 0; nt < 4; ++nt) {
        const int n = nb + nt * 16 + fq * 4;
        if (n < nmax) *(u32x2*)(out + (size_t)m * ldo + n) = pack4(acc[nt][mt]);
      }
    }
  }
};

struct EpiHgIn {
  u16 *Q, *LFf, *LFb, *V, *G; const float* lb;
  DI void operator()(f32x4 (&acc)[4][4], int mb, int nb, int fr, int fq) const {
    const int seg = nb >> 10, c0 = nb & 1023;
    u16* dst = seg == 0 ? Q : seg == 1 ? LFf : seg == 2 ? LFb : seg == 3 ? V : G;
#pragma unroll
    for (int mt = 0; mt < 4; ++mt) {
      const int m = mb + mt * 16 + fr;
#pragma unroll
      for (int nt = 0; nt < 4; ++nt) {
        const int c = c0 + nt * 16 + fq * 4;
        f32x4 a = acc[nt][mt], r;
        if (seg == 0) r = a * 0.08838834764831845f;
        else if (seg == 3) r = a;
        else if (seg == 4) {
#pragma unroll
          for (int j = 0; j < 4; ++j) r[j] = siluf_(a[j]);
        } else {
          const f32x4 l4 = *(const f32x4*)(lb + c);
#pragma unroll
          for (int j = 0; j < 4; ++j) {
            float z = fminf(fmaxf(a[j], -30.f), 30.f);
            float f = l4[j] + (1.f - l4[j]) * sigmoidf_(z);
            r[j] = __logf(f);
          }
        }
        *(u32x2*)(dst + (size_t)m * 1024 + c) = pack4(r);
      }
    }
  }
};

struct EpiNaIn {
  u16 *Q, *K, *VT; const float *qn, *kn;
  DI void operator()(f32x4 (&acc)[4][4], int mb, int nb, int fr, int fq) const {
    const int seg = nb >> 10, h = (nb & 1023) >> 6;
    if (seg < 2) {
      u16* dst = seg == 0 ? Q : K;
      const float* gn = seg == 0 ? qn : kn;
      const float sc = seg == 0 ? 0.125f * LOG2E : 1.f;
#pragma unroll
      for (int mt = 0; mt < 4; ++mt) {
        const int m = mb + mt * 16 + fr;
        float ss = 0.f;
#pragma unroll
        for (int nt = 0; nt < 4; ++nt)
#pragma unroll
          for (int j = 0; j < 4; ++j) ss += acc[nt][mt][j] * acc[nt][mt][j];
        ss += __shfl_xor(ss, 16); ss += __shfl_xor(ss, 32);
        const float rstd = rsqrtf(ss * (1.f / 64.f) + EPS) * sc;
#pragma unroll
        for (int nt = 0; nt < 4; ++nt) {
          const int d = nt * 16 + fq * 4;
          const f32x4 g4 = *(const f32x4*)(gn + d);
          f32x4 r = acc[nt][mt] * rstd * g4;
          *(u32x2*)(dst + (size_t)m * 1024 + h * 64 + d) = pack4(r);
        }
      }
    } else {
#pragma unroll
      for (int mt = 0; mt < 4; ++mt) {
        const int m = mb + mt * 16 + fr;
        const int b = m >> 12, t = m & 4095;
#pragma unroll
        for (int nt = 0; nt < 4; ++nt)
#pragma unroll
          for (int j = 0; j < 4; ++j) {
            const int d = nt * 16 + fq * 4 + j;
            VT[((size_t)((b * 16 + h) * 64 + d)) * 4096 + t] = (u16)f2bf(acc[nt][mt][j]);
          }
      }
    }
  }
};

struct HgBufs {
  u16 *Q, *LFf, *LFb, *V, *G, *QIf, *QIb, *KITf, *KITb, *VTc, *OI, *OF, *OB, *Y;
  float *DECf, *DECb;
};

DI void hg_prep_item(const HgBufs& hb, int item, char* smem) {
  const int h = item & 7, n = (item >> 3) & 255, b = item >> 11;
  float* sq = (float*)smem; float* sbf = sq + 2112; float* sbb = sbf + 2112; float* skf = sbb + 2112;
  float* skb = skf + 2112; float* sv = skb + 2112; float* sA = sv + 2112;
  const int tid = otid();
  const int row = tid >> 4, c8 = (tid & 15) * 8;
  const size_t tok0 = (size_t)b * 4096 + n * 16;
  const size_t gidx = (tok0 + row) * 1024 + h * 128 + c8;
  {
    const u32x4 rq = *(const u32x4*)(hb.Q + gidx), rf = *(const u32x4*)(hb.LFf + gidx);
    const u32x4 rb = *(const u32x4*)(hb.LFb + gidx), rv = *(const u32x4*)(hb.V + gidx);
#pragma unroll
    for (int e = 0; e < 8; ++e) {
      const int o = row * 132 + c8 + e;
      const float lf = bfget(rf, e), lb_ = bfget(rb, e);
      sq[o] = bfget(rq, e); sbf[o] = lf; sbb[o] = lb_;
      skf[o] = 1.f - __expf(lf); skb[o] = 1.f - __expf(lb_); sv[o] = bfget(rv, e);
    }
  }
  __syncthreads();
  if (tid < 128) {
    const int d = tid; float a = 0.f;
#pragma unroll
    for (int t = 0; t < 16; ++t) { a += sbf[t * 132 + d]; sbf[t * 132 + d] = a; }
    hb.DECf[((size_t)b * 256 + n) * 1024 + h * 128 + d] = __expf(a);
  } else {
    const int d = tid - 128; float a = 0.f;
#pragma unroll
    for (int t = 15; t >= 0; --t) { a += sbb[t * 132 + d]; sbb[t * 132 + d] = a; }
    hb.DECb[((size_t)b * 256 + n) * 1024 + h * 128 + d] = __expf(a);
  }
  __syncthreads();
  {
    u32x4 of, ob;
#pragma unroll
    for (int e2 = 0; e2 < 4; ++e2) {
      const int o = row * 132 + c8 + 2 * e2;
      const float q0 = sq[o], q1 = sq[o + 1];
      of[e2] = pack2(q0 * __expf(sbf[o]), q1 * __expf(sbf[o + 1]));
      ob[e2] = pack2(q0 * __expf(sbb[o]), q1 * __expf(sbb[o + 1]));
    }
    *(u32x4*)(hb.QIf + gidx) = of; *(u32x4*)(hb.QIb + gidx) = ob;
  }
  {
    const int d = tid >> 1, t8 = (tid & 1) * 8;
    const float blf = sbf[15 * 132 + d], blb = sbb[d];
    u32x4 kf, kb, vv;
#pragma unroll
    for (int e2 = 0; e2 < 4; ++e2) {
      const int o0 = (t8 + 2 * e2) * 132 + d, o1 = o0 + 132;
      kf[e2] = pack2(skf[o0] * __expf(blf - sbf[o0]), skf[o1] * __expf(blf - sbf[o1]));
      kb[e2] = pack2(skb[o0] * __expf(blb - sbb[o0]), skb[o1] * __expf(blb - sbb[o1]));
      vv[e2] = pack2(sv[o0], sv[o1]);
    }
    const size_t cidx = (((size_t)(b * 8 + h) * 256 + n) * 128 + d) * 16 + t8;
    *(u32x4*)(hb.KITf + cidx) = kf; *(u32x4*)(hb.KITb + cidx) = kb; *(u32x4*)(hb.VTc + cidx) = vv;
  }
  {
    const int t = tid >> 4, s = tid & 15;
    if (s <= t) {
      float af = 0.f, ab = 0.f;
      for (int d4 = 0; d4 < 32; ++d4) {
        const f32x4 qt = *(const f32x4*)(sq + t * 132 + d4 * 4), qs = *(const f32x4*)(sq + s * 132 + d4 * 4);
        const f32x4 kfs = *(const f32x4*)(skf + s * 132 + d4 * 4), kbt = *(const f32x4*)(skb + t * 132 + d4 * 4);
        const f32x4 bft = *(const f32x4*)(sbf + t * 132 + d4 * 4), bfs = *(const f32x4*)(sbf + s * 132 + d4 * 4);
        const f32x4 bbs = *(const f32x4*)(sbb + s * 132 + d4 * 4), bbt = *(const f32x4*)(sbb + t * 132 + d4 * 4);
#pragma unroll
        for (int c = 0; c < 4; ++c) {
          af += qt[c] * kfs[c] * __expf(bft[c] - bfs[c]);
          ab += qs[c] * kbt[c] * __expf(bbs[c] - bbt[c]);
        }
      }
      if (s == t) sA[t * 17 + t] = af + ab;
      else { sA[t * 17 + s] = af; sA[s * 17 + t] = ab; }
    }
  }
  __syncthreads();
  {
    float o[8];
#pragma unroll
    for (int e = 0; e < 8; ++e) o[e] = 0.f;
#pragma unroll
    for (int s = 0; s < 16; ++s) {
      const float a = sA[row * 17 + s];
      const f32x4 v0 = *(const f32x4*)(sv + s * 132 + c8), v1 = *(const f32x4*)(sv + s * 132 + c8 + 4);
#pragma unroll
      for (int e = 0; e < 4; ++e) { o[e] += a * v0[e]; o[4 + e] += a * v1[e]; }
    }
    u32x4 r; r[0] = pack2(o[0], o[1]); r[1] = pack2(o[2], o[3]); r[2] = pack2(o[4], o[5]); r[3] = pack2(o[6], o[7]);
    *(u32x4*)(hb.OI + gidx) = r;
  }
  __syncthreads();
}

struct ScanOps { bf16x8 qa[4]; bf16x8 ka[8]; bf16x8 vb; f32x4 dc[8]; };

DI void scan_load(ScanOps& s, const u16* QI, const u16* KIT, const u16* VTc, const float* DEC, int b, int h, int vs, int n, int fr, int fq) {
  const size_t tok0 = (size_t)b * 4096 + n * 16;
  const u16* qp = QI + (tok0 + fr) * 1024 + h * 128 + fq * 4;
#pragma unroll
  for (int ks = 0; ks < 4; ++ks) s.qa[ks] = cat4(*(const bf16x4*)(qp + ks * 32), *(const bf16x4*)(qp + ks * 32 + 16));
  const size_t cb = ((size_t)(b * 8 + h) * 256 + n) * 2048;
  const int fo = (fq & 1) * 8;
#pragma unroll
  for (int dt = 0; dt < 8; ++dt) s.ka[dt] = *(const bf16x8*)(KIT + cb + (dt * 16 + fr) * 16 + fo);
  s.vb = *(const bf16x8*)(VTc + cb + (vs * 16 + fr) * 16 + fo);
  if (fq >= 2) {
    const bf16x8 z = {0, 0, 0, 0, 0, 0, 0, 0};
#pragma unroll
    for (int dt = 0; dt < 8; ++dt) s.ka[dt] = z;
    s.vb = z;
  }
  const float* dp = DEC + ((size_t)b * 256 + n) * 1024 + h * 128 + fq * 4;
#pragma unroll
  for (int dt = 0; dt < 8; ++dt) s.dc[dt] = *(const f32x4*)(dp + dt * 16);
}

DI void scan_step(f32x4 (&S)[8], const ScanOps& s, u16* Oout, int b, int h, int vs, int n, int fr, int fq) {
  f32x4 o = zero4();
#pragma unroll
  for (int ks = 0; ks < 4; ++ks) o = MFMA32(s.qa[ks], pack8(S[2 * ks], S[2 * ks + 1]), o);
  const size_t tok0 = (size_t)b * 4096 + n * 16;
#pragma unroll
  for (int j = 0; j < 4; ++j) Oout[(tok0 + fq * 4 + j) * 1024 + h * 128 + vs * 16 + fr] = (u16)f2bf(o[j]);
#pragma unroll
  for (int dt = 0; dt < 8; ++dt) { S[dt] = S[dt] * s.dc[dt]; S[dt] = MFMA32(s.ka[dt], s.vb, S[dt]); }
}

DI void hg_scan_phase(const HgBufs& hb) {
  const int lane = otid() & 63, wid = otid() >> 6, fr = lane & 15, fq = lane >> 4;
  for (int item = blockIdx.x * 4 + wid; item < 512; item += gridDim.x * 4) {
    const int vs = item & 7, dir = (item >> 3) & 1, h = (item >> 4) & 7, b = item >> 7;
    const u16* QI = dir ? hb.QIb : hb.QIf; const u16* KIT = dir ? hb.KITb : hb.KITf;
    const float* DEC = dir ? hb.DECb : hb.DECf; u16* Oout = dir ? hb.OB : hb.OF;
    f32x4 S[8];
#pragma unroll
    for (int i = 0; i < 8; ++i) S[i] = zero4();
    ScanOps s0, s1;
    scan_load(s0, QI, KIT, hb.VTc, DEC, b, h, vs, dir ? 255 : 0, fr, fq);
    for (int step = 0; step < 256; step += 2) {
      const int n0 = dir ? 255 - step : step, n1 = dir ? n0 - 1 : n0 + 1;
      scan_load(s1, QI, KIT, hb.VTc, DEC, b, h, vs, n1, fr, fq);
      scan_step(S, s0, Oout, b, h, vs, n0, fr, fq);
      if (step + 2 < 256) scan_load(s0, QI, KIT, hb.VTc, DEC, b, h, vs, dir ? n1 - 1 : n1 + 1, fr, fq);
      scan_step(S, s1, Oout, b, h, vs, n1, fr, fq);
    }
  }
}

DI void hg_combine_phase(const HgBufs& hb, const float* __restrict__ gnorm, int rows) {
  const int lane = otid() & 63, wid = otid() >> 6;
  const int h = lane >> 3, c16 = (lane & 7) * 16;
  for (int row = blockIdx.x * 4 + wid; row < rows; row += gridDim.x * 4) {
    const size_t g = (size_t)row * 1024 + h * 128 + c16;
    float o[16]; float ss = 0.f;
#pragma unroll
    for (int half = 0; half < 2; ++half) {
      const u32x4 a = *(const u32x4*)(hb.OI + g + half * 8), f = *(const u32x4*)(hb.OF + g + half * 8), bb = *(const u32x4*)(hb.OB + g + half * 8);
#pragma unroll
      for (int e = 0; e < 8; ++e) { float v = bfget(a, e) + bfget(f, e) + bfget(bb, e); o[half * 8 + e] = v; ss += v * v; }
    }
    ss += __shfl_xor(ss, 1); ss += __shfl_xor(ss, 2); ss += __shfl_xor(ss, 4);
    const float rstd = rsqrtf(ss * (1.f / 128.f) + EPS);
#pragma unroll
    for (int half = 0; half < 2; ++half) {
      const u32x4 gs = *(const u32x4*)(hb.G + g + half * 8);
      u32x4 r;
#pragma unroll
      for (int e2 = 0; e2 < 4; ++e2) {
        const int e = half * 8 + 2 * e2;
        r[e2] = pack2(o[e] * rstd * gnorm[c16 + e] * bfget(gs, 2 * e2), o[e + 1] * rstd * gnorm[c16 + e + 1] * bfget(gs, 2 * e2 + 1));
      }
      *(u32x4*)(hb.Y + g + half * 8) = r;
    }
  }
}

DI void na_attn_item(const u16* __restrict__ Q, const u16* __restrict__ K, const u16* __restrict__ VT, const float* __restrict__ rpb, u16* __restrict__ O, int item, int fr, int fq) {
  const int h = item & 15, qt = (item >> 4) & 3, r = (item >> 6) & 63, b = item >> 12;
  const int r0 = min(max(r - 4, 0), 56);
  const int cw0 = qt == 0 ? 0 : qt == 1 ? 8 : qt == 2 ? 24 : 32;
  const size_t tokq = (size_t)b * 4096 + r * 64 + qt * 16 + fr;
  bf16x8 qf[2];
#pragma unroll
  for (int ks = 0; ks < 2; ++ks) qf[ks] = *(const bf16x8*)(Q + tokq * 1024 + h * 64 + ks * 32 + fq * 8);
  f32x4 s[8][2];
#pragma unroll
  for (int kr = 0; kr < 8; ++kr)
#pragma unroll
    for (int hf = 0; hf < 2; ++hf) {
      const size_t tokk = (size_t)b * 4096 + (r0 + kr) * 64 + cw0 + hf * 16 + fr;
      const bf16x8 k0 = *(const bf16x8*)(K + tokk * 1024 + h * 64 + fq * 8);
      const bf16x8 k1 = *(const bf16x8*)(K + tokk * 1024 + h * 64 + 32 + fq * 8);
      f32x4 a = MFMA32(k0, qf[0], zero4());
      s[kr][hf] = MFMA32(k1, qf[1], a);
    }
  const int qc = qt * 16 + fr;
  const int cs = min(max(qc - 8, 0), 48);
  float mx = -1e30f;
#pragma unroll
  for (int kr = 0; kr < 8; ++kr) {
    const float* rp = rpb + (h * 15 + (r0 + kr - r + 7)) * 31;
#pragma unroll
    for (int hf = 0; hf < 2; ++hf)
#pragma unroll
      for (int j = 0; j < 4; ++j) {
        const int kc = cw0 + hf * 16 + fq * 4 + j;
        const bool valid = (kc >= cs) && (kc < cs + 16);
        const int ci = min(max(kc - qc + 15, 0), 30);
        const float v = valid ? s[kr][hf][j] + rp[ci] * LOG2E : -1e30f;
        s[kr][hf][j] = v; mx = fmaxf(mx, v);
      }
  }
  mx = fmaxf(mx, __shfl_xor(mx, 16)); mx = fmaxf(mx, __shfl_xor(mx, 32));
  float l = 0.f;
#pragma unroll
  for (int kr = 0; kr < 8; ++kr)
#pragma unroll
    for (int hf = 0; hf < 2; ++hf)
#pragma unroll
      for (int j = 0; j < 4; ++j) { const float pv = exp2f(s[kr][hf][j] - mx); s[kr][hf][j] = pv; l += pv; }
  l += __shfl_xor(l, 16); l += __shfl_xor(l, 32);
  f32x4 o[4];
#pragma unroll
  for (int dt = 0; dt < 4; ++dt) o[dt] = zero4();
#pragma unroll
  for (int kr = 0; kr < 8; ++kr) {
    const bf16x8 pp = pack8(s[kr][0], s[kr][1]);
#pragma unroll
    for (int dt = 0; dt < 4; ++dt) {
      const u16* vp = VT + ((size_t)((b * 16 + h) * 64 + dt * 16 + fr)) * 4096 + (r0 + kr) * 64 + cw0 + fq * 4;
      const bf16x8 vf = cat4(*(const bf16x4*)vp, *(const bf16x4*)(vp + 16));
      o[dt] = MFMA32(vf, pp, o[dt]);
    }
  }
  const float inv = 1.f / l;
#pragma unroll
  for (int dt = 0; dt < 4; ++dt) *(u32x2*)(O + tokq * 1024 + h * 64 + dt * 16 + fq * 4) = pack4(o[dt] * inv);
}

DI void mla_norm_phase(const u16* __restrict__ CRAW, const float* __restrict__ gq, const float* __restrict__ gkv, u16* __restrict__ CQN, u16* __restrict__ CKVN, float* __restrict__ KROPE) {
  const int lane = otid() & 63, wid = otid() >> 6;
  for (int row = blockIdx.x * 4 + wid; row < MTOK; row += gridDim.x * 4) {
    const u16* c = CRAW + (size_t)row * 1056;
    f32x4 v[3]; float ss = 0.f;
#pragma unroll
    for (int i = 0; i < 3; ++i) {
      const u32x2 w = *(const u32x2*)(c + i * 256 + lane * 4);
      v[i][0] = bflo(w[0]); v[i][1] = bfhi(w[0]); v[i][2] = bflo(w[1]); v[i][3] = bfhi(w[1]);
      ss += v[i][0] * v[i][0] + v[i][1] * v[i][1] + v[i][2] * v[i][2] + v[i][3] * v[i][3];
    }
    ss = wave_sum(ss);
    const float rq = rsqrtf(ss * (1.f / 768.f) + EPS);
#pragma unroll
    for (int i = 0; i < 3; ++i) {
      const f32x4 g4 = *(const f32x4*)(gq + i * 256 + lane * 4);
      *(u32x2*)(CQN + (size_t)row * 768 + i * 256 + lane * 4) = pack4(v[i] * rq * g4);
    }
    {
      const u32x2 w = *(const u32x2*)(c + 768 + lane * 4);
      f32x4 k; k[0] = bflo(w[0]); k[1] = bfhi(w[0]); k[2] = bflo(w[1]); k[3] = bfhi(w[1]);
      float s2 = wave_sum(k[0] * k[0] + k[1] * k[1] + k[2] * k[2] + k[3] * k[3]);
      const float rk = rsqrtf(s2 * (1.f / 256.f) + EPS);
      const f32x4 g4 = *(const f32x4*)(gkv + lane * 4);
      *(u32x2*)(CKVN + (size_t)row * 256 + lane * 4) = pack4(k * rk * g4);
    }
    if (lane < 8) {
      const u32x2 w = *(const u32x2*)(c + 1024 + lane * 4);
      f32x4 k; k[0] = bflo(w[0]); k[1] = bfhi(w[0]); k[2] = bflo(w[1]); k[3] = bfhi(w[1]);
      *(f32x4*)(KROPE + (size_t)row * 32 + lane * 4) = k;
    }
  }
}

DI void mla_prep_phase(u16* __restrict__ Q, const u16* __restrict__ KVRAW, const float* __restrict__ KROPE, u16* __restrict__ Kout,
                       const float* __restrict__ gq, const float* __restrict__ gk, const float* __restrict__ RC, const float* __restrict__ RS) {
  const int lane = otid() & 63, wid = otid() >> 6;
  const int h = lane >> 2, sub = lane & 3;
  const float QS = 0.10206207261596577f * LOG2E;
  for (int m = blockIdx.x * 4 + wid; m < MTOK; m += gridDim.x * 4) {
    const int t = m & 4095;
    const f32x4 cs = *(const f32x4*)(RC + t * 16 + sub * 4), sn = *(const f32x4*)(RS + t * 16 + sub * 4);
#pragma unroll
    for (int which = 0; which < 2; ++which) {
      float nope[16]; f32x4 ra, rb;
      u16* dstp = (which == 0 ? Q : Kout) + (size_t)m * 1536 + h * 96;
      const float* gn = which == 0 ? gq : gk;
      if (which == 0) {
        const u32x4 w0 = *(const u32x4*)(dstp + sub * 16), w1 = *(const u32x4*)(dstp + sub * 16 + 8);
#pragma unroll
        for (int e = 0; e < 8; ++e) { nope[e] = bfget(w0, e); nope[8 + e] = bfget(w1, e); }
        const u32x2 a2 = *(const u32x2*)(dstp + 64 + sub * 4), b2 = *(const u32x2*)(dstp + 80 + sub * 4);
        ra[0] = bflo(a2[0]); ra[1] = bfhi(a2[0]); ra[2] = bflo(a2[1]); ra[3] = bfhi(a2[1]);
        rb[0] = bflo(b2[0]); rb[1] = bfhi(b2[0]); rb[2] = bflo(b2[1]); rb[3] = bfhi(b2[1]);
      } else {
        const u16* kp = KVRAW + (size_t)m * 2048 + h * 128 + sub * 16;
        const u32x4 w0 = *(const u32x4*)kp, w1 = *(const u32x4*)(kp + 8);
#pragma unroll
        for (int e = 0; e < 8; ++e) { nope[e] = bfget(w0, e); nope[8 + e] = bfget(w1, e); }
        ra = *(const f32x4*)(KROPE + (size_t)m * 32 + sub * 4);
        rb = *(const f32x4*)(KROPE + (size_t)m * 32 + 16 + sub * 4);
      }
      float ss = 0.f;
#pragma unroll
      for (int e = 0; e < 16; ++e) ss += nope[e] * nope[e];
#pragma unroll
      for (int e = 0; e < 4; ++e) ss += ra[e] * ra[e] + rb[e] * rb[e];
      ss += __shfl_xor(ss, 1); ss += __shfl_xor(ss, 2);
      const float rstd = rsqrtf(ss * (1.f / 96.f) + EPS) * (which == 0 ? QS : 1.f);
      u32x4 o0, o1;
#pragma unroll
      for (int e2 = 0; e2 < 4; ++e2) {
        o0[e2] = pack2(nope[2 * e2] * rstd * gn[sub * 16 + 2 * e2], nope[2 * e2 + 1] * rstd * gn[sub * 16 + 2 * e2 + 1]);
        o1[e2] = pack2(nope[8 + 2 * e2] * rstd * gn[sub * 16 + 8 + 2 * e2], nope[9 + 2 * e2] * rstd * gn[sub * 16 + 9 + 2 * e2]);
      }
      f32x4 oa, ob;
#pragma unroll
      for (int e = 0; e < 4; ++e) {
        const float a = ra[e] * rstd * gn[64 + sub * 4 + e], bq = rb[e] * rstd * gn[80 + sub * 4 + e];
        oa[e] = a * cs[e] - bq * sn[e];
        ob[e] = bq * cs[e] + a * sn[e];
      }
      *(u32x4*)(dstp + sub * 16) = o0; *(u32x4*)(dstp + sub * 16 + 8) = o1;
      *(u32x2*)(dstp + 64 + sub * 4) = pack4(oa); *(u32x2*)(dstp + 80 + sub * 4) = pack4(ob);
    }
  }
}

DI void mla_vt_phase(const u16* __restrict__ KVRAW, u16* __restrict__ VT, char* smem) {
  u16* tile = (u16*)smem;
  const int tid = otid();
  for (int item = blockIdx.x; item < 8192; item += gridDim.x) {
    const int tt = item & 63, bh = item >> 6, b = bh >> 4, h = bh & 15;
    {
      const int row = tid >> 2, part = tid & 3;
      const u16* src = KVRAW + ((size_t)b * 4096 + tt * 64 + row) * 2048 + h * 128 + 64 + part * 16;
      const u32x4 w0 = *(const u32x4*)src, w1 = *(const u32x4*)(src + 8);
      u32* d32 = (u32*)(tile + row * 66 + part * 16);
#pragma unroll
      for (int e = 0; e < 4; ++e) { d32[e] = w0[e]; d32[4 + e] = w1[e]; }
    }
    __syncthreads();
    {
      const int d = tid >> 2, tp = (tid & 3) * 16;
      u32x4 o0, o1;
#pragma unroll
      for (int e2 = 0; e2 < 4; ++e2) {
        o0[e2] = (u32)tile[(tp + 2 * e2) * 66 + d] | ((u32)tile[(tp + 2 * e2 + 1) * 66 + d] << 16);
        o1[e2] = (u32)tile[(tp + 8 + 2 * e2) * 66 + d] | ((u32)tile[(tp + 9 + 2 * e2) * 66 + d] << 16);
      }
      u16* dst = VT + ((size_t)(bh * 64 + d)) * 4096 + tt * 64 + tp;
      *(u32x4*)dst = o0; *(u32x4*)(dst + 8) = o1;
    }
    __syncthreads();
  }
}

constexpr int FA_KROW = 208, FA_VROW = 144, FA_KT = 64 * FA_KROW, FA_BUF = FA_KT + 64 * FA_VROW;
DI void mla_attn_item(const u16* __restrict__ Q, const u16* __restrict__ Kb, const u16* __restrict__ VT, u16* __restrict__ O, int item, char* smem) {
  const int qb = item & 31, bh = item >> 5, b = bh >> 4, h = bh & 15;
  const int tid = otid(), lane = tid & 63, wid = tid >> 6, fr = lane & 15, fq = lane >> 4;
  bf16x8 qf[2][3];
#pragma unroll
  for (int qt = 0; qt < 2; ++qt) {
    const size_t tq = (size_t)b * 4096 + qb * 128 + wid * 32 + qt * 16 + fr;
#pragma unroll
    for (int ks = 0; ks < 3; ++ks) qf[qt][ks] = *(const bf16x8*)(Q + tq * 1536 + h * 96 + ks * 32 + fq * 8);
  }
  f32x4 o[4][2];
#pragma unroll
  for (int i = 0; i < 4; ++i) { o[i][0] = zero4(); o[i][1] = zero4(); }
  float mrun[2] = {-1e30f, -1e30f}, lrun[2] = {0.f, 0.f};
  const u16* kg[3]; int ks_off[3];
#pragma unroll
  for (int i = 0; i < 3; ++i) {
    const int c = tid + 256 * i, row = c / 12, kc = c % 12;
    kg[i] = Kb + ((size_t)b * 4096 + row) * 1536 + h * 96 + kc * 8;
    ks_off[i] = row * FA_KROW + kc * 16;
  }
  const u16* vg[2]; int vs_off[2];
#pragma unroll
  for (int i = 0; i < 2; ++i) {
    const int c = tid + 256 * i, d = c >> 3, kc = c & 7;
    vg[i] = VT + ((size_t)(bh * 64 + d)) * 4096 + kc * 8;
    vs_off[i] = FA_KT + d * FA_VROW + kc * 16;
  }
  u32x4 rk[3], rv[2];
#pragma unroll
  for (int i = 0; i < 3; ++i) rk[i] = *(const u32x4*)(kg[i]);
#pragma unroll
  for (int i = 0; i < 2; ++i) rv[i] = *(const u32x4*)(vg[i]);
#pragma unroll
  for (int i = 0; i < 3; ++i) *(u32x4*)(smem + ks_off[i]) = rk[i];
#pragma unroll
  for (int i = 0; i < 2; ++i) *(u32x4*)(smem + vs_off[i]) = rv[i];
  __syncthreads();
  for (int kt = 0; kt < 64; ++kt) {
    const int cur = (kt & 1) * FA_BUF, nxt = FA_BUF - cur;
    if (kt + 1 < 64) {
      const size_t key0 = (size_t)(kt + 1) * 64;
#pragma unroll
      for (int i = 0; i < 3; ++i) rk[i] = *(const u32x4*)(kg[i] + key0 * 1536);
#pragma unroll
      for (int i = 0; i < 2; ++i) rv[i] = *(const u32x4*)(vg[i] + key0);
    }
    f32x4 s[4][2];
#pragma unroll
    for (int k4 = 0; k4 < 4; ++k4) {
      s[k4][0] = zero4(); s[k4][1] = zero4();
#pragma unroll
      for (int ks = 0; ks < 3; ++ks) {
        const bf16x8 kf = *(const bf16x8*)(smem + cur + (k4 * 16 + fr) * FA_KROW + ks * 64 + fq * 16);
        s[k4][0] = MFMA32(kf, qf[0][ks], s[k4][0]);
        s[k4][1] = MFMA32(kf, qf[1][ks], s[k4][1]);
      }
    }
    bf16x8 pp[2][2];
#pragma unroll
    for (int qt = 0; qt < 2; ++qt) {
      float mx = -1e30f;
#pragma unroll
      for (int k4 = 0; k4 < 4; ++k4)
#pragma unroll
        for (int j = 0; j < 4; ++j) mx = fmaxf(mx, s[k4][qt][j]);
      mx = fmaxf(mx, __shfl_xor(mx, 16)); mx = fmaxf(mx, __shfl_xor(mx, 32));
      const float mnew = fmaxf(mrun[qt], mx);
      const float alpha = exp2f(mrun[qt] - mnew);
      mrun[qt] = mnew;
      float ps = 0.f;
#pragma unroll
      for (int k4 = 0; k4 < 4; ++k4)
#pragma unroll
        for (int j = 0; j < 4; ++j) { const float pv = exp2f(s[k4][qt][j] - mnew); s[k4][qt][j] = pv; ps += pv; }
      lrun[qt] = lrun[qt] * alpha + ps;
#pragma unroll
      for (int dt = 0; dt < 4; ++dt) o[dt][qt] = o[dt][qt] * alpha;
      pp[qt][0] = pack8(s[0][qt], s[1][qt]);
      pp[qt][1] = pack8(s[2][qt], s[3][qt]);
    }
#pragma unroll
    for (int dt = 0; dt < 4; ++dt)
#pragma unroll
      for (int a = 0; a < 2; ++a) {
        const char* vp = smem + cur + FA_KT + (dt * 16 + fr) * FA_VROW + (a * 32 + fq * 4) * 2;
        const bf16x8 vf = cat4(*(const bf16x4*)vp, *(const bf16x4*)(vp + 32));
        o[dt][0] = MFMA32(vf, pp[0][a], o[dt][0]);
        o[dt][1] = MFMA32(vf, pp[1][a], o[dt][1]);
      }
    if (kt + 1 < 64) {
#pragma unroll
      for (int i = 0; i < 3; ++i) *(u32x4*)(smem + nxt + ks_off[i]) = rk[i];
#pragma unroll
      for (int i = 0; i < 2; ++i) *(u32x4*)(smem + nxt + vs_off[i]) = rv[i];
    }
    __syncthreads();
  }
#pragma unroll
  for (int qt = 0; qt < 2; ++qt) {
    float l = lrun[qt];
    l += __shfl_xor(l, 16); l += __shfl_xor(l, 32);
    const float inv = 1.f / l;
    const size_t tq = (size_t)b * 4096 + qb * 128 + wid * 32 + qt * 16 + fr;
#pragma unroll
    for (int dt = 0; dt < 4; ++dt) *(u32x2*)(O + tq * 1024 + h * 64 + dt * 16 + fq * 4) = pack4(o[dt][qt] * inv);
  }
}

#define XB_TMO      128
#define XB_XCNT(j)  (256  + 64 * (j))
#define XB_XSUB(j)  (1280 + 64 * (j))
#define XB_XGEN(j)  (2304 + 64 * (j))
#define XB_TOP      3328
#define XB_TOPGEN   3392
#define XCD_BAR_WORDS 3456
#define XB_SPIN_CAP (1u << 22)
DI unsigned xb_ld(unsigned* p) { return __hip_atomic_load(p, __ATOMIC_RELAXED, __HIP_MEMORY_SCOPE_AGENT); }
DI unsigned xb_add(unsigned* p, unsigned v) { return __hip_atomic_fetch_add(p, v, __ATOMIC_RELAXED, __HIP_MEMORY_SCOPE_AGENT); }
DI unsigned xb_xcc_id() { return (unsigned)__builtin_amdgcn_s_getreg((3 << 11) | 20) & 0xFu; }
#define XB_SPIN(cond, bar) do { unsigned _sp = 0; while (cond) { __builtin_amdgcn_s_sleep(1); \
    if ((++_sp & 255u) == 0u) { if (xb_ld(&(bar)[XB_TMO])) break; if (_sp > XB_SPIN_CAP) { atomicAdd(&(bar)[XB_TMO], 1u); break; } } } } while (0)

DI void xcd_barrier_complete(unsigned* bar, unsigned x, unsigned& nloc, unsigned& nx) {
  const unsigned G = gridDim.x;
  unsigned sum, cnt, mine, sp = 0u;
  for (;;) {
    sum = 0u; cnt = 0u; mine = 0u;
#pragma unroll
    for (unsigned j = 0; j < 16; ++j) { const unsigned c = xb_ld(&bar[XB_XCNT(j)]); sum += c; cnt += (c > 0u) ? 1u : 0u; mine = (j == x) ? c : mine; }
    if (sum == G) break;
    __builtin_amdgcn_s_sleep(1);
    if ((++sp & 255u) == 0u) { if (xb_ld(&bar[XB_TMO])) break; if (sp > XB_SPIN_CAP) { atomicAdd(&bar[XB_TMO], 1u); break; } }
  }
  nloc = mine > 0u ? mine : 1u; nx = cnt > 0u ? cnt : 1u;
}

DI void xcd_barrier(unsigned* bar, volatile unsigned* st) {
  asm volatile("s_waitcnt vmcnt(0)" ::: "memory");
  __syncthreads();
  if (threadIdx.x == 0) {
    __builtin_amdgcn_s_waitcnt(0);
    const unsigned x = xb_xcc_id();
    unsigned nloc = st[0], nx = st[1];
    if (nloc == 0u) { xcd_barrier_complete(bar, x, nloc, nx); st[0] = nloc; st[1] = nx; }
    const unsigned old = xb_add(&bar[XB_XSUB(x)], 1u);
    const unsigned gen = old / nloc;
    if (old + 1u == (gen + 1u) * nloc) {
      __builtin_amdgcn_fence(__ATOMIC_RELEASE, "agent");
      asm volatile("s_waitcnt vmcnt(0)" ::: "memory");
      const unsigned og = xb_add(&bar[XB_TOP], 1u);
      const unsigned tg = og / nx;
      if (og + 1u == (tg + 1u) * nx) xb_add(&bar[XB_TOPGEN], 1u);
      else XB_SPIN(xb_ld(&bar[XB_TOPGEN]) == tg, bar);
      __builtin_amdgcn_fence(__ATOMIC_ACQUIRE, "agent");
      xb_add(&bar[XB_XGEN(x)], 1u);
      asm volatile("s_waitcnt vmcnt(0)" ::: "memory");
    } else {
      XB_SPIN(xb_ld(&bar[XB_XGEN(x)]) == gen, bar);
      __builtin_amdgcn_fence(__ATOMIC_ACQUIRE, "agent");
      asm volatile("s_waitcnt vmcnt(0)" ::: "memory");
    }
  }
  __syncthreads();
}

#ifndef ENMASK
#define ENMASK 0xffffffffu
#endif
#define EN(i) ((ENMASK >> (i)) & 1u)
#define PHASE_BEGIN(i) if (EN(i) && pc >= p.lo && pc < p.hi) {
#define PHASE_END } { if (pc >= p.lo && pc + 1 < p.hi) { if (pc == p.lo) grid.sync(); else xcd_barrier(bar, st); } ++pc; }

__global__ void __launch_bounds__(256, 2) mega(Params p) {
  __shared__ __attribute__((aligned(16))) char smem[73728 + 16];
  cg::grid_group grid = cg::this_grid();
  int pc = 0;
  char* ws = p.ws;
  unsigned* bar = (unsigned*)(ws + OFF_BAR);
  volatile unsigned* st = (volatile unsigned*)(smem + 73728);
  if (threadIdx.x == 0) { st[0] = 0u; st[1] = 0u; (void)xb_add(&bar[XB_XCNT(xb_xcc_id())], 1u); }
  __syncthreads();
  u16* H = (u16*)(ws + OFF_H);
  char* R = ws + OFF_R;
  const float* LB = (const float*)(ws + OFF_TAB);
  const float* RC = LB + 4096; const float* RS = RC + 65536;
  for (int layer = 0; layer < 4; ++layer) {
    const int kind = layer % 3, mi = layer / 3;
    for (int stage = 0; stage < 3; ++stage) {
      if (stage != 1) {
        const float* ng = (stage == 0 ? p.ffn1_norm : p.ffn2_norm) + layer * 1024;
        const u16* wgu = (const u16*)(ws + (stage == 0 ? OFF_WGU1 : OFF_WGU2));
        const u16* wdn = (const u16*)(ws + (stage == 0 ? OFF_WDN1 : OFF_WDN2));
        u16* ACT = (u16*)R;
        PHASE_BEGIN(0)
          const bool first = (layer == 0 && stage == 0);
          if (stage == 0) { if (layer == 0) init_tables(p); cvt_layer(p, layer, smem); }
          norm_phase(first ? p.x : p.X, ng, H, first ? p.X : nullptr, MTOK);
        PHASE_END
        PHASE_BEGIN(1)
          gemm_phase(H, 1024, wgu, 1024, MTOK, 5632, EpiSwiglu{ACT}, smem);
        PHASE_END
        PHASE_BEGIN(2)
          gemm_phase(ACT, 2816, wdn, 2816, MTOK, 1024, EpiResid{p.X, 0.5f}, smem);
        PHASE_END
      } else {
        PHASE_BEGIN(3)
          norm_phase(p.X, p.mix_norm + layer * 1024, H, nullptr, MTOK);
        PHASE_END
        if (kind == 0) {
          constexpr size_t SZ = 32 * MiB;
          HgBufs hb;
          hb.Q = (u16*)(R + 0 * SZ); hb.LFf = (u16*)(R + 1 * SZ); hb.LFb = (u16*)(R + 2 * SZ); hb.V = (u16*)(R + 3 * SZ); hb.G = (u16*)(R + 4 * SZ);
          hb.QIf = (u16*)(R + 5 * SZ); hb.QIb = (u16*)(R + 6 * SZ); hb.KITf = (u16*)(R + 7 * SZ); hb.KITb = (u16*)(R + 8 * SZ);
          hb.VTc = (u16*)(R + 9 * SZ); hb.OI = (u16*)(R + 10 * SZ); hb.OF = hb.Q; hb.OB = hb.LFf; hb.Y = hb.LFb;
          hb.DECf = (float*)(R + 11 * SZ); hb.DECb = (float*)(R + 11 * SZ + 4 * MiB);
          const u16* w_in = (const u16*)(ws + OFF_WMIX); const u16* w_out = (const u16*)(ws + OFF_WMIX + 10485760);
          for (int half = 0; half < 2; ++half) {
            PHASE_BEGIN(4)
              gemm_phase(H + (size_t)half * 16384 * 1024, 1024, w_in, 1024, 16384, 5120, EpiHgIn{hb.Q, hb.LFf, hb.LFb, hb.V, hb.G, LB + layer * 1024}, smem);
            PHASE_END
            PHASE_BEGIN(5)
              for (int item = blockIdx.x; item < 8192; item += gridDim.x) hg_prep_item(hb, item, smem);
            PHASE_END
            PHASE_BEGIN(6)
              hg_scan_phase(hb);
            PHASE_END
            PHASE_BEGIN(7)
              hg_combine_phase(hb, p.hg_g_norm + mi * 128, 16384);
            PHASE_END
            PHASE_BEGIN(8)
              gemm_phase(hb.Y, 1024, w_out, 1024, 16384, 1024, EpiResid{p.X + (size_t)half * 16384 * 1024, 1.0f}, smem);
            PHASE_END
          }
        } else if (kind == 1) {
          u16* Qn = (u16*)R; u16* Kn = (u16*)(R + 64 * MiB); u16* VT = (u16*)(R + 128 * MiB); u16* On = (u16*)(R + 192 * MiB);
          const u16* w_in = (const u16*)(ws + OFF_WMIX); const u16* w_out = (const u16*)(ws + OFF_WMIX + 6291456);
          PHASE_BEGIN(9)
            gemm_phase(H, 1024, w_in, 1024, MTOK, 3072, EpiNaIn{Qn, Kn, VT, p.na_q_norm + mi * 64, p.na_k_norm + mi * 64}, smem);
          PHASE_END
          PHASE_BEGIN(10)
            const int tid_ = otid(), lane = tid_ & 63, wid = tid_ >> 6, fr = lane & 15, fq = lane >> 4;
            for (int item = blockIdx.x * 4 + wid; item < 32768; item += gridDim.x * 4)
              na_attn_item(Qn, Kn, VT, p.na_rpb + (size_t)mi * 16 * 15 * 31, On, item, fr, fq);
          PHASE_END
          PHASE_BEGIN(11)
            gemm_phase(On, 1024, w_out, 1024, MTOK, 1024, EpiResid{p.X, 1.0f}, smem);
          PHASE_END
        } else {
          u16* VT = H;
          u16* CRAW = (u16*)R; u16* On = (u16*)R;
          u16* CQN = (u16*)(R + 66 * MiB); u16* CKVN = (u16*)(R + 114 * MiB); u16* Kk = (u16*)(R + 66 * MiB);
          float* KROPE = (float*)(R + 162 * MiB);
          u16* Qq = (u16*)(R + 166 * MiB); u16* KVRAW = (u16*)(R + 262 * MiB);
          const u16* w_in = (const u16*)(ws + OFF_WMIX); const u16* w_uq = (const u16*)(ws + OFF_WMIX + 2359296);
          const u16* w_ukv = (const u16*)(ws + OFF_WMIX + 4718592); const u16* w_out = (const u16*)(ws + OFF_WMIX + 5767168);
          PHASE_BEGIN(12)
            gemm_phase(H, 1024, w_in, 1024, MTOK, 1152, EpiStore{CRAW, 1056, 1056}, smem);
          PHASE_END
          PHASE_BEGIN(13)
            mla_norm_phase(CRAW, p.mla_q_a_norm + mi * 768, p.mla_kv_a_norm + mi * 256, CQN, CKVN, KROPE);
          PHASE_END
          PHASE_BEGIN(14)
            gemm_phase(CQN, 768, w_uq, 768, MTOK, 1536, EpiStore{Qq, 1536, 1536}, smem);
            gemm_phase(CKVN, 256, w_ukv, 256, MTOK, 2048, EpiStore{KVRAW, 2048, 2048}, smem);
          PHASE_END
          PHASE_BEGIN(15)
            mla_prep_phase(Qq, KVRAW, KROPE, Kk, p.mla_q_norm + mi * 96, p.mla_k_norm + mi * 96, RC, RS);
            mla_vt_phase(KVRAW, VT, smem);
          PHASE_END
          PHASE_BEGIN(16)
            for (int item = blockIdx.x; item < 4096; item += gridDim.x) mla_attn_item(Qq, Kk, VT, On, item, smem);
          PHASE_END
          PHASE_BEGIN(17)
            gemm_phase(On, 1024, w_out, 1024, MTOK, 1024, EpiResid{p.X, 1.0f}, smem);
          PHASE_END
        }
      }
    }
  }
}

static int count_phases() {
  int n = 0;
  for (int layer = 0; layer < 4; ++layer) {
    int kind = layer % 3;
    n += 3 + 3 + 1;
    n += kind == 0 ? 10 : kind == 1 ? 3 : 6;
  }
  return n;
}

extern "C" void kernel_launch(void* const* d_in, const int* in_sizes, int n_in, void* d_out, int out_size, void* d_ws, size_t ws_size, hipStream_t stream) {
  if (ws_size < WS_NEED) { fprintf(stderr, "workspace too small: %zu < %zu\n", ws_size, WS_NEED); return; }
  static int grid_blocks = 0;
  if (!grid_blocks) {
    int dev = 0, cus = 0, per_cu = 0;
    hipGetDevice(&dev);
    hipDeviceGetAttribute(&cus, hipDeviceAttributeMultiprocessorCount, dev);
    hipOccupancyMaxActiveBlocksPerMultiprocessor(&per_cu, mega, 256, 0);
    if (per_cu > 2) per_cu = 2;
    grid_blocks = cus * per_cu;
  }
  Params p{};
  const float** pf = (const float**)&p;
  for (int i = 0; i < 25; ++i) pf[i] = (const float*)d_in[i];
  p.X = (float*)d_out; p.ws = (char*)d_ws;
  const int total = count_phases();
#if MULTI_LAUNCH
  for (int ph = 0; ph < total; ++ph) {
    p.lo = ph; p.hi = ph + 1;
    hipLaunchKernelGGL(mega, dim3(grid_blocks), dim3(256), 0, stream, p);
  }
#else
  hipMemsetAsync((char*)d_ws + OFF_BAR, 0, 16384, stream);
  p.lo = 0; p.hi = total;
  void* args[] = {&p};
  hipError_t e = hipLaunchCooperativeKernel((void*)mega, dim3(grid_blocks), dim3(256), args, 0, stream);
  if (e != hipSuccess) fprintf(stderr, "cooperative launch failed: %s (grid %d)\n", hipGetErrorString(e), grid_blocks);
#endif
}
```

```cpp
#include <hip/hip_runtime.h>
#include <hip/hip_cooperative_groups.h>
#include <cstdio>
#include <cstdint>
namespace cg = cooperative_groups;

#ifndef MULTI_LAUNCH
#define MULTI_LAUNCH 0
#endif

typedef unsigned short u16;
typedef unsigned int u32;
using bf16x8 = __attribute__((ext_vector_type(8))) short;
using bf16x4 = __attribute__((ext_vector_type(4))) short;
using f32x4 = __attribute__((ext_vector_type(4))) float;
using u32x2 = __attribute__((ext_vector_type(2))) unsigned int;
using u32x4 = __attribute__((ext_vector_type(4))) unsigned int;

#define DI __device__ __forceinline__
#define MFMA32(a, b, c) __builtin_amdgcn_mfma_f32_16x16x32_bf16((a), (b), (c), 0, 0, 0)

constexpr int MTOK = 32768;
constexpr float EPS = 1e-6f;
constexpr float LOG2E = 1.4426950408889634f;

constexpr size_t MiB = 1048576;
constexpr size_t OFF_WGU1 = 0;
constexpr size_t OFF_WDN1 = 11534336;
constexpr size_t OFF_WGU2 = 17301504;
constexpr size_t OFF_WDN2 = 28835840;
constexpr size_t OFF_WMIX = 34603008;
constexpr size_t OFF_TAB = 47185920;
constexpr size_t OFF_BAR = OFF_TAB + 786432;
constexpr size_t OFF_H = 46 * MiB;
constexpr size_t OFF_R = 110 * MiB;
constexpr size_t WS_NEED = 500 * MiB;

struct Params {
  const float* x; const float* ffn1_norm; const float* ffn1_w_gu; const float* ffn1_w_down;
  const float* mix_norm; const float* ffn2_norm; const float* ffn2_w_gu; const float* ffn2_w_down;
  const float* hg_lb_logits; const float* hg_w_in; const float* hg_g_norm; const float* hg_w_out;
  const float* na_w_in; const float* na_q_norm; const float* na_k_norm; const float* na_rpb; const float* na_w_out;
  const float* mla_w_in; const float* mla_q_a_norm; const float* mla_w_uq; const float* mla_kv_a_norm; const float* mla_w_ukv;
  const float* mla_q_norm; const float* mla_k_norm; const float* mla_w_out;
  float* X; char* ws; int lo; int hi;
};

DI u32 f2bf(float x) { u32 u = __float_as_uint(x); u += 0x7fffu + ((u >> 16) & 1u); return u >> 16; }
typedef __bf16 bf16v2 __attribute__((ext_vector_type(2)));
typedef float f32v2 __attribute__((ext_vector_type(2)));
DI u32 pack2(float a, float b) { f32v2 v = {a, b}; bf16v2 r = __builtin_convertvector(v, bf16v2); return __builtin_bit_cast(u32, r); }
DI float bflo(u32 w) { return __uint_as_float(w << 16); }
DI float bfhi(u32 w) { return __uint_as_float(w & 0xffff0000u); }
DI float bfget(const u32x4& v, int e) { u32 w = v[e >> 1]; return (e & 1) ? bfhi(w) : bflo(w); }
DI u32x2 pack4(const f32x4& v) { u32x2 r; r[0] = pack2(v[0], v[1]); r[1] = pack2(v[2], v[3]); return r; }
DI bf16x8 pack8(const f32x4& a, const f32x4& b) {
  u32x4 r; r[0] = pack2(a[0], a[1]); r[1] = pack2(a[2], a[3]); r[2] = pack2(b[0], b[1]); r[3] = pack2(b[2], b[3]);
  return __builtin_bit_cast(bf16x8, r);
}
DI bf16x8 cat4(const bf16x4& lo, const bf16x4& hi) { return __builtin_shufflevector(lo, hi, 0, 1, 2, 3, 4, 5, 6, 7); }
DI float wave_sum(float v) {
#pragma unroll
  for (int o = 32; o > 0; o >>= 1) v += __shfl_xor(v, o);
  return v;
}
DI float sigmoidf_(float z) { return 1.f / (1.f + __expf(-z)); }
DI float siluf_(float z) { return z / (1.f + __expf(-z)); }
DI int otid() { int t = threadIdx.x; asm volatile("" : "+v"(t)); return t; }
DI f32x4 zero4() { f32x4 z = {0.f, 0.f, 0.f, 0.f}; return z; }

DI void init_tables(const Params& p) {
  float* LB = (float*)(p.ws + OFF_TAB); float* RC = LB + 4096; float* RS = RC + 65536;
  const int gt = blockIdx.x * 256 + otid(), gs = gridDim.x * 256;
  for (int c = gt; c < 1024; c += gs) {
    float l0 = p.hg_lb_logits[c], l1 = p.hg_lb_logits[1024 + c], l2 = p.hg_lb_logits[2048 + c], l3 = p.hg_lb_logits[3072 + c];
    float mx = fmaxf(fmaxf(l0, l1), fmaxf(l2, l3));
    float e0 = expf(l0 - mx), e1 = expf(l1 - mx), e2 = expf(l2 - mx), e3 = expf(l3 - mx);
    float inv = 1.f / (e0 + e1 + e2 + e3);
    LB[c] = 0.f; LB[1024 + c] = e1 * inv; LB[2048 + c] = (e1 + e2) * inv; LB[3072 + c] = (e1 + e2 + e3) * inv;
  }
  for (int i = gt; i < 65536; i += gs) {
    int t = i >> 4, j = i & 15;
    float inv = exp2f(-(float)j * (13.287712379549449f / 16.f));
    float ang = (float)t * inv;
    double a = (double)ang;
    double k = rint(a * 0.15915494309189535);
    float r = (float)(a - k * 6.283185307179586);
    RC[i] = __cosf(r); RS[i] = __sinf(r);
  }
}

DI void cvt_tiles(const float* __restrict__ src, u16* __restrict__ dst, int K, int N, int Nd, int mode, char* smem) {
  float* tile = (float*)smem;
  const int tk = K >> 6, tn = Nd >> 6, tid = otid();
  for (int t = blockIdx.x; t < tk * tn; t += gridDim.x) {
    const int k0 = (t % tk) << 6, n0 = (t / tk) << 6;
    {
      const int nl = tid & 63, kq = tid >> 6;
      const int nd = n0 + nl;
      int col = nd;
      if (mode == 1) { int a = nd >> 5, r = nd & 31; col = a * 16 + (r & 15) + ((r >= 16) ? 2816 : 0); }
      const bool ok = col < N;
#pragma unroll
      for (int i = 0; i < 16; ++i) {
        int kl = kq + 4 * i;
        tile[kl * 65 + nl] = ok ? src[(size_t)(k0 + kl) * N + col] : 0.f;
      }
    }
    __syncthreads();
    {
      const int kp = (tid & 31) * 2, nq = tid >> 5;
#pragma unroll
      for (int i = 0; i < 8; ++i) {
        int n = nq + 8 * i;
        *(u32*)(dst + (size_t)(n0 + n) * K + k0 + kp) = pack2(tile[kp * 65 + n], tile[(kp + 1) * 65 + n]);
      }
    }
    __syncthreads();
  }
}

DI void cvt_layer(const Params& p, int layer, char* smem) {
  const int kind = layer % 3, mi = layer / 3;
  char* ws = p.ws;
  for (int task = 0; task < 8; ++task) {
    const float* src = nullptr; size_t off = 0; int K = 0, N = 0, Nd = 0, mode = 0;
    if (task == 0) { src = p.ffn1_w_gu + (size_t)layer * 1024 * 5632; off = OFF_WGU1; K = 1024; N = 5632; Nd = 5632; mode = 1; }
    else if (task == 1) { src = p.ffn1_w_down + (size_t)layer * 2816 * 1024; off = OFF_WDN1; K = 2816; N = 1024; Nd = 1024; }
    else if (task == 2) { src = p.ffn2_w_gu + (size_t)layer * 1024 * 5632; off = OFF_WGU2; K = 1024; N = 5632; Nd = 5632; mode = 1; }
    else if (task == 3) { src = p.ffn2_w_down + (size_t)layer * 2816 * 1024; off = OFF_WDN2; K = 2816; N = 1024; Nd = 1024; }
    else if (kind == 0) {
      if (task == 4) { src = p.hg_w_in + (size_t)mi * 1024 * 5120; off = OFF_WMIX; K = 1024; N = 5120; Nd = 5120; }
      else if (task == 5) { src = p.hg_w_out + (size_t)mi * 1024 * 1024; off = OFF_WMIX + 10485760; K = 1024; N = 1024; Nd = 1024; }
    } else if (kind == 1) {
      if (task == 4) { src = p.na_w_in + (size_t)mi * 1024 * 3072; off = OFF_WMIX; K = 1024; N = 3072; Nd = 3072; }
      else if (task == 5) { src = p.na_w_out + (size_t)mi * 1024 * 1024; off = OFF_WMIX + 6291456; K = 1024; N = 1024; Nd = 1024; }
    } else {
      if (task == 4) { src = p.mla_w_in + (size_t)mi * 1024 * 1056; off = OFF_WMIX; K = 1024; N = 1056; Nd = 1152; }
      else if (task == 5) { src = p.mla_w_uq + (size_t)mi * 768 * 1536; off = OFF_WMIX + 2359296; K = 768; N = 1536; Nd = 1536; }
      else if (task == 6) { src = p.mla_w_ukv + (size_t)mi * 256 * 2048; off = OFF_WMIX + 4718592; K = 256; N = 2048; Nd = 2048; }
      else if (task == 7) { src = p.mla_w_out + (size_t)mi * 1024 * 1024; off = OFF_WMIX + 5767168; K = 1024; N = 1024; Nd = 1024; }
    }
    if (src) cvt_tiles(src, (u16*)(ws + off), K, N, Nd, mode, smem);
  }
}

DI void norm_phase(const float* __restrict__ src, const float* __restrict__ gain, u16* __restrict__ dst, float* copy_dst, int rows) {
  const int lane = otid() & 63, wid = otid() >> 6;
  f32x4 g[4];
#pragma unroll
  for (int i = 0; i < 4; ++i) g[i] = *(const f32x4*)(gain + i * 256 + lane * 4);
  for (int row = blockIdx.x * 4 + wid; row < rows; row += gridDim.x * 4) {
    const float* s = src + (size_t)row * 1024;
    f32x4 v[4]; float ss = 0.f;
#pragma unroll
    for (int i = 0; i < 4; ++i) { v[i] = *(const f32x4*)(s + i * 256 + lane * 4); ss += v[i][0] * v[i][0] + v[i][1] * v[i][1] + v[i][2] * v[i][2] + v[i][3] * v[i][3]; }
    ss = wave_sum(ss);
    const float rstd = rsqrtf(ss * (1.f / 1024.f) + EPS);
#pragma unroll
    for (int i = 0; i < 4; ++i) {
      f32x4 y = v[i] * rstd * g[i];
      *(u32x2*)(dst + (size_t)row * 1024 + i * 256 + lane * 4) = pack4(y);
      if (copy_dst) *(f32x4*)(copy_dst + (size_t)row * 1024 + i * 256 + lane * 4) = v[i];
    }
  }
}

constexpr int LDS_TILE = 128 * 128;
constexpr int LDS_BUF = 2 * LDS_TILE;

#define GLDS16(gp, lp) __builtin_amdgcn_global_load_lds((const unsigned*)(gp), (unsigned*)(lp), 16, 0, 0)

template <class Epi>
DI void gemm_tile(const u16* __restrict__ A, int lda, const u16* __restrict__ W, int K, int m0, int n0, const Epi& epi, char* smem) {
  const int tid = otid(), lane = tid & 63, wid = tid >> 6;
  const int wm = wid >> 1, wn = wid & 1, fr = lane & 15, fq = lane >> 4;
  f32x4 acc[4][4];
#pragma unroll
  for (int i = 0; i < 4; ++i)
#pragma unroll
    for (int j = 0; j < 4; ++j) acc[i][j] = zero4();
  const int lrow = tid >> 3, lc = (tid & 7) ^ ((tid >> 4) & 7);
  const u16* ga = A + (size_t)lrow * lda + lc * 8;
  const u16* gw = W + (size_t)lrow * K + lc * 8;
  char* sdst = smem + tid * 16;
  const int sw = fr >> 1;
  const int ro0 = ((fq) ^ sw) * 16, ro1 = ((4 + fq) ^ sw) * 16;
  const char* sa_rd = smem + (wm * 64 + fr) * 128;
  const char* sw_rd = smem + LDS_TILE + (wn * 64 + fr) * 128;
  const int nk = K >> 6;
#pragma unroll
  for (int i = 0; i < 4; ++i) { GLDS16(ga + (size_t)(32 * i) * lda, sdst + i * 4096); GLDS16(gw + (size_t)(32 * i) * K, sdst + LDS_TILE + i * 4096); }
  asm volatile("s_waitcnt vmcnt(0)" ::: "memory");
  __syncthreads();
  for (int t = 0; t < nk; ++t) {
    const int cur = (t & 1) * LDS_BUF, nxt = LDS_BUF - cur;
    if (t + 1 < nk) {
      const int k0 = (t + 1) << 6;
#pragma unroll
      for (int i = 0; i < 4; ++i) { GLDS16(ga + (size_t)(32 * i) * lda + k0, sdst + nxt + i * 4096); GLDS16(gw + (size_t)(32 * i) * K + k0, sdst + nxt + LDS_TILE + i * 4096); }
    }
#pragma unroll
    for (int ks = 0; ks < 2; ++ks) {
      const int ro = ks ? ro1 : ro0;
      bf16x8 af[4], wf[4];
#pragma unroll
      for (int i = 0; i < 4; ++i) {
        af[i] = *(const bf16x8*)(sa_rd + cur + i * 2048 + ro);
        wf[i] = *(const bf16x8*)(sw_rd + cur + i * 2048 + ro);
      }
#pragma unroll
      for (int nt = 0; nt < 4; ++nt)
#pragma unroll
        for (int mt = 0; mt < 4; ++mt) acc[nt][mt] = MFMA32(wf[nt], af[mt], acc[nt][mt]);
    }
    asm volatile("s_waitcnt vmcnt(0)" ::: "memory");
    __syncthreads();
  }
  epi(acc, m0 + wm * 64, n0 + wn * 64, fr, fq);
}

template <class Epi>
DI void gemm_phase(const u16* A, int lda, const u16* W, int K, int Mrows, int Ncols, const Epi& epi, char* smem) {
  const int mtn = Mrows >> 7, ntn = Ncols >> 7;
  const int ntiles = mtn * ntn;
  constexpr int GM = 16;
  for (int tile = blockIdx.x; tile < ntiles; tile += gridDim.x) {
    const int group = tile / (GM * ntn), rem = tile % (GM * ntn);
    const int mt = group * GM + (rem % GM), nt = rem / GM;
    gemm_tile(A + (size_t)mt * 128 * lda, lda, W + (size_t)nt * 128 * K, K, mt * 128, nt * 128, epi, smem);
  }
}

struct EpiSwiglu {
  u16* act;
  DI void operator()(f32x4 (&acc)[4][4], int mb, int nb, int fr, int fq) const {
#pragma unroll
    for (int mt = 0; mt < 4; ++mt) {
      const int m = mb + mt * 16 + fr;
#pragma unroll
      for (int np = 0; np < 2; ++np) {
        const f32x4 g = acc[2 * np][mt], u = acc[2 * np + 1][mt];
        f32x4 r;
#pragma unroll
        for (int j = 0; j < 4; ++j) r[j] = siluf_(g[j]) * u[j];
        const int jc = (nb >> 1) + np * 16 + fq * 4;
        *(u32x2*)(act + (size_t)m * 2816 + jc) = pack4(r);
      }
    }
  }
};

struct EpiResid {
  float* X; float scale;
  DI void operator()(f32x4 (&acc)[4][4], int mb, int nb, int fr, int fq) const {
#pragma unroll
    for (int mt = 0; mt < 4; ++mt) {
      const int m = mb + mt * 16 + fr;
#pragma unroll
      for (int nt = 0; nt < 4; ++nt) {
        f32x4* ptr = (f32x4*)(X + (size_t)m * 1024 + nb + nt * 16 + fq * 4);
        f32x4 v = *ptr;
        v += acc[nt][mt] * scale;
        *ptr = v;
      }
    }
  }
};

struct EpiStore {
  u16* out; int ldo; int nmax;
  DI void operator()(f32x4 (&acc)[4][4], int mb, int nb, int fr, int fq) const {
#pragma unroll
    for (int mt = 0; mt < 4; ++mt) {
      const int m = mb + mt * 16 + fr;
#pragma unroll
      for (int nt = 0; nt < 4; ++nt) {
        const int n = nb + nt * 16 + fq * 4;
        if (n < nmax) *(u32x2*)(out + (size_t)m * ldo + n) = pack4(acc[nt][mt]);
      }
    }
  }
};

struct EpiHgIn {
  u16 *Q, *LFf, *LFb, *V, *G; const float* lb;
  DI void operator()(f32x4 (&acc)[4][4], int mb, int nb, int fr, int fq) const {
    const int seg = nb >> 10, c0 = nb & 1023;
    u16* dst = seg == 0 ? Q : seg == 1 ? LFf : seg == 2 ? LFb : seg == 3 ? V : G;
#pragma unroll
    for (int mt = 0; mt < 4; ++mt) {
      const int m = mb + mt * 16 + fr;
#pragma unroll
      for (int nt = 0; nt < 4; ++nt) {
        const int c = c0 + nt * 16 + fq * 4;
        f32x4 a = acc[nt][mt], r;
        if (seg == 0) r = a * 0.08838834764831845f;
        else if (seg == 3) r = a;
        else if (seg == 4) {
#pragma unroll
          for (int j = 0; j < 4; ++j) r[j] = siluf_(a[j]);
        } else {
          const f32x4 l4 = *(const f32x4*)(lb + c);
#pragma unroll
          for (int j = 0; j < 4; ++j) {
            float z = fminf(fmaxf(a[j], -30.f), 30.f);
            float f = l4[j] + (1.f - l4[j]) * sigmoidf_(z);
            r[j] = __logf(f);
          }
        }
        *(u32x2*)(dst + (size_t)m * 1024 + c) = pack4(r);
      }
    }
  }
};

struct EpiNaIn {
  u16 *Q, *K, *VT; const float *qn, *kn;
  DI void operator()(f32x4 (&acc)[4][4], int mb, int nb, int fr, int fq) const {
    const int seg = nb >> 10, h = (nb & 1023) >> 6;
    if (seg < 2) {
      u16* dst = seg == 0 ? Q : K;
      const float* gn = seg == 0 ? qn : kn;
      const float sc = seg == 0 ? 0.125f * LOG2E : 1.f;
#pragma unroll
      for (int mt = 0; mt < 4; ++mt) {
        const int m = mb + mt * 16 + fr;
        float ss = 0.f;
#pragma unroll
        for (int nt = 0; nt < 4; ++nt)
#pragma unroll
          for (int j = 0; j < 4; ++j) ss += acc[nt][mt][j] * acc[nt][mt][j];
        ss += __shfl_xor(ss, 16); ss += __shfl_xor(ss, 32);
        const float rstd = rsqrtf(ss * (1.f / 64.f) + EPS) * sc;
#pragma unroll
        for (int nt = 0; nt < 4; ++nt) {
          const int d = nt * 16 + fq * 4;
          const f32x4 g4 = *(const f32x4*)(gn + d);
          f32x4 r = acc[nt][mt] * rstd * g4;
          *(u32x2*)(dst + (size_t)m * 1024 + h * 64 + d) = pack4(r);
        }
      }
    } else {
#pragma unroll
      for (int mt = 0; mt < 4; ++mt) {
        const int m = mb + mt * 16 + fr;
        const int b = m >> 12, t = m & 4095;
#pragma unroll
        for (int nt = 0; nt < 4; ++nt)
#pragma unroll
          for (int j = 0; j < 4; ++j) {
            const int d = nt * 16 + fq * 4 + j;
            VT[((size_t)((b * 16 + h) * 64 + d)) * 4096 + t] = (u16)f2bf(acc[nt][mt][j]);
          }
      }
    }
  }
};

struct HgBufs {
  u16 *Q, *LFf, *LFb, *V, *G, *QIf, *QIb, *KITf, *KITb, *VTc, *OI, *OF, *OB, *Y;
  float *DECf, *DECb;
};

DI void hg_prep_item(const HgBufs& hb, int item, char* smem) {
  const int h = item & 7, n = (item >> 3) & 255, b = item >> 11;
  float* sq = (float*)smem; float* sbf = sq + 2112; float* sbb = sbf + 2112; float* skf = sbb + 2112;
  float* skb = skf + 2112; float* sv = skb + 2112; float* sA = sv + 2112;
  const int tid = otid();
  const int row = tid >> 4, c8 = (tid & 15) * 8;
  const size_t tok0 = (size_t)b * 4096 + n * 16;
  const size_t gidx = (tok0 + row) * 1024 + h * 128 + c8;
  {
    const u32x4 rq = *(const u32x4*)(hb.Q + gidx), rf = *(const u32x4*)(hb.LFf + gidx);
    const u32x4 rb = *(const u32x4*)(hb.LFb + gidx), rv = *(const u32x4*)(hb.V + gidx);
#pragma unroll
    for (int e = 0; e < 8; ++e) {
      const int o = row * 132 + c8 + e;
      const float lf = bfget(rf, e), lb_ = bfget(rb, e);
      sq[o] = bfget(rq, e); sbf[o] = lf; sbb[o] = lb_;
      skf[o] = 1.f - __expf(lf); skb[o] = 1.f - __expf(lb_); sv[o] = bfget(rv, e);
    }
  }
  __syncthreads();
  if (tid < 128) {
    const int d = tid; float a = 0.f;
#pragma unroll
    for (int t = 0; t < 16; ++t) { a += sbf[t * 132 + d]; sbf[t * 132 + d] = a; }
    hb.DECf[((size_t)b * 256 + n) * 1024 + h * 128 + d] = __expf(a);
  } else {
    const int d = tid - 128; float a = 0.f;
#pragma unroll
    for (int t = 15; t >= 0; --t) { a += sbb[t * 132 + d]; sbb[t * 132 + d] = a; }
    hb.DECb[((size_t)b * 256 + n) * 1024 + h * 128 + d] = __expf(a);
  }
  __syncthreads();
  {
    u32x4 of, ob;
#pragma unroll
    for (int e2 = 0; e2 < 4; ++e2) {
      const int o = row * 132 + c8 + 2 * e2;
      const float q0 = sq[o], q1 = sq[o + 1];
      of[e2] = pack2(q0 * __expf(sbf[o]), q1 * __expf(sbf[o + 1]));
      ob[e2] = pack2(q0 * __expf(sbb[o]), q1 * __expf(sbb[o + 1]));
    }
    *(u32x4*)(hb.QIf + gidx) = of; *(u32x4*)(hb.QIb + gidx) = ob;
  }
  {
    const int d = tid >> 1, t8 = (tid & 1) * 8;
    const float blf = sbf[15 * 132 + d], blb = sbb[d];
    u32x4 kf, kb, vv;
#pragma unroll
    for (int e2 = 0; e2 < 4; ++e2) {
      const int o0 = (t8 + 2 * e2) * 132 + d, o1 = o0 + 132;
      kf[e2] = pack2(skf[o0] * __expf(blf - sbf[o0]), skf[o1] * __expf(blf - sbf[o1]));
      kb[e2] = pack2(skb[o0] * __expf(blb - sbb[o0]), skb[o1] * __expf(blb - sbb[o1]));
      vv[e2] = pack2(sv[o0], sv[o1]);
    }
    const size_t cidx = (((size_t)(b * 8 + h) * 256 + n) * 128 + d) * 16 + t8;
    *(u32x4*)(hb.KITf + cidx) = kf; *(u32x4*)(hb.KITb + cidx) = kb; *(u32x4*)(hb.VTc + cidx) = vv;
  }
  {
    const int t = tid >> 4, s = tid & 15;
    if (s <= t) {
      float af = 0.f, ab = 0.f;
      for (int d4 = 0; d4 < 32; ++d4) {
        const f32x4 qt = *(const f32x4*)(sq + t * 132 + d4 * 4), qs = *(const f32x4*)(sq + s * 132 + d4 * 4);
        const f32x4 kfs = *(const f32x4*)(skf + s * 132 + d4 * 4), kbt = *(const f32x4*)(skb + t * 132 + d4 * 4);
        const f32x4 bft = *(const f32x4*)(sbf + t * 132 + d4 * 4), bfs = *(const f32x4*)(sbf + s * 132 + d4 * 4);
        const f32x4 bbs = *(const f32x4*)(sbb + s * 132 + d4 * 4), bbt = *(const f32x4*)(sbb + t * 132 + d4 * 4);
#pragma unroll
        for (int c = 0; c < 4; ++c) {
          af += qt[c] * kfs[c] * __expf(bft[c] - bfs[c]);
          ab += qs[c] * kbt[c] * __expf(bbs[c] - bbt[c]);
        }
      }
      if (s == t) sA[t * 17 + t] = af + ab;
      else { sA[t * 17 + s] = af; sA[s * 17 + t] = ab; }
    }
  }
  __syncthreads();
  {
    float o[8];
#pragma unroll
    for (int e = 0; e < 8; ++e) o[e] = 0.f;
#pragma unroll
    for (int s = 0; s < 16; ++s) {
      const float a = sA[row * 17 + s];
      const f32x4 v0 = *(const f32x4*)(sv + s * 132 + c8), v1 = *(const f32x4*)(sv + s * 132 + c8 + 4);
#pragma unroll
      for (int e = 0; e < 4; ++e) { o[e] += a * v0[e]; o[4 + e] += a * v1[e]; }
    }
    u32x4 r; r[0] = pack2(o[0], o[1]); r[1] = pack2(o[2], o[3]); r[2] = pack2(o[4], o[5]); r[3] = pack2(o[6], o[7]);
    *(u32x4*)(hb.OI + gidx) = r;
  }
  __syncthreads();
}

struct ScanOps { bf16x8 qa[4]; bf16x8 ka[8]; bf16x8 vb; f32x4 dc[8]; };

DI void scan_load(ScanOps& s, const u16* QI, const u16* KIT, const u16* VTc, const float* DEC, int b, int h, int vs, int n, int fr, int fq) {
  const size_t tok0 = (size_t)b * 4096 + n * 16;
  const u16* qp = QI + (tok0 + fr) * 1024 + h * 128 + fq * 4;
#pragma unroll
  for (int ks = 0; ks < 4; ++ks) s.qa[ks] = cat4(*(const bf16x4*)(qp + ks * 32), *(const bf16x4*)(qp + ks * 32 + 16));
  const size_t cb = ((size_t)(b * 8 + h) * 256 + n) * 2048;
  const int fo = (fq & 1) * 8;
#pragma unroll
  for (int dt = 0; dt < 8; ++dt) s.ka[dt] = *(const bf16x8*)(KIT + cb + (dt * 16 + fr) * 16 + fo);
  s.vb = *(const bf16x8*)(VTc + cb + (vs * 16 + fr) * 16 + fo);
  if (fq >= 2) {
    const bf16x8 z = {0, 0, 0, 0, 0, 0, 0, 0};
#pragma unroll
    for (int dt = 0; dt < 8; ++dt) s.ka[dt] = z;
    s.vb = z;
  }
  const float* dp = DEC + ((size_t)b * 256 + n) * 1024 + h * 128 + fq * 4;
#pragma unroll
  for (int dt = 0; dt < 8; ++dt) s.dc[dt] = *(const f32x4*)(dp + dt * 16);
}

DI void scan_step(f32x4 (&S)[8], const ScanOps& s, u16* Oout, int b, int h, int vs, int n, int fr, int fq) {
  f32x4 o = zero4();
#pragma unroll
  for (int ks = 0; ks < 4; ++ks) o = MFMA32(s.qa[ks], pack8(S[2 * ks], S[2 * ks + 1]), o);
  const size_t tok0 = (size_t)b * 4096 + n * 16;
#pragma unroll
  for (int j = 0; j < 4; ++j) Oout[(tok0 + fq * 4 + j) * 1024 + h * 128 + vs * 16 + fr] = (u16)f2bf(o[j]);
#pragma unroll
  for (int dt = 0; dt < 8; ++dt) { S[dt] = S[dt] * s.dc[dt]; S[dt] = MFMA32(s.ka[dt], s.vb, S[dt]); }
}

DI void hg_scan_phase(const HgBufs& hb) {
  const int lane = otid() & 63, wid = otid() >> 6, fr = lane & 15, fq = lane >> 4;
  for (int item = blockIdx.x * 4 + wid; item < 512; item += gridDim.x * 4) {
    const int vs = item & 7, dir = (item >> 3) & 1, h = (item >> 4) & 7, b = item >> 7;
    const u16* QI = dir ? hb.QIb : hb.QIf; const u16* KIT = dir ? hb.KITb : hb.KITf;
    const float* DEC = dir ? hb.DECb : hb.DECf; u16* Oout = dir ? hb.OB : hb.OF;
    f32x4 S[8];
#pragma unroll
    for (int i = 0; i < 8; ++i) S[i] = zero4();
    ScanOps s0, s1;
    scan_load(s0, QI, KIT, hb.VTc, DEC, b, h, vs, dir ? 255 : 0, fr, fq);
    for (int step = 0; step < 256; step += 2) {
      const int n0 = dir ? 255 - step : step, n1 = dir ? n0 - 1 : n0 + 1;
      scan_load(s1, QI, KIT, hb.VTc, DEC, b, h, vs, n1, fr, fq);
      scan_step(S, s0, Oout, b, h, vs, n0, fr, fq);
      if (step + 2 < 256) scan_load(s0, QI, KIT, hb.VTc, DEC, b, h, vs, dir ? n1 - 1 : n1 + 1, fr, fq);
      scan_step(S, s1, Oout, b, h, vs, n1, fr, fq);
    }
  }
}

DI void hg_combine_phase(const HgBufs& hb, const float* __restrict__ gnorm, int rows) {
  const int lane = otid() & 63, wid = otid() >> 6;
  const int h = lane >> 3, c16 = (lane & 7) * 16;
  for (int row = blockIdx.x * 4 + wid; row < rows; row += gridDim.x * 4) {
    const size_t g = (size_t)row * 1024 + h * 128 + c16;
    float o[16]; float ss = 0.f;
#pragma unroll
    for (int half = 0; half < 2; ++half) {
      const u32x4 a = *(const u32x4*)(hb.OI + g + half * 8), f = *(const u32x4*)(hb.OF + g + half * 8), bb = *(const u32x4*)(hb.OB + g + half * 8);
#pragma unroll
      for (int e = 0; e < 8; ++e) { float v = bfget(a, e) + bfget(f, e) + bfget(bb, e); o[half * 8 + e] = v; ss += v * v; }
    }
    ss += __shfl_xor(ss, 1); ss += __shfl_xor(ss, 2); ss += __shfl_xor(ss, 4);
    const float rstd = rsqrtf(ss * (1.f / 128.f) + EPS);
#pragma unroll
    for (int half = 0; half < 2; ++half) {
      const u32x4 gs = *(const u32x4*)(hb.G + g + half * 8);
      u32x4 r;
#pragma unroll
      for (int e2 = 0; e2 < 4; ++e2) {
        const int e = half * 8 + 2 * e2;
        r[e2] = pack2(o[e] * rstd * gnorm[c16 + e] * bfget(gs, 2 * e2), o[e + 1] * rstd * gnorm[c16 + e + 1] * bfget(gs, 2 * e2 + 1));
      }
      *(u32x4*)(hb.Y + g + half * 8) = r;
    }
  }
}

DI void na_attn_item(const u16* __restrict__ Q, const u16* __restrict__ K, const u16* __restrict__ VT, const float* __restrict__ rpb, u16* __restrict__ O, int item, int fr, int fq) {
  const int h = item & 15, qt = (item >> 4) & 3, r = (item >> 6) & 63, b = item >> 12;
  const int r0 = min(max(r - 4, 0), 56);
  const int cw0 = qt == 0 ? 0 : qt == 1 ? 8 : qt == 2 ? 24 : 32;
  const size_t tokq = (size_t)b * 4096 + r * 64 + qt * 16 + fr;
  bf16x8 qf[2];
#pragma unroll
  for (int ks = 0; ks < 2; ++ks) qf[ks] = *(const bf16x8*)(Q + tokq * 1024 + h * 64 + ks * 32 + fq * 8);
  f32x4 s[8][2];
#pragma unroll
  for (int kr = 0; kr < 8; ++kr)
#pragma unroll
    for (int hf = 0; hf < 2; ++hf) {
      const size_t tokk = (size_t)b * 4096 + (r0 + kr) * 64 + cw0 + hf * 16 + fr;
      const bf16x8 k0 = *(const bf16x8*)(K + tokk * 1024 + h * 64 + fq * 8);
      const bf16x8 k1 = *(const bf16x8*)(K + tokk * 1024 + h * 64 + 32 + fq * 8);
      f32x4 a = MFMA32(k0, qf[0], zero4());
      s[kr][hf] = MFMA32(k1, qf[1], a);
    }
  const int qc = qt * 16 + fr;
  const int cs = min(max(qc - 8, 0), 48);
  float mx = -1e30f;
#pragma unroll
  for (int kr = 0; kr < 8; ++kr) {
    const float* rp = rpb + (h * 15 + (r0 + kr - r + 7)) * 31;
#pragma unroll
    for (int hf = 0; hf < 2; ++hf)
#pragma unroll
      for (int j = 0; j < 4; ++j) {
        const int kc = cw0 + hf * 16 + fq * 4 + j;
        const bool valid = (kc >= cs) && (kc < cs + 16);
        const int ci = min(max(kc - qc + 15, 0), 30);
        const float v = valid ? s[kr][hf][j] + rp[ci] * LOG2E : -1e30f;
        s[kr][hf][j] = v; mx = fmaxf(mx, v);
      }
  }
  mx = fmaxf(mx, __shfl_xor(mx, 16)); mx = fmaxf(mx, __shfl_xor(mx, 32));
  float l = 0.f;
#pragma unroll
  for (int kr = 0; kr < 8; ++kr)
#pragma unroll
    for (int hf = 0; hf < 2; ++hf)
#pragma unroll
      for (int j = 0; j < 4; ++j) { const float pv = exp2f(s[kr][hf][j] - mx); s[kr][hf][j] = pv; l += pv; }
  l += __shfl_xor(l, 16); l += __shfl_xor(l, 32);
  f32x4 o[4];
#pragma unroll
  for (int dt = 0; dt < 4; ++dt) o[dt] = zero4();
#pragma unroll
  for (int kr = 0; kr < 8; ++kr) {
    const bf16x8 pp = pack8(s[kr][0], s[kr][1]);
#pragma unroll
    for (int dt = 0; dt < 4; ++dt) {
      const u16* vp = VT + ((size_t)((b * 16 + h) * 64 + dt * 16 + fr)) * 4096 + (r0 + kr) * 64 + cw0 + fq * 4;
      const bf16x8 vf = cat4(*(const bf16x4*)vp, *(const bf16x4*)(vp + 16));
      o[dt] = MFMA32(vf, pp, o[dt]);
    }
  }
  const float inv = 1.f / l;
#pragma unroll
  for (int dt = 0; dt < 4; ++dt) *(u32x2*)(O + tokq * 1024 + h * 64 + dt * 16 + fq * 4) = pack4(o[dt] * inv);
}

DI void mla_norm_phase(const u16* __restrict__ CRAW, const float* __restrict__ gq, const float* __restrict__ gkv, u16* __restrict__ CQN, u16* __restrict__ CKVN, float* __restrict__ KROPE) {
  const int lane = otid() & 63, wid = otid() >> 6;
  for (int row = blockIdx.x * 4 + wid; row < MTOK; row += gridDim.x * 4) {
    const u16* c = CRAW + (size_t)row * 1056;
    f32x4 v[3]; float ss = 0.f;
#pragma unroll
    for (int i = 0; i < 3; ++i) {
      const u32x2 w = *(const u32x2*)(c + i * 256 + lane * 4);
      v[i][0] = bflo(w[0]); v[i][1] = bfhi(w[0]); v[i][2] = bflo(w[1]); v[i][3] = bfhi(w[1]);
      ss += v[i][0] * v[i][0] + v[i][1] * v[i][1] + v[i][2] * v[i][2] + v[i][3] * v[i][3];
    }
    ss = wave_sum(ss);
    const float rq = rsqrtf(ss * (1.f / 768.f) + EPS);
#pragma unroll
    for (int i = 0; i < 3; ++i) {
      const f32x4 g4 = *(const f32x4*)(gq + i * 256 + lane * 4);
      *(u32x2*)(CQN + (size_t)row * 768 + i * 256 + lane * 4) = pack4(v[i] * rq * g4);
    }
    {
      const u32x2 w = *(const u32x2*)(c + 768 + lane * 4);
      f32x4 k; k[0] = bflo(w[0]); k[1] = bfhi(w[0]); k[2] = bflo(w[1]); k[3] = bfhi(w[1]);
      float s2 = wave_sum(k[0] * k[0] + k[1] * k[1] + k[2] * k[2] + k[3] * k[3]);
      const float rk = rsqrtf(s2 * (1.f / 256.f) + EPS);
      const f32x4 g4 = *(const f32x4*)(gkv + lane * 4);
      *(u32x2*)(CKVN + (size_t)row * 256 + lane * 4) = pack4(k * rk * g4);
    }
    if (lane < 8) {
      const u32x2 w = *(const u32x2*)(c + 1024 + lane * 4);
      f32x4 k; k[0] = bflo(w[0]); k[1] = bfhi(w[0]); k[2] = bflo(w[1]); k[3] = bfhi(w[1]);
      *(f32x4*)(KROPE + (size_t)row * 32 + lane * 4) = k;
    }
  }
}

DI void mla_prep_phase(u16* __restrict__ Q, const u16* __restrict__ KVRAW, const float* __restrict__ KROPE, u16* __restrict__ Kout,
                       const float* __restrict__ gq, const float* __restrict__ gk, const float* __restrict__ RC, const float* __restrict__ RS) {
  const int lane = otid() & 63, wid = otid() >> 6;
  const int h = lane >> 2, sub = lane & 3;
  const float QS = 0.10206207261596577f * LOG2E;
  for (int m = blockIdx.x * 4 + wid; m < MTOK; m += gridDim.x * 4) {
    const int t = m & 4095;
    const f32x4 cs = *(const f32x4*)(RC + t * 16 + sub * 4), sn = *(const f32x4*)(RS + t * 16 + sub * 4);
#pragma unroll
    for (int which = 0; which < 2; ++which) {
      float nope[16]; f32x4 ra, rb;
      u16* dstp = (which == 0 ? Q : Kout) + (size_t)m * 1536 + h * 96;
      const float* gn = which == 0 ? gq : gk;
      if (which == 0) {
        const u32x4 w0 = *(const u32x4*)(dstp + sub * 16), w1 = *(const u32x4*)(dstp + sub * 16 + 8);
#pragma unroll
        for (int e = 0; e < 8; ++e) { nope[e] = bfget(w0, e); nope[8 + e] = bfget(w1, e); }
        const u32x2 a2 = *(const u32x2*)(dstp + 64 + sub * 4), b2 = *(const u32x2*)(dstp + 80 + sub * 4);
        ra[0] = bflo(a2[0]); ra[1] = bfhi(a2[0]); ra[2] = bflo(a2[1]); ra[3] = bfhi(a2[1]);
        rb[0] = bflo(b2[0]); rb[1] = bfhi(b2[0]); rb[2] = bflo(b2[1]); rb[3] = bfhi(b2[1]);
      } else {
        const u16* kp = KVRAW + (size_t)m * 2048 + h * 128 + sub * 16;
        const u32x4 w0 = *(const u32x4*)kp, w1 = *(const u32x4*)(kp + 8);
#pragma unroll
        for (int e = 0; e < 8; ++e) { nope[e] = bfget(w0, e); nope[8 + e] = bfget(w1, e); }
        ra = *(const f32x4*)(KROPE + (size_t)m * 32 + sub * 4);
        rb = *(const f32x4*)(KROPE + (size_t)m * 32 + 16 + sub * 4);
      }
      float ss = 0.f;
#pragma unroll
      for (int e = 0; e < 16; ++e) ss += nope[e] * nope[e];
#pragma unroll
      for (int e = 0; e < 4; ++e) ss += ra[e] * ra[e] + rb[e] * rb[e];
      ss += __shfl_xor(ss, 1); ss += __shfl_xor(ss, 2);
      const float rstd = rsqrtf(ss * (1.f / 96.f) + EPS) * (which == 0 ? QS : 1.f);
      u32x4 o0, o1;
#pragma unroll
      for (int e2 = 0; e2 < 4; ++e2) {
        o0[e2] = pack2(nope[2 * e2] * rstd * gn[sub * 16 + 2 * e2], nope[2 * e2 + 1] * rstd * gn[sub * 16 + 2 * e2 + 1]);
        o1[e2] = pack2(nope[8 + 2 * e2] * rstd * gn[sub * 16 + 8 + 2 * e2], nope[9 + 2 * e2] * rstd * gn[sub * 16 + 9 + 2 * e2]);
      }
      f32x4 oa, ob;
#pragma unroll
      for (int e = 0; e < 4; ++e) {
        const float a = ra[e] * rstd * gn[64 + sub * 4 + e], bq = rb[e] * rstd * gn[80 + sub * 4 + e];
        oa[e] = a * cs[e] - bq * sn[e];
        ob[e] = bq * cs[e] + a * sn[e];
      }
      *(u32x4*)(dstp + sub * 16) = o0; *(u32x4*)(dstp + sub * 16 + 8) = o1;
      *(u32x2*)(dstp + 64 + sub * 4) = pack4(oa); *(u32x2*)(dstp + 80 + sub * 4) = pack4(ob);
    }
  }
}

DI void mla_vt_phase(const u16* __restrict__ KVRAW, u16* __restrict__ VT, char* smem) {
  u16* tile = (u16*)smem;
  const int tid = otid();
  for (int item = blockIdx.x; item < 8192; item += gridDim.x) {
    const int tt = item & 63, bh = item >> 6, b = bh >> 4, h = bh & 15;
    {
      const int row = tid >> 2, part = tid & 3;
      const u16* src = KVRAW + ((size_t)b * 4096 + tt * 64 + row) * 2048 + h * 128 + 64 + part * 16;
      const u32x4 w0 = *(const u32x4*)src, w1 = *(const u32x4*)(src + 8);
      u32* d32 = (u32*)(tile + row * 66 + part * 16);
#pragma unroll
      for (int e = 0; e < 4; ++e) { d32[e] = w0[e]; d32[4 + e] = w1[e]; }
    }
    __syncthreads();
    {
      const int d = tid >> 2, tp = (tid & 3) * 16;
      u32x4 o0, o1;
#pragma unroll
      for (int e2 = 0; e2 < 4; ++e2) {
        o0[e2] = (u32)tile[(tp + 2 * e2) * 66 + d] | ((u32)tile[(tp + 2 * e2 + 1) * 66 + d] << 16);
        o1[e2] = (u32)tile[(tp + 8 + 2 * e2) * 66 + d] | ((u32)tile[(tp + 9 + 2 * e2) * 66 + d] << 16);
      }
      u16* dst = VT + ((size_t)(bh * 64 + d)) * 4096 + tt * 64 + tp;
      *(u32x4*)dst = o0; *(u32x4*)(dst + 8) = o1;
    }
    __syncthreads();
  }
}

constexpr int FA_KROW = 208, FA_VROW = 144, FA_KT = 64 * FA_KROW, FA_BUF = FA_KT + 64 * FA_VROW;
DI void mla_attn_item(const u16* __restrict__ Q, const u16* __restrict__ Kb, const u16* __restrict__ VT, u16* __restrict__ O, int item, char* smem) {
  const int qb = item & 31, bh = item >> 5, b = bh >> 4, h = bh & 15;
  const int tid = otid(), lane = tid & 63, wid = tid >> 6, fr = lane & 15, fq = lane >> 4;
  bf16x8 qf[2][3];
#pragma unroll
  for (int qt = 0; qt < 2; ++qt) {
    const size_t tq = (size_t)b * 4096 + qb * 128 + wid * 32 + qt * 16 + fr;
#pragma unroll
    for (int ks = 0; ks < 3; ++ks) qf[qt][ks] = *(const bf16x8*)(Q + tq * 1536 + h * 96 + ks * 32 + fq * 8);
  }
  f32x4 o[4][2];
#pragma unroll
  for (int i = 0; i < 4; ++i) { o[i][0] = zero4(); o[i][1] = zero4(); }
  float mrun[2] = {-1e30f, -1e30f}, lrun[2] = {0.f, 0.f};
  const u16* kg[3]; int ks_off[3];
#pragma unroll
  for (int i = 0; i < 3; ++i) {
    const int c = tid + 256 * i, row = c / 12, kc = c % 12;
    kg[i] = Kb + ((size_t)b * 4096 + row) * 1536 + h * 96 + kc * 8;
    ks_off[i] = row * FA_KROW + kc * 16;
  }
  const u16* vg[2]; int vs_off[2];
#pragma unroll
  for (int i = 0; i < 2; ++i) {
    const int c = tid + 256 * i, d = c >> 3, kc = c & 7;
    vg[i] = VT + ((size_t)(bh * 64 + d)) * 4096 + kc * 8;
    vs_off[i] = FA_KT + d * FA_VROW + kc * 16;
  }
  u32x4 rk[3], rv[2];
#pragma unroll
  for (int i = 0; i < 3; ++i) rk[i] = *(const u32x4*)(kg[i]);
#pragma unroll
  for (int i = 0; i < 2; ++i) rv[i] = *(const u32x4*)(vg[i]);
#pragma unroll
  for (int i = 0; i < 3; ++i) *(u32x4*)(smem + ks_off[i]) = rk[i];
#pragma unroll
  for (int i = 0; i < 2; ++i) *(u32x4*)(smem + vs_off[i]) = rv[i];
  __syncthreads();
  for (int kt = 0; kt < 64; ++kt) {
    const int cur = (kt & 1) * FA_BUF, nxt = FA_BUF - cur;
    if (kt + 1 < 64) {
      const size_t key0 = (size_t)(kt + 1) * 64;
#pragma unroll
      for (int i = 0; i < 3; ++i) rk[i] = *(const u32x4*)(kg[i] + key0 * 1536);
#pragma unroll
      for (int i = 0; i < 2; ++i) rv[i] = *(const u32x4*)(vg[i] + key0);
    }
    f32x4 s[4][2];
#pragma unroll
    for (int k4 = 0; k4 < 4; ++k4) {
      s[k4][0] = zero4(); s[k4][1] = zero4();
#pragma unroll
      for (int ks = 0; ks < 3; ++ks) {
        const bf16x8 kf = *(const bf16x8*)(smem + cur + (k4 * 16 + fr) * FA_KROW + ks * 64 + fq * 16);
        s[k4][0] = MFMA32(kf, qf[0][ks], s[k4][0]);
        s[k4][1] = MFMA32(kf, qf[1][ks], s[k4][1]);
      }
    }
    bf16x8 pp[2][2];
#pragma unroll
    for (int qt = 0; qt < 2; ++qt) {
      float mx = -1e30f;
#pragma unroll
      for (int k4 = 0; k4 < 4; ++k4)
#pragma unroll
        for (int j = 0; j < 4; ++j) mx = fmaxf(mx, s[k4][qt][j]);
      mx = fmaxf(mx, __shfl_xor(mx, 16)); mx = fmaxf(mx, __shfl_xor(mx, 32));
      const float mnew = fmaxf(mrun[qt], mx);
      const float alpha = exp2f(mrun[qt] - mnew);
      mrun[qt] = mnew;
      float ps = 0.f;
#pragma unroll
      for (int k4 = 0; k4 < 4; ++k4)
#pragma unroll
        for (int j = 0; j < 4; ++j) { const float pv = exp2f(s[k4][qt][j] - mnew); s[k4][qt][j] = pv; ps += pv; }
      lrun[qt] = lrun[qt] * alpha + ps;
#pragma unroll
      for (int dt = 0; dt < 4; ++dt) o[dt][qt] = o[dt][qt] * alpha;
      pp[qt][0] = pack8(s[0][qt], s[1][qt]);
      pp[qt][1] = pack8(s[2][qt], s[3][qt]);
    }
#pragma unroll
    for (int dt = 0; dt < 4; ++dt)
#pragma unroll
      for (int a = 0; a < 2; ++a) {
        const char* vp = smem + cur + FA_KT + (dt * 16 + fr) * FA_VROW + (a * 32 + fq * 4) * 2;
        const bf16x8 vf = cat4(*(const bf16x4*)vp, *(const bf16x4*)(vp + 32));
        o[dt][0] = MFMA32(vf, pp[0][a], o[dt][0]);
        o[dt][1] = MFMA32(vf, pp[1][a], o[dt][1]);
      }
    if (kt + 1 < 64) {
#pragma unroll
      for (int i = 0; i < 3; ++i) *(u32x4*)(smem + nxt + ks_off[i]) = rk[i];
#pragma unroll
      for (int i = 0; i < 2; ++i) *(u32x4*)(smem + nxt + vs_off[i]) = rv[i];
    }
    __syncthreads();
  }
#pragma unroll
  for (int qt = 0; qt < 2; ++qt) {
    float l = lrun[qt];
    l += __shfl_xor(l, 16); l += __shfl_xor(l, 32);
    const float inv = 1.f / l;
    const size_t tq = (size_t)b * 4096 + qb * 128 + wid * 32 + qt * 16 + fr;
#pragma unroll
    for (int dt = 0; dt < 4; ++dt) *(u32x2*)(O + tq * 1024 + h * 64 + dt * 16 + fq * 4) = pack4(o[dt][qt] * inv);
  }
}

#define XB_TMO      128
#define XB_XCNT(j)  (256  + 64 * (j))
#define XB_XSUB(j)  (1280 + 64 * (j))
#define XB_XGEN(j)  (2304 + 64 * (j))
#define XB_TOP      3328
#define XB_TOPGEN   3392
#define XCD_BAR_WORDS 3456
#define XB_SPIN_CAP (1u << 22)
DI unsigned xb_ld(unsigned* p) { return __hip_atomic_load(p, __ATOMIC_RELAXED, __HIP_MEMORY_SCOPE_AGENT); }
DI unsigned xb_add(unsigned* p, unsigned v) { return __hip_atomic_fetch_add(p, v, __ATOMIC_RELAXED, __HIP_MEMORY_SCOPE_AGENT); }
DI unsigned xb_xcc_id() { return (unsigned)__builtin_amdgcn_s_getreg((3 << 11) | 20) & 0xFu; }
#define XB_SPIN(cond, bar) do { unsigned _sp = 0; while (cond) { __builtin_amdgcn_s_sleep(1); \
    if ((++_sp & 255u) == 0u) { if (xb_ld(&(bar)[XB_TMO])) break; if (_sp > XB_SPIN_CAP) { atomicAdd(&(bar)[XB_TMO], 1u); break; } } } } while (0)

DI void xcd_barrier_complete(unsigned* bar, unsigned x, unsigned& nloc, unsigned& nx) {
  const unsigned G = gridDim.x;
  unsigned sum, cnt, mine, sp = 0u;
  for (;;) {
    sum = 0u; cnt = 0u; mine = 0u;
#pragma unroll
    for (unsigned j = 0; j < 16; ++j) { const unsigned c = xb_ld(&bar[XB_XCNT(j)]); sum += c; cnt += (c > 0u) ? 1u : 0u; mine = (j == x) ? c : mine; }
    if (sum == G) break;
    __builtin_amdgcn_s_sleep(1);
    if ((++sp & 255u) == 0u) { if (xb_ld(&bar[XB_TMO])) break; if (sp > XB_SPIN_CAP) { atomicAdd(&bar[XB_TMO], 1u); break; } }
  }
  nloc = mine > 0u ? mine : 1u; nx = cnt > 0u ? cnt : 1u;
}

DI void xcd_barrier(unsigned* bar, volatile unsigned* st) {
  asm volatile("s_waitcnt vmcnt(0)" ::: "memory");
  __syncthreads();
  if (threadIdx.x == 0) {
    __builtin_amdgcn_s_waitcnt(0);
    const unsigned x = xb_xcc_id();
    unsigned nloc = st[0], nx = st[1];
    if (nloc == 0u) { xcd_barrier_complete(bar, x, nloc, nx); st[0] = nloc; st[1] = nx; }
    const unsigned old = xb_add(&bar[XB_XSUB(x)], 1u);
    const unsigned gen = old / nloc;
    if (old + 1u == (gen + 1u) * nloc) {
      __builtin_amdgcn_fence(__ATOMIC_RELEASE, "agent");
      asm volatile("s_waitcnt vmcnt(0)" ::: "memory");
      const unsigned og = xb_add(&bar[XB_TOP], 1u);
      const unsigned tg = og / nx;
      if (og + 1u == (tg + 1u) * nx) xb_add(&bar[XB_TOPGEN], 1u);
      else XB_SPIN(xb_ld(&bar[XB_TOPGEN]) == tg, bar);
      __builtin_amdgcn_fence(__ATOMIC_ACQUIRE, "agent");
      xb_add(&bar[XB_XGEN(x)], 1u);
      asm volatile("s_waitcnt vmcnt(0)" ::: "memory");
    } else {
      XB_SPIN(xb_ld(&bar[XB_XGEN(x)]) == gen, bar);
      __builtin_amdgcn_fence(__ATOMIC_ACQUIRE, "agent");
      asm volatile("s_waitcnt vmcnt(0)" ::: "memory");
    }
  }
  __syncthreads();
}

#ifndef ENMASK
#define ENMASK 0xffffffffu
#endif
#define EN(i) ((ENMASK >> (i)) & 1u)
#ifndef DUPMASK
#define DUPMASK 0u
#endif
#define DUP(i) ((DUPMASK >> (i)) & 1u)
#define PHASE_BEGIN(i) if (EN(i) && pc >= p.lo && pc < p.hi) for (int rep_ = 0; rep_ < 1 + (int)DUP(i); ++rep_) {
#define PHASE_END } { if (pc >= p.lo && pc + 1 < p.hi) { if (pc == p.lo) grid.sync(); else xcd_barrier(bar, st); } ++pc; }

__global__ void __launch_bounds__(256, 2) mega(Params p) {
  __shared__ __attribute__((aligned(16))) char smem[73728 + 16];
  cg::grid_group grid = cg::this_grid();
  int pc = 0;
  char* ws = p.ws;
  unsigned* bar = (unsigned*)(ws + OFF_BAR);
  volatile unsigned* st = (volatile unsigned*)(smem + 73728);
  if (threadIdx.x == 0) { st[0] = 0u; st[1] = 0u; (void)xb_add(&bar[XB_XCNT(xb_xcc_id())], 1u); }
  __syncthreads();
  u16* H = (u16*)(ws + OFF_H);
  char* R = ws + OFF_R;
  const float* LB = (const float*)(ws + OFF_TAB);
  const float* RC = LB + 4096; const float* RS = RC + 65536;
  for (int layer = 0; layer < 4; ++layer) {
    const int kind = layer % 3, mi = layer / 3;
    for (int stage = 0; stage < 3; ++stage) {
      if (stage != 1) {
        const float* ng = (stage == 0 ? p.ffn1_norm : p.ffn2_norm) + layer * 1024;
        const u16* wgu = (const u16*)(ws + (stage == 0 ? OFF_WGU1 : OFF_WGU2));
        const u16* wdn = (const u16*)(ws + (stage == 0 ? OFF_WDN1 : OFF_WDN2));
        u16* ACT = (u16*)R;
        PHASE_BEGIN(0)
          const bool first = (layer == 0 && stage == 0);
          if (stage == 0) { if (layer == 0) init_tables(p); cvt_layer(p, layer, smem); }
          norm_phase(first ? p.x : p.X, ng, H, first ? p.X : nullptr, MTOK);
        PHASE_END
        PHASE_BEGIN(1)
          gemm_phase(H, 1024, wgu, 1024, MTOK, 5632, EpiSwiglu{ACT}, smem);
        PHASE_END
        PHASE_BEGIN(2)
          gemm_phase(ACT, 2816, wdn, 2816, MTOK, 1024, EpiResid{p.X, 0.5f}, smem);
        PHASE_END
      } else {
        PHASE_BEGIN(3)
          norm_phase(p.X, p.mix_norm + layer * 1024, H, nullptr, MTOK);
        PHASE_END
        if (kind == 0) {
          constexpr size_t SZ = 32 * MiB;
          HgBufs hb;
          hb.Q = (u16*)(R + 0 * SZ); hb.LFf = (u16*)(R + 1 * SZ); hb.LFb = (u16*)(R + 2 * SZ); hb.V = (u16*)(R + 3 * SZ); hb.G = (u16*)(R + 4 * SZ);
          hb.QIf = (u16*)(R + 5 * SZ); hb.QIb = (u16*)(R + 6 * SZ); hb.KITf = (u16*)(R + 7 * SZ); hb.KITb = (u16*)(R + 8 * SZ);
          hb.VTc = (u16*)(R + 9 * SZ); hb.OI = (u16*)(R + 10 * SZ); hb.OF = hb.Q; hb.OB = hb.LFf; hb.Y = hb.LFb;
          hb.DECf = (float*)(R + 11 * SZ); hb.DECb = (float*)(R + 11 * SZ + 4 * MiB);
          const u16* w_in = (const u16*)(ws + OFF_WMIX); const u16* w_out = (const u16*)(ws + OFF_WMIX + 10485760);
          for (int half = 0; half < 2; ++half) {
            PHASE_BEGIN(4)
              gemm_phase(H + (size_t)half * 16384 * 1024, 1024, w_in, 1024, 16384, 5120, EpiHgIn{hb.Q, hb.LFf, hb.LFb, hb.V, hb.G, LB + layer * 1024}, smem);
            PHASE_END
            PHASE_BEGIN(5)
              for (int item = blockIdx.x; item < 8192; item += gridDim.x) hg_prep_item(hb, item, smem);
            PHASE_END
            PHASE_BEGIN(6)
              hg_scan_phase(hb);
            PHASE_END
            PHASE_BEGIN(7)
              hg_combine_phase(hb, p.hg_g_norm + mi * 128, 16384);
            PHASE_END
            PHASE_BEGIN(8)
              gemm_phase(hb.Y, 1024, w_out, 1024, 16384, 1024, EpiResid{p.X + (size_t)half * 16384 * 1024, 1.0f}, smem);
            PHASE_END
          }
        } else if (kind == 1) {
          u16* Qn = (u16*)R; u16* Kn = (u16*)(R + 64 * MiB); u16* VT = (u16*)(R + 128 * MiB); u16* On = (u16*)(R + 192 * MiB);
          const u16* w_in = (const u16*)(ws + OFF_WMIX); const u16* w_out = (const u16*)(ws + OFF_WMIX + 6291456);
          PHASE_BEGIN(9)
            gemm_phase(H, 1024, w_in, 1024, MTOK, 3072, EpiNaIn{Qn, Kn, VT, p.na_q_norm + mi * 64, p.na_k_norm + mi * 64}, smem);
          PHASE_END
          PHASE_BEGIN(10)
            const int tid_ = otid(), lane = tid_ & 63, wid = tid_ >> 6, fr = lane & 15, fq = lane >> 4;
            for (int item = blockIdx.x * 4 + wid; item < 32768; item += gridDim.x * 4)
              na_attn_item(Qn, Kn, VT, p.na_rpb + (size_t)mi * 16 * 15 * 31, On, item, fr, fq);
          PHASE_END
          PHASE_BEGIN(11)
            gemm_phase(On, 1024, w_out, 1024, MTOK, 1024, EpiResid{p.X, 1.0f}, smem);
          PHASE_END
        } else {
          u16* VT = H;
          u16* CRAW = (u16*)R; u16* On = (u16*)R;
          u16* CQN = (u16*)(R + 66 * MiB); u16* CKVN = (u16*)(R + 114 * MiB); u16* Kk = (u16*)(R + 66 * MiB);
          float* KROPE = (float*)(R + 162 * MiB);
          u16* Qq = (u16*)(R + 166 * MiB); u16* KVRAW = (u16*)(R + 262 * MiB);
          const u16* w_in = (const u16*)(ws + OFF_WMIX); const u16* w_uq = (const u16*)(ws + OFF_WMIX + 2359296);
          const u16* w_ukv = (const u16*)(ws + OFF_WMIX + 4718592); const u16* w_out = (const u16*)(ws + OFF_WMIX + 5767168);
          PHASE_BEGIN(12)
            gemm_phase(H, 1024, w_in, 1024, MTOK, 1152, EpiStore{CRAW, 1056, 1056}, smem);
          PHASE_END
          PHASE_BEGIN(13)
            mla_norm_phase(CRAW, p.mla_q_a_norm + mi * 768, p.mla_kv_a_norm + mi * 256, CQN, CKVN, KROPE);
          PHASE_END
          PHASE_BEGIN(14)
            gemm_phase(CQN, 768, w_uq, 768, MTOK, 1536, EpiStore{Qq, 1536, 1536}, smem);
            gemm_phase(CKVN, 256, w_ukv, 256, MTOK, 2048, EpiStore{KVRAW, 2048, 2048}, smem);
          PHASE_END
          PHASE_BEGIN(15)
            mla_prep_phase(Qq, KVRAW, KROPE, Kk, p.mla_q_norm + mi * 96, p.mla_k_norm + mi * 96, RC, RS);
            mla_vt_phase(KVRAW, VT, smem);
          PHASE_END
          PHASE_BEGIN(16)
            for (int item = blockIdx.x; item < 4096; item += gridDim.x) mla_attn_item(Qq, Kk, VT, On, item, smem);
          PHASE_END
          PHASE_BEGIN(17)
            gemm_phase(On, 1024, w_out, 1024, MTOK, 1024, EpiResid{p.X, 1.0f}, smem);
          PHASE_END
        }
      }
    }
  }
}

static int count_phases() {
  int n = 0;
  for (int layer = 0; layer < 4; ++layer) {
    int kind = layer % 3;
    n += 3 + 3 + 1;
    n += kind == 0 ? 10 : kind == 1 ? 3 : 6;
  }
  return n;
}

extern "C" void kernel_launch(void* const* d_in, const int* in_sizes, int n_in, void* d_out, int out_size, void* d_ws, size_t ws_size, hipStream_t stream) {
  if (ws_size < WS_NEED) { fprintf(stderr, "workspace too small: %zu < %zu\n", ws_size, WS_NEED); return; }
  static int grid_blocks = 0;
  if (!grid_blocks) {
    int dev = 0, cus = 0, per_cu = 0;
    hipGetDevice(&dev);
    hipDeviceGetAttribute(&cus, hipDeviceAttributeMultiprocessorCount, dev);
    hipOccupancyMaxActiveBlocksPerMultiprocessor(&per_cu, mega, 256, 0);
    if (per_cu > 2) per_cu = 2;
    grid_blocks = cus * per_cu;
  }
  Params p{};
  const float** pf = (const float**)&p;
  for (int i = 0; i < 25; ++i) pf[i] = (const float*)d_in[i];
  p.X = (float*)d_out; p.ws = (char*)d_ws;
  const int total = count_phases();
#if MULTI_LAUNCH
  for (int ph = 0; ph < total; ++ph) {
    p.lo = ph; p.hi = ph + 1;
    hipLaunchKernelGGL(mega, dim3(grid_blocks), dim3(256), 0, stream, p);
  }
#else
  hipMemsetAsync((char*)d_ws + OFF_BAR, 0, 16384, stream);
  p.lo = 0; p.hi = total;
  void* args[] = {&p};
  hipError_t e = hipLaunchCooperativeKernel((void*)mega, dim3(grid_blocks), dim3(256), args, 0, stream);
  if (e != hipSuccess) fprintf(stderr, "cooperative launch failed: %s (grid %d)\n", hipGetErrorString(e), grid_blocks);
#endif
}
```

```cpp
#include <hip/hip_runtime.h>
#include <hip/hip_cooperative_groups.h>
#include <cstdio>
#include <cstdint>
namespace cg = cooperative_groups;

#ifndef MULTI_LAUNCH
#define MULTI_LAUNCH 0
#endif

typedef unsigned short u16;
typedef unsigned int u32;
using bf16x8 = __attribute__((ext_vector_type(8))) short;
using bf16x4 = __attribute__((ext_vector_type(4))) short;
using f32x4 = __attribute__((ext_vector_type(4))) float;
using u32x2 = __attribute__((ext_vector_type(2))) unsigned int;
using u32x4 = __attribute__((ext_vector_type(4))) unsigned int;

#define DI __device__ __forceinline__
#define MFMA32(a, b, c) __builtin_amdgcn_mfma_f32_16x16x32_bf16((a), (b), (c), 0, 0, 0)

constexpr int MTOK = 32768;
constexpr float EPS = 1e-6f;
constexpr float LOG2E = 1.4426950408889634f;

constexpr size_t MiB = 1048576;
constexpr size_t OFF_WGU1 = 0;
constexpr size_t OFF_WDN1 = 11534336;
constexpr size_t OFF_WGU2 = 17301504;
constexpr size_t OFF_WDN2 = 28835840;
constexpr size_t OFF_WMIX = 34603008;
constexpr size_t OFF_TAB = 47185920;
constexpr size_t OFF_BAR = OFF_TAB + 786432;
constexpr size_t OFF_H = 46 * MiB;
constexpr size_t OFF_R = 110 * MiB;
constexpr size_t WS_NEED = 500 * MiB;

struct Params {
  const float* x; const float* ffn1_norm; const float* ffn1_w_gu; const float* ffn1_w_down;
  const float* mix_norm; const float* ffn2_norm; const float* ffn2_w_gu; const float* ffn2_w_down;
  const float* hg_lb_logits; const float* hg_w_in; const float* hg_g_norm; const float* hg_w_out;
  const float* na_w_in; const float* na_q_norm; const float* na_k_norm; const float* na_rpb; const float* na_w_out;
  const float* mla_w_in; const float* mla_q_a_norm; const float* mla_w_uq; const float* mla_kv_a_norm; const float* mla_w_ukv;
  const float* mla_q_norm; const float* mla_k_norm; const float* mla_w_out;
  float* X; char* ws; int lo; int hi;
};

DI u32 f2bf(float x) { u32 u = __float_as_uint(x); u += 0x7fffu + ((u >> 16) & 1u); return u >> 16; }
typedef __bf16 bf16v2 __attribute__((ext_vector_type(2)));
typedef float f32v2 __attribute__((ext_vector_type(2)));
DI u32 pack2(float a, float b) { f32v2 v = {a, b}; bf16v2 r = __builtin_convertvector(v, bf16v2); return __builtin_bit_cast(u32, r); }
DI float bflo(u32 w) { return __uint_as_float(w << 16); }
DI float bfhi(u32 w) { return __uint_as_float(w & 0xffff0000u); }
DI float bfget(const u32x4& v, int e) { u32 w = v[e >> 1]; return (e & 1) ? bfhi(w) : bflo(w); }
DI u32x2 pack4(const f32x4& v) { u32x2 r; r[0] = pack2(v[0], v[1]); r[1] = pack2(v[2], v[3]); return r; }
DI bf16x8 pack8(const f32x4& a, const f32x4& b) {
  u32x4 r; r[0] = pack2(a[0], a[1]); r[1] = pack2(a[2], a[3]); r[2] = pack2(b[0], b[1]); r[3] = pack2(b[2], b[3]);
  return __builtin_bit_cast(bf16x8, r);
}
DI bf16x8 cat4(const bf16x4& lo, const bf16x4& hi) { return __builtin_shufflevector(lo, hi, 0, 1, 2, 3, 4, 5, 6, 7); }
DI float wave_sum(float v) {
#pragma unroll
  for (int o = 32; o > 0; o >>= 1) v += __shfl_xor(v, o);
  return v;
}
DI float sigmoidf_(float z) { return 1.f / (1.f + __expf(-z)); }
DI float siluf_(float z) { return z / (1.f + __expf(-z)); }
DI int otid() { int t = threadIdx.x; asm volatile("" : "+v"(t)); return t; }
DI f32x4 zero4() { f32x4 z = {0.f, 0.f, 0.f, 0.f}; return z; }

DI void init_tables(const Params& p) {
  float* LB = (float*)(p.ws + OFF_TAB); float* RC = LB + 4096; float* RS = RC + 65536;
  const int gt = blockIdx.x * 256 + otid(), gs = gridDim.x * 256;
  for (int c = gt; c < 1024; c += gs) {
    float l0 = p.hg_lb_logits[c], l1 = p.hg_lb_logits[1024 + c], l2 = p.hg_lb_logits[2048 + c], l3 = p.hg_lb_logits[3072 + c];
    float mx = fmaxf(fmaxf(l0, l1), fmaxf(l2, l3));
    float e0 = expf(l0 - mx), e1 = expf(l1 - mx), e2 = expf(l2 - mx), e3 = expf(l3 - mx);
    float inv = 1.f / (e0 + e1 + e2 + e3);
    LB[c] = 0.f; LB[1024 + c] = e1 * inv; LB[2048 + c] = (e1 + e2) * inv; LB[3072 + c] = (e1 + e2 + e3) * inv;
  }
  for (int i = gt; i < 65536; i += gs) {
    int t = i >> 4, j = i & 15;
    float inv = exp2f(-(float)j * (13.287712379549449f / 16.f));
    float ang = (float)t * inv;
    double a = (double)ang;
    double k = rint(a * 0.15915494309189535);
    float r = (float)(a - k * 6.283185307179586);
    RC[i] = __cosf(r); RS[i] = __sinf(r);
  }
}

DI void cvt_tiles(const float* __restrict__ src, u16* __restrict__ dst, int K, int N, int Nd, int mode, char* smem) {
  float* tile = (float*)smem;
  const int tk = K >> 6, tn = Nd >> 6, tid = otid();
  for (int t = blockIdx.x; t < tk * tn; t += gridDim.x) {
    const int k0 = (t % tk) << 6, n0 = (t / tk) << 6;
    {
      const int nl = tid & 63, kq = tid >> 6;
      const int nd = n0 + nl;
      int col = nd;
      if (mode == 1) { int a = nd >> 5, r = nd & 31; col = a * 16 + (r & 15) + ((r >= 16) ? 2816 : 0); }
      const bool ok = col < N;
#pragma unroll
      for (int i = 0; i < 16; ++i) {
        int kl = kq + 4 * i;
        tile[kl * 65 + nl] = ok ? src[(size_t)(k0 + kl) * N + col] : 0.f;
      }
    }
    __syncthreads();
    {
      const int kp = (tid & 31) * 2, nq = tid >> 5;
#pragma unroll
      for (int i = 0; i < 8; ++i) {
        int n = nq + 8 * i;
        *(u32*)(dst + (size_t)(n0 + n) * K + k0 + kp) = pack2(tile[kp * 65 + n], tile[(kp + 1) * 65 + n]);
      }
    }
    __syncthreads();
  }
}

DI void cvt_layer(const Params& p, int layer, char* smem) {
  const int kind = layer % 3, mi = layer / 3;
  char* ws = p.ws;
  for (int task = 0; task < 8; ++task) {
    const float* src = nullptr; size_t off = 0; int K = 0, N = 0, Nd = 0, mode = 0;
    if (task == 0) { src = p.ffn1_w_gu + (size_t)layer * 1024 * 5632; off = OFF_WGU1; K = 1024; N = 5632; Nd = 5632; mode = 1; }
    else if (task == 1) { src = p.ffn1_w_down + (size_t)layer * 2816 * 1024; off = OFF_WDN1; K = 2816; N = 1024; Nd = 1024; }
    else if (task == 2) { src = p.ffn2_w_gu + (size_t)layer * 1024 * 5632; off = OFF_WGU2; K = 1024; N = 5632; Nd = 5632; mode = 1; }
    else if (task == 3) { src = p.ffn2_w_down + (size_t)layer * 2816 * 1024; off = OFF_WDN2; K = 2816; N = 1024; Nd = 1024; }
    else if (kind == 0) {
      if (task == 4) { src = p.hg_w_in + (size_t)mi * 1024 * 5120; off = OFF_WMIX; K = 1024; N = 5120; Nd = 5120; }
      else if (task == 5) { src = p.hg_w_out + (size_t)mi * 1024 * 1024; off = OFF_WMIX + 10485760; K = 1024; N = 1024; Nd = 1024; }
    } else if (kind == 1) {
      if (task == 4) { src = p.na_w_in + (size_t)mi * 1024 * 3072; off = OFF_WMIX; K = 1024; N = 3072; Nd = 3072; }
      else if (task == 5) { src = p.na_w_out + (size_t)mi * 1024 * 1024; off = OFF_WMIX + 6291456; K = 1024; N = 1024; Nd = 1024; }
    } else {
      if (task == 4) { src = p.mla_w_in + (size_t)mi * 1024 * 1056; off = OFF_WMIX; K = 1024; N = 1056; Nd = 1152; }
      else if (task == 5) { src = p.mla_w_uq + (size_t)mi * 768 * 1536; off = OFF_WMIX + 2359296; K = 768; N = 1536; Nd = 1536; }
      else if (task == 6) { src = p.mla_w_ukv + (size_t)mi * 256 * 2048; off = OFF_WMIX + 4718592; K = 256; N = 2048; Nd = 2048; }
      else if (task == 7) { src = p.mla_w_out + (size_t)mi * 1024 * 1024; off = OFF_WMIX + 5767168; K = 1024; N = 1024; Nd = 1024; }
    }
    if (src) cvt_tiles(src, (u16*)(ws + off), K, N, Nd, mode, smem);
  }
}

DI void norm_phase(const float* __restrict__ src, const float* __restrict__ gain, u16* __restrict__ dst, float* copy_dst, int rows) {
  const int lane = otid() & 63, wid = otid() >> 6;
  f32x4 g[4];
#pragma unroll
  for (int i = 0; i < 4; ++i) g[i] = *(const f32x4*)(gain + i * 256 + lane * 4);
  for (int row = blockIdx.x * 4 + wid; row < rows; row += gridDim.x * 4) {
    const float* s = src + (size_t)row * 1024;
    f32x4 v[4]; float ss = 0.f;
#pragma unroll
    for (int i = 0; i < 4; ++i) { v[i] = *(const f32x4*)(s + i * 256 + lane * 4); ss += v[i][0] * v[i][0] + v[i][1] * v[i][1] + v[i][2] * v[i][2] + v[i][3] * v[i][3]; }
    ss = wave_sum(ss);
    const float rstd = rsqrtf(ss * (1.f / 1024.f) + EPS);
#pragma unroll
    for (int i = 0; i < 4; ++i) {
      f32x4 y = v[i] * rstd * g[i];
      *(u32x2*)(dst + (size_t)row * 1024 + i * 256 + lane * 4) = pack4(y);
      if (copy_dst) *(f32x4*)(copy_dst + (size_t)row * 1024 + i * 256 + lane * 4) = v[i];
    }
  }
}

constexpr int LDS_TILE = 128 * 128;
constexpr int LDS_BUF = 2 * LDS_TILE;

#define GLDS16(gp, lp) __builtin_amdgcn_global_load_lds((const unsigned*)(gp), (unsigned*)(lp), 16, 0, 0)

template <class Epi>
DI void gemm_tile(const u16* __restrict__ A, int lda, const u16* __restrict__ W, int K, int m0, int n0, const Epi& epi, char* smem) {
  const int tid = otid(), lane = tid & 63, wid = tid >> 6;
  const int wm = wid >> 1, wn = wid & 1, fr = lane & 15, fq = lane >> 4;
  f32x4 acc[4][4];
#pragma unroll
  for (int i = 0; i < 4; ++i)
#pragma unroll
    for (int j = 0; j < 4; ++j) acc[i][j] = zero4();
  const int lrow = tid >> 3, lc = (tid & 7) ^ ((tid >> 4) & 7);
  const u16* ga = A + (size_t)lrow * lda + lc * 8;
  const u16* gw = W + (size_t)lrow * K + lc * 8;
  char* sdst = smem + tid * 16;
  const int sw = fr >> 1;
  const int ro0 = ((fq) ^ sw) * 16, ro1 = ((4 + fq) ^ sw) * 16;
  const char* sa_rd = smem + (wm * 64 + fr) * 128;
  const char* sw_rd = smem + LDS_TILE + (wn * 64 + fr) * 128;
  const int nk = K >> 6;
#pragma unroll
  for (int i = 0; i < 4; ++i) { GLDS16(ga + (size_t)(32 * i) * lda, sdst + i * 4096); GLDS16(gw + (size_t)(32 * i) * K, sdst + LDS_TILE + i * 4096); }
  asm volatile("s_waitcnt vmcnt(0)" ::: "memory");
  __syncthreads();
  for (int t = 0; t < nk; ++t) {
    const int cur = (t & 1) * LDS_BUF, nxt = LDS_BUF - cur;
    if (t + 1 < nk) {
      const int k0 = (t + 1) << 6;
#pragma unroll
      for (int i = 0; i < 4; ++i) { GLDS16(ga + (size_t)(32 * i) * lda + k0, sdst + nxt + i * 4096); GLDS16(gw + (size_t)(32 * i) * K + k0, sdst + nxt + LDS_TILE + i * 4096); }
    }
#pragma unroll
    for (int ks = 0; ks < 2; ++ks) {
      const int ro = ks ? ro1 : ro0;
      bf16x8 af[4], wf[4];
#pragma unroll
      for (int i = 0; i < 4; ++i) {
        af[i] = *(const bf16x8*)(sa_rd + cur + i * 2048 + ro);
        wf[i] = *(const bf16x8*)(sw_rd + cur + i * 2048 + ro);
      }
#pragma unroll
      for (int nt = 0; nt < 4; ++nt)
#pragma unroll
        for (int mt = 0; mt < 4; ++mt) acc[nt][mt] = MFMA32(wf[nt], af[mt], acc[nt][mt]);
    }
    asm volatile("s_waitcnt vmcnt(0)" ::: "memory");
    __syncthreads();
  }
  epi(acc, m0 + wm * 64, n0 + wn * 64, fr, fq);
}

template <class Epi>
DI void gemm_phase(const u16* A, int lda, const u16* W, int K, int Mrows, int Ncols, const Epi& epi, char* smem) {
  const int mtn = Mrows >> 7, ntn = Ncols >> 7;
  const int ntiles = mtn * ntn;
  constexpr int GM = 16;
  for (int tile = blockIdx.x; tile < ntiles; tile += gridDim.x) {
    const int group = tile / (GM * ntn), rem = tile % (GM * ntn);
    const int mt = group * GM + (rem % GM), nt = rem / GM;
    gemm_tile(A + (size_t)mt * 128 * lda, lda, W + (size_t)nt * 128 * K, K, mt * 128, nt * 128, epi, smem);
  }
}

struct EpiSwiglu {
  u16* act;
  DI void operator()(f32x4 (&acc)[4][4], int mb, int nb, int fr, int fq) const {
#pragma unroll
    for (int mt = 0; mt < 4; ++mt) {
      const int m = mb + mt * 16 + fr;
#pragma unroll
      for (int np = 0; np < 2; ++np) {
        const f32x4 g = acc[2 * np][mt], u = acc[2 * np + 1][mt];
        f32x4 r;
#pragma unroll
        for (int j = 0; j < 4; ++j) r[j] = siluf_(g[j]) * u[j];
        const int jc = (nb >> 1) + np * 16 + fq * 4;
        *(u32x2*)(act + (size_t)m * 2816 + jc) = pack4(r);
      }
    }
  }
};

struct EpiResid {
  float* X; float scale;
  DI void operator()(f32x4 (&acc)[4][4], int mb, int nb, int fr, int fq) const {
#pragma unroll
    for (int mt = 0; mt < 4; ++mt) {
      const int m = mb + mt * 16 + fr;
#pragma unroll
      for (int nt = 0; nt < 4; ++nt) {
        f32x4* ptr = (f32x4*)(X + (size_t)m * 1024 + nb + nt * 16 + fq * 4);
        f32x4 v = *ptr;
        v += acc[nt][mt] * scale;
        *ptr = v;
      }
    }
  }
};

struct EpiStore {
  u16* out; int ldo; int nmax;
  DI void operator()(f32x4 (&acc)[4][4], int mb, int nb, int fr, int fq) const {
#pragma unroll
    for (int mt = 0; mt < 4; ++mt) {
      const int m = mb + mt * 16 + fr;
#pragma unroll
      for (int nt = 0; nt < 4; ++nt) {
        const int n = nb + nt * 16 + fq * 4;
        if (n < nmax) *(u32x2*)(out + (size_t)m * ldo + n) = pack4(acc[nt][mt]);
      }
    }
  }
};

struct EpiHgIn {
  u16 *Q, *LFf, *LFb, *V, *G; const float* lb;
  DI void operator()(f32x4 (&acc)[4][4], int mb, int nb, int fr, int fq) const {
    const int seg = nb >> 10, c0 = nb & 1023;
    u16* dst = seg == 0 ? Q : seg == 1 ? LFf : seg == 2 ? LFb : seg == 3 ? V : G;
#pragma unroll
    for (int mt = 0; mt < 4; ++mt) {
      const int m = mb + mt * 16 + fr;
#pragma unroll
      for (int nt = 0; nt < 4; ++nt) {
        const int c = c0 + nt * 16 + fq * 4;
        f32x4 a = acc[nt][mt], r;
        if (seg == 0) r = a * 0.08838834764831845f;
        else if (seg == 3) r = a;
        else if (seg == 4) {
#pragma unroll
          for (int j = 0; j < 4; ++j) r[j] = siluf_(a[j]);
        } else {
          const f32x4 l4 = *(const f32x4*)(lb + c);
#pragma unroll
          for (int j = 0; j < 4; ++j) {
            float z = fminf(fmaxf(a[j], -30.f), 30.f);
            float f = l4[j] + (1.f - l4[j]) * sigmoidf_(z);
            r[j] = __logf(f);
          }
        }
        *(u32x2*)(dst + (size_t)m * 1024 + c) = pack4(r);
      }
    }
  }
};

struct EpiNaIn {
  u16 *Q, *K, *VT; const float *qn, *kn;
  DI void operator()(f32x4 (&acc)[4][4], int mb, int nb, int fr, int fq) const {
    const int seg = nb >> 10, h = (nb & 1023) >> 6;
    if (seg < 2) {
      u16* dst = seg == 0 ? Q : K;
      const float* gn = seg == 0 ? qn : kn;
      const float sc = seg == 0 ? 0.125f * LOG2E : 1.f;
#pragma unroll
      for (int mt = 0; mt < 4; ++mt) {
        const int m = mb + mt * 16 + fr;
        float ss = 0.f;
#pragma unroll
        for (int nt = 0; nt < 4; ++nt)
#pragma unroll
          for (int j = 0; j < 4; ++j) ss += acc[nt][mt][j] * acc[nt][mt][j];
        ss += __shfl_xor(ss, 16); ss += __shfl_xor(ss, 32);
        const float rstd = rsqrtf(ss * (1.f / 64.f) + EPS) * sc;
#pragma unroll
        for (int nt = 0; nt < 4; ++nt) {
          const int d = nt * 16 + fq * 4;
          const f32x4 g4 = *(const f32x4*)(gn + d);
          f32x4 r = acc[nt][mt] * rstd * g4;
          *(u32x2*)(dst + (size_t)m * 1024 + h * 64 + d) = pack4(r);
        }
      }
    } else {
#pragma unroll
      for (int mt = 0; mt < 4; ++mt) {
        const int m = mb + mt * 16 + fr;
        const int b = m >> 12, t = m & 4095;
#pragma unroll
        for (int nt = 0; nt < 4; ++nt)
#pragma unroll
          for (int j = 0; j < 4; ++j) {
            const int d = nt * 16 + fq * 4 + j;
            VT[((size_t)((b * 16 + h) * 64 + d)) * 4096 + t] = (u16)f2bf(acc[nt][mt][j]);
          }
      }
    }
  }
};

struct HgBufs {
  u16 *Q, *LFf, *LFb, *V, *G, *QIf, *QIb, *KITf, *KITb, *VTc, *OI, *OF, *OB, *Y;
  float *DECf, *DECb;
};

DI void hg_prep_item(const HgBufs& hb, int item, char* smem) {
  const int h = item & 7, n = (item >> 3) & 255, b = item >> 11;
  float* sq = (float*)smem; float* sbf = sq + 2112; float* sbb = sbf + 2112; float* skf = sbb + 2112;
  float* skb = skf + 2112; float* sv = skb + 2112; float* sA = sv + 2112;
  const int tid = otid();
  const int row = tid >> 4, c8 = (tid & 15) * 8;
  const size_t tok0 = (size_t)b * 4096 + n * 16;
  const size_t gidx = (tok0 + row) * 1024 + h * 128 + c8;
  {
    const u32x4 rq = *(const u32x4*)(hb.Q + gidx), rf = *(const u32x4*)(hb.LFf + gidx);
    const u32x4 rb = *(const u32x4*)(hb.LFb + gidx), rv = *(const u32x4*)(hb.V + gidx);
#pragma unroll
    for (int e = 0; e < 8; ++e) {
      const int o = row * 132 + c8 + e;
      const float lf = bfget(rf, e), lb_ = bfget(rb, e);
      sq[o] = bfget(rq, e); sbf[o] = lf; sbb[o] = lb_;
      skf[o] = 1.f - __expf(lf); skb[o] = 1.f - __expf(lb_); sv[o] = bfget(rv, e);
    }
  }
  __syncthreads();
  if (tid < 128) {
    const int d = tid; float a = 0.f;
#pragma unroll
    for (int t = 0; t < 16; ++t) { a += sbf[t * 132 + d]; sbf[t * 132 + d] = a; }
    hb.DECf[((size_t)b * 256 + n) * 1024 + h * 128 + d] = __expf(a);
  } else {
    const int d = tid - 128; float a = 0.f;
#pragma unroll
    for (int t = 15; t >= 0; --t) { a += sbb[t * 132 + d]; sbb[t * 132 + d] = a; }
    hb.DECb[((size_t)b * 256 + n) * 1024 + h * 128 + d] = __expf(a);
  }
  __syncthreads();
  {
    u32x4 of, ob;
#pragma unroll
    for (int e2 = 0; e2 < 4; ++e2) {
      const int o = row * 132 + c8 + 2 * e2;
      const float q0 = sq[o], q1 = sq[o + 1];
      of[e2] = pack2(q0 * __expf(sbf[o]), q1 * __expf(sbf[o + 1]));
      ob[e2] = pack2(q0 * __expf(sbb[o]), q1 * __expf(sbb[o + 1]));
    }
    *(u32x4*)(hb.QIf + gidx) = of; *(u32x4*)(hb.QIb + gidx) = ob;
  }
  {
    const int d = tid >> 1, t8 = (tid & 1) * 8;
    const float blf = sbf[15 * 132 + d], blb = sbb[d];
    u32x4 kf, kb, vv;
#pragma unroll
    for (int e2 = 0; e2 < 4; ++e2) {
      const int o0 = (t8 + 2 * e2) * 132 + d, o1 = o0 + 132;
      kf[e2] = pack2(skf[o0] * __expf(blf - sbf[o0]), skf[o1] * __expf(blf - sbf[o1]));
      kb[e2] = pack2(skb[o0] * __expf(blb - sbb[o0]), skb[o1] * __expf(blb - sbb[o1]));
      vv[e2] = pack2(sv[o0], sv[o1]);
    }
    const size_t cidx = (((size_t)(b * 8 + h) * 256 + n) * 128 + d) * 16 + t8;
    *(u32x4*)(hb.KITf + cidx) = kf; *(u32x4*)(hb.KITb + cidx) = kb; *(u32x4*)(hb.VTc + cidx) = vv;
  }
  {
    const int t = tid >> 4, s = tid & 15;
    if (s <= t) {
      float af = 0.f, ab = 0.f;
      for (int d4 = 0; d4 < 32; ++d4) {
        const f32x4 qt = *(const f32x4*)(sq + t * 132 + d4 * 4), qs = *(const f32x4*)(sq + s * 132 + d4 * 4);
        const f32x4 kfs = *(const f32x4*)(skf + s * 132 + d4 * 4), kbt = *(const f32x4*)(skb + t * 132 + d4 * 4);
        const f32x4 bft = *(const f32x4*)(sbf + t * 132 + d4 * 4), bfs = *(const f32x4*)(sbf + s * 132 + d4 * 4);
        const f32x4 bbs = *(const f32x4*)(sbb + s * 132 + d4 * 4), bbt = *(const f32x4*)(sbb + t * 132 + d4 * 4);
#pragma unroll
        for (int c = 0; c < 4; ++c) {
          af += qt[c] * kfs[c] * __expf(bft[c] - bfs[c]);
          ab += qs[c] * kbt[c] * __expf(bbs[c] - bbt[c]);
        }
      }
      if (s == t) sA[t * 17 + t] = af + ab;
      else { sA[t * 17 + s] = af; sA[s * 17 + t] = ab; }
    }
  }
  __syncthreads();
  {
    float o[8];
#pragma unroll
    for (int e = 0; e < 8; ++e) o[e] = 0.f;
#pragma unroll
    for (int s = 0; s < 16; ++s) {
      const float a = sA[row * 17 + s];
      const f32x4 v0 = *(const f32x4*)(sv + s * 132 + c8), v1 = *(const f32x4*)(sv + s * 132 + c8 + 4);
#pragma unroll
      for (int e = 0; e < 4; ++e) { o[e] += a * v0[e]; o[4 + e] += a * v1[e]; }
    }
    u32x4 r; r[0] = pack2(o[0], o[1]); r[1] = pack2(o[2], o[3]); r[2] = pack2(o[4], o[5]); r[3] = pack2(o[6], o[7]);
    *(u32x4*)(hb.OI + gidx) = r;
  }
  __syncthreads();
}

constexpr int SC_NS = 6, SC_STAGE = 12288;
DI void scan_issue(char* smem, int slot, const u16* QI, const u16* KIT, const u16* VTc, const float* DEC, int b, int h, int vg, int n, int tid) {
  char* st = smem + slot * SC_STAGE + tid * 16;
  const size_t tok0 = (size_t)b * 4096 + n * 16;
  const int row = tid >> 4, lc = (tid & 15) ^ row;
  GLDS16(QI + (tok0 + row) * 1024 + h * 128 + lc * 8, st);
  const size_t cb = ((size_t)(b * 8 + h) * 256 + n) * 2048;
  GLDS16(KIT + cb + tid * 8, st + 4096);
  const float* dp = DEC + ((size_t)b * 256 + n) * 1024 + h * 128;
  const void* g3 = tid < 128 ? (const void*)(VTc + cb + vg * 1024 + tid * 8) : (const void*)(dp + ((tid - 128) & 31) * 4);
  GLDS16(g3, st + 8192);
}

DI void hg_scan_phase(const HgBufs& hb, char* smem) {
  const int tid = otid(), lane = tid & 63, wid = tid >> 6, fr = lane & 15, fq = lane >> 4;
  for (int item = blockIdx.x; item < 128; item += gridDim.x) {
    const int vg = item & 1, dir = (item >> 1) & 1, h = (item >> 2) & 7, b = item >> 5;
    const u16* QI = dir ? hb.QIb : hb.QIf; const u16* KIT = dir ? hb.KITb : hb.KITf;
    const float* DEC = dir ? hb.DECb : hb.DECf; u16* Oout = dir ? hb.OB : hb.OF;
    const int vs = vg * 4 + wid;
    f32x4 S[8];
#pragma unroll
    for (int i = 0; i < 8; ++i) S[i] = zero4();
#pragma unroll
    for (int s = 0; s < SC_NS - 1; ++s) scan_issue(smem, s, QI, KIT, hb.VTc, DEC, b, h, vg, dir ? 255 - s : s, tid);
    int slot = 0;
    for (int step = 0; step < 256; ++step) {
      if (step < SC_NS - 1) asm volatile("s_waitcnt vmcnt(12)" ::: "memory");
      else asm volatile("s_waitcnt vmcnt(32)" ::: "memory");
      __builtin_amdgcn_s_barrier();
      asm volatile("" ::: "memory");
      {
        const int ns = min(step + SC_NS - 1, 255);
        int islot = slot + SC_NS - 1; if (islot >= SC_NS) islot -= SC_NS;
        scan_issue(smem, islot, QI, KIT, hb.VTc, DEC, b, h, vg, dir ? 255 - ns : ns, tid);
      }
      const int n = dir ? 255 - step : step;
      const char* st = smem + slot * SC_STAGE;
      bf16x8 qa[4], ka[8]; f32x4 dc[8];
#pragma unroll
      for (int ks = 0; ks < 4; ++ks) {
        const int l0 = 4 * ks + (fq >> 1), l1 = l0 + 2;
        const bf16x4 lo = *(const bf16x4*)(st + fr * 256 + ((l0 ^ fr) * 16) + (fq & 1) * 8);
        const bf16x4 hi = *(const bf16x4*)(st + fr * 256 + ((l1 ^ fr) * 16) + (fq & 1) * 8);
        qa[ks] = cat4(lo, hi);
      }
      bf16x8 vb = *(const bf16x8*)(st + 8192 + (wid * 16 + fr) * 32 + (fq & 1) * 16);
#pragma unroll
      for (int dt = 0; dt < 8; ++dt) {
        ka[dt] = *(const bf16x8*)(st + 4096 + (dt * 16 + fr) * 32 + (fq & 1) * 16);
        dc[dt] = *(const f32x4*)(st + 8192 + 2048 + (dt * 16 + fq * 4) * 4);
      }
      asm volatile("s_waitcnt lgkmcnt(0)" ::: "memory");
      __builtin_amdgcn_sched_barrier(0);
      const bf16x8 z8 = {0, 0, 0, 0, 0, 0, 0, 0};
      if (fq >= 2) vb = z8;
      f32x4 o0 = zero4(), o1 = zero4();
      o0 = MFMA32(qa[0], pack8(S[0], S[1]), o0);
      o1 = MFMA32(qa[1], pack8(S[2], S[3]), o1);
      o0 = MFMA32(qa[2], pack8(S[4], S[5]), o0);
      o1 = MFMA32(qa[3], pack8(S[6], S[7]), o1);
#pragma unroll
      for (int dt = 0; dt < 8; ++dt) {
        if (fq >= 2) ka[dt] = z8;
        S[dt] = S[dt] * dc[dt];
        S[dt] = MFMA32(ka[dt], vb, S[dt]);
      }
      {
        const f32x4 o = o0 + o1;
        const size_t tok0 = (size_t)b * 4096 + n * 16;
        u16* op = Oout + (tok0 + fq * 4) * 1024 + h * 128 + vs * 16 + fr;
        const u32 w0 = pack2(o[0], o[1]), w1 = pack2(o[2], o[3]);
        asm volatile("global_store_short %0, %1, off" :: "v"(op), "v"(w0) : "memory");
        asm volatile("global_store_short_d16_hi %0, %1, off" :: "v"(op + 1024), "v"(w0) : "memory");
        asm volatile("global_store_short %0, %1, off" :: "v"(op + 2048), "v"(w1) : "memory");
        asm volatile("global_store_short_d16_hi %0, %1, off" :: "v"(op + 3072), "v"(w1) : "memory");
      }
      if (++slot == SC_NS) slot = 0;
    }
    asm volatile("s_waitcnt vmcnt(0)" ::: "memory");
    __syncthreads();
  }
}

DI void hg_combine_phase(const HgBufs& hb, const float* __restrict__ gnorm, int rows) {
  const int lane = otid() & 63, wid = otid() >> 6;
  const int h = lane >> 3, c16 = (lane & 7) * 16;
  for (int row = blockIdx.x * 4 + wid; row < rows; row += gridDim.x * 4) {
    const size_t g = (size_t)row * 1024 + h * 128 + c16;
    float o[16]; float ss = 0.f;
#pragma unroll
    for (int half = 0; half < 2; ++half) {
      const u32x4 a = *(const u32x4*)(hb.OI + g + half * 8), f = *(const u32x4*)(hb.OF + g + half * 8), bb = *(const u32x4*)(hb.OB + g + half * 8);
#pragma unroll
      for (int e = 0; e < 8; ++e) { float v = bfget(a, e) + bfget(f, e) + bfget(bb, e); o[half * 8 + e] = v; ss += v * v; }
    }
    ss += __shfl_xor(ss, 1); ss += __shfl_xor(ss, 2); ss += __shfl_xor(ss, 4);
    const float rstd = rsqrtf(ss * (1.f / 128.f) + EPS);
#pragma unroll
    for (int half = 0; half < 2; ++half) {
      const u32x4 gs = *(const u32x4*)(hb.G + g + half * 8);
      u32x4 r;
#pragma unroll
      for (int e2 = 0; e2 < 4; ++e2) {
        const int e = half * 8 + 2 * e2;
        r[e2] = pack2(o[e] * rstd * gnorm[c16 + e] * bfget(gs, 2 * e2), o[e + 1] * rstd * gnorm[c16 + e + 1] * bfget(gs, 2 * e2 + 1));
      }
      *(u32x4*)(hb.Y + g + half * 8) = r;
    }
  }
}

DI void na_attn_item(const u16* __restrict__ Q, const u16* __restrict__ K, const u16* __restrict__ VT, const float* __restrict__ rpb, u16* __restrict__ O, int item, int fr, int fq) {
  const int h = item & 15, qt = (item >> 4) & 3, r = (item >> 6) & 63, b = item >> 12;
  const int r0 = min(max(r - 4, 0), 56);
  const int cw0 = qt == 0 ? 0 : qt == 1 ? 8 : qt == 2 ? 24 : 32;
  const size_t tokq = (size_t)b * 4096 + r * 64 + qt * 16 + fr;
  bf16x8 qf[2];
#pragma unroll
  for (int ks = 0; ks < 2; ++ks) qf[ks] = *(const bf16x8*)(Q + tokq * 1024 + h * 64 + ks * 32 + fq * 8);
  f32x4 s[8][2];
#pragma unroll
  for (int kr = 0; kr < 8; ++kr)
#pragma unroll
    for (int hf = 0; hf < 2; ++hf) {
      const size_t tokk = (size_t)b * 4096 + (r0 + kr) * 64 + cw0 + hf * 16 + fr;
      const bf16x8 k0 = *(const bf16x8*)(K + tokk * 1024 + h * 64 + fq * 8);
      const bf16x8 k1 = *(const bf16x8*)(K + tokk * 1024 + h * 64 + 32 + fq * 8);
      f32x4 a = MFMA32(k0, qf[0], zero4());
      s[kr][hf] = MFMA32(k1, qf[1], a);
    }
  const int qc = qt * 16 + fr;
  const int cs = min(max(qc - 8, 0), 48);
  float mx = -1e30f;
#pragma unroll
  for (int kr = 0; kr < 8; ++kr) {
    const float* rp = rpb + (h * 15 + (r0 + kr - r + 7)) * 31;
#pragma unroll
    for (int hf = 0; hf < 2; ++hf)
#pragma unroll
      for (int j = 0; j < 4; ++j) {
        const int kc = cw0 + hf * 16 + fq * 4 + j;
        const bool valid = (kc >= cs) && (kc < cs + 16);
        const int ci = min(max(kc - qc + 15, 0), 30);
        const float v = valid ? s[kr][hf][j] + rp[ci] * LOG2E : -1e30f;
        s[kr][hf][j] = v; mx = fmaxf(mx, v);
      }
  }
  mx = fmaxf(mx, __shfl_xor(mx, 16)); mx = fmaxf(mx, __shfl_xor(mx, 32));
  float l = 0.f;
#pragma unroll
  for (int kr = 0; kr < 8; ++kr)
#pragma unroll
    for (int hf = 0; hf < 2; ++hf)
#pragma unroll
      for (int j = 0; j < 4; ++j) { const float pv = exp2f(s[kr][hf][j] - mx); s[kr][hf][j] = pv; l += pv; }
  l += __shfl_xor(l, 16); l += __shfl_xor(l, 32);
  f32x4 o[4];
#pragma unroll
  for (int dt = 0; dt < 4; ++dt) o[dt] = zero4();
#pragma unroll
  for (int kr = 0; kr < 8; ++kr) {
    const bf16x8 pp = pack8(s[kr][0], s[kr][1]);
#pragma unroll
    for (int dt = 0; dt < 4; ++dt) {
      const u16* vp = VT + ((size_t)((b * 16 + h) * 64 + dt * 16 + fr)) * 4096 + (r0 + kr) * 64 + cw0 + fq * 4;
      const bf16x8 vf = cat4(*(const bf16x4*)vp, *(const bf16x4*)(vp + 16));
      o[dt] = MFMA32(vf, pp, o[dt]);
    }
  }
  const float inv = 1.f / l;
#pragma unroll
  for (int dt = 0; dt < 4; ++dt) *(u32x2*)(O + tokq * 1024 + h * 64 + dt * 16 + fq * 4) = pack4(o[dt] * inv);
}

DI void mla_norm_phase(const u16* __restrict__ CRAW, const float* __restrict__ gq, const float* __restrict__ gkv, u16* __restrict__ CQN, u16* __restrict__ CKVN, float* __restrict__ KROPE) {
  const int lane = otid() & 63, wid = otid() >> 6;
  for (int row = blockIdx.x * 4 + wid; row < MTOK; row += gridDim.x * 4) {
    const u16* c = CRAW + (size_t)row * 1056;
    f32x4 v[3]; float ss = 0.f;
#pragma unroll
    for (int i = 0; i < 3; ++i) {
      const u32x2 w = *(const u32x2*)(c + i * 256 + lane * 4);
      v[i][0] = bflo(w[0]); v[i][1] = bfhi(w[0]); v[i][2] = bflo(w[1]); v[i][3] = bfhi(w[1]);
      ss += v[i][0] * v[i][0] + v[i][1] * v[i][1] + v[i][2] * v[i][2] + v[i][3] * v[i][3];
    }
    ss = wave_sum(ss);
    const float rq = rsqrtf(ss * (1.f / 768.f) + EPS);
#pragma unroll
    for (int i = 0; i < 3; ++i) {
      const f32x4 g4 = *(const f32x4*)(gq + i * 256 + lane * 4);
      *(u32x2*)(CQN + (size_t)row * 768 + i * 256 + lane * 4) = pack4(v[i] * rq * g4);
    }
    {
      const u32x2 w = *(const u32x2*)(c + 768 + lane * 4);
      f32x4 k; k[0] = bflo(w[0]); k[1] = bfhi(w[0]); k[2] = bflo(w[1]); k[3] = bfhi(w[1]);
      float s2 = wave_sum(k[0] * k[0] + k[1] * k[1] + k[2] * k[2] + k[3] * k[3]);
      const float rk = rsqrtf(s2 * (1.f / 256.f) + EPS);
      const f32x4 g4 = *(const f32x4*)(gkv + lane * 4);
      *(u32x2*)(CKVN + (size_t)row * 256 + lane * 4) = pack4(k * rk * g4);
    }
    if (lane < 8) {
      const u32x2 w = *(const u32x2*)(c + 1024 + lane * 4);
      f32x4 k; k[0] = bflo(w[0]); k[1] = bfhi(w[0]); k[2] = bflo(w[1]); k[3] = bfhi(w[1]);
      *(f32x4*)(KROPE + (size_t)row * 32 + lane * 4) = k;
    }
  }
}

DI void mla_prep_phase(u16* __restrict__ Q, const u16* __restrict__ KVRAW, const float* __restrict__ KROPE, u16* __restrict__ Kout,
                       const float* __restrict__ gq, const float* __restrict__ gk, const float* __restrict__ RC, const float* __restrict__ RS) {
  const int lane = otid() & 63, wid = otid() >> 6;
  const int h = lane >> 2, sub = lane & 3;
  const float QS = 0.10206207261596577f * LOG2E;
  for (int m = blockIdx.x * 4 + wid; m < MTOK; m += gridDim.x * 4) {
    const int t = m & 4095;
    const f32x4 cs = *(const f32x4*)(RC + t * 16 + sub * 4), sn = *(const f32x4*)(RS + t * 16 + sub * 4);
#pragma unroll
    for (int which = 0; which < 2; ++which) {
      float nope[16]; f32x4 ra, rb;
      u16* dstp = (which == 0 ? Q : Kout) + (size_t)m * 1536 + h * 96;
      const float* gn = which == 0 ? gq : gk;
      if (which == 0) {
        const u32x4 w0 = *(const u32x4*)(dstp + sub * 16), w1 = *(const u32x4*)(dstp + sub * 16 + 8);
#pragma unroll
        for (int e = 0; e < 8; ++e) { nope[e] = bfget(w0, e); nope[8 + e] = bfget(w1, e); }
        const u32x2 a2 = *(const u32x2*)(dstp + 64 + sub * 4), b2 = *(const u32x2*)(dstp + 80 + sub * 4);
        ra[0] = bflo(a2[0]); ra[1] = bfhi(a2[0]); ra[2] = bflo(a2[1]); ra[3] = bfhi(a2[1]);
        rb[0] = bflo(b2[0]); rb[1] = bfhi(b2[0]); rb[2] = bflo(b2[1]); rb[3] = bfhi(b2[1]);
      } else {
        const u16* kp = KVRAW + (size_t)m * 2048 + h * 128 + sub * 16;
        const u32x4 w0 = *(const u32x4*)kp, w1 = *(const u32x4*)(kp + 8);
#pragma unroll
        for (int e = 0; e < 8; ++e) { nope[e] = bfget(w0, e); nope[8 + e] = bfget(w1, e); }
        ra = *(const f32x4*)(KROPE + (size_t)m * 32 + sub * 4);
        rb = *(const f32x4*)(KROPE + (size_t)m * 32 + 16 + sub * 4);
      }
      float ss = 0.f;
#pragma unroll
      for (int e = 0; e < 16; ++e) ss += nope[e] * nope[e];
#pragma unroll
      for (int e = 0; e < 4; ++e) ss += ra[e] * ra[e] + rb[e] * rb[e];
      ss += __shfl_xor(ss, 1); ss += __shfl_xor(ss, 2);
      const float rstd = rsqrtf(ss * (1.f / 96.f) + EPS) * (which == 0 ? QS : 1.f);
      u32x4 o0, o1;
#pragma unroll
      for (int e2 = 0; e2 < 4; ++e2) {
        o0[e2] = pack2(nope[2 * e2] * rstd * gn[sub * 16 + 2 * e2], nope[2 * e2 + 1] * rstd * gn[sub * 16 + 2 * e2 + 1]);
        o1[e2] = pack2(nope[8 + 2 * e2] * rstd * gn[sub * 16 + 8 + 2 * e2], nope[9 + 2 * e2] * rstd * gn[sub * 16 + 9 + 2 * e2]);
      }
      f32x4 oa, ob;
#pragma unroll
      for (int e = 0; e < 4; ++e) {
        const float a = ra[e] * rstd * gn[64 + sub * 4 + e], bq = rb[e] * rstd * gn[80 + sub * 4 + e];
        oa[e] = a * cs[e] - bq * sn[e];
        ob[e] = bq * cs[e] + a * sn[e];
      }
      *(u32x4*)(dstp + sub * 16) = o0; *(u32x4*)(dstp + sub * 16 + 8) = o1;
      *(u32x2*)(dstp + 64 + sub * 4) = pack4(oa); *(u32x2*)(dstp + 80 + sub * 4) = pack4(ob);
    }
  }
}

DI void mla_vt_phase(const u16* __restrict__ KVRAW, u16* __restrict__ VT, char* smem) {
  u16* tile = (u16*)smem;
  const int tid = otid();
  for (int item = blockIdx.x; item < 8192; item += gridDim.x) {
    const int tt = item & 63, bh = item >> 6, b = bh >> 4, h = bh & 15;
    {
      const int row = tid >> 2, part = tid & 3;
      const u16* src = KVRAW + ((size_t)b * 4096 + tt * 64 + row) * 2048 + h * 128 + 64 + part * 16;
      const u32x4 w0 = *(const u32x4*)src, w1 = *(const u32x4*)(src + 8);
      u32* d32 = (u32*)(tile + row * 66 + part * 16);
#pragma unroll
      for (int e = 0; e < 4; ++e) { d32[e] = w0[e]; d32[4 + e] = w1[e]; }
    }
    __syncthreads();
    {
      const int d = tid >> 2, tp = (tid & 3) * 16;
      u32x4 o0, o1;
#pragma unroll
      for (int e2 = 0; e2 < 4; ++e2) {
        o0[e2] = (u32)tile[(tp + 2 * e2) * 66 + d] | ((u32)tile[(tp + 2 * e2 + 1) * 66 + d] << 16);
        o1[e2] = (u32)tile[(tp + 8 + 2 * e2) * 66 + d] | ((u32)tile[(tp + 9 + 2 * e2) * 66 + d] << 16);
      }
      u16* dst = VT + ((size_t)(bh * 64 + d)) * 4096 + tt * 64 + tp;
      *(u32x4*)dst = o0; *(u32x4*)(dst + 8) = o1;
    }
    __syncthreads();
  }
}

constexpr int FA_KROW = 208, FA_VROW = 144, FA_KT = 64 * FA_KROW, FA_BUF = FA_KT + 64 * FA_VROW;
DI void mla_attn_item(const u16* __restrict__ Q, const u16* __restrict__ Kb, const u16* __restrict__ VT, u16* __restrict__ O, int item, char* smem) {
  const int qb = item & 31, bh = item >> 5, b = bh >> 4, h = bh & 15;
  const int tid = otid(), lane = tid & 63, wid = tid >> 6, fr = lane & 15, fq = lane >> 4;
  bf16x8 qf[2][3];
#pragma unroll
  for (int qt = 0; qt < 2; ++qt) {
    const size_t tq = (size_t)b * 4096 + qb * 128 + wid * 32 + qt * 16 + fr;
#pragma unroll
    for (int ks = 0; ks < 3; ++ks) qf[qt][ks] = *(const bf16x8*)(Q + tq * 1536 + h * 96 + ks * 32 + fq * 8);
  }
  f32x4 o[4][2];
#pragma unroll
  for (int i = 0; i < 4; ++i) { o[i][0] = zero4(); o[i][1] = zero4(); }
  float mrun[2] = {-1e30f, -1e30f}, lrun[2] = {0.f, 0.f};
  const u16* kg[3]; int ks_off[3];
#pragma unroll
  for (int i = 0; i < 3; ++i) {
    const int c = tid + 256 * i, row = c / 12, kc = c % 12;
    kg[i] = Kb + ((size_t)b * 4096 + row) * 1536 + h * 96 + kc * 8;
    ks_off[i] = row * FA_KROW + kc * 16;
  }
  const u16* vg[2]; int vs_off[2];
#pragma unroll
  for (int i = 0; i < 2; ++i) {
    const int c = tid + 256 * i, d = c >> 3, kc = c & 7;
    vg[i] = VT + ((size_t)(bh * 64 + d)) * 4096 + kc * 8;
    vs_off[i] = FA_KT + d * FA_VROW + kc * 16;
  }
  u32x4 rk[3], rv[2];
#pragma unroll
  for (int i = 0; i < 3; ++i) rk[i] = *(const u32x4*)(kg[i]);
#pragma unroll
  for (int i = 0; i < 2; ++i) rv[i] = *(const u32x4*)(vg[i]);
#pragma unroll
  for (int i = 0; i < 3; ++i) *(u32x4*)(smem + ks_off[i]) = rk[i];
#pragma unroll
  for (int i = 0; i < 2; ++i) *(u32x4*)(smem + vs_off[i]) = rv[i];
  __syncthreads();
  for (int kt = 0; kt < 64; ++kt) {
    const int cur = (kt & 1) * FA_BUF, nxt = FA_BUF - cur;
    if (kt + 1 < 64) {
      const size_t key0 = (size_t)(kt + 1) * 64;
#pragma unroll
      for (int i = 0; i < 3; ++i) rk[i] = *(const u32x4*)(kg[i] + key0 * 1536);
#pragma unroll
      for (int i = 0; i < 2; ++i) rv[i] = *(const u32x4*)(vg[i] + key0);
    }
    f32x4 s[4][2];
#pragma unroll
    for (int k4 = 0; k4 < 4; ++k4) {
      s[k4][0] = zero4(); s[k4][1] = zero4();
#pragma unroll
      for (int ks = 0; ks < 3; ++ks) {
        const bf16x8 kf = *(const bf16x8*)(smem + cur + (k4 * 16 + fr) * FA_KROW + ks * 64 + fq * 16);
        s[k4][0] = MFMA32(kf, qf[0][ks], s[k4][0]);
        s[k4][1] = MFMA32(kf, qf[1][ks], s[k4][1]);
      }
    }
    bf16x8 pp[2][2];
#pragma unroll
    for (int qt = 0; qt < 2; ++qt) {
      float mx = -1e30f;
#pragma unroll
      for (int k4 = 0; k4 < 4; ++k4)
#pragma unroll
        for (int j = 0; j < 4; ++j) mx = fmaxf(mx, s[k4][qt][j]);
      mx = fmaxf(mx, __shfl_xor(mx, 16)); mx = fmaxf(mx, __shfl_xor(mx, 32));
      const float mnew = fmaxf(mrun[qt], mx);
      const float alpha = exp2f(mrun[qt] - mnew);
      mrun[qt] = mnew;
      float ps = 0.f;
#pragma unroll
      for (int k4 = 0; k4 < 4; ++k4)
#pragma unroll
        for (int j = 0; j < 4; ++j) { const float pv = exp2f(s[k4][qt][j] - mnew); s[k4][qt][j] = pv; ps += pv; }
      lrun[qt] = lrun[qt] * alpha + ps;
#pragma unroll
      for (int dt = 0; dt < 4; ++dt) o[dt][qt] = o[dt][qt] * alpha;
      pp[qt][0] = pack8(s[0][qt], s[1][qt]);
      pp[qt][1] = pack8(s[2][qt], s[3][qt]);
    }
#pragma unroll
    for (int dt = 0; dt < 4; ++dt)
#pragma unroll
      for (int a = 0; a < 2; ++a) {
        const char* vp = smem + cur + FA_KT + (dt * 16 + fr) * FA_VROW + (a * 32 + fq * 4) * 2;
        const bf16x8 vf = cat4(*(const bf16x4*)vp, *(const bf16x4*)(vp + 32));
        o[dt][0] = MFMA32(vf, pp[0][a], o[dt][0]);
        o[dt][1] = MFMA32(vf, pp[1][a], o[dt][1]);
      }
    if (kt + 1 < 64) {
#pragma unroll
      for (int i = 0; i < 3; ++i) *(u32x4*)(smem + nxt + ks_off[i]) = rk[i];
#pragma unroll
      for (int i = 0; i < 2; ++i) *(u32x4*)(smem + nxt + vs_off[i]) = rv[i];
    }
    __syncthreads();
  }
#pragma unroll
  for (int qt = 0; qt < 2; ++qt) {
    float l = lrun[qt];
    l += __shfl_xor(l, 16); l += __shfl_xor(l, 32);
    const float inv = 1.f / l;
    const size_t tq = (size_t)b * 4096 + qb * 128 + wid * 32 + qt * 16 + fr;
#pragma unroll
    for (int dt = 0; dt < 4; ++dt) *(u32x2*)(O + tq * 1024 + h * 64 + dt * 16 + fq * 4) = pack4(o[dt][qt] * inv);
  }
}

#define XB_TMO      128
#define XB_XCNT(j)  (256  + 64 * (j))
#define XB_XSUB(j)  (1280 + 64 * (j))
#define XB_XGEN(j)  (2304 + 64 * (j))
#define XB_TOP      3328
#define XB_TOPGEN   3392
#define XCD_BAR_WORDS 3456
#define XB_SPIN_CAP (1u << 22)
DI unsigned xb_ld(unsigned* p) { return __hip_atomic_load(p, __ATOMIC_RELAXED, __HIP_MEMORY_SCOPE_AGENT); }
DI unsigned xb_add(unsigned* p, unsigned v) { return __hip_atomic_fetch_add(p, v, __ATOMIC_RELAXED, __HIP_MEMORY_SCOPE_AGENT); }
DI unsigned xb_xcc_id() { return (unsigned)__builtin_amdgcn_s_getreg((3 << 11) | 20) & 0xFu; }
#define XB_SPIN(cond, bar) do { unsigned _sp = 0; while (cond) { __builtin_amdgcn_s_sleep(1); \
    if ((++_sp & 255u) == 0u) { if (xb_ld(&(bar)[XB_TMO])) break; if (_sp > XB_SPIN_CAP) { atomicAdd(&(bar)[XB_TMO], 1u); break; } } } } while (0)

DI void xcd_barrier_complete(unsigned* bar, unsigned x, unsigned& nloc, unsigned& nx) {
  const unsigned G = gridDim.x;
  unsigned sum, cnt, mine, sp = 0u;
  for (;;) {
    sum = 0u; cnt = 0u; mine = 0u;
#pragma unroll
    for (unsigned j = 0; j < 16; ++j) { const unsigned c = xb_ld(&bar[XB_XCNT(j)]); sum += c; cnt += (c > 0u) ? 1u : 0u; mine = (j == x) ? c : mine; }
    if (sum == G) break;
    __builtin_amdgcn_s_sleep(1);
    if ((++sp & 255u) == 0u) { if (xb_ld(&bar[XB_TMO])) break; if (sp > XB_SPIN_CAP) { atomicAdd(&bar[XB_TMO], 1u); break; } }
  }
  nloc = mine > 0u ? mine : 1u; nx = cnt > 0u ? cnt : 1u;
}

DI void xcd_barrier(unsigned* bar, volatile unsigned* st) {
  asm volatile("s_waitcnt vmcnt(0)" ::: "memory");
  __syncthreads();
  if (threadIdx.x == 0) {
    __builtin_amdgcn_s_waitcnt(0);
    const unsigned x = xb_xcc_id();
    unsigned nloc = st[0], nx = st[1];
    if (nloc == 0u) { xcd_barrier_complete(bar, x, nloc, nx); st[0] = nloc; st[1] = nx; }
    const unsigned old = xb_add(&bar[XB_XSUB(x)], 1u);
    const unsigned gen = old / nloc;
    if (old + 1u == (gen + 1u) * nloc) {
      __builtin_amdgcn_fence(__ATOMIC_RELEASE, "agent");
      asm volatile("s_waitcnt vmcnt(0)" ::: "memory");
      const unsigned og = xb_add(&bar[XB_TOP], 1u);
      const unsigned tg = og / nx;
      if (og + 1u == (tg + 1u) * nx) xb_add(&bar[XB_TOPGEN], 1u);
      else XB_SPIN(xb_ld(&bar[XB_TOPGEN]) == tg, bar);
      __builtin_amdgcn_fence(__ATOMIC_ACQUIRE, "agent");
      xb_add(&bar[XB_XGEN(x)], 1u);
      asm volatile("s_waitcnt vmcnt(0)" ::: "memory");
    } else {
      XB_SPIN(xb_ld(&bar[XB_XGEN(x)]) == gen, bar);
      __builtin_amdgcn_fence(__ATOMIC_ACQUIRE, "agent");
      asm volatile("s_waitcnt vmcnt(0)" ::: "memory");
    }
  }
  __syncthreads();
}

#ifndef ENMASK
#define ENMASK 0xffffffffu
#endif
#define EN(i) ((ENMASK >> (i)) & 1u)
#ifndef DUPMASK
#define DUPMASK 0u
#endif
#define DUP(i) ((DUPMASK >> (i)) & 1u)
#define PHASE_BEGIN(i) if (EN(i) && pc >= p.lo && pc < p.hi) for (int rep_ = 0; rep_ < 1 + (int)DUP(i); ++rep_) {
#define PHASE_END } { if (pc >= p.lo && pc + 1 < p.hi) { if (pc == p.lo) grid.sync(); else xcd_barrier(bar, st); } ++pc; }

__global__ void __launch_bounds__(256, 2) mega(Params p) {
  __shared__ __attribute__((aligned(16))) char smem[73728 + 16];
  cg::grid_group grid = cg::this_grid();
  int pc = 0;
  char* ws = p.ws;
  unsigned* bar = (unsigned*)(ws + OFF_BAR);
  volatile unsigned* st = (volatile unsigned*)(smem + 73728);
  if (threadIdx.x == 0) { st[0] = 0u; st[1] = 0u; (void)xb_add(&bar[XB_XCNT(xb_xcc_id())], 1u); }
  __syncthreads();
  u16* H = (u16*)(ws + OFF_H);
  char* R = ws + OFF_R;
  const float* LB = (const float*)(ws + OFF_TAB);
  const float* RC = LB + 4096; const float* RS = RC + 65536;
  for (int layer = 0; layer < 4; ++layer) {
    const int kind = layer % 3, mi = layer / 3;
    for (int stage = 0; stage < 3; ++stage) {
      if (stage != 1) {
        const float* ng = (stage == 0 ? p.ffn1_norm : p.ffn2_norm) + layer * 1024;
        const u16* wgu = (const u16*)(ws + (stage == 0 ? OFF_WGU1 : OFF_WGU2));
        const u16* wdn = (const u16*)(ws + (stage == 0 ? OFF_WDN1 : OFF_WDN2));
        u16* ACT = (u16*)R;
        PHASE_BEGIN(0)
          const bool first = (layer == 0 && stage == 0);
          if (stage == 0) { if (layer == 0) init_tables(p); cvt_layer(p, layer, smem); }
          norm_phase(first ? p.x : p.X, ng, H, first ? p.X : nullptr, MTOK);
        PHASE_END
        PHASE_BEGIN(1)
          gemm_phase(H, 1024, wgu, 1024, MTOK, 5632, EpiSwiglu{ACT}, smem);
        PHASE_END
        PHASE_BEGIN(2)
          gemm_phase(ACT, 2816, wdn, 2816, MTOK, 1024, EpiResid{p.X, 0.5f}, smem);
        PHASE_END
      } else {
        PHASE_BEGIN(3)
          norm_phase(p.X, p.mix_norm + layer * 1024, H, nullptr, MTOK);
        PHASE_END
        if (kind == 0) {
          constexpr size_t SZ = 32 * MiB;
          HgBufs hb;
          hb.Q = (u16*)(R + 0 * SZ); hb.LFf = (u16*)(R + 1 * SZ); hb.LFb = (u16*)(R + 2 * SZ); hb.V = (u16*)(R + 3 * SZ); hb.G = (u16*)(R + 4 * SZ);
          hb.QIf = (u16*)(R + 5 * SZ); hb.QIb = (u16*)(R + 6 * SZ); hb.KITf = (u16*)(R + 7 * SZ); hb.KITb = (u16*)(R + 8 * SZ);
          hb.VTc = (u16*)(R + 9 * SZ); hb.OI = (u16*)(R + 10 * SZ); hb.OF = hb.Q; hb.OB = hb.LFf; hb.Y = hb.LFb;
          hb.DECf = (float*)(R + 11 * SZ); hb.DECb = (float*)(R + 11 * SZ + 4 * MiB);
          const u16* w_in = (const u16*)(ws + OFF_WMIX); const u16* w_out = (const u16*)(ws + OFF_WMIX + 10485760);
          for (int half = 0; half < 2; ++half) {
            PHASE_BEGIN(4)
              gemm_phase(H + (size_t)half * 16384 * 1024, 1024, w_in, 1024, 16384, 5120, EpiHgIn{hb.Q, hb.LFf, hb.LFb, hb.V, hb.G, LB + layer * 1024}, smem);
            PHASE_END
            PHASE_BEGIN(5)
              for (int item = blockIdx.x; item < 8192; item += gridDim.x) hg_prep_item(hb, item, smem);
            PHASE_END
            PHASE_BEGIN(6)
              hg_scan_phase(hb, smem);
            PHASE_END
            PHASE_BEGIN(7)
              hg_combine_phase(hb, p.hg_g_norm + mi * 128, 16384);
            PHASE_END
            PHASE_BEGIN(8)
              gemm_phase(hb.Y, 1024, w_out, 1024, 16384, 1024, EpiResid{p.X + (size_t)half * 16384 * 1024, 1.0f}, smem);
            PHASE_END
          }
        } else if (kind == 1) {
          u16* Qn = (u16*)R; u16* Kn = (u16*)(R + 64 * MiB); u16* VT = (u16*)(R + 128 * MiB); u16* On = (u16*)(R + 192 * MiB);
          const u16* w_in = (const u16*)(ws + OFF_WMIX); const u16* w_out = (const u16*)(ws + OFF_WMIX + 6291456);
          PHASE_BEGIN(9)
            gemm_phase(H, 1024, w_in, 1024, MTOK, 3072, EpiNaIn{Qn, Kn, VT, p.na_q_norm + mi * 64, p.na_k_norm + mi * 64}, smem);
          PHASE_END
          PHASE_BEGIN(10)
            const int tid_ = otid(), lane = tid_ & 63, wid = tid_ >> 6, fr = lane & 15, fq = lane >> 4;
            for (int item = blockIdx.x * 4 + wid; item < 32768; item += gridDim.x * 4)
              na_attn_item(Qn, Kn, VT, p.na_rpb + (size_t)mi * 16 * 15 * 31, On, item, fr, fq);
          PHASE_END
          PHASE_BEGIN(11)
            gemm_phase(On, 1024, w_out, 1024, MTOK, 1024, EpiResid{p.X, 1.0f}, smem);
          PHASE_END
        } else {
          u16* VT = H;
          u16* CRAW = (u16*)R; u16* On = (u16*)R;
          u16* CQN = (u16*)(R + 66 * MiB); u16* CKVN = (u16*)(R + 114 * MiB); u16* Kk = (u16*)(R + 66 * MiB);
          float* KROPE = (float*)(R + 162 * MiB);
          u16* Qq = (u16*)(R + 166 * MiB); u16* KVRAW = (u16*)(R + 262 * MiB);
          const u16* w_in = (const u16*)(ws + OFF_WMIX); const u16* w_uq = (const u16*)(ws + OFF_WMIX + 2359296);
          const u16* w_ukv = (const u16*)(ws + OFF_WMIX + 4718592); const u16* w_out = (const u16*)(ws + OFF_WMIX + 5767168);
          PHASE_BEGIN(12)
            gemm_phase(H, 1024, w_in, 1024, MTOK, 1152, EpiStore{CRAW, 1056, 1056}, smem);
          PHASE_END
          PHASE_BEGIN(13)
            mla_norm_phase(CRAW, p.mla_q_a_norm + mi * 768, p.mla_kv_a_norm + mi * 256, CQN, CKVN, KROPE);
          PHASE_END
          PHASE_BEGIN(14)
            gemm_phase(CQN, 768, w_uq, 768, MTOK, 1536, EpiStore{Qq, 1536, 1536}, smem);
            gemm_phase(CKVN, 256, w_ukv, 256, MTOK, 2048, EpiStore{KVRAW, 2048, 2048}, smem);
          PHASE_END
          PHASE_BEGIN(15)
            mla_prep_phase(Qq, KVRAW, KROPE, Kk, p.mla_q_norm + mi * 96, p.mla_k_norm + mi * 96, RC, RS);
            mla_vt_phase(KVRAW, VT, smem);
          PHASE_END
          PHASE_BEGIN(16)
            for (int item = blockIdx.x; item < 4096; item += gridDim.x) mla_attn_item(Qq, Kk, VT, On, item, smem);
          PHASE_END
          PHASE_BEGIN(17)
            gemm_phase(On, 1024, w_out, 1024, MTOK, 1024, EpiResid{p.X, 1.0f}, smem);
          PHASE_END
        }
      }
    }
  }
}

static int count_phases() {
  int n = 0;
  for (int layer = 0; layer < 4; ++layer) {
    int kind = layer % 3;
    n += 3 + 3 + 1;
    n += kind == 0 ? 10 : kind == 1 ? 3 : 6;
  }
  return n;
}

extern "C" void kernel_launch(void* const* d_in, const int* in_sizes, int n_in, void* d_out, int out_size, void* d_ws, size_t ws_size, hipStream_t stream) {
  if (ws_size < WS_NEED) { fprintf(stderr, "workspace too small: %zu < %zu\n", ws_size, WS_NEED); return; }
  static int grid_blocks = 0;
  if (!grid_blocks) {
    int dev = 0, cus = 0, per_cu = 0;
    hipGetDevice(&dev);
    hipDeviceGetAttribute(&cus, hipDeviceAttributeMultiprocessorCount, dev);
    hipOccupancyMaxActiveBlocksPerMultiprocessor(&per_cu, mega, 256, 0);
    if (per_cu > 2) per_cu = 2;
    grid_blocks = cus * per_cu;
  }
  Params p{};
  const float** pf = (const float**)&p;
  for (int i = 0; i < 25; ++i) pf[i] = (const float*)d_in[i];
  p.X = (float*)d_out; p.ws = (char*)d_ws;
  const int total = count_phases();
#if MULTI_LAUNCH
  for (int ph = 0; ph < total; ++ph) {
    p.lo = ph; p.hi = ph + 1;
    hipLaunchKernelGGL(mega, dim3(grid_blocks), dim3(256), 0, stream, p);
  }
#else
  hipMemsetAsync((char*)d_ws + OFF_BAR, 0, 16384, stream);
  p.lo = 0; p.hi = total;
  void* args[] = {&p};
  hipError_t e = hipLaunchCooperativeKernel((void*)mega, dim3(grid_blocks), dim3(256), args, 0, stream);
  if (e != hipSuccess) fprintf(stderr, "cooperative launch failed: %s (grid %d)\n", hipGetErrorString(e), grid_blocks);
#endif
}
```

```cpp
#include <hip/hip_runtime.h>
#include <hip/hip_cooperative_groups.h>
#include <cstdio>
#include <cstdint>
namespace cg = cooperative_groups;

#ifndef MULTI_LAUNCH
#define MULTI_LAUNCH 0
#endif

typedef unsigned short u16;
typedef unsigned int u32;
using bf16x8 = __attribute__((ext_vector_type(8))) short;
using bf16x4 = __attribute__((ext_vector_type(4))) short;
using f32x4 = __attribute__((ext_vector_type(4))) float;
using u32x2 = __attribute__((ext_vector_type(2))) unsigned int;
using u32x4 = __attribute__((ext_vector_type(4))) unsigned int;

#define DI __device__ __forceinline__
#define MFMA32(a, b, c) __builtin_amdgcn_mfma_f32_16x16x32_bf16((a), (b), (c), 0, 0, 0)

constexpr int MTOK = 32768;
constexpr float EPS = 1e-6f;
constexpr float LOG2E = 1.4426950408889634f;

constexpr size_t MiB = 1048576;
constexpr size_t OFF_WGU1 = 0;
constexpr size_t OFF_WDN1 = 11534336;
constexpr size_t OFF_WGU2 = 17301504;
constexpr size_t OFF_WDN2 = 28835840;
constexpr size_t OFF_WMIX = 34603008;
constexpr size_t OFF_TAB = 47185920;
constexpr size_t OFF_BAR = OFF_TAB + 786432;
constexpr size_t OFF_H = 46 * MiB;
constexpr size_t OFF_R = 110 * MiB;
constexpr size_t WS_NEED = 500 * MiB;

struct Params {
  const float* x; const float* ffn1_norm; const float* ffn1_w_gu; const float* ffn1_w_down;
  const float* mix_norm; const float* ffn2_norm; const float* ffn2_w_gu; const float* ffn2_w_down;
  const float* hg_lb_logits; const float* hg_w_in; const float* hg_g_norm; const float* hg_w_out;
  const float* na_w_in; const float* na_q_norm; const float* na_k_norm; const float* na_rpb; const float* na_w_out;
  const float* mla_w_in; const float* mla_q_a_norm; const float* mla_w_uq; const float* mla_kv_a_norm; const float* mla_w_ukv;
  const float* mla_q_norm; const float* mla_k_norm; const float* mla_w_out;
  float* X; char* ws; int lo; int hi;
};

DI u32 f2bf(float x) { u32 u = __float_as_uint(x); u += 0x7fffu + ((u >> 16) & 1u); return u >> 16; }
typedef __bf16 bf16v2 __attribute__((ext_vector_type(2)));
typedef float f32v2 __attribute__((ext_vector_type(2)));
DI u32 pack2(float a, float b) { f32v2 v = {a, b}; bf16v2 r = __builtin_convertvector(v, bf16v2); return __builtin_bit_cast(u32, r); }
DI float bflo(u32 w) { return __uint_as_float(w << 16); }
DI float bfhi(u32 w) { return __uint_as_float(w & 0xffff0000u); }
DI float bfget(const u32x4& v, int e) { u32 w = v[e >> 1]; return (e & 1) ? bfhi(w) : bflo(w); }
DI u32x2 pack4(const f32x4& v) { u32x2 r; r[0] = pack2(v[0], v[1]); r[1] = pack2(v[2], v[3]); return r; }
DI bf16x8 pack8(const f32x4& a, const f32x4& b) {
  u32x4 r; r[0] = pack2(a[0], a[1]); r[1] = pack2(a[2], a[3]); r[2] = pack2(b[0], b[1]); r[3] = pack2(b[2], b[3]);
  return __builtin_bit_cast(bf16x8, r);
}
DI bf16x8 cat4(const bf16x4& lo, const bf16x4& hi) { return __builtin_shufflevector(lo, hi, 0, 1, 2, 3, 4, 5, 6, 7); }
DI float wave_sum(float v) {
#pragma unroll
  for (int o = 32; o > 0; o >>= 1) v += __shfl_xor(v, o);
  return v;
}
DI float sigmoidf_(float z) { return 1.f / (1.f + __expf(-z)); }
DI float siluf_(float z) { return z / (1.f + __expf(-z)); }
DI int otid() { int t = threadIdx.x; asm volatile("" : "+v"(t)); return t; }
DI f32x4 zero4() { f32x4 z = {0.f, 0.f, 0.f, 0.f}; return z; }

DI void init_tables(const Params& p) {
  float* LB = (float*)(p.ws + OFF_TAB); float* RC = LB + 4096; float* RS = RC + 65536;
  const int gt = blockIdx.x * 256 + otid(), gs = gridDim.x * 256;
  for (int c = gt; c < 1024; c += gs) {
    float l0 = p.hg_lb_logits[c], l1 = p.hg_lb_logits[1024 + c], l2 = p.hg_lb_logits[2048 + c], l3 = p.hg_lb_logits[3072 + c];
    float mx = fmaxf(fmaxf(l0, l1), fmaxf(l2, l3));
    float e0 = expf(l0 - mx), e1 = expf(l1 - mx), e2 = expf(l2 - mx), e3 = expf(l3 - mx);
    float inv = 1.f / (e0 + e1 + e2 + e3);
    LB[c] = 0.f; LB[1024 + c] = e1 * inv; LB[2048 + c] = (e1 + e2) * inv; LB[3072 + c] = (e1 + e2 + e3) * inv;
  }
  for (int i = gt; i < 65536; i += gs) {
    int t = i >> 4, j = i & 15;
    float inv = exp2f(-(float)j * (13.287712379549449f / 16.f));
    float ang = (float)t * inv;
    double a = (double)ang;
    double k = rint(a * 0.15915494309189535);
    float r = (float)(a - k * 6.283185307179586);
    RC[i] = __cosf(r); RS[i] = __sinf(r);
  }
}

DI void cvt_tiles(const float* __restrict__ src, u16* __restrict__ dst, int K, int N, int Nd, int mode, char* smem) {
  float* tile = (float*)smem;
  const int tk = K >> 6, tn = Nd >> 6, tid = otid();
  for (int t = blockIdx.x; t < tk * tn; t += gridDim.x) {
    const int k0 = (t % tk) << 6, n0 = (t / tk) << 6;
    {
      const int nl = tid & 63, kq = tid >> 6;
      const int nd = n0 + nl;
      int col = nd;
      if (mode == 1) { int a = nd >> 5, r = nd & 31; col = a * 16 + (r & 15) + ((r >= 16) ? 2816 : 0); }
      const bool ok = col < N;
#pragma unroll
      for (int i = 0; i < 16; ++i) {
        int kl = kq + 4 * i;
        tile[kl * 65 + nl] = ok ? src[(size_t)(k0 + kl) * N + col] : 0.f;
      }
    }
    __syncthreads();
    {
      const int kp = (tid & 31) * 2, nq = tid >> 5;
#pragma unroll
      for (int i = 0; i < 8; ++i) {
        int n = nq + 8 * i;
        *(u32*)(dst + (size_t)(n0 + n) * K + k0 + kp) = pack2(tile[kp * 65 + n], tile[(kp + 1) * 65 + n]);
      }
    }
    __syncthreads();
  }
}

DI void cvt_layer(const Params& p, int layer, char* smem) {
  const int kind = layer % 3, mi = layer / 3;
  char* ws = p.ws;
  for (int task = 0; task < 8; ++task) {
    const float* src = nullptr; size_t off = 0; int K = 0, N = 0, Nd = 0, mode = 0;
    if (task == 0) { src = p.ffn1_w_gu + (size_t)layer * 1024 * 5632; off = OFF_WGU1; K = 1024; N = 5632; Nd = 5632; mode = 1; }
    else if (task == 1) { src = p.ffn1_w_down + (size_t)layer * 2816 * 1024; off = OFF_WDN1; K = 2816; N = 1024; Nd = 1024; }
    else if (task == 2) { src = p.ffn2_w_gu + (size_t)layer * 1024 * 5632; off = OFF_WGU2; K = 1024; N = 5632; Nd = 5632; mode = 1; }
    else if (task == 3) { src = p.ffn2_w_down + (size_t)layer * 2816 * 1024; off = OFF_WDN2; K = 2816; N = 1024; Nd = 1024; }
    else if (kind == 0) {
      if (task == 4) { src = p.hg_w_in + (size_t)mi * 1024 * 5120; off = OFF_WMIX; K = 1024; N = 5120; Nd = 5120; }
      else if (task == 5) { src = p.hg_w_out + (size_t)mi * 1024 * 1024; off = OFF_WMIX + 10485760; K = 1024; N = 1024; Nd = 1024; }
    } else if (kind == 1) {
      if (task == 4) { src = p.na_w_in + (size_t)mi * 1024 * 3072; off = OFF_WMIX; K = 1024; N = 3072; Nd = 3072; }
      else if (task == 5) { src = p.na_w_out + (size_t)mi * 1024 * 1024; off = OFF_WMIX + 6291456; K = 1024; N = 1024; Nd = 1024; }
    } else {
      if (task == 4) { src = p.mla_w_in + (size_t)mi * 1024 * 1056; off = OFF_WMIX; K = 1024; N = 1056; Nd = 1152; }
      else if (task == 5) { src = p.mla_w_uq + (size_t)mi * 768 * 1536; off = OFF_WMIX + 2359296; K = 768; N = 1536; Nd = 1536; }
      else if (task == 6) { src = p.mla_w_ukv + (size_t)mi * 256 * 2048; off = OFF_WMIX + 4718592; K = 256; N = 2048; Nd = 2048; }
      else if (task == 7) { src = p.mla_w_out + (size_t)mi * 1024 * 1024; off = OFF_WMIX + 5767168; K = 1024; N = 1024; Nd = 1024; }
    }
    if (src) cvt_tiles(src, (u16*)(ws + off), K, N, Nd, mode, smem);
  }
}

DI void norm_phase(const float* __restrict__ src, const float* __restrict__ gain, u16* __restrict__ dst, float* copy_dst, int rows) {
  const int lane = otid() & 63, wid = otid() >> 6;
  f32x4 g[4];
#pragma unroll
  for (int i = 0; i < 4; ++i) g[i] = *(const f32x4*)(gain + i * 256 + lane * 4);
  for (int row = blockIdx.x * 4 + wid; row < rows; row += gridDim.x * 4) {
    const float* s = src + (size_t)row * 1024;
    f32x4 v[4]; float ss = 0.f;
#pragma unroll
    for (int i = 0; i < 4; ++i) { v[i] = *(const f32x4*)(s + i * 256 + lane * 4); ss += v[i][0] * v[i][0] + v[i][1] * v[i][1] + v[i][2] * v[i][2] + v[i][3] * v[i][3]; }
    ss = wave_sum(ss);
    const float rstd = rsqrtf(ss * (1.f / 1024.f) + EPS);
#pragma unroll
    for (int i = 0; i < 4; ++i) {
      f32x4 y = v[i] * rstd * g[i];
      *(u32x2*)(dst + (size_t)row * 1024 + i * 256 + lane * 4) = pack4(y);
      if (copy_dst) *(f32x4*)(copy_dst + (size_t)row * 1024 + i * 256 + lane * 4) = v[i];
    }
  }
}

#define GLDS16(gp, lp) __builtin_amdgcn_global_load_lds((const unsigned*)(gp), (unsigned*)(lp), 16, 0, 0)

constexpr int G_STAGE = 24576, G_WOFF = 16384, G_NS = 3, G_MT = 8;

template <class Epi>
DI void gemm_tile(const u16* __restrict__ A, int lda, const u16* __restrict__ W, int K, int m0, int n0, const Epi& epi, char* smem) {
  const int tid = otid(), lane = tid & 63, wid = tid >> 6;
  const int wm = wid >> 1, wn = wid & 1, fr = lane & 15, fq = lane >> 4;
  f32x4 acc[4][G_MT];
#pragma unroll
  for (int i = 0; i < 4; ++i)
#pragma unroll
    for (int j = 0; j < G_MT; ++j) acc[i][j] = zero4();
  const int lrow = tid >> 2, lc = (tid & 3) ^ ((tid >> 4) & 3);
  const u16* ga = A + (size_t)lrow * lda + lc * 8;
  const u16* gw = W + (size_t)lrow * K + lc * 8;
  char* sdst = smem + tid * 16;
  const int ro = (fq ^ (fr >> 2)) * 16;
  const char* sa_rd = smem + (wm * 128 + fr) * 64 + ro;
  const char* sw_rd = smem + G_WOFF + (wn * 64 + fr) * 64 + ro;
  const int nk = K >> 5;
  __builtin_amdgcn_s_barrier();
  asm volatile("" ::: "memory");
#pragma unroll
  for (int s = 0; s < 2; ++s) {
#pragma unroll
    for (int i = 0; i < 4; ++i) GLDS16(ga + (size_t)(64 * i) * lda + s * 32, sdst + s * G_STAGE + i * 4096);
#pragma unroll
    for (int i = 0; i < 2; ++i) GLDS16(gw + (size_t)(64 * i) * K + s * 32, sdst + s * G_STAGE + G_WOFF + i * 4096);
  }
  int slot = 0;
  for (int t = 0; t < nk; ++t) {
    if (t + 1 < nk) asm volatile("s_waitcnt vmcnt(6)" ::: "memory");
    else asm volatile("s_waitcnt vmcnt(0)" ::: "memory");
    __builtin_amdgcn_s_barrier();
    asm volatile("" ::: "memory");
    if (t + 2 < nk) {
      int is = slot + 2; if (is >= G_NS) is -= G_NS;
      const int k0 = (t + 2) << 5;
#pragma unroll
      for (int i = 0; i < 4; ++i) GLDS16(ga + (size_t)(64 * i) * lda + k0, sdst + is * G_STAGE + i * 4096);
#pragma unroll
      for (int i = 0; i < 2; ++i) GLDS16(gw + (size_t)(64 * i) * K + k0, sdst + is * G_STAGE + G_WOFF + i * 4096);
    }
    const int cur = slot * G_STAGE;
    bf16x8 af[G_MT], wf[4];
#pragma unroll
    for (int i = 0; i < 4; ++i) wf[i] = *(const bf16x8*)(sw_rd + cur + i * 1024);
#pragma unroll
    for (int i = 0; i < G_MT; ++i) af[i] = *(const bf16x8*)(sa_rd + cur + i * 1024);
#pragma unroll
    for (int mt = 0; mt < G_MT; ++mt)
#pragma unroll
      for (int nt = 0; nt < 4; ++nt) acc[nt][mt] = MFMA32(wf[nt], af[mt], acc[nt][mt]);
    if (++slot == G_NS) slot = 0;
  }
  epi(acc, m0 + wm * 128, n0 + wn * 64, fr, fq);
}

template <class Epi>
DI void gemm_phase(const u16* A, int lda, const u16* W, int K, int Mrows, int Ncols, const Epi& epi, char* smem) {
  const int mtn = Mrows >> 8, ntn = Ncols >> 7;
  const int ntiles = mtn * ntn;
  constexpr int GM = 16;
  for (int tile = blockIdx.x; tile < ntiles; tile += gridDim.x) {
    const int group = tile / (GM * ntn), rem = tile % (GM * ntn);
    const int mt = group * GM + (rem % GM), nt = rem / GM;
    gemm_tile(A + (size_t)mt * 256 * lda, lda, W + (size_t)nt * 128 * K, K, mt * 256, nt * 128, epi, smem);
  }
  __syncthreads();
}

struct EpiSwiglu {
  u16* act;
  DI void operator()(f32x4 (&acc)[4][G_MT], int mb, int nb, int fr, int fq) const {
#pragma unroll
    for (int mt = 0; mt < G_MT; ++mt) {
      const int m = mb + mt * 16 + fr;
#pragma unroll
      for (int np = 0; np < 2; ++np) {
        const f32x4 g = acc[2 * np][mt], u = acc[2 * np + 1][mt];
        f32x4 r;
#pragma unroll
        for (int j = 0; j < 4; ++j) r[j] = siluf_(g[j]) * u[j];
        const int jc = (nb >> 1) + np * 16 + fq * 4;
        *(u32x2*)(act + (size_t)m * 2816 + jc) = pack4(r);
      }
    }
  }
};

struct EpiResid {
  float* X; float scale;
  DI void operator()(f32x4 (&acc)[4][G_MT], int mb, int nb, int fr, int fq) const {
#pragma unroll
    for (int mt = 0; mt < G_MT; ++mt) {
      const int m = mb + mt * 16 + fr;
#pragma unroll
      for (int nt = 0; nt < 4; ++nt) {
        f32x4* ptr = (f32x4*)(X + (size_t)m * 1024 + nb + nt * 16 + fq * 4);
        f32x4 v = *ptr;
        v += acc[nt][mt] * scale;
        *ptr = v;
      }
    }
  }
};

struct EpiStore {
  u16* out; int ldo; int nmax;
  DI void operator()(f32x4 (&acc)[4][G_MT], int mb, int nb, int fr, int fq) const {
#pragma unroll
    for (int mt = 0; mt < G_MT; ++mt) {
      const int m = mb + mt * 16 + fr;
#pragma unroll
      for (int nt = 0; nt < 4; ++nt) {
        const int n = nb + nt * 16 + fq * 4;
        if (n < nmax) *(u32x2*)(out + (size_t)m * ldo + n) = pack4(acc[nt][mt]);
      }
    }
  }
};

struct EpiHgIn {
  u16 *Q, *LFf, *LFb, *V, *G; const float* lb;
  DI void operator()(f32x4 (&acc)[4][G_MT], int mb, int nb, int fr, int fq) const {
    const int seg = nb >> 10, c0 = nb & 1023;
    u16* dst = seg == 0 ? Q : seg == 1 ? LFf : seg == 2 ? LFb : seg == 3 ? V : G;
#pragma unroll
    for (int mt = 0; mt < G_MT; ++mt) {
      const int m = mb + mt * 16 + fr;
#pragma unroll
      for (int nt = 0; nt < 4; ++nt) {
        const int c = c0 + nt * 16 + fq * 4;
        f32x4 a = acc[nt][mt], r;
        if (seg == 0) r = a * 0.08838834764831845f;
        else if (seg == 3) r = a;
        else if (seg == 4) {
#pragma unroll
          for (int j = 0; j < 4; ++j) r[j] = siluf_(a[j]);
        } else {
          const f32x4 l4 = *(const f32x4*)(lb + c);
#pragma unroll
          for (int j = 0; j < 4; ++j) {
            float z = fminf(fmaxf(a[j], -30.f), 30.f);
            float f = l4[j] + (1.f - l4[j]) * sigmoidf_(z);
            r[j] = __logf(f);
          }
        }
        *(u32x2*)(dst + (size_t)m * 1024 + c) = pack4(r);
      }
    }
  }
};

struct EpiNaIn {
  u16 *Q, *K, *VT; const float *qn, *kn;
  DI void operator()(f32x4 (&acc)[4][G_MT], int mb, int nb, int fr, int fq) const {
    const int seg = nb >> 10, h = (nb & 1023) >> 6;
    if (seg < 2) {
      u16* dst = seg == 0 ? Q : K;
      const float* gn = seg == 0 ? qn : kn;
      const float sc = seg == 0 ? 0.125f * LOG2E : 1.f;
#pragma unroll
      for (int mt = 0; mt < G_MT; ++mt) {
        const int m = mb + mt * 16 + fr;
        float ss = 0.f;
#pragma unroll
        for (int nt = 0; nt < 4; ++nt)
#pragma unroll
          for (int j = 0; j < 4; ++j) ss += acc[nt][mt][j] * acc[nt][mt][j];
        ss += __shfl_xor(ss, 16); ss += __shfl_xor(ss, 32);
        const float rstd = rsqrtf(ss * (1.f / 64.f) + EPS) * sc;
#pragma unroll
        for (int nt = 0; nt < 4; ++nt) {
          const int d = nt * 16 + fq * 4;
          const f32x4 g4 = *(const f32x4*)(gn + d);
          f32x4 r = acc[nt][mt] * rstd * g4;
          *(u32x2*)(dst + (size_t)m * 1024 + h * 64 + d) = pack4(r);
        }
      }
    } else {
#pragma unroll
      for (int mt = 0; mt < G_MT; ++mt) {
        const int m = mb + mt * 16 + fr;
        const int b = m >> 12, t = m & 4095;
#pragma unroll
        for (int nt = 0; nt < 4; ++nt)
#pragma unroll
          for (int j = 0; j < 4; ++j) {
            const int d = nt * 16 + fq * 4 + j;
            VT[((size_t)((b * 16 + h) * 64 + d)) * 4096 + t] = (u16)f2bf(acc[nt][mt][j]);
          }
      }
    }
  }
};

struct HgBufs {
  u16 *Q, *LFf, *LFb, *V, *G, *QIf, *QIb, *KITf, *KITb, *VTc, *OI, *OF, *OB, *Y;
  float *DECf, *DECb;
};

DI void hg_prep_item(const HgBufs& hb, int item, char* smem) {
  const int h = item & 7, n = (item >> 3) & 255, b = item >> 11;
  float* sq = (float*)smem; float* sbf = sq + 2112; float* sbb = sbf + 2112; float* skf = sbb + 2112;
  float* skb = skf + 2112; float* sv = skb + 2112; float* sA = sv + 2112;
  const int tid = otid();
  const int row = tid >> 4, c8 = (tid & 15) * 8;
  const size_t tok0 = (size_t)b * 4096 + n * 16;
  const size_t gidx = (tok0 + row) * 1024 + h * 128 + c8;
  {
    const u32x4 rq = *(const u32x4*)(hb.Q + gidx), rf = *(const u32x4*)(hb.LFf + gidx);
    const u32x4 rb = *(const u32x4*)(hb.LFb + gidx), rv = *(const u32x4*)(hb.V + gidx);
#pragma unroll
    for (int e = 0; e < 8; ++e) {
      const int o = row * 132 + c8 + e;
      const float lf = bfget(rf, e), lb_ = bfget(rb, e);
      sq[o] = bfget(rq, e); sbf[o] = lf; sbb[o] = lb_;
      skf[o] = 1.f - __expf(lf); skb[o] = 1.f - __expf(lb_); sv[o] = bfget(rv, e);
    }
  }
  __syncthreads();
  if (tid < 128) {
    const int d = tid; float a = 0.f;
#pragma unroll
    for (int t = 0; t < 16; ++t) { a += sbf[t * 132 + d]; sbf[t * 132 + d] = a; }
    hb.DECf[((size_t)b * 256 + n) * 1024 + h * 128 + d] = __expf(a);
  } else {
    const int d = tid - 128; float a = 0.f;
#pragma unroll
    for (int t = 15; t >= 0; --t) { a += sbb[t * 132 + d]; sbb[t * 132 + d] = a; }
    hb.DECb[((size_t)b * 256 + n) * 1024 + h * 128 + d] = __expf(a);
  }
  __syncthreads();
  {
    u32x4 of, ob;
#pragma unroll
    for (int e2 = 0; e2 < 4; ++e2) {
      const int o = row * 132 + c8 + 2 * e2;
      const float q0 = sq[o], q1 = sq[o + 1];
      of[e2] = pack2(q0 * __expf(sbf[o]), q1 * __expf(sbf[o + 1]));
      ob[e2] = pack2(q0 * __expf(sbb[o]), q1 * __expf(sbb[o + 1]));
    }
    *(u32x4*)(hb.QIf + gidx) = of; *(u32x4*)(hb.QIb + gidx) = ob;
  }
  {
    const int d = tid >> 1, t8 = (tid & 1) * 8;
    const float blf = sbf[15 * 132 + d], blb = sbb[d];
    u32x4 kf, kb, vv;
#pragma unroll
    for (int e2 = 0; e2 < 4; ++e2) {
      const int o0 = (t8 + 2 * e2) * 132 + d, o1 = o0 + 132;
      kf[e2] = pack2(skf[o0] * __expf(blf - sbf[o0]), skf[o1] * __expf(blf - sbf[o1]));
      kb[e2] = pack2(skb[o0] * __expf(blb - sbb[o0]), skb[o1] * __expf(blb - sbb[o1]));
      vv[e2] = pack2(sv[o0], sv[o1]);
    }
    const size_t cidx = (((size_t)(b * 8 + h) * 256 + n) * 128 + d) * 16 + t8;
    *(u32x4*)(hb.KITf + cidx) = kf; *(u32x4*)(hb.KITb + cidx) = kb; *(u32x4*)(hb.VTc + cidx) = vv;
  }
  {
    const int t = tid >> 4, s = tid & 15;
    if (s <= t) {
      float af = 0.f, ab = 0.f;
      for (int d4 = 0; d4 < 32; ++d4) {
        const f32x4 qt = *(const f32x4*)(sq + t * 132 + d4 * 4), qs = *(const f32x4*)(sq + s * 132 + d4 * 4);
        const f32x4 kfs = *(const f32x4*)(skf + s * 132 + d4 * 4), kbt = *(const f32x4*)(skb + t * 132 + d4 * 4);
        const f32x4 bft = *(const f32x4*)(sbf + t * 132 + d4 * 4), bfs = *(const f32x4*)(sbf + s * 132 + d4 * 4);
        const f32x4 bbs = *(const f32x4*)(sbb + s * 132 + d4 * 4), bbt = *(const f32x4*)(sbb + t * 132 + d4 * 4);
#pragma unroll
        for (int c = 0; c < 4; ++c) {
          af += qt[c] * kfs[c] * __expf(bft[c] - bfs[c]);
          ab += qs[c] * kbt[c] * __expf(bbs[c] - bbt[c]);
        }
      }
      if (s == t) sA[t * 17 + t] = af + ab;
      else { sA[t * 17 + s] = af; sA[s * 17 + t] = ab; }
    }
  }
  __syncthreads();
  {
    float o[8];
#pragma unroll
    for (int e = 0; e < 8; ++e) o[e] = 0.f;
#pragma unroll
    for (int s = 0; s < 16; ++s) {
      const float a = sA[row * 17 + s];
      const f32x4 v0 = *(const f32x4*)(sv + s * 132 + c8), v1 = *(const f32x4*)(sv + s * 132 + c8 + 4);
#pragma unroll
      for (int e = 0; e < 4; ++e) { o[e] += a * v0[e]; o[4 + e] += a * v1[e]; }
    }
    u32x4 r; r[0] = pack2(o[0], o[1]); r[1] = pack2(o[2], o[3]); r[2] = pack2(o[4], o[5]); r[3] = pack2(o[6], o[7]);
    *(u32x4*)(hb.OI + gidx) = r;
  }
  __syncthreads();
}

constexpr int SC_NS = 6, SC_STAGE = 12288;
DI void scan_issue(char* smem, int slot, const u16* QI, const u16* KIT, const u16* VTc, const float* DEC, int b, int h, int vg, int n, int tid) {
  char* st = smem + slot * SC_STAGE + tid * 16;
  const size_t tok0 = (size_t)b * 4096 + n * 16;
  const int row = tid >> 4, lc = (tid & 15) ^ row;
  GLDS16(QI + (tok0 + row) * 1024 + h * 128 + lc * 8, st);
  const size_t cb = ((size_t)(b * 8 + h) * 256 + n) * 2048;
  GLDS16(KIT + cb + tid * 8, st + 4096);
  const float* dp = DEC + ((size_t)b * 256 + n) * 1024 + h * 128;
  const void* g3 = tid < 128 ? (const void*)(VTc + cb + vg * 1024 + tid * 8) : (const void*)(dp + ((tid - 128) & 31) * 4);
  GLDS16(g3, st + 8192);
}

DI void hg_scan_phase(const HgBufs& hb, char* smem) {
  const int tid = otid(), lane = tid & 63, wid = tid >> 6, fr = lane & 15, fq = lane >> 4;
  for (int item = blockIdx.x; item < 128; item += gridDim.x) {
    const int vg = item & 1, dir = (item >> 1) & 1, h = (item >> 2) & 7, b = item >> 5;
    const u16* QI = dir ? hb.QIb : hb.QIf; const u16* KIT = dir ? hb.KITb : hb.KITf;
    const float* DEC = dir ? hb.DECb : hb.DECf; u16* Oout = dir ? hb.OB : hb.OF;
    const int vs = vg * 4 + wid;
    f32x4 S[8];
#pragma unroll
    for (int i = 0; i < 8; ++i) S[i] = zero4();
#pragma unroll
    for (int s = 0; s < SC_NS - 1; ++s) scan_issue(smem, s, QI, KIT, hb.VTc, DEC, b, h, vg, dir ? 255 - s : s, tid);
    int slot = 0;
    for (int step = 0; step < 256; ++step) {
      if (step < SC_NS - 1) asm volatile("s_waitcnt vmcnt(12)" ::: "memory");
      else asm volatile("s_waitcnt vmcnt(32)" ::: "memory");
      __builtin_amdgcn_s_barrier();
      asm volatile("" ::: "memory");
      {
        const int ns = min(step + SC_NS - 1, 255);
        int islot = slot + SC_NS - 1; if (islot >= SC_NS) islot -= SC_NS;
        scan_issue(smem, islot, QI, KIT, hb.VTc, DEC, b, h, vg, dir ? 255 - ns : ns, tid);
      }
      const int n = dir ? 255 - step : step;
      const char* st = smem + slot * SC_STAGE;
      bf16x8 qa[4], ka[8]; f32x4 dc[8];
#pragma unroll
      for (int ks = 0; ks < 4; ++ks) {
        const int l0 = 4 * ks + (fq >> 1), l1 = l0 + 2;
        const bf16x4 lo = *(const bf16x4*)(st + fr * 256 + ((l0 ^ fr) * 16) + (fq & 1) * 8);
        const bf16x4 hi = *(const bf16x4*)(st + fr * 256 + ((l1 ^ fr) * 16) + (fq & 1) * 8);
        qa[ks] = cat4(lo, hi);
      }
      bf16x8 vb = *(const bf16x8*)(st + 8192 + (wid * 16 + fr) * 32 + (fq & 1) * 16);
#pragma unroll
      for (int dt = 0; dt < 8; ++dt) {
        ka[dt] = *(const bf16x8*)(st + 4096 + (dt * 16 + fr) * 32 + (fq & 1) * 16);
        dc[dt] = *(const f32x4*)(st + 8192 + 2048 + (dt * 16 + fq * 4) * 4);
      }
      asm volatile("s_waitcnt lgkmcnt(0)" ::: "memory");
      __builtin_amdgcn_sched_barrier(0);
      const bf16x8 z8 = {0, 0, 0, 0, 0, 0, 0, 0};
      if (fq >= 2) vb = z8;
      f32x4 o0 = zero4(), o1 = zero4();
      o0 = MFMA32(qa[0], pack8(S[0], S[1]), o0);
      o1 = MFMA32(qa[1], pack8(S[2], S[3]), o1);
      o0 = MFMA32(qa[2], pack8(S[4], S[5]), o0);
      o1 = MFMA32(qa[3], pack8(S[6], S[7]), o1);
#pragma unroll
      for (int dt = 0; dt < 8; ++dt) {
        if (fq >= 2) ka[dt] = z8;
        S[dt] = S[dt] * dc[dt];
        S[dt] = MFMA32(ka[dt], vb, S[dt]);
      }
      {
        const f32x4 o = o0 + o1;
        const size_t tok0 = (size_t)b * 4096 + n * 16;
        u16* op = Oout + (tok0 + fq * 4) * 1024 + h * 128 + vs * 16 + fr;
        const u32 w0 = pack2(o[0], o[1]), w1 = pack2(o[2], o[3]);
        asm volatile("global_store_short %0, %1, off" :: "v"(op), "v"(w0) : "memory");
        asm volatile("global_store_short_d16_hi %0, %1, off" :: "v"(op + 1024), "v"(w0) : "memory");
        asm volatile("global_store_short %0, %1, off" :: "v"(op + 2048), "v"(w1) : "memory");
        asm volatile("global_store_short_d16_hi %0, %1, off" :: "v"(op + 3072), "v"(w1) : "memory");
      }
      if (++slot == SC_NS) slot = 0;
    }
    asm volatile("s_waitcnt vmcnt(0)" ::: "memory");
    __syncthreads();
  }
}

DI void hg_combine_phase(const HgBufs& hb, const float* __restrict__ gnorm, int rows) {
  const int lane = otid() & 63, wid = otid() >> 6;
  const int h = lane >> 3, c16 = (lane & 7) * 16;
  for (int row = blockIdx.x * 4 + wid; row < rows; row += gridDim.x * 4) {
    const size_t g = (size_t)row * 1024 + h * 128 + c16;
    float o[16]; float ss = 0.f;
#pragma unroll
    for (int half = 0; half < 2; ++half) {
      const u32x4 a = *(const u32x4*)(hb.OI + g + half * 8), f = *(const u32x4*)(hb.OF + g + half * 8), bb = *(const u32x4*)(hb.OB + g + half * 8);
#pragma unroll
      for (int e = 0; e < 8; ++e) { float v = bfget(a, e) + bfget(f, e) + bfget(bb, e); o[half * 8 + e] = v; ss += v * v; }
    }
    ss += __shfl_xor(ss, 1); ss += __shfl_xor(ss, 2); ss += __shfl_xor(ss, 4);
    const float rstd = rsqrtf(ss * (1.f / 128.f) + EPS);
#pragma unroll
    for (int half = 0; half < 2; ++half) {
      const u32x4 gs = *(const u32x4*)(hb.G + g + half * 8);
      u32x4 r;
#pragma unroll
      for (int e2 = 0; e2 < 4; ++e2) {
        const int e = half * 8 + 2 * e2;
        r[e2] = pack2(o[e] * rstd * gnorm[c16 + e] * bfget(gs, 2 * e2), o[e + 1] * rstd * gnorm[c16 + e + 1] * bfget(gs, 2 * e2 + 1));
      }
      *(u32x4*)(hb.Y + g + half * 8) = r;
    }
  }
}

DI void na_attn_item(const u16* __restrict__ Q, const u16* __restrict__ K, const u16* __restrict__ VT, const float* __restrict__ rpb, u16* __restrict__ O, int item, int fr, int fq) {
  const int h = item & 15, qt = (item >> 4) & 3, r = (item >> 6) & 63, b = item >> 12;
  const int r0 = min(max(r - 4, 0), 56);
  const int cw0 = qt == 0 ? 0 : qt == 1 ? 8 : qt == 2 ? 24 : 32;
  const size_t tokq = (size_t)b * 4096 + r * 64 + qt * 16 + fr;
  bf16x8 qf[2];
#pragma unroll
  for (int ks = 0; ks < 2; ++ks) qf[ks] = *(const bf16x8*)(Q + tokq * 1024 + h * 64 + ks * 32 + fq * 8);
  f32x4 s[8][2];
#pragma unroll
  for (int kr = 0; kr < 8; ++kr)
#pragma unroll
    for (int hf = 0; hf < 2; ++hf) {
      const size_t tokk = (size_t)b * 4096 + (r0 + kr) * 64 + cw0 + hf * 16 + fr;
      const bf16x8 k0 = *(const bf16x8*)(K + tokk * 1024 + h * 64 + fq * 8);
      const bf16x8 k1 = *(const bf16x8*)(K + tokk * 1024 + h * 64 + 32 + fq * 8);
      f32x4 a = MFMA32(k0, qf[0], zero4());
      s[kr][hf] = MFMA32(k1, qf[1], a);
    }
  const int qc = qt * 16 + fr;
  const int cs = min(max(qc - 8, 0), 48);
  float mx = -1e30f;
#pragma unroll
  for (int kr = 0; kr < 8; ++kr) {
    const float* rp = rpb + (h * 15 + (r0 + kr - r + 7)) * 31;
#pragma unroll
    for (int hf = 0; hf < 2; ++hf)
#pragma unroll
      for (int j = 0; j < 4; ++j) {
        const int kc = cw0 + hf * 16 + fq * 4 + j;
        const bool valid = (kc >= cs) && (kc < cs + 16);
        const int ci = min(max(kc - qc + 15, 0), 30);
        const float v = valid ? s[kr][hf][j] + rp[ci] * LOG2E : -1e30f;
        s[kr][hf][j] = v; mx = fmaxf(mx, v);
      }
  }
  mx = fmaxf(mx, __shfl_xor(mx, 16)); mx = fmaxf(mx, __shfl_xor(mx, 32));
  float l = 0.f;
#pragma unroll
  for (int kr = 0; kr < 8; ++kr)
#pragma unroll
    for (int hf = 0; hf < 2; ++hf)
#pragma unroll
      for (int j = 0; j < 4; ++j) { const float pv = exp2f(s[kr][hf][j] - mx); s[kr][hf][j] = pv; l += pv; }
  l += __shfl_xor(l, 16); l += __shfl_xor(l, 32);
  f32x4 o[4];
#pragma unroll
  for (int dt = 0; dt < 4; ++dt) o[dt] = zero4();
#pragma unroll
  for (int kr = 0; kr < 8; ++kr) {
    const bf16x8 pp = pack8(s[kr][0], s[kr][1]);
#pragma unroll
    for (int dt = 0; dt < 4; ++dt) {
      const u16* vp = VT + ((size_t)((b * 16 + h) * 64 + dt * 16 + fr)) * 4096 + (r0 + kr) * 64 + cw0 + fq * 4;
      const bf16x8 vf = cat4(*(const bf16x4*)vp, *(const bf16x4*)(vp + 16));
      o[dt] = MFMA32(vf, pp, o[dt]);
    }
  }
  const float inv = 1.f / l;
#pragma unroll
  for (int dt = 0; dt < 4; ++dt) *(u32x2*)(O + tokq * 1024 + h * 64 + dt * 16 + fq * 4) = pack4(o[dt] * inv);
}

DI void mla_norm_phase(const u16* __restrict__ CRAW, const float* __restrict__ gq, const float* __restrict__ gkv, u16* __restrict__ CQN, u16* __restrict__ CKVN, float* __restrict__ KROPE) {
  const int lane = otid() & 63, wid = otid() >> 6;
  for (int row = blockIdx.x * 4 + wid; row < MTOK; row += gridDim.x * 4) {
    const u16* c = CRAW + (size_t)row * 1056;
    f32x4 v[3]; float ss = 0.f;
#pragma unroll
    for (int i = 0; i < 3; ++i) {
      const u32x2 w = *(const u32x2*)(c + i * 256 + lane * 4);
      v[i][0] = bflo(w[0]); v[i][1] = bfhi(w[0]); v[i][2] = bflo(w[1]); v[i][3] = bfhi(w[1]);
      ss += v[i][0] * v[i][0] + v[i][1] * v[i][1] + v[i][2] * v[i][2] + v[i][3] * v[i][3];
    }
    ss = wave_sum(ss);
    const float rq = rsqrtf(ss * (1.f / 768.f) + EPS);
#pragma unroll
    for (int i = 0; i < 3; ++i) {
      const f32x4 g4 = *(const f32x4*)(gq + i * 256 + lane * 4);
      *(u32x2*)(CQN + (size_t)row * 768 + i * 256 + lane * 4) = pack4(v[i] * rq * g4);
    }
    {
      const u32x2 w = *(const u32x2*)(c + 768 + lane * 4);
      f32x4 k; k[0] = bflo(w[0]); k[1] = bfhi(w[0]); k[2] = bflo(w[1]); k[3] = bfhi(w[1]);
      float s2 = wave_sum(k[0] * k[0] + k[1] * k[1] + k[2] * k[2] + k[3] * k[3]);
      const float rk = rsqrtf(s2 * (1.f / 256.f) + EPS);
      const f32x4 g4 = *(const f32x4*)(gkv + lane * 4);
      *(u32x2*)(CKVN + (size_t)row * 256 + lane * 4) = pack4(k * rk * g4);
    }
    if (lane < 8) {
      const u32x2 w = *(const u32x2*)(c + 1024 + lane * 4);
      f32x4 k; k[0] = bflo(w[0]); k[1] = bfhi(w[0]); k[2] = bflo(w[1]); k[3] = bfhi(w[1]);
      *(f32x4*)(KROPE + (size_t)row * 32 + lane * 4) = k;
    }
  }
}

DI void mla_prep_phase(u16* __restrict__ Q, const u16* __restrict__ KVRAW, const float* __restrict__ KROPE, u16* __restrict__ Kout,
                       const float* __restrict__ gq, const float* __restrict__ gk, const float* __restrict__ RC, const float* __restrict__ RS) {
  const int lane = otid() & 63, wid = otid() >> 6;
  const int h = lane >> 2, sub = lane & 3;
  const float QS = 0.10206207261596577f * LOG2E;
  for (int m = blockIdx.x * 4 + wid; m < MTOK; m += gridDim.x * 4) {
    const int t = m & 4095;
    const f32x4 cs = *(const f32x4*)(RC + t * 16 + sub * 4), sn = *(const f32x4*)(RS + t * 16 + sub * 4);
#pragma unroll
    for (int which = 0; which < 2; ++which) {
      float nope[16]; f32x4 ra, rb;
      u16* dstp = (which == 0 ? Q : Kout) + (size_t)m * 1536 + h * 96;
      const float* gn = which == 0 ? gq : gk;
      if (which == 0) {
        const u32x4 w0 = *(const u32x4*)(dstp + sub * 16), w1 = *(const u32x4*)(dstp + sub * 16 + 8);
#pragma unroll
        for (int e = 0; e < 8; ++e) { nope[e] = bfget(w0, e); nope[8 + e] = bfget(w1, e); }
        const u32x2 a2 = *(const u32x2*)(dstp + 64 + sub * 4), b2 = *(const u32x2*)(dstp + 80 + sub * 4);
        ra[0] = bflo(a2[0]); ra[1] = bfhi(a2[0]); ra[2] = bflo(a2[1]); ra[3] = bfhi(a2[1]);
        rb[0] = bflo(b2[0]); rb[1] = bfhi(b2[0]); rb[2] = bflo(b2[1]); rb[3] = bfhi(b2[1]);
      } else {
        const u16* kp = KVRAW + (size_t)m * 2048 + h * 128 + sub * 16;
        const u32x4 w0 = *(const u32x4*)kp, w1 = *(const u32x4*)(kp + 8);
#pragma unroll
        for (int e = 0; e < 8; ++e) { nope[e] = bfget(w0, e); nope[8 + e] = bfget(w1, e); }
        ra = *(const f32x4*)(KROPE + (size_t)m * 32 + sub * 4);
        rb = *(const f32x4*)(KROPE + (size_t)m * 32 + 16 + sub * 4);
      }
      float ss = 0.f;
#pragma unroll
      for (int e = 0; e < 16; ++e) ss += nope[e] * nope[e];
#pragma unroll
      for (int e = 0; e < 4; ++e) ss += ra[e] * ra[e] + rb[e] * rb[e];
      ss += __shfl_xor(ss, 1); ss += __shfl_xor(ss, 2);
      const float rstd = rsqrtf(ss * (1.f / 96.f) + EPS) * (which == 0 ? QS : 1.f);
      u32x4 o0, o1;
#pragma unroll
      for (int e2 = 0; e2 < 4; ++e2) {
        o0[e2] = pack2(nope[2 * e2] * rstd * gn[sub * 16 + 2 * e2], nope[2 * e2 + 1] * rstd * gn[sub * 16 + 2 * e2 + 1]);
        o1[e2] = pack2(nope[8 + 2 * e2] * rstd * gn[sub * 16 + 8 + 2 * e2], nope[9 + 2 * e2] * rstd * gn[sub * 16 + 9 + 2 * e2]);
      }
      f32x4 oa, ob;
#pragma unroll
      for (int e = 0; e < 4; ++e) {
        const float a = ra[e] * rstd * gn[64 + sub * 4 + e], bq = rb[e] * rstd * gn[80 + sub * 4 + e];
        oa[e] = a * cs[e] - bq * sn[e];
        ob[e] = bq * cs[e] + a * sn[e];
      }
      *(u32x4*)(dstp + sub * 16) = o0; *(u32x4*)(dstp + sub * 16 + 8) = o1;
      *(u32x2*)(dstp + 64 + sub * 4) = pack4(oa); *(u32x2*)(dstp + 80 + sub * 4) = pack4(ob);
    }
  }
}

DI void mla_vt_phase(const u16* __restrict__ KVRAW, u16* __restrict__ VT, char* smem) {
  u16* tile = (u16*)smem;
  const int tid = otid();
  for (int item = blockIdx.x; item < 8192; item += gridDim.x) {
    const int tt = item & 63, bh = item >> 6, b = bh >> 4, h = bh & 15;
    {
      const int row = tid >> 2, part = tid & 3;
      const u16* src = KVRAW + ((size_t)b * 4096 + tt * 64 + row) * 2048 + h * 128 + 64 + part * 16;
      const u32x4 w0 = *(const u32x4*)src, w1 = *(const u32x4*)(src + 8);
      u32* d32 = (u32*)(tile + row * 66 + part * 16);
#pragma unroll
      for (int e = 0; e < 4; ++e) { d32[e] = w0[e]; d32[4 + e] = w1[e]; }
    }
    __syncthreads();
    {
      const int d = tid >> 2, tp = (tid & 3) * 16;
      u32x4 o0, o1;
#pragma unroll
      for (int e2 = 0; e2 < 4; ++e2) {
        o0[e2] = (u32)tile[(tp + 2 * e2) * 66 + d] | ((u32)tile[(tp + 2 * e2 + 1) * 66 + d] << 16);
        o1[e2] = (u32)tile[(tp + 8 + 2 * e2) * 66 + d] | ((u32)tile[(tp + 9 + 2 * e2) * 66 + d] << 16);
      }
      u16* dst = VT + ((size_t)(bh * 64 + d)) * 4096 + tt * 64 + tp;
      *(u32x4*)dst = o0; *(u32x4*)(dst + 8) = o1;
    }
    __syncthreads();
  }
}

constexpr int FA_KROW = 208, FA_VROW = 144, FA_KT = 64 * FA_KROW, FA_BUF = FA_KT + 64 * FA_VROW;
DI void mla_attn_item(const u16* __restrict__ Q, const u16* __restrict__ Kb, const u16* __restrict__ VT, u16* __restrict__ O, int item, char* smem) {
  const int qb = item & 31, bh = item >> 5, b = bh >> 4, h = bh & 15;
  const int tid = otid(), lane = tid & 63, wid = tid >> 6, fr = lane & 15, fq = lane >> 4;
  bf16x8 qf[2][3];
#pragma unroll
  for (int qt = 0; qt < 2; ++qt) {
    const size_t tq = (size_t)b * 4096 + qb * 128 + wid * 32 + qt * 16 + fr;
#pragma unroll
    for (int ks = 0; ks < 3; ++ks) qf[qt][ks] = *(const bf16x8*)(Q + tq * 1536 + h * 96 + ks * 32 + fq * 8);
  }
  f32x4 o[4][2];
#pragma unroll
  for (int i = 0; i < 4; ++i) { o[i][0] = zero4(); o[i][1] = zero4(); }
  float mrun[2] = {-1e30f, -1e30f}, lrun[2] = {0.f, 0.f};
  const u16* kg[3]; int ks_off[3];
#pragma unroll
  for (int i = 0; i < 3; ++i) {
    const int c = tid + 256 * i, row = c / 12, kc = c % 12;
    kg[i] = Kb + ((size_t)b * 4096 + row) * 1536 + h * 96 + kc * 8;
    ks_off[i] = row * FA_KROW + kc * 16;
  }
  const u16* vg[2]; int vs_off[2];
#pragma unroll
  for (int i = 0; i < 2; ++i) {
    const int c = tid + 256 * i, d = c >> 3, kc = c & 7;
    vg[i] = VT + ((size_t)(bh * 64 + d)) * 4096 + kc * 8;
    vs_off[i] = FA_KT + d * FA_VROW + kc * 16;
  }
  u32x4 rk[3], rv[2];
#pragma unroll
  for (int i = 0; i < 3; ++i) rk[i] = *(const u32x4*)(kg[i]);
#pragma unroll
  for (int i = 0; i < 2; ++i) rv[i] = *(const u32x4*)(vg[i]);
#pragma unroll
  for (int i = 0; i < 3; ++i) *(u32x4*)(smem + ks_off[i]) = rk[i];
#pragma unroll
  for (int i = 0; i < 2; ++i) *(u32x4*)(smem + vs_off[i]) = rv[i];
  __syncthreads();
  for (int kt = 0; kt < 64; ++kt) {
    const int cur = (kt & 1) * FA_BUF, nxt = FA_BUF - cur;
    if (kt + 1 < 64) {
      const size_t key0 = (size_t)(kt + 1) * 64;
#pragma unroll
      for (int i = 0; i < 3; ++i) rk[i] = *(const u32x4*)(kg[i] + key0 * 1536);
#pragma unroll
      for (int i = 0; i < 2; ++i) rv[i] = *(const u32x4*)(vg[i] + key0);
    }
    f32x4 s[4][2];
#pragma unroll
    for (int k4 = 0; k4 < 4; ++k4) {
      s[k4][0] = zero4(); s[k4][1] = zero4();
#pragma unroll
      for (int ks = 0; ks < 3; ++ks) {
        const bf16x8 kf = *(const bf16x8*)(smem + cur + (k4 * 16 + fr) * FA_KROW + ks * 64 + fq * 16);
        s[k4][0] = MFMA32(kf, qf[0][ks], s[k4][0]);
        s[k4][1] = MFMA32(kf, qf[1][ks], s[k4][1]);
      }
    }
    bf16x8 pp[2][2];
#pragma unroll
    for (int qt = 0; qt < 2; ++qt) {
      float mx = -1e30f;
#pragma unroll
      for (int k4 = 0; k4 < 4; ++k4)
#pragma unroll
        for (int j = 0; j < 4; ++j) mx = fmaxf(mx, s[k4][qt][j]);
      mx = fmaxf(mx, __shfl_xor(mx, 16)); mx = fmaxf(mx, __shfl_xor(mx, 32));
      const float mnew = fmaxf(mrun[qt], mx);
      const float alpha = exp2f(mrun[qt] - mnew);
      mrun[qt] = mnew;
      float ps = 0.f;
#pragma unroll
      for (int k4 = 0; k4 < 4; ++k4)
#pragma unroll
        for (int j = 0; j < 4; ++j) { const float pv = exp2f(s[k4][qt][j] - mnew); s[k4][qt][j] = pv; ps += pv; }
      lrun[qt] = lrun[qt] * alpha + ps;
#pragma unroll
      for (int dt = 0; dt < 4; ++dt) o[dt][qt] = o[dt][qt] * alpha;
      pp[qt][0] = pack8(s[0][qt], s[1][qt]);
      pp[qt][1] = pack8(s[2][qt], s[3][qt]);
    }
#pragma unroll
    for (int dt = 0; dt < 4; ++dt)
#pragma unroll
      for (int a = 0; a < 2; ++a) {
        const char* vp = smem + cur + FA_KT + (dt * 16 + fr) * FA_VROW + (a * 32 + fq * 4) * 2;
        const bf16x8 vf = cat4(*(const bf16x4*)vp, *(const bf16x4*)(vp + 32));
        o[dt][0] = MFMA32(vf, pp[0][a], o[dt][0]);
        o[dt][1] = MFMA32(vf, pp[1][a], o[dt][1]);
      }
    if (kt + 1 < 64) {
#pragma unroll
      for (int i = 0; i < 3; ++i) *(u32x4*)(smem + nxt + ks_off[i]) = rk[i];
#pragma unroll
      for (int i = 0; i < 2; ++i) *(u32x4*)(smem + nxt + vs_off[i]) = rv[i];
    }
    __syncthreads();
  }
#pragma unroll
  for (int qt = 0; qt < 2; ++qt) {
    float l = lrun[qt];
    l += __shfl_xor(l, 16); l += __shfl_xor(l, 32);
    const float inv = 1.f / l;
    const size_t tq = (size_t)b * 4096 + qb * 128 + wid * 32 + qt * 16 + fr;
#pragma unroll
    for (int dt = 0; dt < 4; ++dt) *(u32x2*)(O + tq * 1024 + h * 64 + dt * 16 + fq * 4) = pack4(o[dt][qt] * inv);
  }
}

#define XB_TMO      128
#define XB_XCNT(j)  (256  + 64 * (j))
#define XB_XSUB(j)  (1280 + 64 * (j))
#define XB_XGEN(j)  (2304 + 64 * (j))
#define XB_TOP      3328
#define XB_TOPGEN   3392
#define XCD_BAR_WORDS 3456
#define XB_SPIN_CAP (1u << 22)
DI unsigned xb_ld(unsigned* p) { return __hip_atomic_load(p, __ATOMIC_RELAXED, __HIP_MEMORY_SCOPE_AGENT); }
DI unsigned xb_add(unsigned* p, unsigned v) { return __hip_atomic_fetch_add(p, v, __ATOMIC_RELAXED, __HIP_MEMORY_SCOPE_AGENT); }
DI unsigned xb_xcc_id() { return (unsigned)__builtin_amdgcn_s_getreg((3 << 11) | 20) & 0xFu; }
#define XB_SPIN(cond, bar) do { unsigned _sp = 0; while (cond) { __builtin_amdgcn_s_sleep(1); \
    if ((++_sp & 255u) == 0u) { if (xb_ld(&(bar)[XB_TMO])) break; if (_sp > XB_SPIN_CAP) { atomicAdd(&(bar)[XB_TMO], 1u); break; } } } } while (0)

DI void xcd_barrier_complete(unsigned* bar, unsigned x, unsigned& nloc, unsigned& nx) {
  const unsigned G = gridDim.x;
  unsigned sum, cnt, mine, sp = 0u;
  for (;;) {
    sum = 0u; cnt = 0u; mine = 0u;
#pragma unroll
    for (unsigned j = 0; j < 16; ++j) { const unsigned c = xb_ld(&bar[XB_XCNT(j)]); sum += c; cnt += (c > 0u) ? 1u : 0u; mine = (j == x) ? c : mine; }
    if (sum == G) break;
    __builtin_amdgcn_s_sleep(1);
    if ((++sp & 255u) == 0u) { if (xb_ld(&bar[XB_TMO])) break; if (sp > XB_SPIN_CAP) { atomicAdd(&bar[XB_TMO], 1u); break; } }
  }
  nloc = mine > 0u ? mine : 1u; nx = cnt > 0u ? cnt : 1u;
}

DI void xcd_barrier(unsigned* bar, volatile unsigned* st) {
  asm volatile("s_waitcnt vmcnt(0)" ::: "memory");
  __syncthreads();
  if (threadIdx.x == 0) {
    __builtin_amdgcn_s_waitcnt(0);
    const unsigned x = xb_xcc_id();
    unsigned nloc = st[0], nx = st[1];
    if (nloc == 0u) { xcd_barrier_complete(bar, x, nloc, nx); st[0] = nloc; st[1] = nx; }
    const unsigned old = xb_add(&bar[XB_XSUB(x)], 1u);
    const unsigned gen = old / nloc;
    if (old + 1u == (gen + 1u) * nloc) {
      __builtin_amdgcn_fence(__ATOMIC_RELEASE, "agent");
      asm volatile("s_waitcnt vmcnt(0)" ::: "memory");
      const unsigned og = xb_add(&bar[XB_TOP], 1u);
      const unsigned tg = og / nx;
      if (og + 1u == (tg + 1u) * nx) xb_add(&bar[XB_TOPGEN], 1u);
      else XB_SPIN(xb_ld(&bar[XB_TOPGEN]) == tg, bar);
      __builtin_amdgcn_fence(__ATOMIC_ACQUIRE, "agent");
      xb_add(&bar[XB_XGEN(x)], 1u);
      asm volatile("s_waitcnt vmcnt(0)" ::: "memory");
    } else {
      XB_SPIN(xb_ld(&bar[XB_XGEN(x)]) == gen, bar);
      __builtin_amdgcn_fence(__ATOMIC_ACQUIRE, "agent");
      asm volatile("s_waitcnt vmcnt(0)" ::: "memory");
    }
  }
  __syncthreads();
}

#ifndef ENMASK
#define ENMASK 0xffffffffu
#endif
#define EN(i) ((ENMASK >> (i)) & 1u)
#ifndef DUPMASK
#define DUPMASK 0u
#endif
#define DUP(i) ((DUPMASK >> (i)) & 1u)
#define PHASE_BEGIN(i) if (EN(i) && pc >= p.lo && pc < p.hi) for (int rep_ = 0; rep_ < 1 + (int)DUP(i); ++rep_) {
#define PHASE_END } { if (pc >= p.lo && pc + 1 < p.hi) { if (pc == p.lo) grid.sync(); else xcd_barrier(bar, st); } ++pc; }

__global__ void __launch_bounds__(256, 2) mega(Params p) {
  __shared__ __attribute__((aligned(16))) char smem[73728 + 16];
  cg::grid_group grid = cg::this_grid();
  int pc = 0;
  char* ws = p.ws;
  unsigned* bar = (unsigned*)(ws + OFF_BAR);
  volatile unsigned* st = (volatile unsigned*)(smem + 73728);
  if (threadIdx.x == 0) { st[0] = 0u; st[1] = 0u; (void)xb_add(&bar[XB_XCNT(xb_xcc_id())], 1u); }
  __syncthreads();
  u16* H = (u16*)(ws + OFF_H);
  char* R = ws + OFF_R;
  const float* LB = (const float*)(ws + OFF_TAB);
  const float* RC = LB + 4096; const float* RS = RC + 65536;
  for (int layer = 0; layer < 4; ++layer) {
    const int kind = layer % 3, mi = layer / 3;
    for (int stage = 0; stage < 3; ++stage) {
      if (stage != 1) {
        const float* ng = (stage == 0 ? p.ffn1_norm : p.ffn2_norm) + layer * 1024;
        const u16* wgu = (const u16*)(ws + (stage == 0 ? OFF_WGU1 : OFF_WGU2));
        const u16* wdn = (const u16*)(ws + (stage == 0 ? OFF_WDN1 : OFF_WDN2));
        u16* ACT = (u16*)R;
        PHASE_BEGIN(0)
          const bool first = (layer == 0 && stage == 0);
          if (stage == 0) { if (layer == 0) init_tables(p); cvt_layer(p, layer, smem); }
          norm_phase(first ? p.x : p.X, ng, H, first ? p.X : nullptr, MTOK);
        PHASE_END
        PHASE_BEGIN(1)
          gemm_phase(H, 1024, wgu, 1024, MTOK, 5632, EpiSwiglu{ACT}, smem);
        PHASE_END
        PHASE_BEGIN(2)
          gemm_phase(ACT, 2816, wdn, 2816, MTOK, 1024, EpiResid{p.X, 0.5f}, smem);
        PHASE_END
      } else {
        PHASE_BEGIN(3)
          norm_phase(p.X, p.mix_norm + layer * 1024, H, nullptr, MTOK);
        PHASE_END
        if (kind == 0) {
          constexpr size_t SZ = 32 * MiB;
          HgBufs hb;
          hb.Q = (u16*)(R + 0 * SZ); hb.LFf = (u16*)(R + 1 * SZ); hb.LFb = (u16*)(R + 2 * SZ); hb.V = (u16*)(R + 3 * SZ); hb.G = (u16*)(R + 4 * SZ);
          hb.QIf = (u16*)(R + 5 * SZ); hb.QIb = (u16*)(R + 6 * SZ); hb.KITf = (u16*)(R + 7 * SZ); hb.KITb = (u16*)(R + 8 * SZ);
          hb.VTc = (u16*)(R + 9 * SZ); hb.OI = (u16*)(R + 10 * SZ); hb.OF = hb.Q; hb.OB = hb.LFf; hb.Y = hb.LFb;
          hb.DECf = (float*)(R + 11 * SZ); hb.DECb = (float*)(R + 11 * SZ + 4 * MiB);
          const u16* w_in = (const u16*)(ws + OFF_WMIX); const u16* w_out = (const u16*)(ws + OFF_WMIX + 10485760);
          for (int half = 0; half < 2; ++half) {
            PHASE_BEGIN(4)
              gemm_phase(H + (size_t)half * 16384 * 1024, 1024, w_in, 1024, 16384, 5120, EpiHgIn{hb.Q, hb.LFf, hb.LFb, hb.V, hb.G, LB + layer * 1024}, smem);
            PHASE_END
            PHASE_BEGIN(5)
              for (int item = blockIdx.x; item < 8192; item += gridDim.x) hg_prep_item(hb, item, smem);
            PHASE_END
            PHASE_BEGIN(6)
              hg_scan_phase(hb, smem);
            PHASE_END
            PHASE_BEGIN(7)
              hg_combine_phase(hb, p.hg_g_norm + mi * 128, 16384);
            PHASE_END
            PHASE_BEGIN(8)
              gemm_phase(hb.Y, 1024, w_out, 1024, 16384, 1024, EpiResid{p.X + (size_t)half * 16384 * 1024, 1.0f}, smem);
            PHASE_END
          }
        } else if (kind == 1) {
          u16* Qn = (u16*)R; u16* Kn = (u16*)(R + 64 * MiB); u16* VT = (u16*)(R + 128 * MiB); u16* On = (u16*)(R + 192 * MiB);
          const u16* w_in = (const u16*)(ws + OFF_WMIX); const u16* w_out = (const u16*)(ws + OFF_WMIX + 6291456);
          PHASE_BEGIN(9)
            gemm_phase(H, 1024, w_in, 1024, MTOK, 3072, EpiNaIn{Qn, Kn, VT, p.na_q_norm + mi * 64, p.na_k_norm + mi * 64}, smem);
          PHASE_END
          PHASE_BEGIN(10)
            const int tid_ = otid(), lane = tid_ & 63, wid = tid_ >> 6, fr = lane & 15, fq = lane >> 4;
            for (int item = blockIdx.x * 4 + wid; item < 32768; item += gridDim.x * 4)
              na_attn_item(Qn, Kn, VT, p.na_rpb + (size_t)mi * 16 * 15 * 31, On, item, fr, fq);
          PHASE_END
          PHASE_BEGIN(11)
            gemm_phase(On, 1024, w_out, 1024, MTOK, 1024, EpiResid{p.X, 1.0f}, smem);
          PHASE_END
        } else {
          u16* VT = H;
          u16* CRAW = (u16*)R; u16* On = (u16*)R;
          u16* CQN = (u16*)(R + 66 * MiB); u16* CKVN = (u16*)(R + 114 * MiB); u16* Kk = (u16*)(R + 66 * MiB);
          float* KROPE = (float*)(R + 162 * MiB);
          u16* Qq = (u16*)(R + 166 * MiB); u16* KVRAW = (u16*)(R + 262 * MiB);
          const u16* w_in = (const u16*)(ws + OFF_WMIX); const u16* w_uq = (const u16*)(ws + OFF_WMIX + 2359296);
          const u16* w_ukv = (const u16*)(ws + OFF_WMIX + 4718592); const u16* w_out = (const u16*)(ws + OFF_WMIX + 5767168);
          PHASE_BEGIN(12)
            gemm_phase(H, 1024, w_in, 1024, MTOK, 1152, EpiStore{CRAW, 1056, 1056}, smem);
          PHASE_END
          PHASE_BEGIN(13)
            mla_norm_phase(CRAW, p.mla_q_a_norm + mi * 768, p.mla_kv_a_norm + mi * 256, CQN, CKVN, KROPE);
          PHASE_END
          PHASE_BEGIN(14)
            gemm_phase(CQN, 768, w_uq, 768, MTOK, 1536, EpiStore{Qq, 1536, 1536}, smem);
            gemm_phase(CKVN, 256, w_ukv, 256, MTOK, 2048, EpiStore{KVRAW, 2048, 2048}, smem);
          PHASE_END
          PHASE_BEGIN(15)
            mla_prep_phase(Qq, KVRAW, KROPE, Kk, p.mla_q_norm + mi * 96, p.mla_k_norm + mi * 96, RC, RS);
            mla_vt_phase(KVRAW, VT, smem);
          PHASE_END
          PHASE_BEGIN(16)
            for (int item = blockIdx.x; item < 4096; item += gridDim.x) mla_attn_item(Qq, Kk, VT, On, item, smem);
          PHASE_END
          PHASE_BEGIN(17)
            gemm_phase(On, 1024, w_out, 1024, MTOK, 1024, EpiResid{p.X, 1.0f}, smem);
          PHASE_END
        }
      }
    }
  }
}

static int count_phases() {
  int n = 0;
  for (int layer = 0; layer < 4; ++layer) {
    int kind = layer % 3;
    n += 3 + 3 + 1;
    n += kind == 0 ? 10 : kind == 1 ? 3 : 6;
  }
  return n;
}

extern "C" void kernel_launch(void* const* d_in, const int* in_sizes, int n_in, void* d_out, int out_size, void* d_ws, size_t ws_size, hipStream_t stream) {
  if (ws_size < WS_NEED) { fprintf(stderr, "workspace too small: %zu < %zu\n", ws_size, WS_NEED); return; }
  static int grid_blocks = 0;
  if (!grid_blocks) {
    int dev = 0, cus = 0, per_cu = 0;
    hipGetDevice(&dev);
    hipDeviceGetAttribute(&cus, hipDeviceAttributeMultiprocessorCount, dev);
    hipOccupancyMaxActiveBlocksPerMultiprocessor(&per_cu, mega, 256, 0);
    if (per_cu > 2) per_cu = 2;
    grid_blocks = cus * per_cu;
  }
  Params p{};
  const float** pf = (const float**)&p;
  for (int i = 0; i < 25; ++i) pf[i] = (const float*)d_in[i];
  p.X = (float*)d_out; p.ws = (char*)d_ws;
  const int total = count_phases();
#if MULTI_LAUNCH
  for (int ph = 0; ph < total; ++ph) {
    p.lo = ph; p.hi = ph + 1;
    hipLaunchKernelGGL(mega, dim3(grid_blocks), dim3(256), 0, stream, p);
  }
#else
  hipMemsetAsync((char*)d_ws + OFF_BAR, 0, 16384, stream);
  p.lo = 0; p.hi = total;
  void* args[] = {&p};
  hipError_t e = hipLaunchCooperativeKernel((void*)mega, dim3(grid_blocks), dim3(256), args, 0, stream);
  if (e != hipSuccess) fprintf(stderr, "cooperative launch failed: %s (grid %d)\n", hipGetErrorString(e), grid_blocks);
#endif
}
```

```cpp
#include <hip/hip_runtime.h>
#include <hip/hip_cooperative_groups.h>
#include <cstdio>
#include <cstdint>
namespace cg = cooperative_groups;

#ifndef MULTI_LAUNCH
#define MULTI_LAUNCH 0
#endif

typedef unsigned short u16;
typedef unsigned int u32;
using bf16x8 = __attribute__((ext_vector_type(8))) short;
using bf16x4 = __attribute__((ext_vector_type(4))) short;
using f32x4 = __attribute__((ext_vector_type(4))) float;
using u32x2 = __attribute__((ext_vector_type(2))) unsigned int;
using u32x4 = __attribute__((ext_vector_type(4))) unsigned int;

#define DI __device__ __forceinline__
#define MFMA32(a, b, c) __builtin_amdgcn_mfma_f32_16x16x32_bf16((a), (b), (c), 0, 0, 0)

constexpr int MTOK = 32768;
constexpr float EPS = 1e-6f;
constexpr float LOG2E = 1.4426950408889634f;

constexpr size_t MiB = 1048576;
constexpr size_t OFF_WGU1 = 0;
constexpr size_t OFF_WDN1 = 11534336;
constexpr size_t OFF_WGU2 = 17301504;
constexpr size_t OFF_WDN2 = 28835840;
constexpr size_t OFF_WMIX = 34603008;
constexpr size_t OFF_TAB = 47185920;
constexpr size_t OFF_BAR = OFF_TAB + 786432;
constexpr size_t OFF_H = 46 * MiB;
constexpr size_t OFF_R = 110 * MiB;
constexpr size_t WS_NEED = 500 * MiB;

struct Params {
  const float* x; const float* ffn1_norm; const float* ffn1_w_gu; const float* ffn1_w_down;
  const float* mix_norm; const float* ffn2_norm; const float* ffn2_w_gu; const float* ffn2_w_down;
  const float* hg_lb_logits; const float* hg_w_in; const float* hg_g_norm; const float* hg_w_out;
  const float* na_w_in; const float* na_q_norm; const float* na_k_norm; const float* na_rpb; const float* na_w_out;
  const float* mla_w_in; const float* mla_q_a_norm; const float* mla_w_uq; const float* mla_kv_a_norm; const float* mla_w_ukv;
  const float* mla_q_norm; const float* mla_k_norm; const float* mla_w_out;
  float* X; char* ws; int lo; int hi;
};

DI u32 f2bf(float x) { u32 u = __float_as_uint(x); u += 0x7fffu + ((u >> 16) & 1u); return u >> 16; }
typedef __bf16 bf16v2 __attribute__((ext_vector_type(2)));
typedef float f32v2 __attribute__((ext_vector_type(2)));
DI u32 pack2(float a, float b) { f32v2 v = {a, b}; bf16v2 r = __builtin_convertvector(v, bf16v2); return __builtin_bit_cast(u32, r); }
DI float bflo(u32 w) { return __uint_as_float(w << 16); }
DI float bfhi(u32 w) { return __uint_as_float(w & 0xffff0000u); }
DI float bfget(const u32x4& v, int e) { u32 w = v[e >> 1]; return (e & 1) ? bfhi(w) : bflo(w); }
DI u32x2 pack4(const f32x4& v) { u32x2 r; r[0] = pack2(v[0], v[1]); r[1] = pack2(v[2], v[3]); return r; }
DI bf16x8 pack8(const f32x4& a, const f32x4& b) {
  u32x4 r; r[0] = pack2(a[0], a[1]); r[1] = pack2(a[2], a[3]); r[2] = pack2(b[0], b[1]); r[3] = pack2(b[2], b[3]);
  return __builtin_bit_cast(bf16x8, r);
}
DI bf16x8 cat4(const bf16x4& lo, const bf16x4& hi) { return __builtin_shufflevector(lo, hi, 0, 1, 2, 3, 4, 5, 6, 7); }
DI float wave_sum(float v) {
#pragma unroll
  for (int o = 32; o > 0; o >>= 1) v += __shfl_xor(v, o);
  return v;
}
DI float sigmoidf_(float z) { return 1.f / (1.f + __expf(-z)); }
DI float siluf_(float z) { return z / (1.f + __expf(-z)); }
DI int otid() { int t = threadIdx.x; asm volatile("" : "+v"(t)); return t; }
DI f32x4 zero4() { f32x4 z = {0.f, 0.f, 0.f, 0.f}; return z; }

DI void init_tables(const Params& p) {
  float* LB = (float*)(p.ws + OFF_TAB); float* RC = LB + 4096; float* RS = RC + 65536;
  const int gt = blockIdx.x * 256 + otid(), gs = gridDim.x * 256;
  for (int c = gt; c < 1024; c += gs) {
    float l0 = p.hg_lb_logits[c], l1 = p.hg_lb_logits[1024 + c], l2 = p.hg_lb_logits[2048 + c], l3 = p.hg_lb_logits[3072 + c];
    float mx = fmaxf(fmaxf(l0, l1), fmaxf(l2, l3));
    float e0 = expf(l0 - mx), e1 = expf(l1 - mx), e2 = expf(l2 - mx), e3 = expf(l3 - mx);
    float inv = 1.f / (e0 + e1 + e2 + e3);
    LB[c] = 0.f; LB[1024 + c] = e1 * inv; LB[2048 + c] = (e1 + e2) * inv; LB[3072 + c] = (e1 + e2 + e3) * inv;
  }
  for (int i = gt; i < 65536; i += gs) {
    int t = i >> 4, j = i & 15;
    float inv = exp2f(-(float)j * (13.287712379549449f / 16.f));
    float ang = (float)t * inv;
    double a = (double)ang;
    double k = rint(a * 0.15915494309189535);
    float r = (float)(a - k * 6.283185307179586);
    RC[i] = __cosf(r); RS[i] = __sinf(r);
  }
}

DI void cvt_tiles(const float* __restrict__ src, u16* __restrict__ dst, int K, int N, int Nd, int mode, char* smem) {
  float* tile = (float*)smem;
  const int tk = K >> 6, tn = Nd >> 6, tid = otid();
  for (int t = blockIdx.x; t < tk * tn; t += gridDim.x) {
    const int k0 = (t % tk) << 6, n0 = (t / tk) << 6;
    {
      const int nl = tid & 63, kq = tid >> 6;
      const int nd = n0 + nl;
      int col = nd;
      if (mode == 1) { int a = nd >> 5, r = nd & 31; col = a * 16 + (r & 15) + ((r >= 16) ? 2816 : 0); }
      const bool ok = col < N;
#pragma unroll
      for (int i = 0; i < 16; ++i) {
        int kl = kq + 4 * i;
        tile[kl * 65 + nl] = ok ? src[(size_t)(k0 + kl) * N + col] : 0.f;
      }
    }
    __syncthreads();
    {
      const int kp = (tid & 31) * 2, nq = tid >> 5;
#pragma unroll
      for (int i = 0; i < 8; ++i) {
        int n = nq + 8 * i;
        *(u32*)(dst + (size_t)(n0 + n) * K + k0 + kp) = pack2(tile[kp * 65 + n], tile[(kp + 1) * 65 + n]);
      }
    }
    __syncthreads();
  }
}

DI void cvt_layer(const Params& p, int layer, char* smem) {
  const int kind = layer % 3, mi = layer / 3;
  char* ws = p.ws;
  for (int task = 0; task < 8; ++task) {
    const float* src = nullptr; size_t off = 0; int K = 0, N = 0, Nd = 0, mode = 0;
    if (task == 0) { src = p.ffn1_w_gu + (size_t)layer * 1024 * 5632; off = OFF_WGU1; K = 1024; N = 5632; Nd = 5632; mode = 1; }
    else if (task == 1) { src = p.ffn1_w_down + (size_t)layer * 2816 * 1024; off = OFF_WDN1; K = 2816; N = 1024; Nd = 1024; }
    else if (task == 2) { src = p.ffn2_w_gu + (size_t)layer * 1024 * 5632; off = OFF_WGU2; K = 1024; N = 5632; Nd = 5632; mode = 1; }
    else if (task == 3) { src = p.ffn2_w_down + (size_t)layer * 2816 * 1024; off = OFF_WDN2; K = 2816; N = 1024; Nd = 1024; }
    else if (kind == 0) {
      if (task == 4) { src = p.hg_w_in + (size_t)mi * 1024 * 5120; off = OFF_WMIX; K = 1024; N = 5120; Nd = 5120; }
      else if (task == 5) { src = p.hg_w_out + (size_t)mi * 1024 * 1024; off = OFF_WMIX + 10485760; K = 1024; N = 1024; Nd = 1024; }
    } else if (kind == 1) {
      if (task == 4) { src = p.na_w_in + (size_t)mi * 1024 * 3072; off = OFF_WMIX; K = 1024; N = 3072; Nd = 3072; }
      else if (task == 5) { src = p.na_w_out + (size_t)mi * 1024 * 1024; off = OFF_WMIX + 6291456; K = 1024; N = 1024; Nd = 1024; }
    } else {
      if (task == 4) { src = p.mla_w_in + (size_t)mi * 1024 * 1056; off = OFF_WMIX; K = 1024; N = 1056; Nd = 1152; }
      else if (task == 5) { src = p.mla_w_uq + (size_t)mi * 768 * 1536; off = OFF_WMIX + 2359296; K = 768; N = 1536; Nd = 1536; }
      else if (task == 6) { src = p.mla_w_ukv + (size_t)mi * 256 * 2048; off = OFF_WMIX + 4718592; K = 256; N = 2048; Nd = 2048; }
      else if (task == 7) { src = p.mla_w_out + (size_t)mi * 1024 * 1024; off = OFF_WMIX + 5767168; K = 1024; N = 1024; Nd = 1024; }
    }
    if (src) cvt_tiles(src, (u16*)(ws + off), K, N, Nd, mode, smem);
  }
}

DI void norm_phase(const float* __restrict__ src, const float* __restrict__ gain, u16* __restrict__ dst, float* copy_dst, int rows) {
  const int lane = otid() & 63, wid = otid() >> 6;
  f32x4 g[4];
#pragma unroll
  for (int i = 0; i < 4; ++i) g[i] = *(const f32x4*)(gain + i * 256 + lane * 4);
  const int stride = gridDim.x * 4;
  for (int row = blockIdx.x * 4 + wid; row < rows; row += stride * 4) {
    f32x4 v[4][4];
#pragma unroll
    for (int j = 0; j < 4; ++j) {
      const int rj = row + j * stride;
      if (rj < rows) {
#pragma unroll
        for (int i = 0; i < 4; ++i) v[j][i] = *(const f32x4*)(src + (size_t)rj * 1024 + i * 256 + lane * 4);
      }
    }
#pragma unroll
    for (int j = 0; j < 4; ++j) {
      const int rj = row + j * stride;
      if (rj < rows) {
        float ss = 0.f;
#pragma unroll
        for (int i = 0; i < 4; ++i) ss += v[j][i][0] * v[j][i][0] + v[j][i][1] * v[j][i][1] + v[j][i][2] * v[j][i][2] + v[j][i][3] * v[j][i][3];
        ss = wave_sum(ss);
        const float rstd = rsqrtf(ss * (1.f / 1024.f) + EPS);
#pragma unroll
        for (int i = 0; i < 4; ++i) {
          f32x4 y = v[j][i] * rstd * g[i];
          *(u32x2*)(dst + (size_t)rj * 1024 + i * 256 + lane * 4) = pack4(y);
          if (copy_dst) *(f32x4*)(copy_dst + (size_t)rj * 1024 + i * 256 + lane * 4) = v[j][i];
        }
      }
    }
  }
}

#define GLDS16(gp, lp) __builtin_amdgcn_global_load_lds((const unsigned*)(gp), (unsigned*)(lp), 16, 0, 0)

constexpr int G_STAGE = 24576, G_WOFF = 16384, G_NS = 3, G_MT = 8;

template <class Epi>
DI void gemm_tile(const u16* __restrict__ A, int lda, const u16* __restrict__ W, int K, int m0, int n0, const Epi& epi, char* smem) {
  const int tid = otid(), lane = tid & 63, wid = tid >> 6;
  const int wm = wid >> 1, wn = wid & 1, fr = lane & 15, fq = lane >> 4;
  f32x4 acc[4][G_MT];
#pragma unroll
  for (int i = 0; i < 4; ++i)
#pragma unroll
    for (int j = 0; j < G_MT; ++j) acc[i][j] = zero4();
  const int lrow = tid >> 2, lc = (tid & 3) ^ ((tid >> 4) & 3);
  const u16* ga = A + (size_t)lrow * lda + lc * 8;
  const u16* gw = W + (size_t)lrow * K + lc * 8;
  char* sdst = smem + tid * 16;
  const int ro = (fq ^ (fr >> 2)) * 16;
  const char* sa_rd = smem + (wm * 128 + fr) * 64 + ro;
  const char* sw_rd = smem + G_WOFF + (wn * 64 + fr) * 64 + ro;
  const int nk = K >> 5;
  __builtin_amdgcn_s_barrier();
  asm volatile("" ::: "memory");
#pragma unroll
  for (int s = 0; s < 2; ++s) {
#pragma unroll
    for (int i = 0; i < 4; ++i) GLDS16(ga + (size_t)(64 * i) * lda + s * 32, sdst + s * G_STAGE + i * 4096);
#pragma unroll
    for (int i = 0; i < 2; ++i) GLDS16(gw + (size_t)(64 * i) * K + s * 32, sdst + s * G_STAGE + G_WOFF + i * 4096);
  }
  int slot = 0;
  for (int t = 0; t < nk; ++t) {
    if (t + 1 < nk) asm volatile("s_waitcnt vmcnt(6)" ::: "memory");
    else asm volatile("s_waitcnt vmcnt(0)" ::: "memory");
    __builtin_amdgcn_s_barrier();
    asm volatile("" ::: "memory");
    if (t + 2 < nk) {
      int is = slot + 2; if (is >= G_NS) is -= G_NS;
      const int k0 = (t + 2) << 5;
#pragma unroll
      for (int i = 0; i < 4; ++i) GLDS16(ga + (size_t)(64 * i) * lda + k0, sdst + is * G_STAGE + i * 4096);
#pragma unroll
      for (int i = 0; i < 2; ++i) GLDS16(gw + (size_t)(64 * i) * K + k0, sdst + is * G_STAGE + G_WOFF + i * 4096);
    }
    const int cur = slot * G_STAGE;
    bf16x8 af[G_MT], wf[4];
#pragma unroll
    for (int i = 0; i < 4; ++i) wf[i] = *(const bf16x8*)(sw_rd + cur + i * 1024);
#pragma unroll
    for (int i = 0; i < 4; ++i) af[i] = *(const bf16x8*)(sa_rd + cur + i * 1024);
    __builtin_amdgcn_sched_barrier(0);
    acc[0][0] = MFMA32(wf[0], af[0], acc[0][0]);
    __builtin_amdgcn_sched_barrier(0);
#pragma unroll
    for (int i = 4; i < G_MT; ++i) af[i] = *(const bf16x8*)(sa_rd + cur + i * 1024);
    __builtin_amdgcn_sched_barrier(0);
#pragma unroll
    for (int mt = 0; mt < 4; ++mt)
#pragma unroll
      for (int nt = 0; nt < 4; ++nt) if (mt + nt > 0) acc[nt][mt] = MFMA32(wf[nt], af[mt], acc[nt][mt]);
    __builtin_amdgcn_sched_barrier(0);
#pragma unroll
    for (int mt = 4; mt < G_MT; ++mt)
#pragma unroll
      for (int nt = 0; nt < 4; ++nt) acc[nt][mt] = MFMA32(wf[nt], af[mt], acc[nt][mt]);
    if (++slot == G_NS) slot = 0;
  }
  epi(acc, m0 + wm * 128, n0 + wn * 64, fr, fq);
}

template <class Epi>
DI void gemm_phase(const u16* A, int lda, const u16* W, int K, int Mrows, int Ncols, const Epi& epi, char* smem) {
  const int mtn = Mrows >> 8, ntn = Ncols >> 7;
  const int ntiles = mtn * ntn;
  constexpr int GM = 16;
  for (int tile = blockIdx.x; tile < ntiles; tile += gridDim.x) {
    const int group = tile / (GM * ntn), rem = tile % (GM * ntn);
    const int mt = group * GM + (rem % GM), nt = rem / GM;
    gemm_tile(A + (size_t)mt * 256 * lda, lda, W + (size_t)nt * 128 * K, K, mt * 256, nt * 128, epi, smem);
  }
  __syncthreads();
}

struct EpiSwiglu {
  u16* act;
  DI void operator()(f32x4 (&acc)[4][G_MT], int mb, int nb, int fr, int fq) const {
#pragma unroll
    for (int mt = 0; mt < G_MT; ++mt) {
      const int m = mb + mt * 16 + fr;
#pragma unroll
      for (int np = 0; np < 2; ++np) {
        const f32x4 g = acc[2 * np][mt], u = acc[2 * np + 1][mt];
        f32x4 r;
#pragma unroll
        for (int j = 0; j < 4; ++j) r[j] = siluf_(g[j]) * u[j];
        const int jc = (nb >> 1) + np * 16 + fq * 4;
        *(u32x2*)(act + (size_t)m * 2816 + jc) = pack4(r);
      }
    }
  }
};

struct EpiResid {
  float* X; float scale;
  DI void operator()(f32x4 (&acc)[4][G_MT], int mb, int nb, int fr, int fq) const {
#pragma unroll
    for (int mt = 0; mt < G_MT; ++mt) {
      const int m = mb + mt * 16 + fr;
#pragma unroll
      for (int nt = 0; nt < 4; ++nt) {
        f32x4* ptr = (f32x4*)(X + (size_t)m * 1024 + nb + nt * 16 + fq * 4);
        f32x4 v = *ptr;
        v += acc[nt][mt] * scale;
        *ptr = v;
      }
    }
  }
};

struct EpiStore {
  u16* out; int ldo; int nmax;
  DI void operator()(f32x4 (&acc)[4][G_MT], int mb, int nb, int fr, int fq) const {
#pragma unroll
    for (int mt = 0; mt < G_MT; ++mt) {
      const int m = mb + mt * 16 + fr;
#pragma unroll
      for (int nt = 0; nt < 4; ++nt) {
        const int n = nb + nt * 16 + fq * 4;
        if (n < nmax) *(u32x2*)(out + (size_t)m * ldo + n) = pack4(acc[nt][mt]);
      }
    }
  }
};

struct EpiHgIn {
  u16 *Q, *LFf, *LFb, *V, *G; const float* lb;
  DI void operator()(f32x4 (&acc)[4][G_MT], int mb, int nb, int fr, int fq) const {
    const int seg = nb >> 10, c0 = nb & 1023;
    u16* dst = seg == 0 ? Q : seg == 1 ? LFf : seg == 2 ? LFb : seg == 3 ? V : G;
#pragma unroll
    for (int mt = 0; mt < G_MT; ++mt) {
      const int m = mb + mt * 16 + fr;
#pragma unroll
      for (int nt = 0; nt < 4; ++nt) {
        const int c = c0 + nt * 16 + fq * 4;
        f32x4 a = acc[nt][mt], r;
        if (seg == 0) r = a * 0.08838834764831845f;
        else if (seg == 3) r = a;
        else if (seg == 4) {
#pragma unroll
          for (int j = 0; j < 4; ++j) r[j] = siluf_(a[j]);
        } else {
          const f32x4 l4 = *(const f32x4*)(lb + c);
#pragma unroll
          for (int j = 0; j < 4; ++j) {
            float z = fminf(fmaxf(a[j], -30.f), 30.f);
            float f = l4[j] + (1.f - l4[j]) * sigmoidf_(z);
            r[j] = __logf(f);
          }
        }
        *(u32x2*)(dst + (size_t)m * 1024 + c) = pack4(r);
      }
    }
  }
};

struct EpiNaIn {
  u16 *Q, *K, *VT; const float *qn, *kn;
  DI void operator()(f32x4 (&acc)[4][G_MT], int mb, int nb, int fr, int fq) const {
    const int seg = nb >> 10, h = (nb & 1023) >> 6;
    if (seg < 2) {
      u16* dst = seg == 0 ? Q : K;
      const float* gn = seg == 0 ? qn : kn;
      const float sc = seg == 0 ? 0.125f * LOG2E : 1.f;
#pragma unroll
      for (int mt = 0; mt < G_MT; ++mt) {
        const int m = mb + mt * 16 + fr;
        float ss = 0.f;
#pragma unroll
        for (int nt = 0; nt < 4; ++nt)
#pragma unroll
          for (int j = 0; j < 4; ++j) ss += acc[nt][mt][j] * acc[nt][mt][j];
        ss += __shfl_xor(ss, 16); ss += __shfl_xor(ss, 32);
        const float rstd = rsqrtf(ss * (1.f / 64.f) + EPS) * sc;
#pragma unroll
        for (int nt = 0; nt < 4; ++nt) {
          const int d = nt * 16 + fq * 4;
          const f32x4 g4 = *(const f32x4*)(gn + d);
          f32x4 r = acc[nt][mt] * rstd * g4;
          *(u32x2*)(dst + (size_t)m * 1024 + h * 64 + d) = pack4(r);
        }
      }
    } else {
#pragma unroll
      for (int mt = 0; mt < G_MT; ++mt) {
        const int m = mb + mt * 16 + fr;
        const int b = m >> 12, t = m & 4095;
#pragma unroll
        for (int nt = 0; nt < 4; ++nt)
#pragma unroll
          for (int j = 0; j < 4; ++j) {
            const int d = nt * 16 + fq * 4 + j;
            VT[((size_t)((b * 16 + h) * 64 + d)) * 4096 + t] = (u16)f2bf(acc[nt][mt][j]);
          }
      }
    }
  }
};

struct HgBufs {
  u16 *Q, *LFf, *LFb, *V, *G, *QIf, *QIb, *KITf, *KITb, *VTc, *OI, *OF, *OB, *Y;
  float *DECf, *DECb;
};

DI void hg_prep_phase(const HgBufs& hb, char* smem) {
  u32x4 rq, rf, rb, rv;
  {
    const int item0 = blockIdx.x, tid0 = otid();
    if (item0 < 8192) {
      const size_t g0 = ((size_t)(item0 >> 11) * 4096 + ((item0 >> 3) & 255) * 16 + (tid0 >> 4)) * 1024 + (item0 & 7) * 128 + (tid0 & 15) * 8;
      rq = *(const u32x4*)(hb.Q + g0); rf = *(const u32x4*)(hb.LFf + g0); rb = *(const u32x4*)(hb.LFb + g0); rv = *(const u32x4*)(hb.V + g0);
    }
  }
  for (int item = blockIdx.x; item < 8192; item += gridDim.x) {
  const int h = item & 7, n = (item >> 3) & 255, b = item >> 11;
  float* sq = (float*)smem; float* sbf = sq + 2112; float* sbb = sbf + 2112; float* skf = sbb + 2112;
  float* skb = skf + 2112; float* sv = skb + 2112; float* sA = sv + 2112;
  const int tid = otid();
  const int row = tid >> 4, c8 = (tid & 15) * 8;
  const size_t tok0 = (size_t)b * 4096 + n * 16;
  const size_t gidx = (tok0 + row) * 1024 + h * 128 + c8;
  {
#pragma unroll
    for (int e = 0; e < 8; ++e) {
      const int o = row * 132 + c8 + e;
      const float lf = bfget(rf, e), lb_ = bfget(rb, e);
      sq[o] = bfget(rq, e); sbf[o] = lf; sbb[o] = lb_;
      skf[o] = 1.f - __expf(lf); skb[o] = 1.f - __expf(lb_); sv[o] = bfget(rv, e);
    }
  }
  {
    const int nx = item + gridDim.x;
    if (nx < 8192) {
      const size_t g1 = ((size_t)(nx >> 11) * 4096 + ((nx >> 3) & 255) * 16 + row) * 1024 + (nx & 7) * 128 + c8;
      rq = *(const u32x4*)(hb.Q + g1); rf = *(const u32x4*)(hb.LFf + g1); rb = *(const u32x4*)(hb.LFb + g1); rv = *(const u32x4*)(hb.V + g1);
    }
  }
  __syncthreads();
  if (tid < 128) {
    const int d = tid; float a = 0.f;
#pragma unroll
    for (int t = 0; t < 16; ++t) { a += sbf[t * 132 + d]; sbf[t * 132 + d] = a; }
    hb.DECf[((size_t)b * 256 + n) * 1024 + h * 128 + d] = __expf(a);
  } else {
    const int d = tid - 128; float a = 0.f;
#pragma unroll
    for (int t = 15; t >= 0; --t) { a += sbb[t * 132 + d]; sbb[t * 132 + d] = a; }
    hb.DECb[((size_t)b * 256 + n) * 1024 + h * 128 + d] = __expf(a);
  }
  __syncthreads();
  {
    u32x4 of, ob;
#pragma unroll
    for (int e2 = 0; e2 < 4; ++e2) {
      const int o = row * 132 + c8 + 2 * e2;
      const float q0 = sq[o], q1 = sq[o + 1];
      of[e2] = pack2(q0 * __expf(sbf[o]), q1 * __expf(sbf[o + 1]));
      ob[e2] = pack2(q0 * __expf(sbb[o]), q1 * __expf(sbb[o + 1]));
    }
    *(u32x4*)(hb.QIf + gidx) = of; *(u32x4*)(hb.QIb + gidx) = ob;
  }
  {
    const int d = tid >> 1, t8 = (tid & 1) * 8;
    const float blf = sbf[15 * 132 + d], blb = sbb[d];
    u32x4 kf, kb, vv;
#pragma unroll
    for (int e2 = 0; e2 < 4; ++e2) {
      const int o0 = (t8 + 2 * e2) * 132 + d, o1 = o0 + 132;
      kf[e2] = pack2(skf[o0] * __expf(blf - sbf[o0]), skf[o1] * __expf(blf - sbf[o1]));
      kb[e2] = pack2(skb[o0] * __expf(blb - sbb[o0]), skb[o1] * __expf(blb - sbb[o1]));
      vv[e2] = pack2(sv[o0], sv[o1]);
    }
    const size_t cidx = (((size_t)(b * 8 + h) * 256 + n) * 128 + d) * 16 + t8;
    *(u32x4*)(hb.KITf + cidx) = kf; *(u32x4*)(hb.KITb + cidx) = kb; *(u32x4*)(hb.VTc + cidx) = vv;
  }
  {
    const int s = tid >> 4, dg = tid & 15, d0 = dg * 8, sw0 = (tid >> 6) * 4;
    float w[8];
    {
      const f32x4 a = *(const f32x4*)(skf + s * 132 + d0), b2 = *(const f32x4*)(skf + s * 132 + d0 + 4);
#pragma unroll
      for (int e = 0; e < 4; ++e) { w[e] = a[e]; w[4 + e] = b2[e]; }
    }
    float pdiag = 0.f;
    for (int t = sw0; t < 16; ++t) {
      if (t > s) {
        const f32x4 a = *(const f32x4*)(skf + t * 132 + d0), b2 = *(const f32x4*)(skf + t * 132 + d0 + 4);
#pragma unroll
        for (int e = 0; e < 4; ++e) { w[e] *= (1.f - a[e]); w[4 + e] *= (1.f - b2[e]); }
      }
      const f32x4 q0 = *(const f32x4*)(sq + t * 132 + d0), q1 = *(const f32x4*)(sq + t * 132 + d0 + 4);
      float part = 0.f;
#pragma unroll
      for (int e = 0; e < 4; ++e) part += q0[e] * w[e] + q1[e] * w[4 + e];
      part += __shfl_xor(part, 1); part += __shfl_xor(part, 2); part += __shfl_xor(part, 4); part += __shfl_xor(part, 8);
      if (t == s) pdiag = part;
      else if (t > s && dg == 0) sA[t * 17 + s] = part;
    }
    {
      const f32x4 a = *(const f32x4*)(skb + s * 132 + d0), b2 = *(const f32x4*)(skb + s * 132 + d0 + 4);
#pragma unroll
      for (int e = 0; e < 4; ++e) { w[e] = a[e]; w[4 + e] = b2[e]; }
    }
    for (int t = sw0 + 3; t >= 0; --t) {
      if (t < s) {
        const f32x4 a = *(const f32x4*)(skb + t * 132 + d0), b2 = *(const f32x4*)(skb + t * 132 + d0 + 4);
#pragma unroll
        for (int e = 0; e < 4; ++e) { w[e] *= (1.f - a[e]); w[4 + e] *= (1.f - b2[e]); }
      }
      const f32x4 q0 = *(const f32x4*)(sq + t * 132 + d0), q1 = *(const f32x4*)(sq + t * 132 + d0 + 4);
      float part = 0.f;
#pragma unroll
      for (int e = 0; e < 4; ++e) part += q0[e] * w[e] + q1[e] * w[4 + e];
      part += __shfl_xor(part, 1); part += __shfl_xor(part, 2); part += __shfl_xor(part, 4); part += __shfl_xor(part, 8);
      if (dg == 0) { if (t == s) sA[s * 17 + s] = pdiag + part; else if (t < s) sA[t * 17 + s] = part; }
    }
  }
  __syncthreads();
  {
    float o[8];
#pragma unroll
    for (int e = 0; e < 8; ++e) o[e] = 0.f;
#pragma unroll
    for (int s = 0; s < 16; ++s) {
      const float a = sA[row * 17 + s];
      const f32x4 v0 = *(const f32x4*)(sv + s * 132 + c8), v1 = *(const f32x4*)(sv + s * 132 + c8 + 4);
#pragma unroll
      for (int e = 0; e < 4; ++e) { o[e] += a * v0[e]; o[4 + e] += a * v1[e]; }
    }
    u32x4 r; r[0] = pack2(o[0], o[1]); r[1] = pack2(o[2], o[3]); r[2] = pack2(o[4], o[5]); r[3] = pack2(o[6], o[7]);
    *(u32x4*)(hb.OI + gidx) = r;
  }
  __syncthreads();
  }
}

constexpr int SC_NS = 6, SC_STAGE = 12288;
DI void scan_issue(char* smem, int slot, const u16* QI, const u16* KIT, const u16* VTc, const float* DEC, int b, int h, int vg, int n, int tid) {
  char* st = smem + slot * SC_STAGE + tid * 16;
  const size_t tok0 = (size_t)b * 4096 + n * 16;
  const int row = tid >> 4, lc = (tid & 15) ^ row;
  GLDS16(QI + (tok0 + row) * 1024 + h * 128 + lc * 8, st);
  const size_t cb = ((size_t)(b * 8 + h) * 256 + n) * 2048;
  GLDS16(KIT + cb + tid * 8, st + 4096);
  const float* dp = DEC + ((size_t)b * 256 + n) * 1024 + h * 128;
  const void* g3 = tid < 128 ? (const void*)(VTc + cb + vg * 1024 + tid * 8) : (const void*)(dp + ((tid - 128) & 31) * 4);
  GLDS16(g3, st + 8192);
}

DI void hg_scan_phase(const HgBufs& hb, char* smem) {
  const int tid = otid(), lane = tid & 63, wid = tid >> 6, fr = lane & 15, fq = lane >> 4;
  for (int item = blockIdx.x; item < 128; item += gridDim.x) {
    const int vg = item & 1, dir = (item >> 1) & 1, h = (item >> 2) & 7, b = item >> 5;
    const u16* QI = dir ? hb.QIb : hb.QIf; const u16* KIT = dir ? hb.KITb : hb.KITf;
    const float* DEC = dir ? hb.DECb : hb.DECf; u16* Oout = dir ? hb.OB : hb.OF;
    const int vs = vg * 4 + wid;
    f32x4 S[8];
#pragma unroll
    for (int i = 0; i < 8; ++i) S[i] = zero4();
#pragma unroll
    for (int s = 0; s < SC_NS - 1; ++s) scan_issue(smem, s, QI, KIT, hb.VTc, DEC, b, h, vg, dir ? 255 - s : s, tid);
    int slot = 0;
    for (int step = 0; step < 256; ++step) {
      if (step < SC_NS - 1) asm volatile("s_waitcnt vmcnt(12)" ::: "memory");
      else asm volatile("s_waitcnt vmcnt(32)" ::: "memory");
      __builtin_amdgcn_s_barrier();
      asm volatile("" ::: "memory");
      {
        const int ns = min(step + SC_NS - 1, 255);
        int islot = slot + SC_NS - 1; if (islot >= SC_NS) islot -= SC_NS;
        scan_issue(smem, islot, QI, KIT, hb.VTc, DEC, b, h, vg, dir ? 255 - ns : ns, tid);
      }
      const int n = dir ? 255 - step : step;
      const char* st = smem + slot * SC_STAGE;
      bf16x8 qa[4], ka[8]; f32x4 dc[8];
#pragma unroll
      for (int ks = 0; ks < 4; ++ks) {
        const int l0 = 4 * ks + (fq >> 1), l1 = l0 + 2;
        const bf16x4 lo = *(const bf16x4*)(st + fr * 256 + ((l0 ^ fr) * 16) + (fq & 1) * 8);
        const bf16x4 hi = *(const bf16x4*)(st + fr * 256 + ((l1 ^ fr) * 16) + (fq & 1) * 8);
        qa[ks] = cat4(lo, hi);
      }
      bf16x8 vb = *(const bf16x8*)(st + 8192 + (wid * 16 + fr) * 32 + (fq & 1) * 16);
#pragma unroll
      for (int dt = 0; dt < 8; ++dt) {
        ka[dt] = *(const bf16x8*)(st + 4096 + (dt * 16 + fr) * 32 + (fq & 1) * 16);
        dc[dt] = *(const f32x4*)(st + 8192 + 2048 + (dt * 16 + fq * 4) * 4);
      }
      asm volatile("s_waitcnt lgkmcnt(0)" ::: "memory");
      __builtin_amdgcn_sched_barrier(0);
      const bf16x8 z8 = {0, 0, 0, 0, 0, 0, 0, 0};
      if (fq >= 2) vb = z8;
      f32x4 o0 = zero4(), o1 = zero4();
      o0 = MFMA32(qa[0], pack8(S[0], S[1]), o0);
      o1 = MFMA32(qa[1], pack8(S[2], S[3]), o1);
      o0 = MFMA32(qa[2], pack8(S[4], S[5]), o0);
      o1 = MFMA32(qa[3], pack8(S[6], S[7]), o1);
#pragma unroll
      for (int dt = 0; dt < 8; ++dt) {
        if (fq >= 2) ka[dt] = z8;
        S[dt] = S[dt] * dc[dt];
        S[dt] = MFMA32(ka[dt], vb, S[dt]);
      }
      {
        const f32x4 o = o0 + o1;
        const size_t tok0 = (size_t)b * 4096 + n * 16;
        u16* op = Oout + (tok0 + fq * 4) * 1024 + h * 128 + vs * 16 + fr;
        const u32 w0 = pack2(o[0], o[1]), w1 = pack2(o[2], o[3]);
        asm volatile("global_store_short %0, %1, off" :: "v"(op), "v"(w0) : "memory");
        asm volatile("global_store_short_d16_hi %0, %1, off" :: "v"(op + 1024), "v"(w0) : "memory");
        asm volatile("global_store_short %0, %1, off" :: "v"(op + 2048), "v"(w1) : "memory");
        asm volatile("global_store_short_d16_hi %0, %1, off" :: "v"(op + 3072), "v"(w1) : "memory");
      }
      if (++slot == SC_NS) slot = 0;
    }
    asm volatile("s_waitcnt vmcnt(0)" ::: "memory");
    __syncthreads();
  }
}

DI void hg_combine_phase(const HgBufs& hb, const float* __restrict__ gnorm, int rows) {
  const int lane = otid() & 63, wid = otid() >> 6;
  const int h = lane >> 3, c16 = (lane & 7) * 16;
  const int stride = gridDim.x * 4;
  f32x4 gn[4];
#pragma unroll
  for (int i = 0; i < 4; ++i) gn[i] = *(const f32x4*)(gnorm + c16 + i * 4);
  for (int row = blockIdx.x * 4 + wid; row < rows; row += stride * 2) {
    u32x4 ra[2][2], rf[2][2], rb[2][2], rg[2][2];
#pragma unroll
    for (int j = 0; j < 2; ++j) {
      const int rj = row + j * stride;
      if (rj < rows) {
        const size_t g = (size_t)rj * 1024 + h * 128 + c16;
#pragma unroll
        for (int half = 0; half < 2; ++half) {
          ra[j][half] = *(const u32x4*)(hb.OI + g + half * 8); rf[j][half] = *(const u32x4*)(hb.OF + g + half * 8);
          rb[j][half] = *(const u32x4*)(hb.OB + g + half * 8); rg[j][half] = *(const u32x4*)(hb.G + g + half * 8);
        }
      }
    }
#pragma unroll
    for (int j = 0; j < 2; ++j) {
      const int rj = row + j * stride;
      if (rj < rows) {
        const size_t g = (size_t)rj * 1024 + h * 128 + c16;
        float o[16]; float ss = 0.f;
#pragma unroll
        for (int half = 0; half < 2; ++half)
#pragma unroll
          for (int e = 0; e < 8; ++e) { float v = bfget(ra[j][half], e) + bfget(rf[j][half], e) + bfget(rb[j][half], e); o[half * 8 + e] = v; ss += v * v; }
        ss += __shfl_xor(ss, 1); ss += __shfl_xor(ss, 2); ss += __shfl_xor(ss, 4);
        const float rstd = rsqrtf(ss * (1.f / 128.f) + EPS);
#pragma unroll
        for (int half = 0; half < 2; ++half) {
          u32x4 r;
#pragma unroll
          for (int e2 = 0; e2 < 4; ++e2) {
            const int e = half * 8 + 2 * e2;
            r[e2] = pack2(o[e] * rstd * gn[e >> 2][e & 3] * bfget(rg[j][half], 2 * e2), o[e + 1] * rstd * gn[(e + 1) >> 2][(e + 1) & 3] * bfget(rg[j][half], 2 * e2 + 1));
          }
          *(u32x4*)(hb.Y + g + half * 8) = r;
        }
      }
    }
  }
}

DI void na_attn_item(const u16* __restrict__ Q, const u16* __restrict__ K, const u16* __restrict__ VT, const float* __restrict__ rpb, u16* __restrict__ O, int item, int fr, int fq) {
  const int qt = item & 3, h = (item >> 2) & 15, r = (item >> 6) & 63, b = item >> 12;
  const int r0 = min(max(r - 4, 0), 56);
  const int cw0 = qt == 0 ? 0 : qt == 1 ? 8 : qt == 2 ? 24 : 32;
  const size_t tokq = (size_t)b * 4096 + r * 64 + qt * 16 + fr;
  bf16x8 qf[2];
#pragma unroll
  for (int ks = 0; ks < 2; ++ks) qf[ks] = *(const bf16x8*)(Q + tokq * 1024 + h * 64 + ks * 32 + fq * 8);
  f32x4 s[8][2];
#pragma unroll
  for (int kr = 0; kr < 8; ++kr)
#pragma unroll
    for (int hf = 0; hf < 2; ++hf) {
      const size_t tokk = (size_t)b * 4096 + (r0 + kr) * 64 + cw0 + hf * 16 + fr;
      const bf16x8 k0 = *(const bf16x8*)(K + tokk * 1024 + h * 64 + fq * 8);
      const bf16x8 k1 = *(const bf16x8*)(K + tokk * 1024 + h * 64 + 32 + fq * 8);
      f32x4 a = MFMA32(k0, qf[0], zero4());
      s[kr][hf] = MFMA32(k1, qf[1], a);
    }
  const int qc = qt * 16 + fr;
  const int cs = min(max(qc - 8, 0), 48);
  float mx = -1e30f;
#pragma unroll
  for (int kr = 0; kr < 8; ++kr) {
    const float* rp = rpb + (h * 15 + (r0 + kr - r + 7)) * 31;
#pragma unroll
    for (int hf = 0; hf < 2; ++hf)
#pragma unroll
      for (int j = 0; j < 4; ++j) {
        const int kc = cw0 + hf * 16 + fq * 4 + j;
        const bool valid = (kc >= cs) && (kc < cs + 16);
        const int ci = min(max(kc - qc + 15, 0), 30);
        const float v = valid ? s[kr][hf][j] + rp[ci] * LOG2E : -1e30f;
        s[kr][hf][j] = v; mx = fmaxf(mx, v);
      }
  }
  mx = fmaxf(mx, __shfl_xor(mx, 16)); mx = fmaxf(mx, __shfl_xor(mx, 32));
  float l = 0.f;
#pragma unroll
  for (int kr = 0; kr < 8; ++kr)
#pragma unroll
    for (int hf = 0; hf < 2; ++hf)
#pragma unroll
      for (int j = 0; j < 4; ++j) { const float pv = __builtin_amdgcn_exp2f(s[kr][hf][j] - mx); s[kr][hf][j] = pv; l += pv; }
  l += __shfl_xor(l, 16); l += __shfl_xor(l, 32);
  f32x4 o[4];
#pragma unroll
  for (int dt = 0; dt < 4; ++dt) o[dt] = zero4();
#pragma unroll
  for (int kr = 0; kr < 8; ++kr) {
    const bf16x8 pp = pack8(s[kr][0], s[kr][1]);
#pragma unroll
    for (int dt = 0; dt < 4; ++dt) {
      const u16* vp = VT + ((size_t)((b * 16 + h) * 64 + dt * 16 + fr)) * 4096 + (r0 + kr) * 64 + cw0 + fq * 4;
      const bf16x8 vf = cat4(*(const bf16x4*)vp, *(const bf16x4*)(vp + 16));
      o[dt] = MFMA32(vf, pp, o[dt]);
    }
  }
  const float inv = 1.f / l;
#pragma unroll
  for (int dt = 0; dt < 4; ++dt) *(u32x2*)(O + tokq * 1024 + h * 64 + dt * 16 + fq * 4) = pack4(o[dt] * inv);
}

DI void mla_norm_phase(const u16* __restrict__ CRAW, const float* __restrict__ gq, const float* __restrict__ gkv, u16* __restrict__ CQN, u16* __restrict__ CKVN, float* __restrict__ KROPE) {
  const int lane = otid() & 63, wid = otid() >> 6;
  for (int row = blockIdx.x * 4 + wid; row < MTOK; row += gridDim.x * 4) {
    const u16* c = CRAW + (size_t)row * 1056;
    f32x4 v[3]; float ss = 0.f;
#pragma unroll
    for (int i = 0; i < 3; ++i) {
      const u32x2 w = *(const u32x2*)(c + i * 256 + lane * 4);
      v[i][0] = bflo(w[0]); v[i][1] = bfhi(w[0]); v[i][2] = bflo(w[1]); v[i][3] = bfhi(w[1]);
      ss += v[i][0] * v[i][0] + v[i][1] * v[i][1] + v[i][2] * v[i][2] + v[i][3] * v[i][3];
    }
    ss = wave_sum(ss);
    const float rq = rsqrtf(ss * (1.f / 768.f) + EPS);
#pragma unroll
    for (int i = 0; i < 3; ++i) {
      const f32x4 g4 = *(const f32x4*)(gq + i * 256 + lane * 4);
      *(u32x2*)(CQN + (size_t)row * 768 + i * 256 + lane * 4) = pack4(v[i] * rq * g4);
    }
    {
      const u32x2 w = *(const u32x2*)(c + 768 + lane * 4);
      f32x4 k; k[0] = bflo(w[0]); k[1] = bfhi(w[0]); k[2] = bflo(w[1]); k[3] = bfhi(w[1]);
      float s2 = wave_sum(k[0] * k[0] + k[1] * k[1] + k[2] * k[2] + k[3] * k[3]);
      const float rk = rsqrtf(s2 * (1.f / 256.f) + EPS);
      const f32x4 g4 = *(const f32x4*)(gkv + lane * 4);
      *(u32x2*)(CKVN + (size_t)row * 256 + lane * 4) = pack4(k * rk * g4);
    }
    if (lane < 8) {
      const u32x2 w = *(const u32x2*)(c + 1024 + lane * 4);
      f32x4 k; k[0] = bflo(w[0]); k[1] = bfhi(w[0]); k[2] = bflo(w[1]); k[3] = bfhi(w[1]);
      *(f32x4*)(KROPE + (size_t)row * 32 + lane * 4) = k;
    }
  }
}

DI void mla_prep_phase(u16* __restrict__ Q, const u16* __restrict__ KVRAW, const float* __restrict__ KROPE, u16* __restrict__ Kout,
                       const float* __restrict__ gq, const float* __restrict__ gk, const float* __restrict__ RC, const float* __restrict__ RS) {
  const int lane = otid() & 63, wid = otid() >> 6;
  const int h = lane >> 2, sub = lane & 3;
  const float QS = 0.10206207261596577f * LOG2E;
  for (int m = blockIdx.x * 4 + wid; m < MTOK; m += gridDim.x * 4) {
    const int t = m & 4095;
    const f32x4 cs = *(const f32x4*)(RC + t * 16 + sub * 4), sn = *(const f32x4*)(RS + t * 16 + sub * 4);
#pragma unroll
    for (int which = 0; which < 2; ++which) {
      float nope[16]; f32x4 ra, rb;
      u16* dstp = (which == 0 ? Q : Kout) + (size_t)m * 1536 + h * 96;
      const float* gn = which == 0 ? gq : gk;
      if (which == 0) {
        const u32x4 w0 = *(const u32x4*)(dstp + sub * 16), w1 = *(const u32x4*)(dstp + sub * 16 + 8);
#pragma unroll
        for (int e = 0; e < 8; ++e) { nope[e] = bfget(w0, e); nope[8 + e] = bfget(w1, e); }
        const u32x2 a2 = *(const u32x2*)(dstp + 64 + sub * 4), b2 = *(const u32x2*)(dstp + 80 + sub * 4);
        ra[0] = bflo(a2[0]); ra[1] = bfhi(a2[0]); ra[2] = bflo(a2[1]); ra[3] = bfhi(a2[1]);
        rb[0] = bflo(b2[0]); rb[1] = bfhi(b2[0]); rb[2] = bflo(b2[1]); rb[3] = bfhi(b2[1]);
      } else {
        const u16* kp = KVRAW + (size_t)m * 2048 + h * 128 + sub * 16;
        const u32x4 w0 = *(const u32x4*)kp, w1 = *(const u32x4*)(kp + 8);
#pragma unroll
        for (int e = 0; e < 8; ++e) { nope[e] = bfget(w0, e); nope[8 + e] = bfget(w1, e); }
        ra = *(const f32x4*)(KROPE + (size_t)m * 32 + sub * 4);
        rb = *(const f32x4*)(KROPE + (size_t)m * 32 + 16 + sub * 4);
      }
      float ss = 0.f;
#pragma unroll
      for (int e = 0; e < 16; ++e) ss += nope[e] * nope[e];
#pragma unroll
      for (int e = 0; e < 4; ++e) ss += ra[e] * ra[e] + rb[e] * rb[e];
      ss += __shfl_xor(ss, 1); ss += __shfl_xor(ss, 2);
      const float rstd = rsqrtf(ss * (1.f / 96.f) + EPS) * (which == 0 ? QS : 1.f);
      u32x4 o0, o1;
#pragma unroll
      for (int e2 = 0; e2 < 4; ++e2) {
        o0[e2] = pack2(nope[2 * e2] * rstd * gn[sub * 16 + 2 * e2], nope[2 * e2 + 1] * rstd * gn[sub * 16 + 2 * e2 + 1]);
        o1[e2] = pack2(nope[8 + 2 * e2] * rstd * gn[sub * 16 + 8 + 2 * e2], nope[9 + 2 * e2] * rstd * gn[sub * 16 + 9 + 2 * e2]);
      }
      f32x4 oa, ob;
#pragma unroll
      for (int e = 0; e < 4; ++e) {
        const float a = ra[e] * rstd * gn[64 + sub * 4 + e], bq = rb[e] * rstd * gn[80 + sub * 4 + e];
        oa[e] = a * cs[e] - bq * sn[e];
        ob[e] = bq * cs[e] + a * sn[e];
      }
      *(u32x4*)(dstp + sub * 16) = o0; *(u32x4*)(dstp + sub * 16 + 8) = o1;
      *(u32x2*)(dstp + 64 + sub * 4) = pack4(oa); *(u32x2*)(dstp + 80 + sub * 4) = pack4(ob);
    }
  }
}

DI void mla_vt_phase(const u16* __restrict__ KVRAW, u16* __restrict__ VT, char* smem) {
  u16* tile = (u16*)smem;
  const int tid = otid();
  for (int item = blockIdx.x; item < 8192; item += gridDim.x) {
    const int tt = item & 63, bh = item >> 6, b = bh >> 4, h = bh & 15;
    {
      const int row = tid >> 2, part = tid & 3;
      const u16* src = KVRAW + ((size_t)b * 4096 + tt * 64 + row) * 2048 + h * 128 + 64 + part * 16;
      const u32x4 w0 = *(const u32x4*)src, w1 = *(const u32x4*)(src + 8);
      u32* d32 = (u32*)(tile + row * 66 + part * 16);
#pragma unroll
      for (int e = 0; e < 4; ++e) { d32[e] = w0[e]; d32[4 + e] = w1[e]; }
    }
    __syncthreads();
    {
      const int d = tid >> 2, tp = (tid & 3) * 16;
      u32x4 o0, o1;
#pragma unroll
      for (int e2 = 0; e2 < 4; ++e2) {
        o0[e2] = (u32)tile[(tp + 2 * e2) * 66 + d] | ((u32)tile[(tp + 2 * e2 + 1) * 66 + d] << 16);
        o1[e2] = (u32)tile[(tp + 8 + 2 * e2) * 66 + d] | ((u32)tile[(tp + 9 + 2 * e2) * 66 + d] << 16);
      }
      u16* dst = VT + ((size_t)(bh * 64 + d)) * 4096 + tt * 64 + tp;
      *(u32x4*)dst = o0; *(u32x4*)(dst + 8) = o1;
    }
    __syncthreads();
  }
}

constexpr int FA_KROW = 208, FA_VROW = 144, FA_KT = 64 * FA_KROW, FA_BUF = FA_KT + 64 * FA_VROW;
DI void mla_attn_item(const u16* __restrict__ Q, const u16* __restrict__ Kb, const u16* __restrict__ VT, u16* __restrict__ O, int item, char* smem) {
  const int qb = item & 31, bh = item >> 5, b = bh >> 4, h = bh & 15;
  const int tid = otid(), lane = tid & 63, wid = tid >> 6, fr = lane & 15, fq = lane >> 4;
  bf16x8 qf[2][3];
#pragma unroll
  for (int qt = 0; qt < 2; ++qt) {
    const size_t tq = (size_t)b * 4096 + qb * 128 + wid * 32 + qt * 16 + fr;
#pragma unroll
    for (int ks = 0; ks < 3; ++ks) qf[qt][ks] = *(const bf16x8*)(Q + tq * 1536 + h * 96 + ks * 32 + fq * 8);
  }
  f32x4 o[4][2];
#pragma unroll
  for (int i = 0; i < 4; ++i) { o[i][0] = zero4(); o[i][1] = zero4(); }
  float mrun[2] = {-1e30f, -1e30f}, lrun[2] = {0.f, 0.f};
  const u16* kg[3]; int ks_off[3];
#pragma unroll
  for (int i = 0; i < 3; ++i) {
    const int c = tid + 256 * i, row = c / 12, kc = c % 12;
    kg[i] = Kb + ((size_t)b * 4096 + row) * 1536 + h * 96 + kc * 8;
    ks_off[i] = row * FA_KROW + kc * 16;
  }
  const u16* vg[2]; int vs_off[2];
#pragma unroll
  for (int i = 0; i < 2; ++i) {
    const int c = tid + 256 * i, d = c >> 3, kc = c & 7;
    vg[i] = VT + ((size_t)(bh * 64 + d)) * 4096 + kc * 8;
    vs_off[i] = FA_KT + d * FA_VROW + kc * 16;
  }
  u32x4 rk[3], rv[2];
#pragma unroll
  for (int i = 0; i < 3; ++i) rk[i] = *(const u32x4*)(kg[i]);
#pragma unroll
  for (int i = 0; i < 2; ++i) rv[i] = *(const u32x4*)(vg[i]);
#pragma unroll
  for (int i = 0; i < 3; ++i) *(u32x4*)(smem + ks_off[i]) = rk[i];
#pragma unroll
  for (int i = 0; i < 2; ++i) *(u32x4*)(smem + vs_off[i]) = rv[i];
  __syncthreads();
  for (int kt = 0; kt < 64; ++kt) {
    const int cur = (kt & 1) * FA_BUF, nxt = FA_BUF - cur;
    if (kt + 1 < 64) {
      const size_t key0 = (size_t)(kt + 1) * 64;
#pragma unroll
      for (int i = 0; i < 3; ++i) rk[i] = *(const u32x4*)(kg[i] + key0 * 1536);
#pragma unroll
      for (int i = 0; i < 2; ++i) rv[i] = *(const u32x4*)(vg[i] + key0);
    }
    f32x4 s[4][2];
#pragma unroll
    for (int k4 = 0; k4 < 4; ++k4) {
      s[k4][0] = zero4(); s[k4][1] = zero4();
#pragma unroll
      for (int ks = 0; ks < 3; ++ks) {
        const bf16x8 kf = *(const bf16x8*)(smem + cur + (k4 * 16 + fr) * FA_KROW + ks * 64 + fq * 16);
        s[k4][0] = MFMA32(kf, qf[0][ks], s[k4][0]);
        s[k4][1] = MFMA32(kf, qf[1][ks], s[k4][1]);
      }
    }
    bf16x8 pp[2][2];
    {
      float lm[2];
#pragma unroll
      for (int qt = 0; qt < 2; ++qt) {
        float mx = fmaxf(fmaxf(s[0][qt][0], s[0][qt][1]), fmaxf(s[0][qt][2], s[0][qt][3]));
#pragma unroll
        for (int k4 = 1; k4 < 4; ++k4) mx = fmaxf(mx, fmaxf(fmaxf(s[k4][qt][0], s[k4][qt][1]), fmaxf(s[k4][qt][2], s[k4][qt][3])));
        lm[qt] = mx;
      }
      if (__any((lm[0] > mrun[0] + 8.f) || (lm[1] > mrun[1] + 8.f))) {
#pragma unroll
        for (int qt = 0; qt < 2; ++qt) {
          float mx = lm[qt];
          mx = fmaxf(mx, __shfl_xor(mx, 16)); mx = fmaxf(mx, __shfl_xor(mx, 32));
          const float mnew = fmaxf(mrun[qt], mx);
          const float alpha = __builtin_amdgcn_exp2f(mrun[qt] - mnew);
          mrun[qt] = mnew;
          lrun[qt] *= alpha;
#pragma unroll
          for (int dt = 0; dt < 4; ++dt) o[dt][qt] = o[dt][qt] * alpha;
        }
      }
#pragma unroll
      for (int qt = 0; qt < 2; ++qt) {
        const float mr = mrun[qt];
        float ps = 0.f;
#pragma unroll
        for (int k4 = 0; k4 < 4; ++k4)
#pragma unroll
          for (int j = 0; j < 4; ++j) { const float pv = __builtin_amdgcn_exp2f(s[k4][qt][j] - mr); s[k4][qt][j] = pv; ps += pv; }
        lrun[qt] += ps;
        pp[qt][0] = pack8(s[0][qt], s[1][qt]);
        pp[qt][1] = pack8(s[2][qt], s[3][qt]);
      }
    }
#pragma unroll
    for (int dt = 0; dt < 4; ++dt)
#pragma unroll
      for (int a = 0; a < 2; ++a) {
        const char* vp = smem + cur + FA_KT + (dt * 16 + fr) * FA_VROW + (a * 32 + fq * 4) * 2;
        const bf16x8 vf = cat4(*(const bf16x4*)vp, *(const bf16x4*)(vp + 32));
        o[dt][0] = MFMA32(vf, pp[0][a], o[dt][0]);
        o[dt][1] = MFMA32(vf, pp[1][a], o[dt][1]);
      }
    if (kt + 1 < 64) {
#pragma unroll
      for (int i = 0; i < 3; ++i) *(u32x4*)(smem + nxt + ks_off[i]) = rk[i];
#pragma unroll
      for (int i = 0; i < 2; ++i) *(u32x4*)(smem + nxt + vs_off[i]) = rv[i];
    }
    __syncthreads();
  }
#pragma unroll
  for (int qt = 0; qt < 2; ++qt) {
    float l = lrun[qt];
    l += __shfl_xor(l, 16); l += __shfl_xor(l, 32);
    const float inv = 1.f / l;
    const size_t tq = (size_t)b * 4096 + qb * 128 + wid * 32 + qt * 16 + fr;
#pragma unroll
    for (int dt = 0; dt < 4; ++dt) *(u32x2*)(O + tq * 1024 + h * 64 + dt * 16 + fq * 4) = pack4(o[dt][qt] * inv);
  }
}

#define XB_TMO      128
#define XB_XCNT(j)  (256  + 64 * (j))
#define XB_XSUB(j)  (1280 + 64 * (j))
#define XB_XGEN(j)  (2304 + 64 * (j))
#define XB_TOP      3328
#define XB_TOPGEN   3392
#define XCD_BAR_WORDS 3456
#define XB_SPIN_CAP (1u << 22)
DI unsigned xb_ld(unsigned* p) { return __hip_atomic_load(p, __ATOMIC_RELAXED, __HIP_MEMORY_SCOPE_AGENT); }
DI unsigned xb_add(unsigned* p, unsigned v) { return __hip_atomic_fetch_add(p, v, __ATOMIC_RELAXED, __HIP_MEMORY_SCOPE_AGENT); }
DI unsigned xb_xcc_id() { return (unsigned)__builtin_amdgcn_s_getreg((3 << 11) | 20) & 0xFu; }
#define XB_SPIN(cond, bar) do { unsigned _sp = 0; while (cond) { __builtin_amdgcn_s_sleep(1); \
    if ((++_sp & 255u) == 0u) { if (xb_ld(&(bar)[XB_TMO])) break; if (_sp > XB_SPIN_CAP) { atomicAdd(&(bar)[XB_TMO], 1u); break; } } } } while (0)

DI void xcd_barrier_complete(unsigned* bar, unsigned x, unsigned& nloc, unsigned& nx) {
  const unsigned G = gridDim.x;
  unsigned sum, cnt, mine, sp = 0u;
  for (;;) {
    sum = 0u; cnt = 0u; mine = 0u;
#pragma unroll
    for (unsigned j = 0; j < 16; ++j) { const unsigned c = xb_ld(&bar[XB_XCNT(j)]); sum += c; cnt += (c > 0u) ? 1u : 0u; mine = (j == x) ? c : mine; }
    if (sum == G) break;
    __builtin_amdgcn_s_sleep(1);
    if ((++sp & 255u) == 0u) { if (xb_ld(&bar[XB_TMO])) break; if (sp > XB_SPIN_CAP) { atomicAdd(&bar[XB_TMO], 1u); break; } }
  }
  nloc = mine > 0u ? mine : 1u; nx = cnt > 0u ? cnt : 1u;
}

DI void xcd_barrier(unsigned* bar, volatile unsigned* st) {
  asm volatile("s_waitcnt vmcnt(0)" ::: "memory");
  __syncthreads();
  if (threadIdx.x == 0) {
    __builtin_amdgcn_s_waitcnt(0);
    const unsigned x = xb_xcc_id();
    unsigned nloc = st[0], nx = st[1];
    if (nloc == 0u) { xcd_barrier_complete(bar, x, nloc, nx); st[0] = nloc; st[1] = nx; }
    const unsigned old = xb_add(&bar[XB_XSUB(x)], 1u);
    const unsigned gen = old / nloc;
    if (old + 1u == (gen + 1u) * nloc) {
      __builtin_amdgcn_fence(__ATOMIC_RELEASE, "agent");
      asm volatile("s_waitcnt vmcnt(0)" ::: "memory");
      const unsigned og = xb_add(&bar[XB_TOP], 1u);
      const unsigned tg = og / nx;
      if (og + 1u == (tg + 1u) * nx) xb_add(&bar[XB_TOPGEN], 1u);
      else XB_SPIN(xb_ld(&bar[XB_TOPGEN]) == tg, bar);
      __builtin_amdgcn_fence(__ATOMIC_ACQUIRE, "agent");
      xb_add(&bar[XB_XGEN(x)], 1u);
      asm volatile("s_waitcnt vmcnt(0)" ::: "memory");
    } else {
      XB_SPIN(xb_ld(&bar[XB_XGEN(x)]) == gen, bar);
      __builtin_amdgcn_fence(__ATOMIC_ACQUIRE, "agent");
      asm volatile("s_waitcnt vmcnt(0)" ::: "memory");
    }
  }
  __syncthreads();
}

#ifndef ENMASK
#define ENMASK 0xffffffffu
#endif
#define EN(i) ((ENMASK >> (i)) & 1u)
#ifndef DUPMASK
#define DUPMASK 0u
#endif
#define DUP(i) ((DUPMASK >> (i)) & 1u)
#ifndef BAR2
#define BAR2 0
#endif
#define PHASE_BEGIN(i) if (EN(i) && pc >= p.lo && pc < p.hi) for (int rep_ = 0; rep_ < 1 + (int)DUP(i); ++rep_) {
#define PHASE_END } { if (pc >= p.lo && pc + 1 < p.hi) { if (pc == p.lo) grid.sync(); else { xcd_barrier(bar, st); if (BAR2) xcd_barrier(bar, st); } } ++pc; }

__global__ void __launch_bounds__(256, 2) mega(Params p) {
  __shared__ __attribute__((aligned(16))) char smem[73728 + 16];
  cg::grid_group grid = cg::this_grid();
  int pc = 0;
  char* ws = p.ws;
  unsigned* bar = (unsigned*)(ws + OFF_BAR);
  volatile unsigned* st = (volatile unsigned*)(smem + 73728);
  if (threadIdx.x == 0) { st[0] = 0u; st[1] = 0u; (void)xb_add(&bar[XB_XCNT(xb_xcc_id())], 1u); }
  __syncthreads();
  u16* H = (u16*)(ws + OFF_H);
  char* R = ws + OFF_R;
  const float* LB = (const float*)(ws + OFF_TAB);
  const float* RC = LB + 4096; const float* RS = RC + 65536;
  for (int layer = 0; layer < 4; ++layer) {
    const int kind = layer % 3, mi = layer / 3;
    for (int stage = 0; stage < 3; ++stage) {
      if (stage != 1) {
        const float* ng = (stage == 0 ? p.ffn1_norm : p.ffn2_norm) + layer * 1024;
        const u16* wgu = (const u16*)(ws + (stage == 0 ? OFF_WGU1 : OFF_WGU2));
        const u16* wdn = (const u16*)(ws + (stage == 0 ? OFF_WDN1 : OFF_WDN2));
        u16* ACT = (u16*)R;
        PHASE_BEGIN(0)
          const bool first = (layer == 0 && stage == 0);
          if (stage == 0) { if (layer == 0) init_tables(p); cvt_layer(p, layer, smem); }
          norm_phase(first ? p.x : p.X, ng, H, first ? p.X : nullptr, MTOK);
        PHASE_END
        PHASE_BEGIN(1)
          gemm_phase(H, 1024, wgu, 1024, MTOK, 5632, EpiSwiglu{ACT}, smem);
        PHASE_END
        PHASE_BEGIN(2)
          gemm_phase(ACT, 2816, wdn, 2816, MTOK, 1024, EpiResid{p.X, 0.5f}, smem);
        PHASE_END
      } else {
        PHASE_BEGIN(3)
          norm_phase(p.X, p.mix_norm + layer * 1024, H, nullptr, MTOK);
        PHASE_END
        if (kind == 0) {
          constexpr size_t SZ = 32 * MiB;
          HgBufs hb;
          hb.Q = (u16*)(R + 0 * SZ); hb.LFf = (u16*)(R + 1 * SZ); hb.LFb = (u16*)(R + 2 * SZ); hb.V = (u16*)(R + 3 * SZ); hb.G = (u16*)(R + 4 * SZ);
          hb.QIf = (u16*)(R + 5 * SZ); hb.QIb = (u16*)(R + 6 * SZ); hb.KITf = (u16*)(R + 7 * SZ); hb.KITb = (u16*)(R + 8 * SZ);
          hb.VTc = (u16*)(R + 9 * SZ); hb.OI = (u16*)(R + 10 * SZ); hb.OF = hb.Q; hb.OB = hb.LFf; hb.Y = hb.LFb;
          hb.DECf = (float*)(R + 11 * SZ); hb.DECb = (float*)(R + 11 * SZ + 4 * MiB);
          const u16* w_in = (const u16*)(ws + OFF_WMIX); const u16* w_out = (const u16*)(ws + OFF_WMIX + 10485760);
          for (int half = 0; half < 2; ++half) {
            PHASE_BEGIN(4)
              gemm_phase(H + (size_t)half * 16384 * 1024, 1024, w_in, 1024, 16384, 5120, EpiHgIn{hb.Q, hb.LFf, hb.LFb, hb.V, hb.G, LB + layer * 1024}, smem);
            PHASE_END
            PHASE_BEGIN(5)
              hg_prep_phase(hb, smem);
            PHASE_END
            PHASE_BEGIN(6)
              hg_scan_phase(hb, smem);
            PHASE_END
            PHASE_BEGIN(7)
              hg_combine_phase(hb, p.hg_g_norm + mi * 128, 16384);
            PHASE_END
            PHASE_BEGIN(8)
              gemm_phase(hb.Y, 1024, w_out, 1024, 16384, 1024, EpiResid{p.X + (size_t)half * 16384 * 1024, 1.0f}, smem);
            PHASE_END
          }
        } else if (kind == 1) {
          u16* Qn = (u16*)R; u16* Kn = (u16*)(R + 64 * MiB); u16* VT = (u16*)(R + 128 * MiB); u16* On = (u16*)(R + 192 * MiB);
          const u16* w_in = (const u16*)(ws + OFF_WMIX); const u16* w_out = (const u16*)(ws + OFF_WMIX + 6291456);
          PHASE_BEGIN(9)
            gemm_phase(H, 1024, w_in, 1024, MTOK, 3072, EpiNaIn{Qn, Kn, VT, p.na_q_norm + mi * 64, p.na_k_norm + mi * 64}, smem);
          PHASE_END
          PHASE_BEGIN(10)
            const int tid_ = otid(), lane = tid_ & 63, wid = tid_ >> 6, fr = lane & 15, fq = lane >> 4;
            for (int item = blockIdx.x * 4 + wid; item < 32768; item += gridDim.x * 4)
              na_attn_item(Qn, Kn, VT, p.na_rpb + (size_t)mi * 16 * 15 * 31, On, item, fr, fq);
          PHASE_END
          PHASE_BEGIN(11)
            gemm_phase(On, 1024, w_out, 1024, MTOK, 1024, EpiResid{p.X, 1.0f}, smem);
          PHASE_END
        } else {
          u16* VT = H;
          u16* CRAW = (u16*)R; u16* On = (u16*)R;
          u16* CQN = (u16*)(R + 66 * MiB); u16* CKVN = (u16*)(R + 114 * MiB); u16* Kk = (u16*)(R + 66 * MiB);
          float* KROPE = (float*)(R + 162 * MiB);
          u16* Qq = (u16*)(R + 166 * MiB); u16* KVRAW = (u16*)(R + 262 * MiB);
          const u16* w_in = (const u16*)(ws + OFF_WMIX); const u16* w_uq = (const u16*)(ws + OFF_WMIX + 2359296);
          const u16* w_ukv = (const u16*)(ws + OFF_WMIX + 4718592); const u16* w_out = (const u16*)(ws + OFF_WMIX + 5767168);
          PHASE_BEGIN(12)
            gemm_phase(H, 1024, w_in, 1024, MTOK, 1152, EpiStore{CRAW, 1056, 1056}, smem);
          PHASE_END
          PHASE_BEGIN(13)
            mla_norm_phase(CRAW, p.mla_q_a_norm + mi * 768, p.mla_kv_a_norm + mi * 256, CQN, CKVN, KROPE);
          PHASE_END
          PHASE_BEGIN(14)
            gemm_phase(CQN, 768, w_uq, 768, MTOK, 1536, EpiStore{Qq, 1536, 1536}, smem);
            gemm_phase(CKVN, 256, w_ukv, 256, MTOK, 2048, EpiStore{KVRAW, 2048, 2048}, smem);
          PHASE_END
          PHASE_BEGIN(15)
            mla_prep_phase(Qq, KVRAW, KROPE, Kk, p.mla_q_norm + mi * 96, p.mla_k_norm + mi * 96, RC, RS);
            mla_vt_phase(KVRAW, VT, smem);
          PHASE_END
          PHASE_BEGIN(16)
            for (int item = blockIdx.x; item < 4096; item += gridDim.x) mla_attn_item(Qq, Kk, VT, On, item, smem);
          PHASE_END
          PHASE_BEGIN(17)
            gemm_phase(On, 1024, w_out, 1024, MTOK, 1024, EpiResid{p.X, 1.0f}, smem);
          PHASE_END
        }
      }
    }
  }
}

static int count_phases() {
  int n = 0;
  for (int layer = 0; layer < 4; ++layer) {
    int kind = layer % 3;
    n += 3 + 3 + 1;
    n += kind == 0 ? 10 : kind == 1 ? 3 : 6;
  }
  return n;
}

extern "C" void kernel_launch(void* const* d_in, const int* in_sizes, int n_in, void* d_out, int out_size, void* d_ws, size_t ws_size, hipStream_t stream) {
  if (ws_size < WS_NEED) { fprintf(stderr, "workspace too small: %zu < %zu\n", ws_size, WS_NEED); return; }
  static int grid_blocks = 0;
  if (!grid_blocks) {
    int dev = 0, cus = 0, per_cu = 0;
    hipGetDevice(&dev);
    hipDeviceGetAttribute(&cus, hipDeviceAttributeMultiprocessorCount, dev);
    hipOccupancyMaxActiveBlocksPerMultiprocessor(&per_cu, mega, 256, 0);
    if (per_cu > 2) per_cu = 2;
    grid_blocks = cus * per_cu;
  }
  Params p{};
  const float** pf = (const float**)&p;
  for (int i = 0; i < 25; ++i) pf[i] = (const float*)d_in[i];
  p.X = (float*)d_out; p.ws = (char*)d_ws;
  const int total = count_phases();
#if MULTI_LAUNCH
  for (int ph = 0; ph < total; ++ph) {
    p.lo = ph; p.hi = ph + 1;
    hipLaunchKernelGGL(mega, dim3(grid_blocks), dim3(256), 0, stream, p);
  }
#else
  hipMemsetAsync((char*)d_ws + OFF_BAR, 0, 16384, stream);
  p.lo = 0; p.hi = total;
  void* args[] = {&p};
  hipError_t e = hipLaunchCooperativeKernel((void*)mega, dim3(grid_blocks), dim3(256), args, 0, stream);
  if (e != hipSuccess) fprintf(stderr, "cooperative launch failed: %s (grid %d)\n", hipGetErrorString(e), grid_blocks);
#endif
}
```

```cpp
#include <hip/hip_runtime.h>
#include <hip/hip_cooperative_groups.h>
#include <cstdio>
#include <cstdint>
namespace cg = cooperative_groups;

#ifndef MULTI_LAUNCH
#define MULTI_LAUNCH 0
#endif

typedef unsigned short u16;
typedef unsigned int u32;
using bf16x8 = __attribute__((ext_vector_type(8))) short;
using bf16x4 = __attribute__((ext_vector_type(4))) short;
using f32x4 = __attribute__((ext_vector_type(4))) float;
using u32x2 = __attribute__((ext_vector_type(2))) unsigned int;
using u32x4 = __attribute__((ext_vector_type(4))) unsigned int;

#define DI __device__ __forceinline__
#define MFMA32(a, b, c) __builtin_amdgcn_mfma_f32_16x16x32_bf16((a), (b), (c), 0, 0, 0)

constexpr int MTOK = 32768;
constexpr float EPS = 1e-6f;
constexpr float LOG2E = 1.4426950408889634f;

constexpr size_t MiB = 1048576;
constexpr size_t OFF_WGU1 = 0;
constexpr size_t OFF_WDN1 = 11534336;
constexpr size_t OFF_WGU2 = 17301504;
constexpr size_t OFF_WDN2 = 28835840;
constexpr size_t OFF_WMIX = 34603008;
constexpr size_t OFF_TAB = 47185920;
constexpr size_t OFF_BAR = OFF_TAB + 786432;
constexpr size_t OFF_H = 46 * MiB;
constexpr size_t OFF_R = 110 * MiB;
constexpr size_t WS_NEED = 500 * MiB;

struct Params {
  const float* x; const float* ffn1_norm; const float* ffn1_w_gu; const float* ffn1_w_down;
  const float* mix_norm; const float* ffn2_norm; const float* ffn2_w_gu; const float* ffn2_w_down;
  const float* hg_lb_logits; const float* hg_w_in; const float* hg_g_norm; const float* hg_w_out;
  const float* na_w_in; const float* na_q_norm; const float* na_k_norm; const float* na_rpb; const float* na_w_out;
  const float* mla_w_in; const float* mla_q_a_norm; const float* mla_w_uq; const float* mla_kv_a_norm; const float* mla_w_ukv;
  const float* mla_q_norm; const float* mla_k_norm; const float* mla_w_out;
  float* X; char* ws; int lo; int hi;
};

DI u32 f2bf(float x) { u32 u = __float_as_uint(x); u += 0x7fffu + ((u >> 16) & 1u); return u >> 16; }
typedef __bf16 bf16v2 __attribute__((ext_vector_type(2)));
typedef float f32v2 __attribute__((ext_vector_type(2)));
DI u32 pack2(float a, float b) { f32v2 v = {a, b}; bf16v2 r = __builtin_convertvector(v, bf16v2); return __builtin_bit_cast(u32, r); }
DI float bflo(u32 w) { return __uint_as_float(w << 16); }
DI float bfhi(u32 w) { return __uint_as_float(w & 0xffff0000u); }
DI float bfget(const u32x4& v, int e) { u32 w = v[e >> 1]; return (e & 1) ? bfhi(w) : bflo(w); }
DI u32x2 pack4(const f32x4& v) { u32x2 r; r[0] = pack2(v[0], v[1]); r[1] = pack2(v[2], v[3]); return r; }
DI bf16x8 pack8(const f32x4& a, const f32x4& b) {
  u32x4 r; r[0] = pack2(a[0], a[1]); r[1] = pack2(a[2], a[3]); r[2] = pack2(b[0], b[1]); r[3] = pack2(b[2], b[3]);
  return __builtin_bit_cast(bf16x8, r);
}
DI bf16x8 cat4(const bf16x4& lo, const bf16x4& hi) { return __builtin_shufflevector(lo, hi, 0, 1, 2, 3, 4, 5, 6, 7); }
DI float wave_sum(float v) {
#pragma unroll
  for (int o = 32; o > 0; o >>= 1) v += __shfl_xor(v, o);
  return v;
}
DI float sigmoidf_(float z) { return 1.f / (1.f + __expf(-z)); }
DI float siluf_(float z) { return z / (1.f + __expf(-z)); }
DI int otid() { int t = threadIdx.x; asm volatile("" : "+v"(t)); return t; }
DI f32x4 zero4() { f32x4 z = {0.f, 0.f, 0.f, 0.f}; return z; }

DI void init_tables(const Params& p) {
  float* LB = (float*)(p.ws + OFF_TAB); float* RC = LB + 4096; float* RS = RC + 65536;
  const int gt = blockIdx.x * 256 + otid(), gs = gridDim.x * 256;
  for (int c = gt; c < 1024; c += gs) {
    float l0 = p.hg_lb_logits[c], l1 = p.hg_lb_logits[1024 + c], l2 = p.hg_lb_logits[2048 + c], l3 = p.hg_lb_logits[3072 + c];
    float mx = fmaxf(fmaxf(l0, l1), fmaxf(l2, l3));
    float e0 = expf(l0 - mx), e1 = expf(l1 - mx), e2 = expf(l2 - mx), e3 = expf(l3 - mx);
    float inv = 1.f / (e0 + e1 + e2 + e3);
    LB[c] = 0.f; LB[1024 + c] = e1 * inv; LB[2048 + c] = (e1 + e2) * inv; LB[3072 + c] = (e1 + e2 + e3) * inv;
  }
  for (int i = gt; i < 65536; i += gs) {
    int t = i >> 4, j = i & 15;
    float inv = exp2f(-(float)j * (13.287712379549449f / 16.f));
    float ang = (float)t * inv;
    double a = (double)ang;
    double k = rint(a * 0.15915494309189535);
    float r = (float)(a - k * 6.283185307179586);
    RC[i] = __cosf(r); RS[i] = __sinf(r);
  }
}

DI void cvt_tiles(const float* __restrict__ src, u16* __restrict__ dst, int K, int N, int Nd, int mode, char* smem) {
  float* tile = (float*)smem;
  const int tk = K >> 6, tn = Nd >> 6, tid = otid();
  for (int t = blockIdx.x; t < tk * tn; t += gridDim.x) {
    const int k0 = (t % tk) << 6, n0 = (t / tk) << 6;
    {
      const int nl = tid & 63, kq = tid >> 6;
      const int nd = n0 + nl;
      int col = nd;
      if (mode == 1) { int a = nd >> 5, r = nd & 31; col = a * 16 + (r & 15) + ((r >= 16) ? 2816 : 0); }
      const bool ok = col < N;
#pragma unroll
      for (int i = 0; i < 16; ++i) {
        int kl = kq + 4 * i;
        tile[kl * 65 + nl] = ok ? src[(size_t)(k0 + kl) * N + col] : 0.f;
      }
    }
    __syncthreads();
    {
      const int kp = (tid & 31) * 2, nq = tid >> 5;
#pragma unroll
      for (int i = 0; i < 8; ++i) {
        int n = nq + 8 * i;
        *(u32*)(dst + (size_t)(n0 + n) * K + k0 + kp) = pack2(tile[kp * 65 + n], tile[(kp + 1) * 65 + n]);
      }
    }
    __syncthreads();
  }
}

DI void cvt_layer(const Params& p, int layer, char* smem) {
  const int kind = layer % 3, mi = layer / 3;
  char* ws = p.ws;
  for (int task = 0; task < 8; ++task) {
    const float* src = nullptr; size_t off = 0; int K = 0, N = 0, Nd = 0, mode = 0;
    if (task == 0) { src = p.ffn1_w_gu + (size_t)layer * 1024 * 5632; off = OFF_WGU1; K = 1024; N = 5632; Nd = 5632; mode = 1; }
    else if (task == 1) { src = p.ffn1_w_down + (size_t)layer * 2816 * 1024; off = OFF_WDN1; K = 2816; N = 1024; Nd = 1024; }
    else if (task == 2) { src = p.ffn2_w_gu + (size_t)layer * 1024 * 5632; off = OFF_WGU2; K = 1024; N = 5632; Nd = 5632; mode = 1; }
    else if (task == 3) { src = p.ffn2_w_down + (size_t)layer * 2816 * 1024; off = OFF_WDN2; K = 2816; N = 1024; Nd = 1024; }
    else if (kind == 0) {
      if (task == 4) { src = p.hg_w_in + (size_t)mi * 1024 * 5120; off = OFF_WMIX; K = 1024; N = 5120; Nd = 5120; }
      else if (task == 5) { src = p.hg_w_out + (size_t)mi * 1024 * 1024; off = OFF_WMIX + 10485760; K = 1024; N = 1024; Nd = 1024; }
    } else if (kind == 1) {
      if (task == 4) { src = p.na_w_in + (size_t)mi * 1024 * 3072; off = OFF_WMIX; K = 1024; N = 3072; Nd = 3072; }
      else if (task == 5) { src = p.na_w_out + (size_t)mi * 1024 * 1024; off = OFF_WMIX + 6291456; K = 1024; N = 1024; Nd = 1024; }
    } else {
      if (task == 4) { src = p.mla_w_in + (size_t)mi * 1024 * 1056; off = OFF_WMIX; K = 1024; N = 1056; Nd = 1152; }
      else if (task == 5) { src = p.mla_w_uq + (size_t)mi * 768 * 1536; off = OFF_WMIX + 2359296; K = 768; N = 1536; Nd = 1536; }
      else if (task == 6) { src = p.mla_w_ukv + (size_t)mi * 256 * 2048; off = OFF_WMIX + 4718592; K = 256; N = 2048; Nd = 2048; }
      else if (task == 7) { src = p.mla_w_out + (size_t)mi * 1024 * 1024; off = OFF_WMIX + 5767168; K = 1024; N = 1024; Nd = 1024; }
    }
    if (src) cvt_tiles(src, (u16*)(ws + off), K, N, Nd, mode, smem);
  }
}

DI void norm_phase(const float* __restrict__ src, const float* __restrict__ gain, u16* __restrict__ dst, float* copy_dst, int rows) {
  const int lane = otid() & 63, wid = otid() >> 6;
  f32x4 g[4];
#pragma unroll
  for (int i = 0; i < 4; ++i) g[i] = *(const f32x4*)(gain + i * 256 + lane * 4);
  const int stride = gridDim.x * 4;
  for (int row = blockIdx.x * 4 + wid; row < rows; row += stride * 4) {
    f32x4 v[4][4];
#pragma unroll
    for (int j = 0; j < 4; ++j) {
      const int rj = row + j * stride;
      if (rj < rows) {
#pragma unroll
        for (int i = 0; i < 4; ++i) v[j][i] = *(const f32x4*)(src + (size_t)rj * 1024 + i * 256 + lane * 4);
      }
    }
#pragma unroll
    for (int j = 0; j < 4; ++j) {
      const int rj = row + j * stride;
      if (rj < rows) {
        float ss = 0.f;
#pragma unroll
        for (int i = 0; i < 4; ++i) ss += v[j][i][0] * v[j][i][0] + v[j][i][1] * v[j][i][1] + v[j][i][2] * v[j][i][2] + v[j][i][3] * v[j][i][3];
        ss = wave_sum(ss);
        const float rstd = rsqrtf(ss * (1.f / 1024.f) + EPS);
#pragma unroll
        for (int i = 0; i < 4; ++i) {
          f32x4 y = v[j][i] * rstd * g[i];
          *(u32x2*)(dst + (size_t)rj * 1024 + i * 256 + lane * 4) = pack4(y);
          if (copy_dst) *(f32x4*)(copy_dst + (size_t)rj * 1024 + i * 256 + lane * 4) = v[j][i];
        }
      }
    }
  }
}

#define GLDS16(gp, lp) __builtin_amdgcn_global_load_lds((const unsigned*)(gp), (unsigned*)(lp), 16, 0, 0)

constexpr int G_STAGE = 24576, G_WOFF = 16384, G_NS = 3, G_MT = 8;

template <class Epi>
DI void gemm_phase(const u16* __restrict__ A, int lda, const u16* __restrict__ W, int K, int Mrows, int Ncols, const Epi& epi, char* smem) {
  const int mtn = Mrows >> 8, ntn = Ncols >> 7;
  const int ntiles = mtn * ntn, nk = K >> 5;
  constexpr int GM = 16;
  const int bid = blockIdx.x, gsz = gridDim.x;
  const int my_tiles = bid < ntiles ? (ntiles - bid + gsz - 1) / gsz : 0;
  const int total = my_tiles * nk;
  if (total > 0) {
    const int tid = otid(), lane = tid & 63, wid = tid >> 6;
    const int wm = wid >> 1, wn = wid & 1, fr = lane & 15, fq = lane >> 4;
    f32x4 acc[4][G_MT];
#pragma unroll
    for (int i = 0; i < 4; ++i)
#pragma unroll
      for (int j = 0; j < G_MT; ++j) acc[i][j] = zero4();
    const int lrow = tid >> 2, lc = (tid & 3) ^ ((tid >> 4) & 3);
    char* sdst = smem + tid * 16;
    const int ro = (fq ^ (fr >> 2)) * 16;
    const char* sa_rd = smem + (wm * 128 + fr) * 64 + ro;
    const char* sw_rd = smem + G_WOFF + (wn * 64 + fr) * 64 + ro;
    int ij = 0, ik = 0;
    const u16 *ga, *gw;
    {
      const int tile = bid, group = tile / (GM * ntn), rem = tile % (GM * ntn);
      const int mt = group * GM + (rem % GM), nt = rem / GM;
      ga = A + ((size_t)mt * 256 + lrow) * lda + lc * 8; gw = W + ((size_t)nt * 128 + lrow) * K + lc * 8;
    }
    __builtin_amdgcn_s_barrier();
    asm volatile("" ::: "memory");
#define G_ISSUE(SLOT) do { \
      const int k0_ = ik << 5; char* sd_ = sdst + (SLOT) * G_STAGE; \
      _Pragma("unroll") for (int i = 0; i < 4; ++i) GLDS16(ga + (size_t)(64 * i) * lda + k0_, sd_ + i * 4096); \
      _Pragma("unroll") for (int i = 0; i < 2; ++i) GLDS16(gw + (size_t)(64 * i) * K + k0_, sd_ + G_WOFF + i * 4096); \
      if (++ik == nk) { ik = 0; ++ij; if (ij < my_tiles) { \
        const int tile = bid + ij * gsz, group = tile / (GM * ntn), rem = tile % (GM * ntn); \
        const int mt = group * GM + (rem % GM), nt = rem / GM; \
        ga = A + ((size_t)mt * 256 + lrow) * lda + lc * 8; gw = W + ((size_t)nt * 128 + lrow) * K + lc * 8; } } } while (0)
    G_ISSUE(0);
    if (total > 1) G_ISSUE(1);
    int slot = 0, ck = 0, cj = 0;
    for (int step = 0; step < total; ++step) {
      if (step + 1 < total) asm volatile("s_waitcnt vmcnt(6)" ::: "memory");
      else asm volatile("s_waitcnt vmcnt(0)" ::: "memory");
      __builtin_amdgcn_s_barrier();
      asm volatile("" ::: "memory");
      if (step + 2 < total) {
        int is = slot + 2; if (is >= G_NS) is -= G_NS;
        G_ISSUE(is);
      }
      const int cur = slot * G_STAGE;
      bf16x8 af[G_MT], wf[4];
#pragma unroll
      for (int i = 0; i < 4; ++i) wf[i] = *(const bf16x8*)(sw_rd + cur + i * 1024);
#pragma unroll
      for (int i = 0; i < 4; ++i) af[i] = *(const bf16x8*)(sa_rd + cur + i * 1024);
      __builtin_amdgcn_sched_barrier(0);
      acc[0][0] = MFMA32(wf[0], af[0], acc[0][0]);
      __builtin_amdgcn_sched_barrier(0);
#pragma unroll
      for (int i = 4; i < G_MT; ++i) af[i] = *(const bf16x8*)(sa_rd + cur + i * 1024);
      __builtin_amdgcn_sched_barrier(0);
#pragma unroll
      for (int mt = 0; mt < 4; ++mt)
#pragma unroll
        for (int nt = 0; nt < 4; ++nt) if (mt + nt > 0) acc[nt][mt] = MFMA32(wf[nt], af[mt], acc[nt][mt]);
      __builtin_amdgcn_sched_barrier(0);
#pragma unroll
      for (int mt = 4; mt < G_MT; ++mt)
#pragma unroll
        for (int nt = 0; nt < 4; ++nt) acc[nt][mt] = MFMA32(wf[nt], af[mt], acc[nt][mt]);
      if (++slot == G_NS) slot = 0;
      if (++ck == nk) {
        const int tile = bid + cj * gsz, group = tile / (GM * ntn), rem = tile % (GM * ntn);
        const int mt = group * GM + (rem % GM), nt = rem / GM;
        epi(acc, mt * 256 + wm * 128, nt * 128 + wn * 64, fr, fq);
#pragma unroll
        for (int i = 0; i < 4; ++i)
#pragma unroll
          for (int j = 0; j < G_MT; ++j) acc[i][j] = zero4();
        ck = 0; ++cj;
      }
    }
#undef G_ISSUE
  }
  __syncthreads();
}

struct EpiSwiglu {
  u16* act;
  DI void operator()(f32x4 (&acc)[4][G_MT], int mb, int nb, int fr, int fq) const {
#pragma unroll
    for (int mt = 0; mt < G_MT; ++mt) {
      const int m = mb + mt * 16 + fr;
#pragma unroll
      for (int np = 0; np < 2; ++np) {
        const f32x4 g = acc[2 * np][mt], u = acc[2 * np + 1][mt];
        f32x4 r;
#pragma unroll
        for (int j = 0; j < 4; ++j) r[j] = siluf_(g[j]) * u[j];
        const int jc = (nb >> 1) + np * 16 + fq * 4;
        *(u32x2*)(act + (size_t)m * 2816 + jc) = pack4(r);
      }
    }
  }
};

struct EpiResid {
  float* X; float scale;
  DI void operator()(f32x4 (&acc)[4][G_MT], int mb, int nb, int fr, int fq) const {
#pragma unroll
    for (int mt = 0; mt < G_MT; ++mt) {
      const int m = mb + mt * 16 + fr;
#pragma unroll
      for (int nt = 0; nt < 4; ++nt) {
        f32x4* ptr = (f32x4*)(X + (size_t)m * 1024 + nb + nt * 16 + fq * 4);
        f32x4 v = *ptr;
        v += acc[nt][mt] * scale;
        *ptr = v;
      }
    }
  }
};

struct EpiStore {
  u16* out; int ldo; int nmax;
  DI void operator()(f32x4 (&acc)[4][G_MT], int mb, int nb, int fr, int fq) const {
#pragma unroll
    for (int mt = 0; mt < G_MT; ++mt) {
      const int m = mb + mt * 16 + fr;
#pragma unroll
      for (int nt = 0; nt < 4; ++nt) {
        const int n = nb + nt * 16 + fq * 4;
        if (n < nmax) *(u32x2*)(out + (size_t)m * ldo + n) = pack4(acc[nt][mt]);
      }
    }
  }
};

struct EpiHgIn {
  u16 *Q, *LFf, *LFb, *V, *G; const float* lb;
  DI void operator()(f32x4 (&acc)[4][G_MT], int mb, int nb, int fr, int fq) const {
    const int seg = nb >> 10, c0 = nb & 1023;
    u16* dst = seg == 0 ? Q : seg == 1 ? LFf : seg == 2 ? LFb : seg == 3 ? V : G;
#pragma unroll
    for (int mt = 0; mt < G_MT; ++mt) {
      const int m = mb + mt * 16 + fr;
#pragma unroll
      for (int nt = 0; nt < 4; ++nt) {
        const int c = c0 + nt * 16 + fq * 4;
        f32x4 a = acc[nt][mt], r;
        if (seg == 0) r = a * 0.08838834764831845f;
        else if (seg == 3) r = a;
        else if (seg == 4) {
#pragma unroll
          for (int j = 0; j < 4; ++j) r[j] = siluf_(a[j]);
        } else {
          const f32x4 l4 = *(const f32x4*)(lb + c);
#pragma unroll
          for (int j = 0; j < 4; ++j) {
            float z = fminf(fmaxf(a[j], -30.f), 30.f);
            float f = l4[j] + (1.f - l4[j]) * sigmoidf_(z);
            r[j] = __logf(f);
          }
        }
        *(u32x2*)(dst + (size_t)m * 1024 + c) = pack4(r);
      }
    }
  }
};

struct EpiNaIn {
  u16 *Q, *K, *VT; const float *qn, *kn;
  DI void operator()(f32x4 (&acc)[4][G_MT], int mb, int nb, int fr, int fq) const {
    const int seg = nb >> 10, h = (nb & 1023) >> 6;
    if (seg < 2) {
      u16* dst = seg == 0 ? Q : K;
      const float* gn = seg == 0 ? qn : kn;
      const float sc = seg == 0 ? 0.125f * LOG2E : 1.f;
#pragma unroll
      for (int mt = 0; mt < G_MT; ++mt) {
        const int m = mb + mt * 16 + fr;
        float ss = 0.f;
#pragma unroll
        for (int nt = 0; nt < 4; ++nt)
#pragma unroll
          for (int j = 0; j < 4; ++j) ss += acc[nt][mt][j] * acc[nt][mt][j];
        ss += __shfl_xor(ss, 16); ss += __shfl_xor(ss, 32);
        const float rstd = rsqrtf(ss * (1.f / 64.f) + EPS) * sc;
#pragma unroll
        for (int nt = 0; nt < 4; ++nt) {
          const int d = nt * 16 + fq * 4;
          const f32x4 g4 = *(const f32x4*)(gn + d);
          f32x4 r = acc[nt][mt] * rstd * g4;
          *(u32x2*)(dst + (size_t)m * 1024 + h * 64 + d) = pack4(r);
        }
      }
    } else {
#pragma unroll
      for (int mt = 0; mt < G_MT; ++mt) {
        const int m = mb + mt * 16 + fr;
        const int b = m >> 12, t = m & 4095;
#pragma unroll
        for (int nt = 0; nt < 4; ++nt)
#pragma unroll
          for (int j = 0; j < 4; ++j) {
            const int d = nt * 16 + fq * 4 + j;
            VT[((size_t)((b * 16 + h) * 64 + d)) * 4096 + t] = (u16)f2bf(acc[nt][mt][j]);
          }
      }
    }
  }
};

struct HgBufs {
  u16 *Q, *LFf, *LFb, *V, *G, *QIf, *QIb, *KITf, *KITb, *VTc, *OI, *OF, *OB, *Y;
  float *DECf, *DECb;
};

DI void hg_prep_phase(const HgBufs& hb, char* smem) {
  u32x4 rq, rf, rb, rv;
  {
    const int item0 = blockIdx.x, tid0 = otid();
    if (item0 < 8192) {
      const size_t g0 = ((size_t)(item0 >> 11) * 4096 + ((item0 >> 3) & 255) * 16 + (tid0 >> 4)) * 1024 + (item0 & 7) * 128 + (tid0 & 15) * 8;
      rq = *(const u32x4*)(hb.Q + g0); rf = *(const u32x4*)(hb.LFf + g0); rb = *(const u32x4*)(hb.LFb + g0); rv = *(const u32x4*)(hb.V + g0);
    }
  }
  for (int item = blockIdx.x; item < 8192; item += gridDim.x) {
  const int h = item & 7, n = (item >> 3) & 255, b = item >> 11;
  float* sq = (float*)smem; float* sbf = sq + 2112; float* sbb = sbf + 2112; float* skf = sbb + 2112;
  float* skb = skf + 2112; float* sv = skb + 2112; float* sA = sv + 2112;
  const int tid = otid();
  const int row = tid >> 4, c8 = (tid & 15) * 8;
  const size_t tok0 = (size_t)b * 4096 + n * 16;
  const size_t gidx = (tok0 + row) * 1024 + h * 128 + c8;
  {
#pragma unroll
    for (int e = 0; e < 8; ++e) {
      const int o = row * 132 + c8 + e;
      const float lf = bfget(rf, e), lb_ = bfget(rb, e);
      sq[o] = bfget(rq, e); sbf[o] = lf; sbb[o] = lb_;
      skf[o] = 1.f - __expf(lf); skb[o] = 1.f - __expf(lb_); sv[o] = bfget(rv, e);
    }
  }
  {
    const int nx = item + gridDim.x;
    if (nx < 8192) {
      const size_t g1 = ((size_t)(nx >> 11) * 4096 + ((nx >> 3) & 255) * 16 + row) * 1024 + (nx & 7) * 128 + c8;
      rq = *(const u32x4*)(hb.Q + g1); rf = *(const u32x4*)(hb.LFf + g1); rb = *(const u32x4*)(hb.LFb + g1); rv = *(const u32x4*)(hb.V + g1);
    }
  }
  __syncthreads();
  if (tid < 128) {
    const int d = tid; float a = 0.f;
#pragma unroll
    for (int t = 0; t < 16; ++t) { a += sbf[t * 132 + d]; sbf[t * 132 + d] = a; }
    hb.DECf[((size_t)b * 256 + n) * 1024 + h * 128 + d] = __expf(a);
  } else {
    const int d = tid - 128; float a = 0.f;
#pragma unroll
    for (int t = 15; t >= 0; --t) { a += sbb[t * 132 + d]; sbb[t * 132 + d] = a; }
    hb.DECb[((size_t)b * 256 + n) * 1024 + h * 128 + d] = __expf(a);
  }
  __syncthreads();
  {
    u32x4 of, ob;
#pragma unroll
    for (int e2 = 0; e2 < 4; ++e2) {
      const int o = row * 132 + c8 + 2 * e2;
      const float q0 = sq[o], q1 = sq[o + 1];
      of[e2] = pack2(q0 * __expf(sbf[o]), q1 * __expf(sbf[o + 1]));
      ob[e2] = pack2(q0 * __expf(sbb[o]), q1 * __expf(sbb[o + 1]));
    }
    *(u32x4*)(hb.QIf + gidx) = of; *(u32x4*)(hb.QIb + gidx) = ob;
  }
  {
    const int d = tid >> 1, t8 = (tid & 1) * 8;
    const float blf = sbf[15 * 132 + d], blb = sbb[d];
    u32x4 kf, kb, vv;
#pragma unroll
    for (int e2 = 0; e2 < 4; ++e2) {
      const int o0 = (t8 + 2 * e2) * 132 + d, o1 = o0 + 132;
      kf[e2] = pack2(skf[o0] * __expf(blf - sbf[o0]), skf[o1] * __expf(blf - sbf[o1]));
      kb[e2] = pack2(skb[o0] * __expf(blb - sbb[o0]), skb[o1] * __expf(blb - sbb[o1]));
      vv[e2] = pack2(sv[o0], sv[o1]);
    }
    const size_t cidx = (((size_t)(b * 8 + h) * 256 + n) * 128 + d) * 16 + t8;
    *(u32x4*)(hb.KITf + cidx) = kf; *(u32x4*)(hb.KITb + cidx) = kb; *(u32x4*)(hb.VTc + cidx) = vv;
  }
  {
    const int s = tid >> 4, dg = tid & 15, d0 = dg * 8, sw0 = (tid >> 6) * 4;
    float w[8];
    {
      const f32x4 a = *(const f32x4*)(skf + s * 132 + d0), b2 = *(const f32x4*)(skf + s * 132 + d0 + 4);
#pragma unroll
      for (int e = 0; e < 4; ++e) { w[e] = a[e]; w[4 + e] = b2[e]; }
    }
    float pdiag = 0.f;
    for (int t = sw0; t < 16; ++t) {
      if (t > s) {
        const f32x4 a = *(const f32x4*)(skf + t * 132 + d0), b2 = *(const f32x4*)(skf + t * 132 + d0 + 4);
#pragma unroll
        for (int e = 0; e < 4; ++e) { w[e] *= (1.f - a[e]); w[4 + e] *= (1.f - b2[e]); }
      }
      const f32x4 q0 = *(const f32x4*)(sq + t * 132 + d0), q1 = *(const f32x4*)(sq + t * 132 + d0 + 4);
      float part = 0.f;
#pragma unroll
      for (int e = 0; e < 4; ++e) part += q0[e] * w[e] + q1[e] * w[4 + e];
      part += __shfl_xor(part, 1); part += __shfl_xor(part, 2); part += __shfl_xor(part, 4); part += __shfl_xor(part, 8);
      if (t == s) pdiag = part;
      else if (t > s && dg == 0) sA[t * 17 + s] = part;
    }
    {
      const f32x4 a = *(const f32x4*)(skb + s * 132 + d0), b2 = *(const f32x4*)(skb + s * 132 + d0 + 4);
#pragma unroll
      for (int e = 0; e < 4; ++e) { w[e] = a[e]; w[4 + e] = b2[e]; }
    }
    for (int t = sw0 + 3; t >= 0; --t) {
      if (t < s) {
        const f32x4 a = *(const f32x4*)(skb + t * 132 + d0), b2 = *(const f32x4*)(skb + t * 132 + d0 + 4);
#pragma unroll
        for (int e = 0; e < 4; ++e) { w[e] *= (1.f - a[e]); w[4 + e] *= (1.f - b2[e]); }
      }
      const f32x4 q0 = *(const f32x4*)(sq + t * 132 + d0), q1 = *(const f32x4*)(sq + t * 132 + d0 + 4);
      float part = 0.f;
#pragma unroll
      for (int e = 0; e < 4; ++e) part += q0[e] * w[e] + q1[e] * w[4 + e];
      part += __shfl_xor(part, 1); part += __shfl_xor(part, 2); part += __shfl_xor(part, 4); part += __shfl_xor(part, 8);
      if (dg == 0) { if (t == s) sA[s * 17 + s] = pdiag + part; else if (t < s) sA[t * 17 + s] = part; }
    }
  }
  __syncthreads();
  {
    float o[8];
#pragma unroll
    for (int e = 0; e < 8; ++e) o[e] = 0.f;
#pragma unroll
    for (int s = 0; s < 16; ++s) {
      const float a = sA[row * 17 + s];
      const f32x4 v0 = *(const f32x4*)(sv + s * 132 + c8), v1 = *(const f32x4*)(sv + s * 132 + c8 + 4);
#pragma unroll
      for (int e = 0; e < 4; ++e) { o[e] += a * v0[e]; o[4 + e] += a * v1[e]; }
    }
    u32x4 r; r[0] = pack2(o[0], o[1]); r[1] = pack2(o[2], o[3]); r[2] = pack2(o[4], o[5]); r[3] = pack2(o[6], o[7]);
    *(u32x4*)(hb.OI + gidx) = r;
  }
  __syncthreads();
  }
}

constexpr int SC_NS = 6, SC_STAGE = 12288;
DI void scan_issue(char* smem, int slot, const u16* QI, const u16* KIT, const u16* VTc, const float* DEC, int b, int h, int vg, int n, int tid) {
  char* st = smem + slot * SC_STAGE + tid * 16;
  const size_t tok0 = (size_t)b * 4096 + n * 16;
  const int row = tid >> 4, lc = (tid & 15) ^ row;
  GLDS16(QI + (tok0 + row) * 1024 + h * 128 + lc * 8, st);
  const size_t cb = ((size_t)(b * 8 + h) * 256 + n) * 2048;
  GLDS16(KIT + cb + tid * 8, st + 4096);
  const float* dp = DEC + ((size_t)b * 256 + n) * 1024 + h * 128;
  const void* g3 = tid < 128 ? (const void*)(VTc + cb + vg * 1024 + tid * 8) : (const void*)(dp + ((tid - 128) & 31) * 4);
  GLDS16(g3, st + 8192);
}

DI void hg_scan_phase(const HgBufs& hb, char* smem) {
  const int tid = otid(), lane = tid & 63, wid = tid >> 6, fr = lane & 15, fq = lane >> 4;
  for (int item = blockIdx.x; item < 128; item += gridDim.x) {
    const int vg = item & 1, dir = (item >> 1) & 1, h = (item >> 2) & 7, b = item >> 5;
    const u16* QI = dir ? hb.QIb : hb.QIf; const u16* KIT = dir ? hb.KITb : hb.KITf;
    const float* DEC = dir ? hb.DECb : hb.DECf; u16* Oout = dir ? hb.OB : hb.OF;
    const int vs = vg * 4 + wid;
    f32x4 S[8];
#pragma unroll
    for (int i = 0; i < 8; ++i) S[i] = zero4();
#pragma unroll
    for (int s = 0; s < SC_NS - 1; ++s) scan_issue(smem, s, QI, KIT, hb.VTc, DEC, b, h, vg, dir ? 255 - s : s, tid);
    int slot = 0;
    for (int step = 0; step < 256; ++step) {
      if (step < SC_NS - 1) asm volatile("s_waitcnt vmcnt(12)" ::: "memory");
      else asm volatile("s_waitcnt vmcnt(32)" ::: "memory");
      __builtin_amdgcn_s_barrier();
      asm volatile("" ::: "memory");
      {
        const int ns = min(step + SC_NS - 1, 255);
        int islot = slot + SC_NS - 1; if (islot >= SC_NS) islot -= SC_NS;
        scan_issue(smem, islot, QI, KIT, hb.VTc, DEC, b, h, vg, dir ? 255 - ns : ns, tid);
      }
      const int n = dir ? 255 - step : step;
      const char* st = smem + slot * SC_STAGE;
      bf16x8 qa[4], ka[8]; f32x4 dc[8];
#pragma unroll
      for (int ks = 0; ks < 4; ++ks) {
        const int l0 = 4 * ks + (fq >> 1), l1 = l0 + 2;
        const bf16x4 lo = *(const bf16x4*)(st + fr * 256 + ((l0 ^ fr) * 16) + (fq & 1) * 8);
        const bf16x4 hi = *(const bf16x4*)(st + fr * 256 + ((l1 ^ fr) * 16) + (fq & 1) * 8);
        qa[ks] = cat4(lo, hi);
      }
      bf16x8 vb = *(const bf16x8*)(st + 8192 + (wid * 16 + fr) * 32 + (fq & 1) * 16);
#pragma unroll
      for (int dt = 0; dt < 8; ++dt) {
        ka[dt] = *(const bf16x8*)(st + 4096 + (dt * 16 + fr) * 32 + (fq & 1) * 16);
        dc[dt] = *(const f32x4*)(st + 8192 + 2048 + (dt * 16 + fq * 4) * 4);
      }
      asm volatile("s_waitcnt lgkmcnt(0)" ::: "memory");
      __builtin_amdgcn_sched_barrier(0);
      const bf16x8 z8 = {0, 0, 0, 0, 0, 0, 0, 0};
      if (fq >= 2) vb = z8;
      f32x4 o0 = zero4(), o1 = zero4();
      o0 = MFMA32(qa[0], pack8(S[0], S[1]), o0);
      o1 = MFMA32(qa[1], pack8(S[2], S[3]), o1);
      o0 = MFMA32(qa[2], pack8(S[4], S[5]), o0);
      o1 = MFMA32(qa[3], pack8(S[6], S[7]), o1);
#pragma unroll
      for (int dt = 0; dt < 8; ++dt) {
        if (fq >= 2) ka[dt] = z8;
        S[dt] = S[dt] * dc[dt];
        S[dt] = MFMA32(ka[dt], vb, S[dt]);
      }
      {
        const f32x4 o = o0 + o1;
        const size_t tok0 = (size_t)b * 4096 + n * 16;
        u16* op = Oout + (tok0 + fq * 4) * 1024 + h * 128 + vs * 16 + fr;
        const u32 w0 = pack2(o[0], o[1]), w1 = pack2(o[2], o[3]);
        asm volatile("global_store_short %0, %1, off" :: "v"(op), "v"(w0) : "memory");
        asm volatile("global_store_short_d16_hi %0, %1, off" :: "v"(op + 1024), "v"(w0) : "memory");
        asm volatile("global_store_short %0, %1, off" :: "v"(op + 2048), "v"(w1) : "memory");
        asm volatile("global_store_short_d16_hi %0, %1, off" :: "v"(op + 3072), "v"(w1) : "memory");
      }
      if (++slot == SC_NS) slot = 0;
    }
    asm volatile("s_waitcnt vmcnt(0)" ::: "memory");
    __syncthreads();
  }
}

DI void hg_combine_phase(const HgBufs& hb, const float* __restrict__ gnorm, int rows) {
  const int lane = otid() & 63, wid = otid() >> 6;
  const int h = lane >> 3, c16 = (lane & 7) * 16;
  const int stride = gridDim.x * 4;
  f32x4 gn[4];
#pragma unroll
  for (int i = 0; i < 4; ++i) gn[i] = *(const f32x4*)(gnorm + c16 + i * 4);
  for (int row = blockIdx.x * 4 + wid; row < rows; row += stride * 2) {
    u32x4 ra[2][2], rf[2][2], rb[2][2], rg[2][2];
#pragma unroll
    for (int j = 0; j < 2; ++j) {
      const int rj = row + j * stride;
      if (rj < rows) {
        const size_t g = (size_t)rj * 1024 + h * 128 + c16;
#pragma unroll
        for (int half = 0; half < 2; ++half) {
          ra[j][half] = *(const u32x4*)(hb.OI + g + half * 8); rf[j][half] = *(const u32x4*)(hb.OF + g + half * 8);
          rb[j][half] = *(const u32x4*)(hb.OB + g + half * 8); rg[j][half] = *(const u32x4*)(hb.G + g + half * 8);
        }
      }
    }
#pragma unroll
    for (int j = 0; j < 2; ++j) {
      const int rj = row + j * stride;
      if (rj < rows) {
        const size_t g = (size_t)rj * 1024 + h * 128 + c16;
        float o[16]; float ss = 0.f;
#pragma unroll
        for (int half = 0; half < 2; ++half)
#pragma unroll
          for (int e = 0; e < 8; ++e) { float v = bfget(ra[j][half], e) + bfget(rf[j][half], e) + bfget(rb[j][half], e); o[half * 8 + e] = v; ss += v * v; }
        ss += __shfl_xor(ss, 1); ss += __shfl_xor(ss, 2); ss += __shfl_xor(ss, 4);
        const float rstd = rsqrtf(ss * (1.f / 128.f) + EPS);
#pragma unroll
        for (int half = 0; half < 2; ++half) {
          u32x4 r;
#pragma unroll
          for (int e2 = 0; e2 < 4; ++e2) {
            const int e = half * 8 + 2 * e2;
            r[e2] = pack2(o[e] * rstd * gn[e >> 2][e & 3] * bfget(rg[j][half], 2 * e2), o[e + 1] * rstd * gn[(e + 1) >> 2][(e + 1) & 3] * bfget(rg[j][half], 2 * e2 + 1));
          }
          *(u32x4*)(hb.Y + g + half * 8) = r;
        }
      }
    }
  }
}

DI void na_attn_item(const u16* __restrict__ Q, const u16* __restrict__ K, const u16* __restrict__ VT, const float* __restrict__ rpb, u16* __restrict__ O, int item, int fr, int fq) {
  const int qt = item & 3, h = (item >> 2) & 15, r = (item >> 6) & 63, b = item >> 12;
  const int r0 = min(max(r - 4, 0), 56);
  const int cw0 = qt == 0 ? 0 : qt == 1 ? 8 : qt == 2 ? 24 : 32;
  const size_t tokq = (size_t)b * 4096 + r * 64 + qt * 16 + fr;
  bf16x8 qf[2];
#pragma unroll
  for (int ks = 0; ks < 2; ++ks) qf[ks] = *(const bf16x8*)(Q + tokq * 1024 + h * 64 + ks * 32 + fq * 8);
  f32x4 s[8][2];
#pragma unroll
  for (int kr = 0; kr < 8; ++kr)
#pragma unroll
    for (int hf = 0; hf < 2; ++hf) {
      const size_t tokk = (size_t)b * 4096 + (r0 + kr) * 64 + cw0 + hf * 16 + fr;
      const bf16x8 k0 = *(const bf16x8*)(K + tokk * 1024 + h * 64 + fq * 8);
      const bf16x8 k1 = *(const bf16x8*)(K + tokk * 1024 + h * 64 + 32 + fq * 8);
      f32x4 a = MFMA32(k0, qf[0], zero4());
      s[kr][hf] = MFMA32(k1, qf[1], a);
    }
  const int qc = qt * 16 + fr;
  const int cs = min(max(qc - 8, 0), 48);
  float mx = -1e30f;
#pragma unroll
  for (int kr = 0; kr < 8; ++kr) {
    const float* rp = rpb + (h * 15 + (r0 + kr - r + 7)) * 31;
#pragma unroll
    for (int hf = 0; hf < 2; ++hf)
#pragma unroll
      for (int j = 0; j < 4; ++j) {
        const int kc = cw0 + hf * 16 + fq * 4 + j;
        const bool valid = (kc >= cs) && (kc < cs + 16);
        const int ci = min(max(kc - qc + 15, 0), 30);
        const float v = valid ? s[kr][hf][j] + rp[ci] * LOG2E : -1e30f;
        s[kr][hf][j] = v; mx = fmaxf(mx, v);
      }
  }
  mx = fmaxf(mx, __shfl_xor(mx, 16)); mx = fmaxf(mx, __shfl_xor(mx, 32));
  float l = 0.f;
#pragma unroll
  for (int kr = 0; kr < 8; ++kr)
#pragma unroll
    for (int hf = 0; hf < 2; ++hf)
#pragma unroll
      for (int j = 0; j < 4; ++j) { const float pv = __builtin_amdgcn_exp2f(s[kr][hf][j] - mx); s[kr][hf][j] = pv; l += pv; }
  l += __shfl_xor(l, 16); l += __shfl_xor(l, 32);
  f32x4 o[4];
#pragma unroll
  for (int dt = 0; dt < 4; ++dt) o[dt] = zero4();
#pragma unroll
  for (int kr = 0; kr < 8; ++kr) {
    const bf16x8 pp = pack8(s[kr][0], s[kr][1]);
#pragma unroll
    for (int dt = 0; dt < 4; ++dt) {
      const u16* vp = VT + ((size_t)((b * 16 + h) * 64 + dt * 16 + fr)) * 4096 + (r0 + kr) * 64 + cw0 + fq * 4;
      const bf16x8 vf = cat4(*(const bf16x4*)vp, *(const bf16x4*)(vp + 16));
      o[dt] = MFMA32(vf, pp, o[dt]);
    }
  }
  const float inv = 1.f / l;
#pragma unroll
  for (int dt = 0; dt < 4; ++dt) *(u32x2*)(O + tokq * 1024 + h * 64 + dt * 16 + fq * 4) = pack4(o[dt] * inv);
}

DI void mla_norm_phase(const u16* __restrict__ CRAW, const float* __restrict__ gq, const float* __restrict__ gkv, u16* __restrict__ CQN, u16* __restrict__ CKVN, float* __restrict__ KROPE) {
  const int lane = otid() & 63, wid = otid() >> 6;
  for (int row = blockIdx.x * 4 + wid; row < MTOK; row += gridDim.x * 4) {
    const u16* c = CRAW + (size_t)row * 1056;
    f32x4 v[3]; float ss = 0.f;
#pragma unroll
    for (int i = 0; i < 3; ++i) {
      const u32x2 w = *(const u32x2*)(c + i * 256 + lane * 4);
      v[i][0] = bflo(w[0]); v[i][1] = bfhi(w[0]); v[i][2] = bflo(w[1]); v[i][3] = bfhi(w[1]);
      ss += v[i][0] * v[i][0] + v[i][1] * v[i][1] + v[i][2] * v[i][2] + v[i][3] * v[i][3];
    }
    ss = wave_sum(ss);
    const float rq = rsqrtf(ss * (1.f / 768.f) + EPS);
#pragma unroll
    for (int i = 0; i < 3; ++i) {
      const f32x4 g4 = *(const f32x4*)(gq + i * 256 + lane * 4);
      *(u32x2*)(CQN + (size_t)row * 768 + i * 256 + lane * 4) = pack4(v[i] * rq * g4);
    }
    {
      const u32x2 w = *(const u32x2*)(c + 768 + lane * 4);
      f32x4 k; k[0] = bflo(w[0]); k[1] = bfhi(w[0]); k[2] = bflo(w[1]); k[3] = bfhi(w[1]);
      float s2 = wave_sum(k[0] * k[0] + k[1] * k[1] + k[2] * k[2] + k[3] * k[3]);
      const float rk = rsqrtf(s2 * (1.f / 256.f) + EPS);
      const f32x4 g4 = *(const f32x4*)(gkv + lane * 4);
      *(u32x2*)(CKVN + (size_t)row * 256 + lane * 4) = pack4(k * rk * g4);
    }
    if (lane < 8) {
      const u32x2 w = *(const u32x2*)(c + 1024 + lane * 4);
      f32x4 k; k[0] = bflo(w[0]); k[1] = bfhi(w[0]); k[2] = bflo(w[1]); k[3] = bfhi(w[1]);
      *(f32x4*)(KROPE + (size_t)row * 32 + lane * 4) = k;
    }
  }
}

DI void mla_prep_phase(u16* __restrict__ Q, const u16* __restrict__ KVRAW, const float* __restrict__ KROPE, u16* __restrict__ Kout,
                       const float* __restrict__ gq, const float* __restrict__ gk, const float* __restrict__ RC, const float* __restrict__ RS) {
  const int lane = otid() & 63, wid = otid() >> 6;
  const int h = lane >> 2, sub = lane & 3;
  const float QS = 0.10206207261596577f * LOG2E;
  for (int m = blockIdx.x * 4 + wid; m < MTOK; m += gridDim.x * 4) {
    const int t = m & 4095;
    const f32x4 cs = *(const f32x4*)(RC + t * 16 + sub * 4), sn = *(const f32x4*)(RS + t * 16 + sub * 4);
#pragma unroll
    for (int which = 0; which < 2; ++which) {
      float nope[16]; f32x4 ra, rb;
      u16* dstp = (which == 0 ? Q : Kout) + (size_t)m * 1536 + h * 96;
      const float* gn = which == 0 ? gq : gk;
      if (which == 0) {
        const u32x4 w0 = *(const u32x4*)(dstp + sub * 16), w1 = *(const u32x4*)(dstp + sub * 16 + 8);
#pragma unroll
        for (int e = 0; e < 8; ++e) { nope[e] = bfget(w0, e); nope[8 + e] = bfget(w1, e); }
        const u32x2 a2 = *(const u32x2*)(dstp + 64 + sub * 4), b2 = *(const u32x2*)(dstp + 80 + sub * 4);
        ra[0] = bflo(a2[0]); ra[1] = bfhi(a2[0]); ra[2] = bflo(a2[1]); ra[3] = bfhi(a2[1]);
        rb[0] = bflo(b2[0]); rb[1] = bfhi(b2[0]); rb[2] = bflo(b2[1]); rb[3] = bfhi(b2[1]);
      } else {
        const u16* kp = KVRAW + (size_t)m * 2048 + h * 128 + sub * 16;
        const u32x4 w0 = *(const u32x4*)kp, w1 = *(const u32x4*)(kp + 8);
#pragma unroll
        for (int e = 0; e < 8; ++e) { nope[e] = bfget(w0, e); nope[8 + e] = bfget(w1, e); }
        ra = *(const f32x4*)(KROPE + (size_t)m * 32 + sub * 4);
        rb = *(const f32x4*)(KROPE + (size_t)m * 32 + 16 + sub * 4);
      }
      float ss = 0.f;
#pragma unroll
      for (int e = 0; e < 16; ++e) ss += nope[e] * nope[e];
#pragma unroll
      for (int e = 0; e < 4; ++e) ss += ra[e] * ra[e] + rb[e] * rb[e];
      ss += __shfl_xor(ss, 1); ss += __shfl_xor(ss, 2);
      const float rstd = rsqrtf(ss * (1.f / 96.f) + EPS) * (which == 0 ? QS : 1.f);
      u32x4 o0, o1;
#pragma unroll
      for (int e2 = 0; e2 < 4; ++e2) {
        o0[e2] = pack2(nope[2 * e2] * rstd * gn[sub * 16 + 2 * e2], nope[2 * e2 + 1] * rstd * gn[sub * 16 + 2 * e2 + 1]);
        o1[e2] = pack2(nope[8 + 2 * e2] * rstd * gn[sub * 16 + 8 + 2 * e2], nope[9 + 2 * e2] * rstd * gn[sub * 16 + 9 + 2 * e2]);
      }
      f32x4 oa, ob;
#pragma unroll
      for (int e = 0; e < 4; ++e) {
        const float a = ra[e] * rstd * gn[64 + sub * 4 + e], bq = rb[e] * rstd * gn[80 + sub * 4 + e];
        oa[e] = a * cs[e] - bq * sn[e];
        ob[e] = bq * cs[e] + a * sn[e];
      }
      *(u32x4*)(dstp + sub * 16) = o0; *(u32x4*)(dstp + sub * 16 + 8) = o1;
      *(u32x2*)(dstp + 64 + sub * 4) = pack4(oa); *(u32x2*)(dstp + 80 + sub * 4) = pack4(ob);
    }
  }
}

DI void mla_vt_phase(const u16* __restrict__ KVRAW, u16* __restrict__ VT, char* smem) {
  u16* tile = (u16*)smem;
  const int tid = otid();
  for (int item = blockIdx.x; item < 8192; item += gridDim.x) {
    const int tt = item & 63, bh = item >> 6, b = bh >> 4, h = bh & 15;
    {
      const int row = tid >> 2, part = tid & 3;
      const u16* src = KVRAW + ((size_t)b * 4096 + tt * 64 + row) * 2048 + h * 128 + 64 + part * 16;
      const u32x4 w0 = *(const u32x4*)src, w1 = *(const u32x4*)(src + 8);
      u32* d32 = (u32*)(tile + row * 66 + part * 16);
#pragma unroll
      for (int e = 0; e < 4; ++e) { d32[e] = w0[e]; d32[4 + e] = w1[e]; }
    }
    __syncthreads();
    {
      const int d = tid >> 2, tp = (tid & 3) * 16;
      u32x4 o0, o1;
#pragma unroll
      for (int e2 = 0; e2 < 4; ++e2) {
        o0[e2] = (u32)tile[(tp + 2 * e2) * 66 + d] | ((u32)tile[(tp + 2 * e2 + 1) * 66 + d] << 16);
        o1[e2] = (u32)tile[(tp + 8 + 2 * e2) * 66 + d] | ((u32)tile[(tp + 9 + 2 * e2) * 66 + d] << 16);
      }
      u16* dst = VT + ((size_t)(bh * 64 + d)) * 4096 + tt * 64 + tp;
      *(u32x4*)dst = o0; *(u32x4*)(dst + 8) = o1;
    }
    __syncthreads();
  }
}

constexpr int FA_KROW = 208, FA_VROW = 144, FA_KT = 64 * FA_KROW, FA_BUF = FA_KT + 64 * FA_VROW;
DI void mla_attn_item(const u16* __restrict__ Q, const u16* __restrict__ Kb, const u16* __restrict__ VT, u16* __restrict__ O, int item, char* smem) {
  const int qb = item & 15, bh = item >> 4, b = bh >> 4, h = bh & 15;
  const int tid = otid(), lane = tid & 63, wid = tid >> 6, fr = lane & 15, fq = lane >> 4;
  bf16x8 qf[4][3];
#pragma unroll
  for (int qt = 0; qt < 4; ++qt) {
    const size_t tq = (size_t)b * 4096 + qb * 256 + wid * 64 + qt * 16 + fr;
#pragma unroll
    for (int ks = 0; ks < 3; ++ks) qf[qt][ks] = *(const bf16x8*)(Q + tq * 1536 + h * 96 + ks * 32 + fq * 8);
  }
  f32x4 o[4][4];
#pragma unroll
  for (int i = 0; i < 4; ++i)
#pragma unroll
    for (int j = 0; j < 4; ++j) o[i][j] = zero4();
  float mrun[4] = {-1e30f, -1e30f, -1e30f, -1e30f}, lrun[4] = {0.f, 0.f, 0.f, 0.f};
  const u16* kg[3]; int ks_off[3];
#pragma unroll
  for (int i = 0; i < 3; ++i) {
    const int c = tid + 256 * i, row = c / 12, kc = c % 12;
    kg[i] = Kb + ((size_t)b * 4096 + row) * 1536 + h * 96 + kc * 8;
    ks_off[i] = row * FA_KROW + kc * 16;
  }
  const u16* vg[2]; int vs_off[2];
#pragma unroll
  for (int i = 0; i < 2; ++i) {
    const int c = tid + 256 * i, d = c >> 3, kc = c & 7;
    vg[i] = VT + ((size_t)(bh * 64 + d)) * 4096 + kc * 8;
    vs_off[i] = FA_KT + d * FA_VROW + kc * 16;
  }
  u32x4 rk[3], rv[2];
#pragma unroll
  for (int i = 0; i < 3; ++i) rk[i] = *(const u32x4*)(kg[i]);
#pragma unroll
  for (int i = 0; i < 2; ++i) rv[i] = *(const u32x4*)(vg[i]);
#pragma unroll
  for (int i = 0; i < 3; ++i) *(u32x4*)(smem + ks_off[i]) = rk[i];
#pragma unroll
  for (int i = 0; i < 2; ++i) *(u32x4*)(smem + vs_off[i]) = rv[i];
  __syncthreads();
  for (int kt = 0; kt < 64; ++kt) {
    const int cur = (kt & 1) * FA_BUF, nxt = FA_BUF - cur;
    if (kt + 1 < 64) {
      const size_t key0 = (size_t)(kt + 1) * 64;
#pragma unroll
      for (int i = 0; i < 3; ++i) rk[i] = *(const u32x4*)(kg[i] + key0 * 1536);
#pragma unroll
      for (int i = 0; i < 2; ++i) rv[i] = *(const u32x4*)(vg[i] + key0);
    }
#pragma unroll
    for (int kh = 0; kh < 2; ++kh) {
      f32x4 s[2][4];
#pragma unroll
      for (int kl = 0; kl < 2; ++kl) {
#pragma unroll
        for (int qt = 0; qt < 4; ++qt) s[kl][qt] = zero4();
#pragma unroll
        for (int ks = 0; ks < 3; ++ks) {
          const bf16x8 kf = *(const bf16x8*)(smem + cur + ((kh * 2 + kl) * 16 + fr) * FA_KROW + ks * 64 + fq * 16);
#pragma unroll
          for (int qt = 0; qt < 4; ++qt) s[kl][qt] = MFMA32(kf, qf[qt][ks], s[kl][qt]);
        }
      }
      bf16x8 pp[4];
      {
        float lm[4]; bool need = false;
#pragma unroll
        for (int qt = 0; qt < 4; ++qt) {
          const float m0 = fmaxf(fmaxf(s[0][qt][0], s[0][qt][1]), fmaxf(s[0][qt][2], s[0][qt][3]));
          const float m1 = fmaxf(fmaxf(s[1][qt][0], s[1][qt][1]), fmaxf(s[1][qt][2], s[1][qt][3]));
          lm[qt] = fmaxf(m0, m1);
          need = need || (lm[qt] > mrun[qt] + 8.f);
        }
        if (__any(need)) {
#pragma unroll
          for (int qt = 0; qt < 4; ++qt) {
            float mx = lm[qt];
            mx = fmaxf(mx, __shfl_xor(mx, 16)); mx = fmaxf(mx, __shfl_xor(mx, 32));
            const float mnew = fmaxf(mrun[qt], mx);
            const float alpha = __builtin_amdgcn_exp2f(mrun[qt] - mnew);
            mrun[qt] = mnew;
            lrun[qt] *= alpha;
#pragma unroll
            for (int dt = 0; dt < 4; ++dt) o[dt][qt] = o[dt][qt] * alpha;
          }
        }
#pragma unroll
        for (int qt = 0; qt < 4; ++qt) {
          const float mr = mrun[qt];
          float ps = 0.f;
#pragma unroll
          for (int kl = 0; kl < 2; ++kl)
#pragma unroll
            for (int j = 0; j < 4; ++j) { const float pv = __builtin_amdgcn_exp2f(s[kl][qt][j] - mr); s[kl][qt][j] = pv; ps += pv; }
          lrun[qt] += ps;
          pp[qt] = pack8(s[0][qt], s[1][qt]);
        }
      }
#pragma unroll
      for (int dt = 0; dt < 4; ++dt) {
        const char* vp = smem + cur + FA_KT + (dt * 16 + fr) * FA_VROW + (kh * 32 + fq * 4) * 2;
        const bf16x8 vf = cat4(*(const bf16x4*)vp, *(const bf16x4*)(vp + 32));
#pragma unroll
        for (int qt = 0; qt < 4; ++qt) o[dt][qt] = MFMA32(vf, pp[qt], o[dt][qt]);
      }
    }
    if (kt + 1 < 64) {
#pragma unroll
      for (int i = 0; i < 3; ++i) *(u32x4*)(smem + nxt + ks_off[i]) = rk[i];
#pragma unroll
      for (int i = 0; i < 2; ++i) *(u32x4*)(smem + nxt + vs_off[i]) = rv[i];
    }
    __syncthreads();
  }
#pragma unroll
  for (int qt = 0; qt < 4; ++qt) {
    float l = lrun[qt];
    l += __shfl_xor(l, 16); l += __shfl_xor(l, 32);
    const float inv = 1.f / l;
    const size_t tq = (size_t)b * 4096 + qb * 256 + wid * 64 + qt * 16 + fr;
#pragma unroll
    for (int dt = 0; dt < 4; ++dt) *(u32x2*)(O + tq * 1024 + h * 64 + dt * 16 + fq * 4) = pack4(o[dt][qt] * inv);
  }
}

#define XB_TMO      128
#define XB_XCNT(j)  (256  + 64 * (j))
#define XB_XSUB(j)  (1280 + 64 * (j))
#define XB_XGEN(j)  (2304 + 64 * (j))
#define XB_TOP      3328
#define XB_TOPGEN   3392
#define XCD_BAR_WORDS 3456
#define XB_SPIN_CAP (1u << 22)
DI unsigned xb_ld(unsigned* p) { return __hip_atomic_load(p, __ATOMIC_RELAXED, __HIP_MEMORY_SCOPE_AGENT); }
DI unsigned xb_add(unsigned* p, unsigned v) { return __hip_atomic_fetch_add(p, v, __ATOMIC_RELAXED, __HIP_MEMORY_SCOPE_AGENT); }
DI unsigned xb_xcc_id() { return (unsigned)__builtin_amdgcn_s_getreg((3 << 11) | 20) & 0xFu; }
#define XB_SPIN(cond, bar) do { unsigned _sp = 0; while (cond) { __builtin_amdgcn_s_sleep(1); \
    if ((++_sp & 255u) == 0u) { if (xb_ld(&(bar)[XB_TMO])) break; if (_sp > XB_SPIN_CAP) { atomicAdd(&(bar)[XB_TMO], 1u); break; } } } } while (0)

DI void xcd_barrier_complete(unsigned* bar, unsigned x, unsigned& nloc, unsigned& nx) {
  const unsigned G = gridDim.x;
  unsigned sum, cnt, mine, sp = 0u;
  for (;;) {
    sum = 0u; cnt = 0u; mine = 0u;
#pragma unroll
    for (unsigned j = 0; j < 16; ++j) { const unsigned c = xb_ld(&bar[XB_XCNT(j)]); sum += c; cnt += (c > 0u) ? 1u : 0u; mine = (j == x) ? c : mine; }
    if (sum == G) break;
    __builtin_amdgcn_s_sleep(1);
    if ((++sp & 255u) == 0u) { if (xb_ld(&bar[XB_TMO])) break; if (sp > XB_SPIN_CAP) { atomicAdd(&bar[XB_TMO], 1u); break; } }
  }
  nloc = mine > 0u ? mine : 1u; nx = cnt > 0u ? cnt : 1u;
}

DI void xcd_barrier(unsigned* bar, volatile unsigned* st) {
  asm volatile("s_waitcnt vmcnt(0)" ::: "memory");
  __syncthreads();
  if (threadIdx.x == 0) {
    __builtin_amdgcn_s_waitcnt(0);
    const unsigned x = xb_xcc_id();
    unsigned nloc = st[0], nx = st[1];
    if (nloc == 0u) { xcd_barrier_complete(bar, x, nloc, nx); st[0] = nloc; st[1] = nx; }
    const unsigned old = xb_add(&bar[XB_XSUB(x)], 1u);
    const unsigned gen = old / nloc;
    if (old + 1u == (gen + 1u) * nloc) {
      __builtin_amdgcn_fence(__ATOMIC_RELEASE, "agent");
      asm volatile("s_waitcnt vmcnt(0)" ::: "memory");
      const unsigned og = xb_add(&bar[XB_TOP], 1u);
      const unsigned tg = og / nx;
      if (og + 1u == (tg + 1u) * nx) xb_add(&bar[XB_TOPGEN], 1u);
      else XB_SPIN(xb_ld(&bar[XB_TOPGEN]) == tg, bar);
      __builtin_amdgcn_fence(__ATOMIC_ACQUIRE, "agent");
      xb_add(&bar[XB_XGEN(x)], 1u);
      asm volatile("s_waitcnt vmcnt(0)" ::: "memory");
    } else {
      XB_SPIN(xb_ld(&bar[XB_XGEN(x)]) == gen, bar);
      __builtin_amdgcn_fence(__ATOMIC_ACQUIRE, "agent");
      asm volatile("s_waitcnt vmcnt(0)" ::: "memory");
    }
  }
  __syncthreads();
}

#ifndef ENMASK
#define ENMASK 0xffffffffu
#endif
#define EN(i) ((ENMASK >> (i)) & 1u)
#ifndef DUPMASK
#define DUPMASK 0u
#endif
#define DUP(i) ((DUPMASK >> (i)) & 1u)
#ifndef BAR2
#define BAR2 0
#endif
#define PHASE_BEGIN(i) if (EN(i) && pc >= p.lo && pc < p.hi) for (int rep_ = 0; rep_ < 1 + (int)DUP(i); ++rep_) {
#define PHASE_END } { if (pc >= p.lo && pc + 1 < p.hi) { if (pc == p.lo) grid.sync(); else { xcd_barrier(bar, st); if (BAR2) xcd_barrier(bar, st); } } ++pc; }

__global__ void __launch_bounds__(256, 2) mega(Params p) {
  __shared__ __attribute__((aligned(16))) char smem[73728 + 16];
  cg::grid_group grid = cg::this_grid();
  int pc = 0;
  char* ws = p.ws;
  unsigned* bar = (unsigned*)(ws + OFF_BAR);
  volatile unsigned* st = (volatile unsigned*)(smem + 73728);
  if (threadIdx.x == 0) { st[0] = 0u; st[1] = 0u; (void)xb_add(&bar[XB_XCNT(xb_xcc_id())], 1u); }
  __syncthreads();
  u16* H = (u16*)(ws + OFF_H);
  char* R = ws + OFF_R;
  const float* LB = (const float*)(ws + OFF_TAB);
  const float* RC = LB + 4096; const float* RS = RC + 65536;
  for (int layer = 0; layer < 4; ++layer) {
    const int kind = layer % 3, mi = layer / 3;
    for (int stage = 0; stage < 3; ++stage) {
      if (stage != 1) {
        const float* ng = (stage == 0 ? p.ffn1_norm : p.ffn2_norm) + layer * 1024;
        const u16* wgu = (const u16*)(ws + (stage == 0 ? OFF_WGU1 : OFF_WGU2));
        const u16* wdn = (const u16*)(ws + (stage == 0 ? OFF_WDN1 : OFF_WDN2));
        u16* ACT = (u16*)R;
        PHASE_BEGIN(0)
          const bool first = (layer == 0 && stage == 0);
          if (stage == 0) { if (layer == 0) init_tables(p); cvt_layer(p, layer, smem); }
          norm_phase(first ? p.x : p.X, ng, H, first ? p.X : nullptr, MTOK);
        PHASE_END
        PHASE_BEGIN(1)
          gemm_phase(H, 1024, wgu, 1024, MTOK, 5632, EpiSwiglu{ACT}, smem);
        PHASE_END
        PHASE_BEGIN(2)
          gemm_phase(ACT, 2816, wdn, 2816, MTOK, 1024, EpiResid{p.X, 0.5f}, smem);
        PHASE_END
      } else {
        PHASE_BEGIN(3)
          norm_phase(p.X, p.mix_norm + layer * 1024, H, nullptr, MTOK);
        PHASE_END
        if (kind == 0) {
          constexpr size_t SZ = 32 * MiB;
          HgBufs hb;
          hb.Q = (u16*)(R + 0 * SZ); hb.LFf = (u16*)(R + 1 * SZ); hb.LFb = (u16*)(R + 2 * SZ); hb.V = (u16*)(R + 3 * SZ); hb.G = (u16*)(R + 4 * SZ);
          hb.QIf = (u16*)(R + 5 * SZ); hb.QIb = (u16*)(R + 6 * SZ); hb.KITf = (u16*)(R + 7 * SZ); hb.KITb = (u16*)(R + 8 * SZ);
          hb.VTc = (u16*)(R + 9 * SZ); hb.OI = (u16*)(R + 10 * SZ); hb.OF = hb.Q; hb.OB = hb.LFf; hb.Y = hb.LFb;
          hb.DECf = (float*)(R + 11 * SZ); hb.DECb = (float*)(R + 11 * SZ + 4 * MiB);
          const u16* w_in = (const u16*)(ws + OFF_WMIX); const u16* w_out = (const u16*)(ws + OFF_WMIX + 10485760);
          for (int half = 0; half < 2; ++half) {
            PHASE_BEGIN(4)
              gemm_phase(H + (size_t)half * 16384 * 1024, 1024, w_in, 1024, 16384, 5120, EpiHgIn{hb.Q, hb.LFf, hb.LFb, hb.V, hb.G, LB + layer * 1024}, smem);
            PHASE_END
            PHASE_BEGIN(5)
              hg_prep_phase(hb, smem);
            PHASE_END
            PHASE_BEGIN(6)
              hg_scan_phase(hb, smem);
            PHASE_END
            PHASE_BEGIN(7)
              hg_combine_phase(hb, p.hg_g_norm + mi * 128, 16384);
            PHASE_END
            PHASE_BEGIN(8)
              gemm_phase(hb.Y, 1024, w_out, 1024, 16384, 1024, EpiResid{p.X + (size_t)half * 16384 * 1024, 1.0f}, smem);
            PHASE_END
          }
        } else if (kind == 1) {
          u16* Qn = (u16*)R; u16* Kn = (u16*)(R + 64 * MiB); u16* VT = (u16*)(R + 128 * MiB); u16* On = (u16*)(R + 192 * MiB);
          const u16* w_in = (const u16*)(ws + OFF_WMIX); const u16* w_out = (const u16*)(ws + OFF_WMIX + 6291456);
          PHASE_BEGIN(9)
            gemm_phase(H, 1024, w_in, 1024, MTOK, 3072, EpiNaIn{Qn, Kn, VT, p.na_q_norm + mi * 64, p.na_k_norm + mi * 64}, smem);
          PHASE_END
          PHASE_BEGIN(10)
            const int tid_ = otid(), lane = tid_ & 63, wid = tid_ >> 6, fr = lane & 15, fq = lane >> 4;
            for (int item = blockIdx.x * 4 + wid; item < 32768; item += gridDim.x * 4)
              na_attn_item(Qn, Kn, VT, p.na_rpb + (size_t)mi * 16 * 15 * 31, On, item, fr, fq);
          PHASE_END
          PHASE_BEGIN(11)
            gemm_phase(On, 1024, w_out, 1024, MTOK, 1024, EpiResid{p.X, 1.0f}, smem);
          PHASE_END
        } else {
          u16* VT = H;
          u16* CRAW = (u16*)R; u16* On = (u16*)R;
          u16* CQN = (u16*)(R + 66 * MiB); u16* CKVN = (u16*)(R + 114 * MiB); u16* Kk = (u16*)(R + 66 * MiB);
          float* KROPE = (float*)(R + 162 * MiB);
          u16* Qq = (u16*)(R + 166 * MiB); u16* KVRAW = (u16*)(R + 262 * MiB);
          const u16* w_in = (const u16*)(ws + OFF_WMIX); const u16* w_uq = (const u16*)(ws + OFF_WMIX + 2359296);
          const u16* w_ukv = (const u16*)(ws + OFF_WMIX + 4718592); const u16* w_out = (const u16*)(ws + OFF_WMIX + 5767168);
          PHASE_BEGIN(12)
            gemm_phase(H, 1024, w_in, 1024, MTOK, 1152, EpiStore{CRAW, 1056, 1056}, smem);
          PHASE_END
          PHASE_BEGIN(13)
            mla_norm_phase(CRAW, p.mla_q_a_norm + mi * 768, p.mla_kv_a_norm + mi * 256, CQN, CKVN, KROPE);
          PHASE_END
          PHASE_BEGIN(14)
            gemm_phase(CQN, 768, w_uq, 768, MTOK, 1536, EpiStore{Qq, 1536, 1536}, smem);
            gemm_phase(CKVN, 256, w_ukv, 256, MTOK, 2048, EpiStore{KVRAW, 2048, 2048}, smem);
          PHASE_END
          PHASE_BEGIN(15)
            mla_prep_phase(Qq, KVRAW, KROPE, Kk, p.mla_q_norm + mi * 96, p.mla_k_norm + mi * 96, RC, RS);
            mla_vt_phase(KVRAW, VT, smem);
          PHASE_END
          PHASE_BEGIN(16)
            for (int item = blockIdx.x; item < 2048; item += gridDim.x) mla_attn_item(Qq, Kk, VT, On, item, smem);
          PHASE_END
          PHASE_BEGIN(17)
            gemm_phase(On, 1024, w_out, 1024, MTOK, 1024, EpiResid{p.X, 1.0f}, smem);
          PHASE_END
        }
      }
    }
  }
}

static int count_phases() {
  int n = 0;
  for (int layer = 0; layer < 4; ++layer) {
    int kind = layer % 3;
    n += 3 + 3 + 1;
    n += kind == 0 ? 10 : kind == 1 ? 3 : 6;
  }
  return n;
}

extern "C" void kernel_launch(void* const* d_in, const int* in_sizes, int n_in, void* d_out, int out_size, void* d_ws, size_t ws_size, hipStream_t stream) {
  if (ws_size < WS_NEED) { fprintf(stderr, "workspace too small: %zu < %zu\n", ws_size, WS_NEED); return; }
  static int grid_blocks = 0;
  if (!grid_blocks) {
    int dev = 0, cus = 0, per_cu = 0;
    hipGetDevice(&dev);
    hipDeviceGetAttribute(&cus, hipDeviceAttributeMultiprocessorCount, dev);
    hipOccupancyMaxActiveBlocksPerMultiprocessor(&per_cu, mega, 256, 0);
    if (per_cu > 2) per_cu = 2;
    grid_blocks = cus * per_cu;
  }
  Params p{};
  const float** pf = (const float**)&p;
  for (int i = 0; i < 25; ++i) pf[i] = (const float*)d_in[i];
  p.X = (float*)d_out; p.ws = (char*)d_ws;
  const int total = count_phases();
#if MULTI_LAUNCH
  for (int ph = 0; ph < total; ++ph) {
    p.lo = ph; p.hi = ph + 1;
    hipLaunchKernelGGL(mega, dim3(grid_blocks), dim3(256), 0, stream, p);
  }
#else
  hipMemsetAsync((char*)d_ws + OFF_BAR, 0, 16384, stream);
  p.lo = 0; p.hi = total;
  void* args[] = {&p};
  hipError_t e = hipLaunchCooperativeKernel((void*)mega, dim3(grid_blocks), dim3(256), args, 0, stream);
  if (e != hipSuccess) fprintf(stderr, "cooperative launch failed: %s (grid %d)\n", hipGetErrorString(e), grid_blocks);
#endif
}
```

```cpp
#include <hip/hip_runtime.h>
#include <hip/hip_cooperative_groups.h>
#include <cstdio>
#include <cstdint>
namespace cg = cooperative_groups;

#ifndef MULTI_LAUNCH
#define MULTI_LAUNCH 0
#endif

typedef unsigned short u16;
typedef unsigned int u32;
using bf16x8 = __attribute__((ext_vector_type(8))) short;
using bf16x4 = __attribute__((ext_vector_type(4))) short;
using f32x4 = __attribute__((ext_vector_type(4))) float;
using u32x2 = __attribute__((ext_vector_type(2))) unsigned int;
using u32x4 = __attribute__((ext_vector_type(4))) unsigned int;

#define DI __device__ __forceinline__
#define MFMA32(a, b, c) __builtin_amdgcn_mfma_f32_16x16x32_bf16((a), (b), (c), 0, 0, 0)

constexpr int MTOK = 32768;
constexpr float EPS = 1e-6f;
constexpr float LOG2E = 1.4426950408889634f;

constexpr size_t MiB = 1048576;
constexpr size_t OFF_WGU1 = 0;
constexpr size_t OFF_WDN1 = 11534336;
constexpr size_t OFF_WGU2 = 17301504;
constexpr size_t OFF_WDN2 = 28835840;
constexpr size_t OFF_WMIX = 34603008;
constexpr size_t OFF_TAB = 47185920;
constexpr size_t OFF_BAR = OFF_TAB + 786432;
constexpr size_t OFF_H = 46 * MiB;
constexpr size_t OFF_R = 110 * MiB;
constexpr size_t WS_NEED = 500 * MiB;

struct Params {
  const float* x; const float* ffn1_norm; const float* ffn1_w_gu; const float* ffn1_w_down;
  const float* mix_norm; const float* ffn2_norm; const float* ffn2_w_gu; const float* ffn2_w_down;
  const float* hg_lb_logits; const float* hg_w_in; const float* hg_g_norm; const float* hg_w_out;
  const float* na_w_in; const float* na_q_norm; const float* na_k_norm; const float* na_rpb; const float* na_w_out;
  const float* mla_w_in; const float* mla_q_a_norm; const float* mla_w_uq; const float* mla_kv_a_norm; const float* mla_w_ukv;
  const float* mla_q_norm; const float* mla_k_norm; const float* mla_w_out;
  float* X; char* ws; int lo; int hi;
};

DI u32 f2bf(float x) { u32 u = __float_as_uint(x); u += 0x7fffu + ((u >> 16) & 1u); return u >> 16; }
typedef __bf16 bf16v2 __attribute__((ext_vector_type(2)));
typedef float f32v2 __attribute__((ext_vector_type(2)));
DI u32 pack2(float a, float b) { f32v2 v = {a, b}; bf16v2 r = __builtin_convertvector(v, bf16v2); return __builtin_bit_cast(u32, r); }
DI float bflo(u32 w) { return __uint_as_float(w << 16); }
DI float bfhi(u32 w) { return __uint_as_float(w & 0xffff0000u); }
DI float bfget(const u32x4& v, int e) { u32 w = v[e >> 1]; return (e & 1) ? bfhi(w) : bflo(w); }
DI u32x2 pack4(const f32x4& v) { u32x2 r; r[0] = pack2(v[0], v[1]); r[1] = pack2(v[2], v[3]); return r; }
DI bf16x8 pack8(const f32x4& a, const f32x4& b) {
  u32x4 r; r[0] = pack2(a[0], a[1]); r[1] = pack2(a[2], a[3]); r[2] = pack2(b[0], b[1]); r[3] = pack2(b[2], b[3]);
  return __builtin_bit_cast(bf16x8, r);
}
DI bf16x8 cat4(const bf16x4& lo, const bf16x4& hi) { return __builtin_shufflevector(lo, hi, 0, 1, 2, 3, 4, 5, 6, 7); }
DI float wave_sum(float v) {
#pragma unroll
  for (int o = 32; o > 0; o >>= 1) v += __shfl_xor(v, o);
  return v;
}
DI float sigmoidf_(float z) { return 1.f / (1.f + __expf(-z)); }
DI float siluf_(float z) { return z / (1.f + __expf(-z)); }
DI int otid() { int t = threadIdx.x; asm volatile("" : "+v"(t)); return t; }
DI f32x4 zero4() { f32x4 z = {0.f, 0.f, 0.f, 0.f}; return z; }

DI void init_tables(const Params& p) {
  float* LB = (float*)(p.ws + OFF_TAB); float* RC = LB + 4096; float* RS = RC + 65536;
  const int gt = blockIdx.x * 256 + otid(), gs = gridDim.x * 256;
  for (int c = gt; c < 1024; c += gs) {
    float l0 = p.hg_lb_logits[c], l1 = p.hg_lb_logits[1024 + c], l2 = p.hg_lb_logits[2048 + c], l3 = p.hg_lb_logits[3072 + c];
    float mx = fmaxf(fmaxf(l0, l1), fmaxf(l2, l3));
    float e0 = expf(l0 - mx), e1 = expf(l1 - mx), e2 = expf(l2 - mx), e3 = expf(l3 - mx);
    float inv = 1.f / (e0 + e1 + e2 + e3);
    LB[c] = 0.f; LB[1024 + c] = e1 * inv; LB[2048 + c] = (e1 + e2) * inv; LB[3072 + c] = (e1 + e2 + e3) * inv;
  }
  for (int i = gt; i < 65536; i += gs) {
    int t = i >> 4, j = i & 15;
    float inv = exp2f(-(float)j * (13.287712379549449f / 16.f));
    float ang = (float)t * inv;
    double a = (double)ang;
    double k = rint(a * 0.15915494309189535);
    float r = (float)(a - k * 6.283185307179586);
    RC[i] = __cosf(r); RS[i] = __sinf(r);
  }
}

DI void cvt_tiles(const float* __restrict__ src, u16* __restrict__ dst, int K, int N, int Nd, int mode, char* smem) {
  float* tile = (float*)smem;
  const int tk = K >> 6, tn = Nd >> 6, tid = otid();
  for (int t = blockIdx.x; t < tk * tn; t += gridDim.x) {
    const int k0 = (t % tk) << 6, n0 = (t / tk) << 6;
    {
      const int nl = tid & 63, kq = tid >> 6;
      const int nd = n0 + nl;
      int col = nd;
      if (mode == 1) { int a = nd >> 5, r = nd & 31; col = a * 16 + (r & 15) + ((r >= 16) ? 2816 : 0); }
      const bool ok = col < N;
#pragma unroll
      for (int i = 0; i < 16; ++i) {
        int kl = kq + 4 * i;
        tile[kl * 65 + nl] = ok ? src[(size_t)(k0 + kl) * N + col] : 0.f;
      }
    }
    __syncthreads();
    {
      const int kp = (tid & 31) * 2, nq = tid >> 5;
#pragma unroll
      for (int i = 0; i < 8; ++i) {
        int n = nq + 8 * i;
        *(u32*)(dst + (size_t)(n0 + n) * K + k0 + kp) = pack2(tile[kp * 65 + n], tile[(kp + 1) * 65 + n]);
      }
    }
    __syncthreads();
  }
}

DI void cvt_layer(const Params& p, int layer, char* smem) {
  const int kind = layer % 3, mi = layer / 3;
  char* ws = p.ws;
  for (int task = 0; task < 8; ++task) {
    const float* src = nullptr; size_t off = 0; int K = 0, N = 0, Nd = 0, mode = 0;
    if (task == 0) { src = p.ffn1_w_gu + (size_t)layer * 1024 * 5632; off = OFF_WGU1; K = 1024; N = 5632; Nd = 5632; mode = 1; }
    else if (task == 1) { src = p.ffn1_w_down + (size_t)layer * 2816 * 1024; off = OFF_WDN1; K = 2816; N = 1024; Nd = 1024; }
    else if (task == 2) { src = p.ffn2_w_gu + (size_t)layer * 1024 * 5632; off = OFF_WGU2; K = 1024; N = 5632; Nd = 5632; mode = 1; }
    else if (task == 3) { src = p.ffn2_w_down + (size_t)layer * 2816 * 1024; off = OFF_WDN2; K = 2816; N = 1024; Nd = 1024; }
    else if (kind == 0) {
      if (task == 4) { src = p.hg_w_in + (size_t)mi * 1024 * 5120; off = OFF_WMIX; K = 1024; N = 5120; Nd = 5120; }
      else if (task == 5) { src = p.hg_w_out + (size_t)mi * 1024 * 1024; off = OFF_WMIX + 10485760; K = 1024; N = 1024; Nd = 1024; }
    } else if (kind == 1) {
      if (task == 4) { src = p.na_w_in + (size_t)mi * 1024 * 3072; off = OFF_WMIX; K = 1024; N = 3072; Nd = 3072; }
      else if (task == 5) { src = p.na_w_out + (size_t)mi * 1024 * 1024; off = OFF_WMIX + 6291456; K = 1024; N = 1024; Nd = 1024; }
    } else {
      if (task == 4) { src = p.mla_w_in + (size_t)mi * 1024 * 1056; off = OFF_WMIX; K = 1024; N = 1056; Nd = 1152; }
      else if (task == 5) { src = p.mla_w_uq + (size_t)mi * 768 * 1536; off = OFF_WMIX + 2359296; K = 768; N = 1536; Nd = 1536; }
      else if (task == 6) { src = p.mla_w_ukv + (size_t)mi * 256 * 2048; off = OFF_WMIX + 4718592; K = 256; N = 2048; Nd = 2048; }
      else if (task == 7) { src = p.mla_w_out + (size_t)mi * 1024 * 1024; off = OFF_WMIX + 5767168; K = 1024; N = 1024; Nd = 1024; }
    }
    if (src) cvt_tiles(src, (u16*)(ws + off), K, N, Nd, mode, smem);
  }
}

DI void norm_phase(const float* __restrict__ src, const float* __restrict__ gain, u16* __restrict__ dst, float* copy_dst, int rows) {
  const int lane = otid() & 63, wid = otid() >> 6;
  f32x4 g[4];
#pragma unroll
  for (int i = 0; i < 4; ++i) g[i] = *(const f32x4*)(gain + i * 256 + lane * 4);
  const int stride = gridDim.x * 4;
  for (int row = blockIdx.x * 4 + wid; row < rows; row += stride * 4) {
    f32x4 v[4][4];
#pragma unroll
    for (int j = 0; j < 4; ++j) {
      const int rj = row + j * stride;
      if (rj < rows) {
#pragma unroll
        for (int i = 0; i < 4; ++i) v[j][i] = *(const f32x4*)(src + (size_t)rj * 1024 + i * 256 + lane * 4);
      }
    }
#pragma unroll
    for (int j = 0; j < 4; ++j) {
      const int rj = row + j * stride;
      if (rj < rows) {
        float ss = 0.f;
#pragma unroll
        for (int i = 0; i < 4; ++i) ss += v[j][i][0] * v[j][i][0] + v[j][i][1] * v[j][i][1] + v[j][i][2] * v[j][i][2] + v[j][i][3] * v[j][i][3];
        ss = wave_sum(ss);
        const float rstd = rsqrtf(ss * (1.f / 1024.f) + EPS);
#pragma unroll
        for (int i = 0; i < 4; ++i) {
          f32x4 y = v[j][i] * rstd * g[i];
          *(u32x2*)(dst + (size_t)rj * 1024 + i * 256 + lane * 4) = pack4(y);
          if (copy_dst) *(f32x4*)(copy_dst + (size_t)rj * 1024 + i * 256 + lane * 4) = v[j][i];
        }
      }
    }
  }
}

#define GLDS16(gp, lp) __builtin_amdgcn_global_load_lds((const unsigned*)(gp), (unsigned*)(lp), 16, 0, 0)

constexpr int G_STAGE = 24576, G_WOFF = 16384, G_NS = 3, G_MT = 8;

template <class Epi>
DI void gemm_phase(const u16* __restrict__ A, int lda, const u16* __restrict__ W, int K, int Mrows, int Ncols, const Epi& epi, char* smem) {
  const int mtn = Mrows >> 8, ntn = Ncols >> 7;
  const int ntiles = mtn * ntn, nk = K >> 5;
  constexpr int GM = 16;
  const int bid = blockIdx.x, gsz = gridDim.x;
  const int my_tiles = bid < ntiles ? (ntiles - bid + gsz - 1) / gsz : 0;
  const int total = my_tiles * nk;
  if (total > 0) {
    const int tid = otid(), lane = tid & 63, wid = tid >> 6;
    const int wm = wid >> 1, wn = wid & 1, fr = lane & 15, fq = lane >> 4;
    f32x4 acc[4][G_MT];
#pragma unroll
    for (int i = 0; i < 4; ++i)
#pragma unroll
      for (int j = 0; j < G_MT; ++j) acc[i][j] = zero4();
    const int lrow = tid >> 2, lc = (tid & 3) ^ ((tid >> 4) & 3);
    char* sdst = smem + tid * 16;
    const int ro = (fq ^ (fr >> 2)) * 16;
    const char* sa_rd = smem + (wm * 128 + fr) * 64 + ro;
    const char* sw_rd = smem + G_WOFF + (wn * 64 + fr) * 64 + ro;
    int ij = 0, ik = 0;
    const u16 *ga, *gw;
    {
      const int tile = bid, group = tile / (GM * ntn), rem = tile % (GM * ntn);
      const int mt = group * GM + (rem % GM), nt = rem / GM;
      ga = A + ((size_t)mt * 256 + lrow) * lda + lc * 8; gw = W + ((size_t)nt * 128 + lrow) * K + lc * 8;
    }
    __builtin_amdgcn_s_barrier();
    asm volatile("" ::: "memory");
#define G_ISSUE(SLOT) do { \
      const int k0_ = ik << 5; char* sd_ = sdst + (SLOT) * G_STAGE; \
      _Pragma("unroll") for (int i = 0; i < 4; ++i) GLDS16(ga + (size_t)(64 * i) * lda + k0_, sd_ + i * 4096); \
      _Pragma("unroll") for (int i = 0; i < 2; ++i) GLDS16(gw + (size_t)(64 * i) * K + k0_, sd_ + G_WOFF + i * 4096); \
      if (++ik == nk) { ik = 0; ++ij; if (ij < my_tiles) { \
        const int tile = bid + ij * gsz, group = tile / (GM * ntn), rem = tile % (GM * ntn); \
        const int mt = group * GM + (rem % GM), nt = rem / GM; \
        ga = A + ((size_t)mt * 256 + lrow) * lda + lc * 8; gw = W + ((size_t)nt * 128 + lrow) * K + lc * 8; } } } while (0)
    G_ISSUE(0);
    if (total > 1) G_ISSUE(1);
    int slot = 0, ck = 0, cj = 0;
    for (int step = 0; step < total; ++step) {
      if (step + 1 < total) asm volatile("s_waitcnt vmcnt(6)" ::: "memory");
      else asm volatile("s_waitcnt vmcnt(0)" ::: "memory");
      __builtin_amdgcn_s_barrier();
      asm volatile("" ::: "memory");
      if (step + 2 < total) {
        int is = slot + 2; if (is >= G_NS) is -= G_NS;
        G_ISSUE(is);
      }
      const int cur = slot * G_STAGE;
      bf16x8 af[G_MT], wf[4];
#pragma unroll
      for (int i = 0; i < 4; ++i) wf[i] = *(const bf16x8*)(sw_rd + cur + i * 1024);
#pragma unroll
      for (int i = 0; i < 4; ++i) af[i] = *(const bf16x8*)(sa_rd + cur + i * 1024);
      __builtin_amdgcn_sched_barrier(0);
      acc[0][0] = MFMA32(wf[0], af[0], acc[0][0]);
      __builtin_amdgcn_sched_barrier(0);
#pragma unroll
      for (int i = 4; i < G_MT; ++i) af[i] = *(const bf16x8*)(sa_rd + cur + i * 1024);
      __builtin_amdgcn_sched_barrier(0);
#pragma unroll
      for (int mt = 0; mt < 4; ++mt)
#pragma unroll
        for (int nt = 0; nt < 4; ++nt) if (mt + nt > 0) acc[nt][mt] = MFMA32(wf[nt], af[mt], acc[nt][mt]);
      __builtin_amdgcn_sched_barrier(0);
#pragma unroll
      for (int mt = 4; mt < G_MT; ++mt)
#pragma unroll
        for (int nt = 0; nt < 4; ++nt) acc[nt][mt] = MFMA32(wf[nt], af[mt], acc[nt][mt]);
      if (++slot == G_NS) slot = 0;
      if (++ck == nk) {
        const int tile = bid + cj * gsz, group = tile / (GM * ntn), rem = tile % (GM * ntn);
        const int mt = group * GM + (rem % GM), nt = rem / GM;
        epi(acc, mt * 256 + wm * 128, nt * 128 + wn * 64, fr, fq);
#pragma unroll
        for (int i = 0; i < 4; ++i)
#pragma unroll
          for (int j = 0; j < G_MT; ++j) acc[i][j] = zero4();
        ck = 0; ++cj;
      }
    }
#undef G_ISSUE
  }
  __syncthreads();
}

struct EpiSwiglu {
  u16* act;
  DI void operator()(f32x4 (&acc)[4][G_MT], int mb, int nb, int fr, int fq) const {
#pragma unroll
    for (int mt = 0; mt < G_MT; ++mt) {
      const int m = mb + mt * 16 + fr;
#pragma unroll
      for (int np = 0; np < 2; ++np) {
        const f32x4 g = acc[2 * np][mt], u = acc[2 * np + 1][mt];
        f32x4 r;
#pragma unroll
        for (int j = 0; j < 4; ++j) r[j] = siluf_(g[j]) * u[j];
        const int jc = (nb >> 1) + np * 16 + fq * 4;
        *(u32x2*)(act + (size_t)m * 2816 + jc) = pack4(r);
      }
    }
  }
};

struct EpiResid {
  float* X; float scale;
  DI void operator()(f32x4 (&acc)[4][G_MT], int mb, int nb, int fr, int fq) const {
#pragma unroll
    for (int mt = 0; mt < G_MT; ++mt) {
      const int m = mb + mt * 16 + fr;
#pragma unroll
      for (int nt = 0; nt < 4; ++nt) {
        f32x4* ptr = (f32x4*)(X + (size_t)m * 1024 + nb + nt * 16 + fq * 4);
        f32x4 v = *ptr;
        v += acc[nt][mt] * scale;
        *ptr = v;
      }
    }
  }
};

struct EpiStore {
  u16* out; int ldo; int nmax;
  DI void operator()(f32x4 (&acc)[4][G_MT], int mb, int nb, int fr, int fq) const {
#pragma unroll
    for (int mt = 0; mt < G_MT; ++mt) {
      const int m = mb + mt * 16 + fr;
#pragma unroll
      for (int nt = 0; nt < 4; ++nt) {
        const int n = nb + nt * 16 + fq * 4;
        if (n < nmax) *(u32x2*)(out + (size_t)m * ldo + n) = pack4(acc[nt][mt]);
      }
    }
  }
};

struct EpiHgIn {
  u16 *Q, *LFf, *LFb, *V, *G; const float* lb;
  DI void operator()(f32x4 (&acc)[4][G_MT], int mb, int nb, int fr, int fq) const {
    const int seg = nb >> 10, c0 = nb & 1023;
    u16* dst = seg == 0 ? Q : seg == 1 ? LFf : seg == 2 ? LFb : seg == 3 ? V : G;
#pragma unroll
    for (int mt = 0; mt < G_MT; ++mt) {
      const int m = mb + mt * 16 + fr;
#pragma unroll
      for (int nt = 0; nt < 4; ++nt) {
        const int c = c0 + nt * 16 + fq * 4;
        f32x4 a = acc[nt][mt], r;
        if (seg == 0) r = a * 0.08838834764831845f;
        else if (seg == 3) r = a;
        else if (seg == 4) {
#pragma unroll
          for (int j = 0; j < 4; ++j) r[j] = siluf_(a[j]);
        } else {
          const f32x4 l4 = *(const f32x4*)(lb + c);
#pragma unroll
          for (int j = 0; j < 4; ++j) {
            float z = fminf(fmaxf(a[j], -30.f), 30.f);
            float f = l4[j] + (1.f - l4[j]) * sigmoidf_(z);
            r[j] = __logf(f);
          }
        }
        *(u32x2*)(dst + (size_t)m * 1024 + c) = pack4(r);
      }
    }
  }
};

struct EpiNaIn {
  u16 *Q, *K, *VT; const float *qn, *kn;
  DI void operator()(f32x4 (&acc)[4][G_MT], int mb, int nb, int fr, int fq) const {
    const int seg = nb >> 10, h = (nb & 1023) >> 6;
    if (seg < 2) {
      u16* dst = seg == 0 ? Q : K;
      const float* gn = seg == 0 ? qn : kn;
      const float sc = seg == 0 ? 0.125f * LOG2E : 1.f;
#pragma unroll
      for (int mt = 0; mt < G_MT; ++mt) {
        const int m = mb + mt * 16 + fr;
        float ss = 0.f;
#pragma unroll
        for (int nt = 0; nt < 4; ++nt)
#pragma unroll
          for (int j = 0; j < 4; ++j) ss += acc[nt][mt][j] * acc[nt][mt][j];
        ss += __shfl_xor(ss, 16); ss += __shfl_xor(ss, 32);
        const float rstd = rsqrtf(ss * (1.f / 64.f) + EPS) * sc;
#pragma unroll
        for (int nt = 0; nt < 4; ++nt) {
          const int d = nt * 16 + fq * 4;
          const f32x4 g4 = *(const f32x4*)(gn + d);
          f32x4 r = acc[nt][mt] * rstd * g4;
          *(u32x2*)(dst + (size_t)m * 1024 + h * 64 + d) = pack4(r);
        }
      }
    } else {
#pragma unroll
      for (int mt = 0; mt < G_MT; ++mt) {
        const int m = mb + mt * 16 + fr;
        const int b = m >> 12, t = m & 4095;
#pragma unroll
        for (int nt = 0; nt < 4; ++nt)
#pragma unroll
          for (int j = 0; j < 4; ++j) {
            const int d = nt * 16 + fq * 4 + j;
            VT[((size_t)((b * 16 + h) * 64 + d)) * 4096 + t] = (u16)f2bf(acc[nt][mt][j]);
          }
      }
    }
  }
};

struct HgBufs {
  u16 *Q, *LFf, *LFb, *V, *G, *QIf, *QIb, *KITf, *KITb, *VTc, *OI, *OF, *OB, *Y;
  float *DECf, *DECb;
};

DI void hg_prep_phase(const HgBufs& hb, char* smem) {
  u32x4 rq, rf, rb, rv;
  {
    const int item0 = blockIdx.x, tid0 = otid();
    if (item0 < 8192) {
      const size_t g0 = ((size_t)(item0 >> 11) * 4096 + ((item0 >> 3) & 255) * 16 + (tid0 >> 4)) * 1024 + (item0 & 7) * 128 + (tid0 & 15) * 8;
      rq = *(const u32x4*)(hb.Q + g0); rf = *(const u32x4*)(hb.LFf + g0); rb = *(const u32x4*)(hb.LFb + g0); rv = *(const u32x4*)(hb.V + g0);
    }
  }
  for (int item = blockIdx.x; item < 8192; item += gridDim.x) {
  const int h = item & 7, n = (item >> 3) & 255, b = item >> 11;
  float* sq = (float*)smem; float* sbf = sq + 2112; float* sbb = sbf + 2112; float* skf = sbb + 2112;
  float* skb = skf + 2112; float* sv = skb + 2112; float* sP = sv + 2112; float* sA = sP + 5120;
  const int tid = otid();
  const int row = tid >> 4, c8 = (tid & 15) * 8;
  const size_t tok0 = (size_t)b * 4096 + n * 16;
  const size_t gidx = (tok0 + row) * 1024 + h * 128 + c8;
  {
#pragma unroll
    for (int e = 0; e < 8; ++e) {
      const int o = row * 132 + c8 + e;
      const float lf = bfget(rf, e), lb_ = bfget(rb, e);
      sq[o] = bfget(rq, e); sbf[o] = lf; sbb[o] = lb_;
      skf[o] = 1.f - __expf(lf); skb[o] = 1.f - __expf(lb_); sv[o] = bfget(rv, e);
    }
  }
  {
    const int nx = item + gridDim.x;
    if (nx < 8192) {
      const size_t g1 = ((size_t)(nx >> 11) * 4096 + ((nx >> 3) & 255) * 16 + row) * 1024 + (nx & 7) * 128 + c8;
      rq = *(const u32x4*)(hb.Q + g1); rf = *(const u32x4*)(hb.LFf + g1); rb = *(const u32x4*)(hb.LFb + g1); rv = *(const u32x4*)(hb.V + g1);
    }
  }
  __syncthreads();
  if (tid < 128) {
    const int d = tid; float a = 0.f;
#pragma unroll
    for (int t = 0; t < 16; ++t) { a += sbf[t * 132 + d]; sbf[t * 132 + d] = a; }
    hb.DECf[((size_t)b * 256 + n) * 1024 + h * 128 + d] = __expf(a);
  } else {
    const int d = tid - 128; float a = 0.f;
#pragma unroll
    for (int t = 15; t >= 0; --t) { a += sbb[t * 132 + d]; sbb[t * 132 + d] = a; }
    hb.DECb[((size_t)b * 256 + n) * 1024 + h * 128 + d] = __expf(a);
  }
  __syncthreads();
  {
    u32x4 of, ob;
#pragma unroll
    for (int e2 = 0; e2 < 4; ++e2) {
      const int o = row * 132 + c8 + 2 * e2;
      const float q0 = sq[o], q1 = sq[o + 1];
      of[e2] = pack2(q0 * __expf(sbf[o]), q1 * __expf(sbf[o + 1]));
      ob[e2] = pack2(q0 * __expf(sbb[o]), q1 * __expf(sbb[o + 1]));
    }
    *(u32x4*)(hb.QIf + gidx) = of; *(u32x4*)(hb.QIb + gidx) = ob;
  }
  {
    const int d = tid >> 1, t8 = (tid & 1) * 8;
    const float blf = sbf[15 * 132 + d], blb = sbb[d];
    u32x4 kf, kb, vv;
#pragma unroll
    for (int e2 = 0; e2 < 4; ++e2) {
      const int o0 = (t8 + 2 * e2) * 132 + d, o1 = o0 + 132;
      kf[e2] = pack2(skf[o0] * __expf(blf - sbf[o0]), skf[o1] * __expf(blf - sbf[o1]));
      kb[e2] = pack2(skb[o0] * __expf(blb - sbb[o0]), skb[o1] * __expf(blb - sbb[o1]));
      vv[e2] = pack2(sv[o0], sv[o1]);
    }
    const size_t cidx = (((size_t)(b * 8 + h) * 256 + n) * 128 + d) * 16 + t8;
    *(u32x4*)(hb.KITf + cidx) = kf; *(u32x4*)(hb.KITb + cidx) = kb; *(u32x4*)(hb.VTc + cidx) = vv;
  }
  {
    const int s = tid >> 4, dg = tid & 15, d0 = dg * 8, sw0 = (tid >> 6) * 4;
    float w[8];
    {
      const f32x4 a = *(const f32x4*)(skf + s * 132 + d0), b2 = *(const f32x4*)(skf + s * 132 + d0 + 4);
#pragma unroll
      for (int e = 0; e < 4; ++e) { w[e] = a[e]; w[4 + e] = b2[e]; }
    }
    float pdiag = 0.f;
    for (int t = sw0; t < 16; ++t) {
      if (t > s) {
        const f32x4 a = *(const f32x4*)(skf + t * 132 + d0), b2 = *(const f32x4*)(skf + t * 132 + d0 + 4);
#pragma unroll
        for (int e = 0; e < 4; ++e) { w[e] *= (1.f - a[e]); w[4 + e] *= (1.f - b2[e]); }
      }
      const f32x4 q0 = *(const f32x4*)(sq + t * 132 + d0), q1 = *(const f32x4*)(sq + t * 132 + d0 + 4);
      float part = 0.f;
#pragma unroll
      for (int e = 0; e < 4; ++e) part += q0[e] * w[e] + q1[e] * w[4 + e];
      if (t == s) pdiag = part;
      else if (t > s) sP[(t * 16 + s) * 20 + dg] = part;
    }
    {
      const f32x4 a = *(const f32x4*)(skb + s * 132 + d0), b2 = *(const f32x4*)(skb + s * 132 + d0 + 4);
#pragma unroll
      for (int e = 0; e < 4; ++e) { w[e] = a[e]; w[4 + e] = b2[e]; }
    }
    for (int t = sw0 + 3; t >= 0; --t) {
      if (t < s) {
        const f32x4 a = *(const f32x4*)(skb + t * 132 + d0), b2 = *(const f32x4*)(skb + t * 132 + d0 + 4);
#pragma unroll
        for (int e = 0; e < 4; ++e) { w[e] *= (1.f - a[e]); w[4 + e] *= (1.f - b2[e]); }
      }
      const f32x4 q0 = *(const f32x4*)(sq + t * 132 + d0), q1 = *(const f32x4*)(sq + t * 132 + d0 + 4);
      float part = 0.f;
#pragma unroll
      for (int e = 0; e < 4; ++e) part += q0[e] * w[e] + q1[e] * w[4 + e];
      if (t == s) sP[(s * 16 + s) * 20 + dg] = pdiag + part;
      else if (t < s) sP[(t * 16 + s) * 20 + dg] = part;
    }
  }
  __syncthreads();
  {
    const int t = tid >> 4, s = tid & 15;
    const float* pp = sP + (t * 16 + s) * 20;
    const f32x4 p0 = *(const f32x4*)pp, p1 = *(const f32x4*)(pp + 4), p2 = *(const f32x4*)(pp + 8), p3 = *(const f32x4*)(pp + 12);
    const f32x4 ps = (p0 + p1) + (p2 + p3);
    sA[t * 17 + s] = (ps[0] + ps[1]) + (ps[2] + ps[3]);
  }
  __syncthreads();
  {
    float o[8];
#pragma unroll
    for (int e = 0; e < 8; ++e) o[e] = 0.f;
#pragma unroll
    for (int s = 0; s < 16; ++s) {
      const float a = sA[row * 17 + s];
      const f32x4 v0 = *(const f32x4*)(sv + s * 132 + c8), v1 = *(const f32x4*)(sv + s * 132 + c8 + 4);
#pragma unroll
      for (int e = 0; e < 4; ++e) { o[e] += a * v0[e]; o[4 + e] += a * v1[e]; }
    }
    u32x4 r; r[0] = pack2(o[0], o[1]); r[1] = pack2(o[2], o[3]); r[2] = pack2(o[4], o[5]); r[3] = pack2(o[6], o[7]);
    *(u32x4*)(hb.OI + gidx) = r;
  }
  __syncthreads();
  }
}

constexpr int SC_NS = 6, SC_STAGE = 12288;
DI void scan_issue(char* smem, int slot, const u16* QI, const u16* KIT, const u16* VTc, const float* DEC, int b, int h, int vg, int n, int tid) {
  char* st = smem + slot * SC_STAGE + tid * 16;
  const size_t tok0 = (size_t)b * 4096 + n * 16;
  const int row = tid >> 4, lc = (tid & 15) ^ row;
  GLDS16(QI + (tok0 + row) * 1024 + h * 128 + lc * 8, st);
  const size_t cb = ((size_t)(b * 8 + h) * 256 + n) * 2048;
  GLDS16(KIT + cb + tid * 8, st + 4096);
  const float* dp = DEC + ((size_t)b * 256 + n) * 1024 + h * 128;
  const void* g3 = tid < 128 ? (const void*)(VTc + cb + vg * 1024 + tid * 8) : (const void*)(dp + ((tid - 128) & 31) * 4);
  GLDS16(g3, st + 8192);
}

struct ScanRegs { bf16x8 qa[4]; bf16x8 ka[8]; bf16x8 vb; };

DI void scan_read(ScanRegs& r, const char* st, int wid, int fr, int fq) {
#pragma unroll
  for (int ks = 0; ks < 4; ++ks) {
    const int l0 = 4 * ks + (fq >> 1), l1 = l0 + 2;
    const bf16x4 lo = *(const bf16x4*)(st + fr * 256 + ((l0 ^ fr) * 16) + (fq & 1) * 8);
    const bf16x4 hi = *(const bf16x4*)(st + fr * 256 + ((l1 ^ fr) * 16) + (fq & 1) * 8);
    r.qa[ks] = cat4(lo, hi);
  }
  r.vb = *(const bf16x8*)(st + 8192 + (wid * 16 + fr) * 32 + (fq & 1) * 16);
#pragma unroll
  for (int dt = 0; dt < 8; ++dt) r.ka[dt] = *(const bf16x8*)(st + 4096 + (dt * 16 + fr) * 32 + (fq & 1) * 16);
}

DI void scan_compute(f32x4 (&S)[8], ScanRegs& r, const f32x4 (&dc)[8], u16* op, int fq) {
  const bf16x8 z8 = {0, 0, 0, 0, 0, 0, 0, 0};
  if (fq >= 2) r.vb = z8;
  f32x4 o0 = zero4(), o1 = zero4();
  o0 = MFMA32(r.qa[0], pack8(S[0], S[1]), o0);
  o1 = MFMA32(r.qa[1], pack8(S[2], S[3]), o1);
  o0 = MFMA32(r.qa[2], pack8(S[4], S[5]), o0);
  o1 = MFMA32(r.qa[3], pack8(S[6], S[7]), o1);
#pragma unroll
  for (int dt = 0; dt < 8; ++dt) {
    if (fq >= 2) r.ka[dt] = z8;
    S[dt] = S[dt] * dc[dt];
    S[dt] = MFMA32(r.ka[dt], r.vb, S[dt]);
  }
  const f32x4 o = o0 + o1;
  const u32 w0 = pack2(o[0], o[1]), w1 = pack2(o[2], o[3]);
  asm volatile("global_store_short %0, %1, off" :: "v"(op), "v"(w0) : "memory");
  asm volatile("global_store_short_d16_hi %0, %1, off" :: "v"(op + 1024), "v"(w0) : "memory");
  asm volatile("global_store_short %0, %1, off" :: "v"(op + 2048), "v"(w1) : "memory");
  asm volatile("global_store_short_d16_hi %0, %1, off" :: "v"(op + 3072), "v"(w1) : "memory");
}

DI void hg_scan_phase(const HgBufs& hb, char* smem) {
  const int tid = otid(), lane = tid & 63, wid = tid >> 6, fr = lane & 15, fq = lane >> 4;
  for (int item = blockIdx.x; item < 128; item += gridDim.x) {
    const int vg = item & 1, dir = (item >> 1) & 1, h = (item >> 2) & 7, b = item >> 5;
    const u16* QI = dir ? hb.QIb : hb.QIf; const u16* KIT = dir ? hb.KITb : hb.KITf;
    const float* DEC = dir ? hb.DECb : hb.DECf; u16* Oout = dir ? hb.OB : hb.OF;
    const int vs = vg * 4 + wid;
    u16* obase = Oout + ((size_t)b * 4096 + fq * 4) * 1024 + h * 128 + vs * 16 + fr;
    f32x4 S[8];
#pragma unroll
    for (int i = 0; i < 8; ++i) S[i] = zero4();
#pragma unroll
    for (int s = 0; s < SC_NS - 1; ++s) scan_issue(smem, s, QI, KIT, hb.VTc, DEC, b, h, vg, dir ? 255 - s : s, tid);
    asm volatile("s_waitcnt vmcnt(12)" ::: "memory");
    __builtin_amdgcn_s_barrier();
    asm volatile("" ::: "memory");
    ScanRegs ra, rb;
    scan_read(ra, smem, wid, fr, fq);
    int slot = 0;
#define SCAN_STEP(STEP, CUR, NXT) do { \
      const int step_ = (STEP); \
      if (step_ < 4) asm volatile("s_waitcnt vmcnt(9) lgkmcnt(0)" ::: "memory"); \
      else asm volatile("s_waitcnt vmcnt(25) lgkmcnt(0)" ::: "memory"); \
      __builtin_amdgcn_s_barrier(); \
      asm volatile("" ::: "memory"); \
      { const int ns_ = min(step_ + SC_NS - 1, 255); \
        int is_ = slot + SC_NS - 1; if (is_ >= SC_NS) is_ -= SC_NS; \
        scan_issue(smem, is_, QI, KIT, hb.VTc, DEC, b, h, vg, dir ? 255 - ns_ : ns_, tid); } \
      f32x4 dc_[8]; \
      { const char* st_ = smem + slot * SC_STAGE + 8192 + 2048 + fq * 16; \
        _Pragma("unroll") for (int dt = 0; dt < 8; ++dt) dc_[dt] = *(const f32x4*)(st_ + dt * 64); } \
      int nslot_ = slot + 1; if (nslot_ == SC_NS) nslot_ = 0; \
      if (step_ + 1 < 256) scan_read(NXT, smem + nslot_ * SC_STAGE, wid, fr, fq); \
      { const int n_ = dir ? 255 - step_ : step_; \
        scan_compute(S, CUR, dc_, obase + (size_t)n_ * 16 * 1024, fq); } \
      slot = nslot_; } while (0)
    for (int step = 0; step < 256; step += 2) {
      SCAN_STEP(step, ra, rb);
      SCAN_STEP(step + 1, rb, ra);
    }
#undef SCAN_STEP
    asm volatile("s_waitcnt vmcnt(0)" ::: "memory");
    __syncthreads();
  }
}

DI void hg_combine_phase(const HgBufs& hb, const float* __restrict__ gnorm, int rows) {
  const int lane = otid() & 63, wid = otid() >> 6;
  const int h = lane >> 3, c16 = (lane & 7) * 16;
  const int stride = gridDim.x * 4;
  f32x4 gn[4];
#pragma unroll
  for (int i = 0; i < 4; ++i) gn[i] = *(const f32x4*)(gnorm + c16 + i * 4);
  for (int row = blockIdx.x * 4 + wid; row < rows; row += stride * 2) {
    u32x4 ra[2][2], rf[2][2], rb[2][2], rg[2][2];
#pragma unroll
    for (int j = 0; j < 2; ++j) {
      const int rj = row + j * stride;
      if (rj < rows) {
        const size_t g = (size_t)rj * 1024 + h * 128 + c16;
#pragma unroll
        for (int half = 0; half < 2; ++half) {
          ra[j][half] = *(const u32x4*)(hb.OI + g + half * 8); rf[j][half] = *(const u32x4*)(hb.OF + g + half * 8);
          rb[j][half] = *(const u32x4*)(hb.OB + g + half * 8); rg[j][half] = *(const u32x4*)(hb.G + g + half * 8);
        }
      }
    }
#pragma unroll
    for (int j = 0; j < 2; ++j) {
      const int rj = row + j * stride;
      if (rj < rows) {
        const size_t g = (size_t)rj * 1024 + h * 128 + c16;
        float o[16]; float ss = 0.f;
#pragma unroll
        for (int half = 0; half < 2; ++half)
#pragma unroll
          for (int e = 0; e < 8; ++e) { float v = bfget(ra[j][half], e) + bfget(rf[j][half], e) + bfget(rb[j][half], e); o[half * 8 + e] = v; ss += v * v; }
        ss += __shfl_xor(ss, 1); ss += __shfl_xor(ss, 2); ss += __shfl_xor(ss, 4);
        const float rstd = rsqrtf(ss * (1.f / 128.f) + EPS);
#pragma unroll
        for (int half = 0; half < 2; ++half) {
          u32x4 r;
#pragma unroll
          for (int e2 = 0; e2 < 4; ++e2) {
            const int e = half * 8 + 2 * e2;
            r[e2] = pack2(o[e] * rstd * gn[e >> 2][e & 3] * bfget(rg[j][half], 2 * e2), o[e + 1] * rstd * gn[(e + 1) >> 2][(e + 1) & 3] * bfget(rg[j][half], 2 * e2 + 1));
          }
          *(u32x4*)(hb.Y + g + half * 8) = r;
        }
      }
    }
  }
}

DI void na_attn_item(const u16* __restrict__ Q, const u16* __restrict__ K, const u16* __restrict__ VT, const float* __restrict__ rpb, u16* __restrict__ O, int item, int fr, int fq) {
  const int qt = item & 3, h = (item >> 2) & 15, r = (item >> 6) & 63, b = item >> 12;
  const int r0 = min(max(r - 4, 0), 56);
  const int cw0 = qt == 0 ? 0 : qt == 1 ? 8 : qt == 2 ? 24 : 32;
  const size_t tokq = (size_t)b * 4096 + r * 64 + qt * 16 + fr;
  bf16x8 qf[2];
#pragma unroll
  for (int ks = 0; ks < 2; ++ks) qf[ks] = *(const bf16x8*)(Q + tokq * 1024 + h * 64 + ks * 32 + fq * 8);
  f32x4 s[8][2];
#pragma unroll
  for (int kr = 0; kr < 8; ++kr)
#pragma unroll
    for (int hf = 0; hf < 2; ++hf) {
      const size_t tokk = (size_t)b * 4096 + (r0 + kr) * 64 + cw0 + hf * 16 + fr;
      const bf16x8 k0 = *(const bf16x8*)(K + tokk * 1024 + h * 64 + fq * 8);
      const bf16x8 k1 = *(const bf16x8*)(K + tokk * 1024 + h * 64 + 32 + fq * 8);
      f32x4 a = MFMA32(k0, qf[0], zero4());
      s[kr][hf] = MFMA32(k1, qf[1], a);
    }
  const int qc = qt * 16 + fr;
  const int cs = min(max(qc - 8, 0), 48);
  float mx = -1e30f;
#pragma unroll
  for (int kr = 0; kr < 8; ++kr) {
    const float* rp = rpb + (h * 15 + (r0 + kr - r + 7)) * 31;
#pragma unroll
    for (int hf = 0; hf < 2; ++hf)
#pragma unroll
      for (int j = 0; j < 4; ++j) {
        const int kc = cw0 + hf * 16 + fq * 4 + j;
        const bool valid = (kc >= cs) && (kc < cs + 16);
        const int ci = min(max(kc - qc + 15, 0), 30);
        const float v = valid ? s[kr][hf][j] + rp[ci] * LOG2E : -1e30f;
        s[kr][hf][j] = v; mx = fmaxf(mx, v);
      }
  }
  mx = fmaxf(mx, __shfl_xor(mx, 16)); mx = fmaxf(mx, __shfl_xor(mx, 32));
  float l = 0.f;
#pragma unroll
  for (int kr = 0; kr < 8; ++kr)
#pragma unroll
    for (int hf = 0; hf < 2; ++hf)
#pragma unroll
      for (int j = 0; j < 4; ++j) { const float pv = __builtin_amdgcn_exp2f(s[kr][hf][j] - mx); s[kr][hf][j] = pv; l += pv; }
  l += __shfl_xor(l, 16); l += __shfl_xor(l, 32);
  f32x4 o[4];
#pragma unroll
  for (int dt = 0; dt < 4; ++dt) o[dt] = zero4();
#pragma unroll
  for (int kr = 0; kr < 8; ++kr) {
    const bf16x8 pp = pack8(s[kr][0], s[kr][1]);
#pragma unroll
    for (int dt = 0; dt < 4; ++dt) {
      const u16* vp = VT + ((size_t)((b * 16 + h) * 64 + dt * 16 + fr)) * 4096 + (r0 + kr) * 64 + cw0 + fq * 4;
      const bf16x8 vf = cat4(*(const bf16x4*)vp, *(const bf16x4*)(vp + 16));
      o[dt] = MFMA32(vf, pp, o[dt]);
    }
  }
  const float inv = 1.f / l;
#pragma unroll
  for (int dt = 0; dt < 4; ++dt) *(u32x2*)(O + tokq * 1024 + h * 64 + dt * 16 + fq * 4) = pack4(o[dt] * inv);
}

DI void mla_norm_phase(const u16* __restrict__ CRAW, const float* __restrict__ gq, const float* __restrict__ gkv, u16* __restrict__ CQN, u16* __restrict__ CKVN, float* __restrict__ KROPE) {
  const int lane = otid() & 63, wid = otid() >> 6;
  for (int row = blockIdx.x * 4 + wid; row < MTOK; row += gridDim.x * 4) {
    const u16* c = CRAW + (size_t)row * 1056;
    f32x4 v[3]; float ss = 0.f;
#pragma unroll
    for (int i = 0; i < 3; ++i) {
      const u32x2 w = *(const u32x2*)(c + i * 256 + lane * 4);
      v[i][0] = bflo(w[0]); v[i][1] = bfhi(w[0]); v[i][2] = bflo(w[1]); v[i][3] = bfhi(w[1]);
      ss += v[i][0] * v[i][0] + v[i][1] * v[i][1] + v[i][2] * v[i][2] + v[i][3] * v[i][3];
    }
    ss = wave_sum(ss);
    const float rq = rsqrtf(ss * (1.f / 768.f) + EPS);
#pragma unroll
    for (int i = 0; i < 3; ++i) {
      const f32x4 g4 = *(const f32x4*)(gq + i * 256 + lane * 4);
      *(u32x2*)(CQN + (size_t)row * 768 + i * 256 + lane * 4) = pack4(v[i] * rq * g4);
    }
    {
      const u32x2 w = *(const u32x2*)(c + 768 + lane * 4);
      f32x4 k; k[0] = bflo(w[0]); k[1] = bfhi(w[0]); k[2] = bflo(w[1]); k[3] = bfhi(w[1]);
      float s2 = wave_sum(k[0] * k[0] + k[1] * k[1] + k[2] * k[2] + k[3] * k[3]);
      const float rk = rsqrtf(s2 * (1.f / 256.f) + EPS);
      const f32x4 g4 = *(const f32x4*)(gkv + lane * 4);
      *(u32x2*)(CKVN + (size_t)row * 256 + lane * 4) = pack4(k * rk * g4);
    }
    if (lane < 8) {
      const u32x2 w = *(const u32x2*)(c + 1024 + lane * 4);
      f32x4 k; k[0] = bflo(w[0]); k[1] = bfhi(w[0]); k[2] = bflo(w[1]); k[3] = bfhi(w[1]);
      *(f32x4*)(KROPE + (size_t)row * 32 + lane * 4) = k;
    }
  }
}

DI void mla_prep_phase(u16* __restrict__ Q, const u16* __restrict__ KVRAW, const float* __restrict__ KROPE, u16* __restrict__ Kout,
                       const float* __restrict__ gq, const float* __restrict__ gk, const float* __restrict__ RC, const float* __restrict__ RS) {
  const int lane = otid() & 63, wid = otid() >> 6;
  const int h = lane >> 2, sub = lane & 3;
  const float QS = 0.10206207261596577f * LOG2E;
  for (int m = blockIdx.x * 4 + wid; m < MTOK; m += gridDim.x * 4) {
    const int t = m & 4095;
    const f32x4 cs = *(const f32x4*)(RC + t * 16 + sub * 4), sn = *(const f32x4*)(RS + t * 16 + sub * 4);
#pragma unroll
    for (int which = 0; which < 2; ++which) {
      float nope[16]; f32x4 ra, rb;
      u16* dstp = (which == 0 ? Q : Kout) + (size_t)m * 1536 + h * 96;
      const float* gn = which == 0 ? gq : gk;
      if (which == 0) {
        const u32x4 w0 = *(const u32x4*)(dstp + sub * 16), w1 = *(const u32x4*)(dstp + sub * 16 + 8);
#pragma unroll
        for (int e = 0; e < 8; ++e) { nope[e] = bfget(w0, e); nope[8 + e] = bfget(w1, e); }
        const u32x2 a2 = *(const u32x2*)(dstp + 64 + sub * 4), b2 = *(const u32x2*)(dstp + 80 + sub * 4);
        ra[0] = bflo(a2[0]); ra[1] = bfhi(a2[0]); ra[2] = bflo(a2[1]); ra[3] = bfhi(a2[1]);
        rb[0] = bflo(b2[0]); rb[1] = bfhi(b2[0]); rb[2] = bflo(b2[1]); rb[3] = bfhi(b2[1]);
      } else {
        const u16* kp = KVRAW + (size_t)m * 2048 + h * 128 + sub * 16;
        const u32x4 w0 = *(const u32x4*)kp, w1 = *(const u32x4*)(kp + 8);
#pragma unroll
        for (int e = 0; e < 8; ++e) { nope[e] = bfget(w0, e); nope[8 + e] = bfget(w1, e); }
        ra = *(const f32x4*)(KROPE + (size_t)m * 32 + sub * 4);
        rb = *(const f32x4*)(KROPE + (size_t)m * 32 + 16 + sub * 4);
      }
      float ss = 0.f;
#pragma unroll
      for (int e = 0; e < 16; ++e) ss += nope[e] * nope[e];
#pragma unroll
      for (int e = 0; e < 4; ++e) ss += ra[e] * ra[e] + rb[e] * rb[e];
      ss += __shfl_xor(ss, 1); ss += __shfl_xor(ss, 2);
      const float rstd = rsqrtf(ss * (1.f / 96.f) + EPS) * (which == 0 ? QS : 1.f);
      u32x4 o0, o1;
#pragma unroll
      for (int e2 = 0; e2 < 4; ++e2) {
        o0[e2] = pack2(nope[2 * e2] * rstd * gn[sub * 16 + 2 * e2], nope[2 * e2 + 1] * rstd * gn[sub * 16 + 2 * e2 + 1]);
        o1[e2] = pack2(nope[8 + 2 * e2] * rstd * gn[sub * 16 + 8 + 2 * e2], nope[9 + 2 * e2] * rstd * gn[sub * 16 + 9 + 2 * e2]);
      }
      f32x4 oa, ob;
#pragma unroll
      for (int e = 0; e < 4; ++e) {
        const float a = ra[e] * rstd * gn[64 + sub * 4 + e], bq = rb[e] * rstd * gn[80 + sub * 4 + e];
        oa[e] = a * cs[e] - bq * sn[e];
        ob[e] = bq * cs[e] + a * sn[e];
      }
      *(u32x4*)(dstp + sub * 16) = o0; *(u32x4*)(dstp + sub * 16 + 8) = o1;
      *(u32x2*)(dstp + 64 + sub * 4) = pack4(oa); *(u32x2*)(dstp + 80 + sub * 4) = pack4(ob);
    }
  }
}

DI void mla_vt_phase(const u16* __restrict__ KVRAW, u16* __restrict__ VT, char* smem) {
  u16* tile = (u16*)smem;
  const int tid = otid();
  for (int item = blockIdx.x; item < 8192; item += gridDim.x) {
    const int tt = item & 63, bh = item >> 6, b = bh >> 4, h = bh & 15;
    {
      const int row = tid >> 2, part = tid & 3;
      const u16* src = KVRAW + ((size_t)b * 4096 + tt * 64 + row) * 2048 + h * 128 + 64 + part * 16;
      const u32x4 w0 = *(const u32x4*)src, w1 = *(const u32x4*)(src + 8);
      u32* d32 = (u32*)(tile + row * 66 + part * 16);
#pragma unroll
      for (int e = 0; e < 4; ++e) { d32[e] = w0[e]; d32[4 + e] = w1[e]; }
    }
    __syncthreads();
    {
      const int d = tid >> 2, tp = (tid & 3) * 16;
      u32x4 o0, o1;
#pragma unroll
      for (int e2 = 0; e2 < 4; ++e2) {
        o0[e2] = (u32)tile[(tp + 2 * e2) * 66 + d] | ((u32)tile[(tp + 2 * e2 + 1) * 66 + d] << 16);
        o1[e2] = (u32)tile[(tp + 8 + 2 * e2) * 66 + d] | ((u32)tile[(tp + 9 + 2 * e2) * 66 + d] << 16);
      }
      u16* dst = VT + ((size_t)(bh * 64 + d)) * 4096 + tt * 64 + tp;
      *(u32x4*)dst = o0; *(u32x4*)(dst + 8) = o1;
    }
    __syncthreads();
  }
}

constexpr int FA_KROW = 208, FA_VROW = 144, FA_KT = 64 * FA_KROW, FA_BUF = FA_KT + 64 * FA_VROW;
DI void mla_attn_item(const u16* __restrict__ Q, const u16* __restrict__ Kb, const u16* __restrict__ VT, u16* __restrict__ O, int item, char* smem) {
  const int qb = item & 15, bh = item >> 4, b = bh >> 4, h = bh & 15;
  const int tid = otid(), lane = tid & 63, wid = tid >> 6, fr = lane & 15, fq = lane >> 4;
  bf16x8 qf[4][3];
#pragma unroll
  for (int qt = 0; qt < 4; ++qt) {
    const size_t tq = (size_t)b * 4096 + qb * 256 + wid * 64 + qt * 16 + fr;
#pragma unroll
    for (int ks = 0; ks < 3; ++ks) qf[qt][ks] = *(const bf16x8*)(Q + tq * 1536 + h * 96 + ks * 32 + fq * 8);
  }
  f32x4 o[4][4];
#pragma unroll
  for (int i = 0; i < 4; ++i)
#pragma unroll
    for (int j = 0; j < 4; ++j) o[i][j] = zero4();
  float mrun[4] = {-1e30f, -1e30f, -1e30f, -1e30f}, lrun[4] = {0.f, 0.f, 0.f, 0.f};
  const u16* kg[3]; int ks_off[3];
#pragma unroll
  for (int i = 0; i < 3; ++i) {
    const int c = tid + 256 * i, row = c / 12, kc = c % 12;
    kg[i] = Kb + ((size_t)b * 4096 + row) * 1536 + h * 96 + kc * 8;
    ks_off[i] = row * FA_KROW + kc * 16;
  }
  const u16* vg[2]; int vs_off[2];
#pragma unroll
  for (int i = 0; i < 2; ++i) {
    const int c = tid + 256 * i, d = c >> 3, kc = c & 7;
    vg[i] = VT + ((size_t)(bh * 64 + d)) * 4096 + kc * 8;
    vs_off[i] = FA_KT + d * FA_VROW + kc * 16;
  }
  u32x4 rk[3], rv[2];
#pragma unroll
  for (int i = 0; i < 3; ++i) rk[i] = *(const u32x4*)(kg[i]);
#pragma unroll
  for (int i = 0; i < 2; ++i) rv[i] = *(const u32x4*)(vg[i]);
#pragma unroll
  for (int i = 0; i < 3; ++i) *(u32x4*)(smem + ks_off[i]) = rk[i];
#pragma unroll
  for (int i = 0; i < 2; ++i) *(u32x4*)(smem + vs_off[i]) = rv[i];
#pragma unroll
  for (int qt = 0; qt < 4; ++qt)
#pragma unroll
    for (int ks = 0; ks < 3; ++ks) asm volatile("" :: "v"(qf[qt][ks]));
  __syncthreads();
  for (int kt = 0; kt < 64; ++kt) {
    const int cur = (kt & 1) * FA_BUF, nxt = FA_BUF - cur;
    if (kt + 1 < 64) {
      const size_t key0 = (size_t)(kt + 1) * 64;
#pragma unroll
      for (int i = 0; i < 3; ++i) rk[i] = *(const u32x4*)(kg[i] + key0 * 1536);
#pragma unroll
      for (int i = 0; i < 2; ++i) rv[i] = *(const u32x4*)(vg[i] + key0);
    }
#pragma unroll
    for (int kh = 0; kh < 2; ++kh) {
      f32x4 s[2][4];
#pragma unroll
      for (int kl = 0; kl < 2; ++kl) {
#pragma unroll
        for (int qt = 0; qt < 4; ++qt) s[kl][qt] = zero4();
#pragma unroll
        for (int ks = 0; ks < 3; ++ks) {
          const bf16x8 kf = *(const bf16x8*)(smem + cur + ((kh * 2 + kl) * 16 + fr) * FA_KROW + ks * 64 + fq * 16);
#pragma unroll
          for (int qt = 0; qt < 4; ++qt) s[kl][qt] = MFMA32(kf, qf[qt][ks], s[kl][qt]);
        }
      }
      bf16x8 pp[4];
      {
        float lm[4]; bool need = false;
#pragma unroll
        for (int qt = 0; qt < 4; ++qt) {
          const float m0 = fmaxf(fmaxf(s[0][qt][0], s[0][qt][1]), fmaxf(s[0][qt][2], s[0][qt][3]));
          const float m1 = fmaxf(fmaxf(s[1][qt][0], s[1][qt][1]), fmaxf(s[1][qt][2], s[1][qt][3]));
          lm[qt] = fmaxf(m0, m1);
          need = need || (lm[qt] > mrun[qt] + 8.f);
        }
        if (__any(need)) {
#pragma unroll
          for (int qt = 0; qt < 4; ++qt) {
            float mx = lm[qt];
            mx = fmaxf(mx, __shfl_xor(mx, 16)); mx = fmaxf(mx, __shfl_xor(mx, 32));
            const float mnew = fmaxf(mrun[qt], mx);
            const float alpha = __builtin_amdgcn_exp2f(mrun[qt] - mnew);
            mrun[qt] = mnew;
            lrun[qt] *= alpha;
#pragma unroll
            for (int dt = 0; dt < 4; ++dt) o[dt][qt] = o[dt][qt] * alpha;
          }
        }
#pragma unroll
        for (int qt = 0; qt < 4; ++qt) {
          const float mr = mrun[qt];
          float ps = 0.f;
#pragma unroll
          for (int kl = 0; kl < 2; ++kl)
#pragma unroll
            for (int j = 0; j < 4; ++j) { const float pv = __builtin_amdgcn_exp2f(s[kl][qt][j] - mr); s[kl][qt][j] = pv; ps += pv; }
          lrun[qt] += ps;
          pp[qt] = pack8(s[0][qt], s[1][qt]);
        }
      }
#pragma unroll
      for (int dt = 0; dt < 4; ++dt) {
        const char* vp = smem + cur + FA_KT + (dt * 16 + fr) * FA_VROW + (kh * 32 + fq * 4) * 2;
        const bf16x8 vf = cat4(*(const bf16x4*)vp, *(const bf16x4*)(vp + 32));
#pragma unroll
        for (int qt = 0; qt < 4; ++qt) o[dt][qt] = MFMA32(vf, pp[qt], o[dt][qt]);
      }
    }
    if (kt + 1 < 64) {
#pragma unroll
      for (int i = 0; i < 3; ++i) *(u32x4*)(smem + nxt + ks_off[i]) = rk[i];
#pragma unroll
      for (int i = 0; i < 2; ++i) *(u32x4*)(smem + nxt + vs_off[i]) = rv[i];
    }
    __syncthreads();
  }
#pragma unroll
  for (int qt = 0; qt < 4; ++qt) {
    float l = lrun[qt];
    l += __shfl_xor(l, 16); l += __shfl_xor(l, 32);
    const float inv = 1.f / l;
    const size_t tq = (size_t)b * 4096 + qb * 256 + wid * 64 + qt * 16 + fr;
#pragma unroll
    for (int dt = 0; dt < 4; ++dt) *(u32x2*)(O + tq * 1024 + h * 64 + dt * 16 + fq * 4) = pack4(o[dt][qt] * inv);
  }
}

#define XB_TMO      128
#define XB_XCNT(j)  (256  + 64 * (j))
#define XB_XSUB(j)  (1280 + 64 * (j))
#define XB_XGEN(j)  (2304 + 64 * (j))
#define XB_TOP      3328
#define XB_TOPGEN   3392
#define XCD_BAR_WORDS 3456
#define XB_SPIN_CAP (1u << 22)
DI unsigned xb_ld(unsigned* p) { return __hip_atomic_load(p, __ATOMIC_RELAXED, __HIP_MEMORY_SCOPE_AGENT); }
DI unsigned xb_add(unsigned* p, unsigned v) { return __hip_atomic_fetch_add(p, v, __ATOMIC_RELAXED, __HIP_MEMORY_SCOPE_AGENT); }
DI unsigned xb_xcc_id() { return (unsigned)__builtin_amdgcn_s_getreg((3 << 11) | 20) & 0xFu; }
#define XB_SPIN(cond, bar) do { unsigned _sp = 0; while (cond) { __builtin_amdgcn_s_sleep(1); \
    if ((++_sp & 255u) == 0u) { if (xb_ld(&(bar)[XB_TMO])) break; if (_sp > XB_SPIN_CAP) { atomicAdd(&(bar)[XB_TMO], 1u); break; } } } } while (0)

DI void xcd_barrier_complete(unsigned* bar, unsigned x, unsigned& nloc, unsigned& nx) {
  const unsigned G = gridDim.x;
  unsigned sum, cnt, mine, sp = 0u;
  for (;;) {
    sum = 0u; cnt = 0u; mine = 0u;
#pragma unroll
    for (unsigned j = 0; j < 16; ++j) { const unsigned c = xb_ld(&bar[XB_XCNT(j)]); sum += c; cnt += (c > 0u) ? 1u : 0u; mine = (j == x) ? c : mine; }
    if (sum == G) break;
    __builtin_amdgcn_s_sleep(1);
    if ((++sp & 255u) == 0u) { if (xb_ld(&bar[XB_TMO])) break; if (sp > XB_SPIN_CAP) { atomicAdd(&bar[XB_TMO], 1u); break; } }
  }
  nloc = mine > 0u ? mine : 1u; nx = cnt > 0u ? cnt : 1u;
}

DI void xcd_barrier(unsigned* bar, volatile unsigned* st) {
  asm volatile("s_waitcnt vmcnt(0)" ::: "memory");
  __syncthreads();
  if (threadIdx.x == 0) {
    __builtin_amdgcn_s_waitcnt(0);
    const unsigned x = xb_xcc_id();
    unsigned nloc = st[0], nx = st[1];
    if (nloc == 0u) { xcd_barrier_complete(bar, x, nloc, nx); st[0] = nloc; st[1] = nx; }
    const unsigned old = xb_add(&bar[XB_XSUB(x)], 1u);
    const unsigned gen = old / nloc;
    if (old + 1u == (gen + 1u) * nloc) {
      __builtin_amdgcn_fence(__ATOMIC_RELEASE, "agent");
      asm volatile("s_waitcnt vmcnt(0)" ::: "memory");
      const unsigned og = xb_add(&bar[XB_TOP], 1u);
      const unsigned tg = og / nx;
      if (og + 1u == (tg + 1u) * nx) xb_add(&bar[XB_TOPGEN], 1u);
      else XB_SPIN(xb_ld(&bar[XB_TOPGEN]) == tg, bar);
      __builtin_amdgcn_fence(__ATOMIC_ACQUIRE, "agent");
      xb_add(&bar[XB_XGEN(x)], 1u);
      asm volatile("s_waitcnt vmcnt(0)" ::: "memory");
    } else {
      XB_SPIN(xb_ld(&bar[XB_XGEN(x)]) == gen, bar);
      __builtin_amdgcn_fence(__ATOMIC_ACQUIRE, "agent");
      asm volatile("s_waitcnt vmcnt(0)" ::: "memory");
    }
  }
  __syncthreads();
}

#ifndef ENMASK
#define ENMASK 0xffffffffu
#endif
#define EN(i) ((ENMASK >> (i)) & 1u)
#ifndef DUPMASK
#define DUPMASK 0u
#endif
#define DUP(i) ((DUPMASK >> (i)) & 1u)
#ifndef BAR2
#define BAR2 0
#endif
#define PHASE_BEGIN(i) if (EN(i) && pc >= p.lo && pc < p.hi) for (int rep_ = 0; rep_ < 1 + (int)DUP(i); ++rep_) {
#define PHASE_END } { if (pc >= p.lo && pc + 1 < p.hi) { if (pc == p.lo) grid.sync(); else { xcd_barrier(bar, st); if (BAR2) xcd_barrier(bar, st); } } ++pc; }

__global__ void __launch_bounds__(256, 2) mega(Params p) {
  __shared__ __attribute__((aligned(16))) char smem[73728 + 16];
  cg::grid_group grid = cg::this_grid();
  int pc = 0;
  char* ws = p.ws;
  unsigned* bar = (unsigned*)(ws + OFF_BAR);
  volatile unsigned* st = (volatile unsigned*)(smem + 73728);
  if (threadIdx.x == 0) { st[0] = 0u; st[1] = 0u; (void)xb_add(&bar[XB_XCNT(xb_xcc_id())], 1u); }
  __syncthreads();
  u16* H = (u16*)(ws + OFF_H);
  char* R = ws + OFF_R;
  const float* LB = (const float*)(ws + OFF_TAB);
  const float* RC = LB + 4096; const float* RS = RC + 65536;
  for (int layer = 0; layer < 4; ++layer) {
    const int kind = layer % 3, mi = layer / 3;
    for (int stage = 0; stage < 3; ++stage) {
      if (stage != 1) {
        const float* ng = (stage == 0 ? p.ffn1_norm : p.ffn2_norm) + layer * 1024;
        const u16* wgu = (const u16*)(ws + (stage == 0 ? OFF_WGU1 : OFF_WGU2));
        const u16* wdn = (const u16*)(ws + (stage == 0 ? OFF_WDN1 : OFF_WDN2));
        u16* ACT = (u16*)R;
        PHASE_BEGIN(0)
          const bool first = (layer == 0 && stage == 0);
          if (stage == 0) { if (layer == 0) init_tables(p); cvt_layer(p, layer, smem); }
          norm_phase(first ? p.x : p.X, ng, H, first ? p.X : nullptr, MTOK);
        PHASE_END
        PHASE_BEGIN(1)
          gemm_phase(H, 1024, wgu, 1024, MTOK, 5632, EpiSwiglu{ACT}, smem);
        PHASE_END
        PHASE_BEGIN(2)
          gemm_phase(ACT, 2816, wdn, 2816, MTOK, 1024, EpiResid{p.X, 0.5f}, smem);
        PHASE_END
      } else {
        PHASE_BEGIN(3)
          norm_phase(p.X, p.mix_norm + layer * 1024, H, nullptr, MTOK);
        PHASE_END
        if (kind == 0) {
          constexpr size_t SZ = 32 * MiB;
          HgBufs hb;
          hb.Q = (u16*)(R + 0 * SZ); hb.LFf = (u16*)(R + 1 * SZ); hb.LFb = (u16*)(R + 2 * SZ); hb.V = (u16*)(R + 3 * SZ); hb.G = (u16*)(R + 4 * SZ);
          hb.QIf = (u16*)(R + 5 * SZ); hb.QIb = (u16*)(R + 6 * SZ); hb.KITf = (u16*)(R + 7 * SZ); hb.KITb = (u16*)(R + 8 * SZ);
          hb.VTc = (u16*)(R + 9 * SZ); hb.OI = (u16*)(R + 10 * SZ); hb.OF = hb.Q; hb.OB = hb.LFf; hb.Y = hb.LFb;
          hb.DECf = (float*)(R + 11 * SZ); hb.DECb = (float*)(R + 11 * SZ + 4 * MiB);
          const u16* w_in = (const u16*)(ws + OFF_WMIX); const u16* w_out = (const u16*)(ws + OFF_WMIX + 10485760);
          for (int half = 0; half < 2; ++half) {
            PHASE_BEGIN(4)
              gemm_phase(H + (size_t)half * 16384 * 1024, 1024, w_in, 1024, 16384, 5120, EpiHgIn{hb.Q, hb.LFf, hb.LFb, hb.V, hb.G, LB + layer * 1024}, smem);
            PHASE_END
            PHASE_BEGIN(5)
              hg_prep_phase(hb, smem);
            PHASE_END
            PHASE_BEGIN(6)
              hg_scan_phase(hb, smem);
            PHASE_END
            PHASE_BEGIN(7)
              hg_combine_phase(hb, p.hg_g_norm + mi * 128, 16384);
            PHASE_END
            PHASE_BEGIN(8)
              gemm_phase(hb.Y, 1024, w_out, 1024, 16384, 1024, EpiResid{p.X + (size_t)half * 16384 * 1024, 1.0f}, smem);
            PHASE_END
          }
        } else if (kind == 1) {
          u16* Qn = (u16*)R; u16* Kn = (u16*)(R + 64 * MiB); u16* VT = (u16*)(R + 128 * MiB); u16* On = (u16*)(R + 192 * MiB);
          const u16* w_in = (const u16*)(ws + OFF_WMIX); const u16* w_out = (const u16*)(ws + OFF_WMIX + 6291456);
          PHASE_BEGIN(9)
            gemm_phase(H, 1024, w_in, 1024, MTOK, 3072, EpiNaIn{Qn, Kn, VT, p.na_q_norm + mi * 64, p.na_k_norm + mi * 64}, smem);
          PHASE_END
          PHASE_BEGIN(10)
            const int tid_ = otid(), lane = tid_ & 63, wid = tid_ >> 6, fr = lane & 15, fq = lane >> 4;
            for (int item = blockIdx.x * 4 + wid; item < 32768; item += gridDim.x * 4)
              na_attn_item(Qn, Kn, VT, p.na_rpb + (size_t)mi * 16 * 15 * 31, On, item, fr, fq);
          PHASE_END
          PHASE_BEGIN(11)
            gemm_phase(On, 1024, w_out, 1024, MTOK, 1024, EpiResid{p.X, 1.0f}, smem);
          PHASE_END
        } else {
          u16* VT = H;
          u16* CRAW = (u16*)R; u16* On = (u16*)R;
          u16* CQN = (u16*)(R + 66 * MiB); u16* CKVN = (u16*)(R + 114 * MiB); u16* Kk = (u16*)(R + 66 * MiB);
          float* KROPE = (float*)(R + 162 * MiB);
          u16* Qq = (u16*)(R + 166 * MiB); u16* KVRAW = (u16*)(R + 262 * MiB);
          const u16* w_in = (const u16*)(ws + OFF_WMIX); const u16* w_uq = (const u16*)(ws + OFF_WMIX + 2359296);
          const u16* w_ukv = (const u16*)(ws + OFF_WMIX + 4718592); const u16* w_out = (const u16*)(ws + OFF_WMIX + 5767168);
          PHASE_BEGIN(12)
            gemm_phase(H, 1024, w_in, 1024, MTOK, 1152, EpiStore{CRAW, 1056, 1056}, smem);
          PHASE_END
          PHASE_BEGIN(13)
            mla_norm_phase(CRAW, p.mla_q_a_norm + mi * 768, p.mla_kv_a_norm + mi * 256, CQN, CKVN, KROPE);
          PHASE_END
          PHASE_BEGIN(14)
            gemm_phase(CQN, 768, w_uq, 768, MTOK, 1536, EpiStore{Qq, 1536, 1536}, smem);
            gemm_phase(CKVN, 256, w_ukv, 256, MTOK, 2048, EpiStore{KVRAW, 2048, 2048}, smem);
          PHASE_END
          PHASE_BEGIN(15)
            mla_prep_phase(Qq, KVRAW, KROPE, Kk, p.mla_q_norm + mi * 96, p.mla_k_norm + mi * 96, RC, RS);
            mla_vt_phase(KVRAW, VT, smem);
          PHASE_END
          PHASE_BEGIN(16)
            for (int item = blockIdx.x; item < 2048; item += gridDim.x) mla_attn_item(Qq, Kk, VT, On, item, smem);
          PHASE_END
          PHASE_BEGIN(17)
            gemm_phase(On, 1024, w_out, 1024, MTOK, 1024, EpiResid{p.X, 1.0f}, smem);
          PHASE_END
        }
      }
    }
  }
}

static int count_phases() {
  int n = 0;
  for (int layer = 0; layer < 4; ++layer) {
    int kind = layer % 3;
    n += 3 + 3 + 1;
    n += kind == 0 ? 10 : kind == 1 ? 3 : 6;
  }
  return n;
}

extern "C" void kernel_launch(void* const* d_in, const int* in_sizes, int n_in, void* d_out, int out_size, void* d_ws, size_t ws_size, hipStream_t stream) {
  if (ws_size < WS_NEED) { fprintf(stderr, "workspace too small: %zu < %zu\n", ws_size, WS_NEED); return; }
  static int grid_blocks = 0;
  if (!grid_blocks) {
    int dev = 0, cus = 0, per_cu = 0;
    hipGetDevice(&dev);
    hipDeviceGetAttribute(&cus, hipDeviceAttributeMultiprocessorCount, dev);
    hipOccupancyMaxActiveBlocksPerMultiprocessor(&per_cu, mega, 256, 0);
    if (per_cu > 2) per_cu = 2;
    grid_blocks = cus * per_cu;
  }
  Params p{};
  const float** pf = (const float**)&p;
  for (int i = 0; i < 25; ++i) pf[i] = (const float*)d_in[i];
  p.X = (float*)d_out; p.ws = (char*)d_ws;
  const int total = count_phases();
#if MULTI_LAUNCH
  for (int ph = 0; ph < total; ++ph) {
    p.lo = ph; p.hi = ph + 1;
    hipLaunchKernelGGL(mega, dim3(grid_blocks), dim3(256), 0, stream, p);
  }
#else
  hipMemsetAsync((char*)d_ws + OFF_BAR, 0, 16384, stream);
  p.lo = 0; p.hi = total;
  void* args[] = {&p};
  hipError_t e = hipLaunchCooperativeKernel((void*)mega, dim3(grid_blocks), dim3(256), args, 0, stream);
  if (e != hipSuccess) fprintf(stderr, "cooperative launch failed: %s (grid %d)\n", hipGetErrorString(e), grid_blocks);
#endif
}
```

```cpp
#include <hip/hip_runtime.h>
#include <hip/hip_cooperative_groups.h>
#include <cstdio>
#include <cstdint>
namespace cg = cooperative_groups;

#ifndef MULTI_LAUNCH
#define MULTI_LAUNCH 0
#endif

typedef unsigned short u16;
typedef unsigned int u32;
using bf16x8 = __attribute__((ext_vector_type(8))) short;
using bf16x4 = __attribute__((ext_vector_type(4))) short;
using f32x4 = __attribute__((ext_vector_type(4))) float;
using u32x2 = __attribute__((ext_vector_type(2))) unsigned int;
using u32x4 = __attribute__((ext_vector_type(4))) unsigned int;

#define DI __device__ __forceinline__
#define MFMA32(a, b, c) __builtin_amdgcn_mfma_f32_16x16x32_bf16((a), (b), (c), 0, 0, 0)

constexpr int MTOK = 32768;
constexpr float EPS = 1e-6f;
constexpr float LOG2E = 1.4426950408889634f;

constexpr size_t MiB = 1048576;
constexpr size_t OFF_WGU1 = 0;
constexpr size_t OFF_WDN1 = 11534336;
constexpr size_t OFF_WGU2 = 17301504;
constexpr size_t OFF_WDN2 = 28835840;
constexpr size_t OFF_WMIX = 34603008;
constexpr size_t OFF_TAB = 47185920;
constexpr size_t OFF_BAR = OFF_TAB + 786432;
constexpr size_t OFF_H = 46 * MiB;
constexpr size_t OFF_R = 110 * MiB;
constexpr size_t WS_NEED = 500 * MiB;

struct Params {
  const float* x; const float* ffn1_norm; const float* ffn1_w_gu; const float* ffn1_w_down;
  const float* mix_norm; const float* ffn2_norm; const float* ffn2_w_gu; const float* ffn2_w_down;
  const float* hg_lb_logits; const float* hg_w_in; const float* hg_g_norm; const float* hg_w_out;
  const float* na_w_in; const float* na_q_norm; const float* na_k_norm; const float* na_rpb; const float* na_w_out;
  const float* mla_w_in; const float* mla_q_a_norm; const float* mla_w_uq; const float* mla_kv_a_norm; const float* mla_w_ukv;
  const float* mla_q_norm; const float* mla_k_norm; const float* mla_w_out;
  float* X; char* ws; int lo; int hi;
};

DI u32 f2bf(float x) { u32 u = __float_as_uint(x); u += 0x7fffu + ((u >> 16) & 1u); return u >> 16; }
typedef __bf16 bf16v2 __attribute__((ext_vector_type(2)));
typedef float f32v2 __attribute__((ext_vector_type(2)));
DI u32 pack2(float a, float b) { f32v2 v = {a, b}; bf16v2 r = __builtin_convertvector(v, bf16v2); return __builtin_bit_cast(u32, r); }
DI float bflo(u32 w) { return __uint_as_float(w << 16); }
DI float bfhi(u32 w) { return __uint_as_float(w & 0xffff0000u); }
DI float bfget(const u32x4& v, int e) { u32 w = v[e >> 1]; return (e & 1) ? bfhi(w) : bflo(w); }
DI u32x2 pack4(const f32x4& v) { u32x2 r; r[0] = pack2(v[0], v[1]); r[1] = pack2(v[2], v[3]); return r; }
DI bf16x8 pack8(const f32x4& a, const f32x4& b) {
  u32x4 r; r[0] = pack2(a[0], a[1]); r[1] = pack2(a[2], a[3]); r[2] = pack2(b[0], b[1]); r[3] = pack2(b[2], b[3]);
  return __builtin_bit_cast(bf16x8, r);
}
DI bf16x8 cat4(const bf16x4& lo, const bf16x4& hi) { return __builtin_shufflevector(lo, hi, 0, 1, 2, 3, 4, 5, 6, 7); }
DI float wave_sum(float v) {
#pragma unroll
  for (int o = 32; o > 0; o >>= 1) v += __shfl_xor(v, o);
  return v;
}
DI float sigmoidf_(float z) { return __builtin_amdgcn_rcpf(1.f + __expf(-z)); }
DI float siluf_(float z) { return z * __builtin_amdgcn_rcpf(1.f + __expf(-z)); }
DI int otid() { int t = threadIdx.x; asm volatile("" : "+v"(t)); return t; }
DI f32x4 zero4() { f32x4 z = {0.f, 0.f, 0.f, 0.f}; return z; }

DI void init_tables(const Params& p) {
  float* LB = (float*)(p.ws + OFF_TAB); float* RC = LB + 4096; float* RS = RC + 65536;
  const int gt = blockIdx.x * 256 + otid(), gs = gridDim.x * 256;
  for (int c = gt; c < 1024; c += gs) {
    float l0 = p.hg_lb_logits[c], l1 = p.hg_lb_logits[1024 + c], l2 = p.hg_lb_logits[2048 + c], l3 = p.hg_lb_logits[3072 + c];
    float mx = fmaxf(fmaxf(l0, l1), fmaxf(l2, l3));
    float e0 = expf(l0 - mx), e1 = expf(l1 - mx), e2 = expf(l2 - mx), e3 = expf(l3 - mx);
    float inv = 1.f / (e0 + e1 + e2 + e3);
    LB[c] = 0.f; LB[1024 + c] = e1 * inv; LB[2048 + c] = (e1 + e2) * inv; LB[3072 + c] = (e1 + e2 + e3) * inv;
  }
  for (int i = gt; i < 65536; i += gs) {
    int t = i >> 4, j = i & 15;
    float inv = exp2f(-(float)j * (13.287712379549449f / 16.f));
    float ang = (float)t * inv;
    double a = (double)ang;
    double k = rint(a * 0.15915494309189535);
    float r = (float)(a - k * 6.283185307179586);
    RC[i] = __cosf(r); RS[i] = __sinf(r);
  }
}

DI void cvt_tiles(const float* __restrict__ src, u16* __restrict__ dst, int K, int N, int Nd, int mode, char* smem) {
  float* tile = (float*)smem;
  const int tk = K >> 6, tn = Nd >> 6, tid = otid();
  for (int t = blockIdx.x; t < tk * tn; t += gridDim.x) {
    const int k0 = (t % tk) << 6, n0 = (t / tk) << 6;
    {
      const int nl = tid & 63, kq = tid >> 6;
      const int nd = n0 + nl;
      int col = nd;
      if (mode == 1) { int a = nd >> 5, r = nd & 31; col = a * 16 + (r & 15) + ((r >= 16) ? 2816 : 0); }
      const bool ok = col < N;
#pragma unroll
      for (int i = 0; i < 16; ++i) {
        int kl = kq + 4 * i;
        tile[kl * 65 + nl] = ok ? src[(size_t)(k0 + kl) * N + col] : 0.f;
      }
    }
    __syncthreads();
    {
      const int kp = (tid & 31) * 2, nq = tid >> 5;
#pragma unroll
      for (int i = 0; i < 8; ++i) {
        int n = nq + 8 * i;
        *(u32*)(dst + (size_t)(n0 + n) * K + k0 + kp) = pack2(tile[kp * 65 + n], tile[(kp + 1) * 65 + n]);
      }
    }
    __syncthreads();
  }
}

DI void cvt_layer(const Params& p, int layer, char* smem) {
  const int kind = layer % 3, mi = layer / 3;
  char* ws = p.ws;
  for (int task = 0; task < 8; ++task) {
    const float* src = nullptr; size_t off = 0; int K = 0, N = 0, Nd = 0, mode = 0;
    if (task == 0) { src = p.ffn1_w_gu + (size_t)layer * 1024 * 5632; off = OFF_WGU1; K = 1024; N = 5632; Nd = 5632; mode = 1; }
    else if (task == 1) { src = p.ffn1_w_down + (size_t)layer * 2816 * 1024; off = OFF_WDN1; K = 2816; N = 1024; Nd = 1024; }
    else if (task == 2) { src = p.ffn2_w_gu + (size_t)layer * 1024 * 5632; off = OFF_WGU2; K = 1024; N = 5632; Nd = 5632; mode = 1; }
    else if (task == 3) { src = p.ffn2_w_down + (size_t)layer * 2816 * 1024; off = OFF_WDN2; K = 2816; N = 1024; Nd = 1024; }
    else if (kind == 0) {
      if (task == 4) { src = p.hg_w_in + (size_t)mi * 1024 * 5120; off = OFF_WMIX; K = 1024; N = 5120; Nd = 5120; }
      else if (task == 5) { src = p.hg_w_out + (size_t)mi * 1024 * 1024; off = OFF_WMIX + 10485760; K = 1024; N = 1024; Nd = 1024; }
    } else if (kind == 1) {
      if (task == 4) { src = p.na_w_in + (size_t)mi * 1024 * 3072; off = OFF_WMIX; K = 1024; N = 3072; Nd = 3072; }
      else if (task == 5) { src = p.na_w_out + (size_t)mi * 1024 * 1024; off = OFF_WMIX + 6291456; K = 1024; N = 1024; Nd = 1024; }
    } else {
      if (task == 4) { src = p.mla_w_in + (size_t)mi * 1024 * 1056; off = OFF_WMIX; K = 1024; N = 1056; Nd = 1152; }
      else if (task == 5) { src = p.mla_w_uq + (size_t)mi * 768 * 1536; off = OFF_WMIX + 2359296; K = 768; N = 1536; Nd = 1536; }
      else if (task == 6) { src = p.mla_w_ukv + (size_t)mi * 256 * 2048; off = OFF_WMIX + 4718592; K = 256; N = 2048; Nd = 2048; }
      else if (task == 7) { src = p.mla_w_out + (size_t)mi * 1024 * 1024; off = OFF_WMIX + 5767168; K = 1024; N = 1024; Nd = 1024; }
    }
    if (src) cvt_tiles(src, (u16*)(ws + off), K, N, Nd, mode, smem);
  }
}

DI void norm_phase(const float* __restrict__ src, const float* __restrict__ gain, u16* __restrict__ dst, float* copy_dst, int rows) {
  const int lane = otid() & 63, wid = otid() >> 6;
  f32x4 g[4];
#pragma unroll
  for (int i = 0; i < 4; ++i) g[i] = *(const f32x4*)(gain + i * 256 + lane * 4);
  const int stride = gridDim.x * 4;
  for (int row = blockIdx.x * 4 + wid; row < rows; row += stride * 4) {
    f32x4 v[4][4];
#pragma unroll
    for (int j = 0; j < 4; ++j) {
      const int rj = row + j * stride;
      if (rj < rows) {
#pragma unroll
        for (int i = 0; i < 4; ++i) v[j][i] = *(const f32x4*)(src + (size_t)rj * 1024 + i * 256 + lane * 4);
      }
    }
#pragma unroll
    for (int j = 0; j < 4; ++j) {
      const int rj = row + j * stride;
      if (rj < rows) {
        float ss = 0.f;
#pragma unroll
        for (int i = 0; i < 4; ++i) ss += v[j][i][0] * v[j][i][0] + v[j][i][1] * v[j][i][1] + v[j][i][2] * v[j][i][2] + v[j][i][3] * v[j][i][3];
        ss = wave_sum(ss);
        const float rstd = rsqrtf(ss * (1.f / 1024.f) + EPS);
#pragma unroll
        for (int i = 0; i < 4; ++i) {
          f32x4 y = v[j][i] * rstd * g[i];
          *(u32x2*)(dst + (size_t)rj * 1024 + i * 256 + lane * 4) = pack4(y);
          if (copy_dst) *(f32x4*)(copy_dst + (size_t)rj * 1024 + i * 256 + lane * 4) = v[j][i];
        }
      }
    }
  }
}

#define GLDS16(gp, lp) __builtin_amdgcn_global_load_lds((const unsigned*)(gp), (unsigned*)(lp), 16, 0, 0)

constexpr int G_STAGE = 24576, G_WOFF = 16384, G_NS = 3, G_MT = 8;

template <class Epi>
DI void gemm_phase(const u16* __restrict__ A, int lda, const u16* __restrict__ W, int K, int Mrows, int Ncols, const Epi& epi, char* smem) {
  const int mtn = Mrows >> 8, ntn = Ncols >> 7;
  const int ntiles = mtn * ntn, nk = K >> 5;
  constexpr int GM = 16;
  const int bid = blockIdx.x, gsz = gridDim.x;
  const int my_tiles = bid < ntiles ? (ntiles - bid + gsz - 1) / gsz : 0;
  const int total = my_tiles * nk;
  if (total > 0) {
    const int tid = otid(), lane = tid & 63, wid = tid >> 6;
    const int wm = wid >> 1, wn = wid & 1, fr = lane & 15, fq = lane >> 4;
    f32x4 acc[4][G_MT];
#pragma unroll
    for (int i = 0; i < 4; ++i)
#pragma unroll
      for (int j = 0; j < G_MT; ++j) acc[i][j] = zero4();
    const int lrow = tid >> 2, lc = (tid & 3) ^ ((tid >> 4) & 3);
    char* sdst = smem + tid * 16;
    const int ro = (fq ^ (fr >> 2)) * 16;
    const char* sa_rd = smem + (wm * 128 + fr) * 64 + ro;
    const char* sw_rd = smem + G_WOFF + (wn * 64 + fr) * 64 + ro;
    int ij = 0, ik = 0;
    const u16 *ga, *gw;
    {
      const int tile = bid, group = tile / (GM * ntn), rem = tile % (GM * ntn);
      const int mt = group * GM + (rem % GM), nt = rem / GM;
      ga = A + ((size_t)mt * 256 + lrow) * lda + lc * 8; gw = W + ((size_t)nt * 128 + lrow) * K + lc * 8;
    }
    __builtin_amdgcn_s_barrier();
    asm volatile("" ::: "memory");
#define G_ISSUE(SLOT) do { \
      const int k0_ = ik << 5; char* sd_ = sdst + (SLOT) * G_STAGE; \
      _Pragma("unroll") for (int i = 0; i < 4; ++i) GLDS16(ga + (size_t)(64 * i) * lda + k0_, sd_ + i * 4096); \
      _Pragma("unroll") for (int i = 0; i < 2; ++i) GLDS16(gw + (size_t)(64 * i) * K + k0_, sd_ + G_WOFF + i * 4096); \
      if (++ik == nk) { ik = 0; ++ij; if (ij < my_tiles) { \
        const int tile = bid + ij * gsz, group = tile / (GM * ntn), rem = tile % (GM * ntn); \
        const int mt = group * GM + (rem % GM), nt = rem / GM; \
        ga = A + ((size_t)mt * 256 + lrow) * lda + lc * 8; gw = W + ((size_t)nt * 128 + lrow) * K + lc * 8; } } } while (0)
    G_ISSUE(0);
    if (total > 1) G_ISSUE(1);
    int slot = 0, ck = 0, cj = 0;
    for (int step = 0; step < total; ++step) {
      if (step + 1 < total) asm volatile("s_waitcnt vmcnt(6)" ::: "memory");
      else asm volatile("s_waitcnt vmcnt(0)" ::: "memory");
      __builtin_amdgcn_s_barrier();
      asm volatile("" ::: "memory");
      const bool doiss = step + 2 < total;
      int isl = slot + 2; if (isl >= G_NS) isl -= G_NS;
      char* sd2 = sdst + isl * G_STAGE;
      const int k02 = ik << 5;
#define G_PA(i) do { if (doiss) GLDS16(ga + (size_t)(64 * (i)) * lda + k02, sd2 + (i) * 4096); } while (0)
#define G_PW(i) do { if (doiss) GLDS16(gw + (size_t)(64 * (i)) * K + k02, sd2 + G_WOFF + (i) * 4096); } while (0)
      const int cur = slot * G_STAGE;
      bf16x8 af[G_MT], wf[4];
#pragma unroll
      for (int i = 0; i < 4; ++i) wf[i] = *(const bf16x8*)(sw_rd + cur + i * 1024);
#pragma unroll
      for (int i = 0; i < 4; ++i) af[i] = *(const bf16x8*)(sa_rd + cur + i * 1024);
      G_PA(0); G_PA(1);
      __builtin_amdgcn_sched_barrier(0);
      acc[0][0] = MFMA32(wf[0], af[0], acc[0][0]);
      __builtin_amdgcn_sched_barrier(0);
#pragma unroll
      for (int i = 4; i < G_MT; ++i) af[i] = *(const bf16x8*)(sa_rd + cur + i * 1024);
      __builtin_amdgcn_sched_barrier(0);
#pragma unroll
      for (int mt = 0; mt < 2; ++mt)
#pragma unroll
        for (int nt = 0; nt < 4; ++nt) if (mt + nt > 0) acc[nt][mt] = MFMA32(wf[nt], af[mt], acc[nt][mt]);
      __builtin_amdgcn_sched_barrier(0);
      G_PA(2);
      __builtin_amdgcn_sched_barrier(0);
#pragma unroll
      for (int mt = 2; mt < 4; ++mt)
#pragma unroll
        for (int nt = 0; nt < 4; ++nt) acc[nt][mt] = MFMA32(wf[nt], af[mt], acc[nt][mt]);
      __builtin_amdgcn_sched_barrier(0);
      G_PA(3);
      __builtin_amdgcn_sched_barrier(0);
#pragma unroll
      for (int mt = 4; mt < 6; ++mt)
#pragma unroll
        for (int nt = 0; nt < 4; ++nt) acc[nt][mt] = MFMA32(wf[nt], af[mt], acc[nt][mt]);
      __builtin_amdgcn_sched_barrier(0);
      G_PW(0);
      __builtin_amdgcn_sched_barrier(0);
#pragma unroll
      for (int mt = 6; mt < G_MT; ++mt)
#pragma unroll
        for (int nt = 0; nt < 4; ++nt) acc[nt][mt] = MFMA32(wf[nt], af[mt], acc[nt][mt]);
      __builtin_amdgcn_sched_barrier(0);
      G_PW(1);
#undef G_PA
#undef G_PW
      if (doiss) {
        if (++ik == nk) { ik = 0; ++ij; if (ij < my_tiles) {
          const int tile = bid + ij * gsz, group = tile / (GM * ntn), rem = tile % (GM * ntn);
          const int mt = group * GM + (rem % GM), nt = rem / GM;
          ga = A + ((size_t)mt * 256 + lrow) * lda + lc * 8; gw = W + ((size_t)nt * 128 + lrow) * K + lc * 8; } }
      }
      if (++slot == G_NS) slot = 0;
      if (++ck == nk) {
        const int tile = bid + cj * gsz, group = tile / (GM * ntn), rem = tile % (GM * ntn);
        const int mt = group * GM + (rem % GM), nt = rem / GM;
        epi(acc, mt * 256 + wm * 128, nt * 128 + wn * 64, fr, fq);
#pragma unroll
        for (int i = 0; i < 4; ++i)
#pragma unroll
          for (int j = 0; j < G_MT; ++j) acc[i][j] = zero4();
        ck = 0; ++cj;
      }
    }
#undef G_ISSUE
  }
  __syncthreads();
}

struct EpiSwiglu {
  u16* act;
  DI void operator()(f32x4 (&acc)[4][G_MT], int mb, int nb, int fr, int fq) const {
#pragma unroll
    for (int mt = 0; mt < G_MT; ++mt) {
      const int m = mb + mt * 16 + fr;
#pragma unroll
      for (int np = 0; np < 2; ++np) {
        const f32x4 g = acc[2 * np][mt], u = acc[2 * np + 1][mt];
        f32x4 r;
#pragma unroll
        for (int j = 0; j < 4; ++j) r[j] = siluf_(g[j]) * u[j];
        const int jc = (nb >> 1) + np * 16 + fq * 4;
        *(u32x2*)(act + (size_t)m * 2816 + jc) = pack4(r);
      }
    }
  }
};

struct EpiResid {
  float* X; float scale;
  DI void operator()(f32x4 (&acc)[4][G_MT], int mb, int nb, int fr, int fq) const {
#pragma unroll
    for (int mt = 0; mt < G_MT; ++mt) {
      const int m = mb + mt * 16 + fr;
#pragma unroll
      for (int nt = 0; nt < 4; ++nt) {
        f32x4* ptr = (f32x4*)(X + (size_t)m * 1024 + nb + nt * 16 + fq * 4);
        f32x4 v = *ptr;
        v += acc[nt][mt] * scale;
        *ptr = v;
      }
    }
  }
};

struct EpiStore {
  u16* out; int ldo; int nmax;
  DI void operator()(f32x4 (&acc)[4][G_MT], int mb, int nb, int fr, int fq) const {
#pragma unroll
    for (int mt = 0; mt < G_MT; ++mt) {
      const int m = mb + mt * 16 + fr;
#pragma unroll
      for (int nt = 0; nt < 4; ++nt) {
        const int n = nb + nt * 16 + fq * 4;
        if (n < nmax) *(u32x2*)(out + (size_t)m * ldo + n) = pack4(acc[nt][mt]);
      }
    }
  }
};

struct EpiHgIn {
  u16 *Q, *LFf, *LFb, *V, *G; const float* lb;
  DI void operator()(f32x4 (&acc)[4][G_MT], int mb, int nb, int fr, int fq) const {
    const int seg = nb >> 10, c0 = nb & 1023;
    u16* dst = seg == 0 ? Q : seg == 1 ? LFf : seg == 2 ? LFb : seg == 3 ? V : G;
#pragma unroll
    for (int mt = 0; mt < G_MT; ++mt) {
      const int m = mb + mt * 16 + fr;
#pragma unroll
      for (int nt = 0; nt < 4; ++nt) {
        const int c = c0 + nt * 16 + fq * 4;
        f32x4 a = acc[nt][mt], r;
        if (seg == 0) r = a * 0.08838834764831845f;
        else if (seg == 3) r = a;
        else if (seg == 4) {
#pragma unroll
          for (int j = 0; j < 4; ++j) r[j] = siluf_(a[j]);
        } else {
          const f32x4 l4 = *(const f32x4*)(lb + c);
#pragma unroll
          for (int j = 0; j < 4; ++j) {
            float z = fminf(fmaxf(a[j], -30.f), 30.f);
            float f = l4[j] + (1.f - l4[j]) * sigmoidf_(z);
            r[j] = __logf(f);
          }
        }
        *(u32x2*)(dst + (size_t)m * 1024 + c) = pack4(r);
      }
    }
  }
};

struct EpiNaIn {
  u16 *Q, *K, *VT; const float *qn, *kn;
  DI void operator()(f32x4 (&acc)[4][G_MT], int mb, int nb, int fr, int fq) const {
    const int seg = nb >> 10, h = (nb & 1023) >> 6;
    if (seg < 2) {
      u16* dst = seg == 0 ? Q : K;
      const float* gn = seg == 0 ? qn : kn;
      const float sc = seg == 0 ? 0.125f * LOG2E : 1.f;
#pragma unroll
      for (int mt = 0; mt < G_MT; ++mt) {
        const int m = mb + mt * 16 + fr;
        float ss = 0.f;
#pragma unroll
        for (int nt = 0; nt < 4; ++nt)
#pragma unroll
          for (int j = 0; j < 4; ++j) ss += acc[nt][mt][j] * acc[nt][mt][j];
        ss += __shfl_xor(ss, 16); ss += __shfl_xor(ss, 32);
        const float rstd = rsqrtf(ss * (1.f / 64.f) + EPS) * sc;
#pragma unroll
        for (int nt = 0; nt < 4; ++nt) {
          const int d = nt * 16 + fq * 4;
          const f32x4 g4 = *(const f32x4*)(gn + d);
          f32x4 r = acc[nt][mt] * rstd * g4;
          *(u32x2*)(dst + (size_t)m * 1024 + h * 64 + d) = pack4(r);
        }
      }
    } else {
#pragma unroll
      for (int mt = 0; mt < G_MT; ++mt) {
        const int m = mb + mt * 16 + fr;
        const int b = m >> 12, t = m & 4095;
#pragma unroll
        for (int nt = 0; nt < 4; ++nt)
#pragma unroll
          for (int j = 0; j < 4; ++j) {
            const int d = nt * 16 + fq * 4 + j;
            VT[((size_t)((b * 16 + h) * 64 + d)) * 4096 + t] = (u16)f2bf(acc[nt][mt][j]);
          }
      }
    }
  }
};

struct HgBufs {
  u16 *Q, *LFf, *LFb, *V, *G, *QIf, *QIb, *KITf, *KITb, *VTc, *OI, *OF, *OB, *Y;
  float *DECf, *DECb;
};

DI void hg_prep_phase(const HgBufs& hb, char* smem) {
  u32x4 rq, rf, rb, rv;
  {
    const int item0 = blockIdx.x, tid0 = otid();
    if (item0 < 8192) {
      const size_t g0 = ((size_t)(item0 >> 11) * 4096 + ((item0 >> 3) & 255) * 16 + (tid0 >> 4)) * 1024 + (item0 & 7) * 128 + (tid0 & 15) * 8;
      rq = *(const u32x4*)(hb.Q + g0); rf = *(const u32x4*)(hb.LFf + g0); rb = *(const u32x4*)(hb.LFb + g0); rv = *(const u32x4*)(hb.V + g0);
    }
  }
  for (int item = blockIdx.x; item < 8192; item += gridDim.x) {
  const int h = item & 7, n = (item >> 3) & 255, b = item >> 11;
  float* sq = (float*)smem; float* sbf = sq + 2112; float* sbb = sbf + 2112; float* skf = sbb + 2112;
  float* skb = skf + 2112; float* sv = skb + 2112; float* sP = sv + 2112; float* sA = sP + 5120;
  const int tid = otid();
  const int row = tid >> 4, c8 = (tid & 15) * 8;
  const size_t tok0 = (size_t)b * 4096 + n * 16;
  const size_t gidx = (tok0 + row) * 1024 + h * 128 + c8;
  {
#pragma unroll
    for (int e = 0; e < 8; ++e) {
      const int o = row * 132 + c8 + e;
      const float lf = bfget(rf, e), lb_ = bfget(rb, e);
      sq[o] = bfget(rq, e); sbf[o] = lf; sbb[o] = lb_;
      skf[o] = 1.f - __expf(lf); skb[o] = 1.f - __expf(lb_); sv[o] = bfget(rv, e);
    }
  }
  {
    const int nx = item + gridDim.x;
    if (nx < 8192) {
      const size_t g1 = ((size_t)(nx >> 11) * 4096 + ((nx >> 3) & 255) * 16 + row) * 1024 + (nx & 7) * 128 + c8;
      rq = *(const u32x4*)(hb.Q + g1); rf = *(const u32x4*)(hb.LFf + g1); rb = *(const u32x4*)(hb.LFb + g1); rv = *(const u32x4*)(hb.V + g1);
    }
  }
  __syncthreads();
  if (tid < 128) {
    const int d = tid; float a = 0.f;
#pragma unroll
    for (int t = 0; t < 16; ++t) { a += sbf[t * 132 + d]; sbf[t * 132 + d] = a; }
    hb.DECf[((size_t)b * 256 + n) * 1024 + h * 128 + d] = __expf(a);
  } else {
    const int d = tid - 128; float a = 0.f;
#pragma unroll
    for (int t = 15; t >= 0; --t) { a += sbb[t * 132 + d]; sbb[t * 132 + d] = a; }
    hb.DECb[((size_t)b * 256 + n) * 1024 + h * 128 + d] = __expf(a);
  }
  __syncthreads();
  {
    u32x4 of, ob;
#pragma unroll
    for (int e2 = 0; e2 < 4; ++e2) {
      const int o = row * 132 + c8 + 2 * e2;
      const float q0 = sq[o], q1 = sq[o + 1];
      of[e2] = pack2(q0 * __expf(sbf[o]), q1 * __expf(sbf[o + 1]));
      ob[e2] = pack2(q0 * __expf(sbb[o]), q1 * __expf(sbb[o + 1]));
    }
    *(u32x4*)(hb.QIf + gidx) = of; *(u32x4*)(hb.QIb + gidx) = ob;
  }
  {
    const int d = tid >> 1, t8 = (tid & 1) * 8;
    const float blf = sbf[15 * 132 + d], blb = sbb[d];
    u32x4 kf, kb, vv;
#pragma unroll
    for (int e2 = 0; e2 < 4; ++e2) {
      const int o0 = (t8 + 2 * e2) * 132 + d, o1 = o0 + 132;
      kf[e2] = pack2(skf[o0] * __expf(blf - sbf[o0]), skf[o1] * __expf(blf - sbf[o1]));
      kb[e2] = pack2(skb[o0] * __expf(blb - sbb[o0]), skb[o1] * __expf(blb - sbb[o1]));
      vv[e2] = pack2(sv[o0], sv[o1]);
    }
    const size_t cidx = (((size_t)(b * 8 + h) * 256 + n) * 128 + d) * 16 + t8;
    *(u32x4*)(hb.KITf + cidx) = kf; *(u32x4*)(hb.KITb + cidx) = kb; *(u32x4*)(hb.VTc + cidx) = vv;
  }
  {
    const int s = tid >> 4, dg = tid & 15, d0 = dg * 8, sw0 = (tid >> 6) * 4;
    float w[8];
    {
      const f32x4 a = *(const f32x4*)(skf + s * 132 + d0), b2 = *(const f32x4*)(skf + s * 132 + d0 + 4);
#pragma unroll
      for (int e = 0; e < 4; ++e) { w[e] = a[e]; w[4 + e] = b2[e]; }
    }
    float pdiag = 0.f;
    for (int t = sw0; t < 16; ++t) {
      if (t > s) {
        const f32x4 a = *(const f32x4*)(skf + t * 132 + d0), b2 = *(const f32x4*)(skf + t * 132 + d0 + 4);
#pragma unroll
        for (int e = 0; e < 4; ++e) { w[e] *= (1.f - a[e]); w[4 + e] *= (1.f - b2[e]); }
      }
      const f32x4 q0 = *(const f32x4*)(sq + t * 132 + d0), q1 = *(const f32x4*)(sq + t * 132 + d0 + 4);
      float part = 0.f;
#pragma unroll
      for (int e = 0; e < 4; ++e) part += q0[e] * w[e] + q1[e] * w[4 + e];
      if (t == s) pdiag = part;
      else if (t > s) sP[(t * 16 + s) * 20 + dg] = part;
    }
    {
      const f32x4 a = *(const f32x4*)(skb + s * 132 + d0), b2 = *(const f32x4*)(skb + s * 132 + d0 + 4);
#pragma unroll
      for (int e = 0; e < 4; ++e) { w[e] = a[e]; w[4 + e] = b2[e]; }
    }
    for (int t = sw0 + 3; t >= 0; --t) {
      if (t < s) {
        const f32x4 a = *(const f32x4*)(skb + t * 132 + d0), b2 = *(const f32x4*)(skb + t * 132 + d0 + 4);
#pragma unroll
        for (int e = 0; e < 4; ++e) { w[e] *= (1.f - a[e]); w[4 + e] *= (1.f - b2[e]); }
      }
      const f32x4 q0 = *(const f32x4*)(sq + t * 132 + d0), q1 = *(const f32x4*)(sq + t * 132 + d0 + 4);
      float part = 0.f;
#pragma unroll
      for (int e = 0; e < 4; ++e) part += q0[e] * w[e] + q1[e] * w[4 + e];
      if (t == s) sP[(s * 16 + s) * 20 + dg] = pdiag + part;
      else if (t < s) sP[(t * 16 + s) * 20 + dg] = part;
    }
  }
  __syncthreads();
  {
    const int t = tid >> 4, s = tid & 15;
    const float* pp = sP + (t * 16 + s) * 20;
    const f32x4 p0 = *(const f32x4*)pp, p1 = *(const f32x4*)(pp + 4), p2 = *(const f32x4*)(pp + 8), p3 = *(const f32x4*)(pp + 12);
    const f32x4 ps = (p0 + p1) + (p2 + p3);
    sA[t * 17 + s] = (ps[0] + ps[1]) + (ps[2] + ps[3]);
  }
  __syncthreads();
  {
    float o[8];
#pragma unroll
    for (int e = 0; e < 8; ++e) o[e] = 0.f;
#pragma unroll
    for (int s = 0; s < 16; ++s) {
      const float a = sA[row * 17 + s];
      const f32x4 v0 = *(const f32x4*)(sv + s * 132 + c8), v1 = *(const f32x4*)(sv + s * 132 + c8 + 4);
#pragma unroll
      for (int e = 0; e < 4; ++e) { o[e] += a * v0[e]; o[4 + e] += a * v1[e]; }
    }
    u32x4 r; r[0] = pack2(o[0], o[1]); r[1] = pack2(o[2], o[3]); r[2] = pack2(o[4], o[5]); r[3] = pack2(o[6], o[7]);
    *(u32x4*)(hb.OI + gidx) = r;
  }
  __syncthreads();
  }
}

constexpr int SC_NS = 6, SC_STAGE = 12288;
DI void scan_issue(char* smem, int slot, const u16* QI, const u16* KIT, const u16* VTc, const float* DEC, int b, int h, int vg, int n, int tid) {
  char* st = smem + slot * SC_STAGE + tid * 16;
  const size_t tok0 = (size_t)b * 4096 + n * 16;
  const int row = tid >> 4, lc = (tid & 15) ^ row;
  GLDS16(QI + (tok0 + row) * 1024 + h * 128 + lc * 8, st);
  const size_t cb = ((size_t)(b * 8 + h) * 256 + n) * 2048;
  GLDS16(KIT + cb + tid * 8, st + 4096);
  const float* dp = DEC + ((size_t)b * 256 + n) * 1024 + h * 128;
  const void* g3 = tid < 128 ? (const void*)(VTc + cb + vg * 1024 + tid * 8) : (const void*)(dp + ((tid - 128) & 31) * 4);
  GLDS16(g3, st + 8192);
}

struct ScanRegs { bf16x8 qa[4]; bf16x8 ka[8]; bf16x8 vb; };

DI void scan_read(ScanRegs& r, const char* st, int wid, int fr, int fq) {
#pragma unroll
  for (int ks = 0; ks < 4; ++ks) {
    const int l0 = 4 * ks + (fq >> 1), l1 = l0 + 2;
    const bf16x4 lo = *(const bf16x4*)(st + fr * 256 + ((l0 ^ fr) * 16) + (fq & 1) * 8);
    const bf16x4 hi = *(const bf16x4*)(st + fr * 256 + ((l1 ^ fr) * 16) + (fq & 1) * 8);
    r.qa[ks] = cat4(lo, hi);
  }
  r.vb = *(const bf16x8*)(st + 8192 + (wid * 16 + fr) * 32 + (fq & 1) * 16);
#pragma unroll
  for (int dt = 0; dt < 8; ++dt) r.ka[dt] = *(const bf16x8*)(st + 4096 + (dt * 16 + fr) * 32 + (fq & 1) * 16);
}

DI void scan_compute(f32x4 (&S)[8], ScanRegs& r, const f32x4 (&dc)[8], u16* op, int fq) {
  const bf16x8 z8 = {0, 0, 0, 0, 0, 0, 0, 0};
  if (fq >= 2) r.vb = z8;
  f32x4 o0 = zero4(), o1 = zero4();
  o0 = MFMA32(r.qa[0], pack8(S[0], S[1]), o0);
  o1 = MFMA32(r.qa[1], pack8(S[2], S[3]), o1);
  o0 = MFMA32(r.qa[2], pack8(S[4], S[5]), o0);
  o1 = MFMA32(r.qa[3], pack8(S[6], S[7]), o1);
#pragma unroll
  for (int dt = 0; dt < 8; ++dt) {
    if (fq >= 2) r.ka[dt] = z8;
    S[dt] = S[dt] * dc[dt];
    S[dt] = MFMA32(r.ka[dt], r.vb, S[dt]);
  }
  const f32x4 o = o0 + o1;
  const u32 w0 = pack2(o[0], o[1]), w1 = pack2(o[2], o[3]);
  asm volatile("global_store_short %0, %1, off" :: "v"(op), "v"(w0) : "memory");
  asm volatile("global_store_short_d16_hi %0, %1, off" :: "v"(op + 1024), "v"(w0) : "memory");
  asm volatile("global_store_short %0, %1, off" :: "v"(op + 2048), "v"(w1) : "memory");
  asm volatile("global_store_short_d16_hi %0, %1, off" :: "v"(op + 3072), "v"(w1) : "memory");
}

DI void hg_scan_phase(const HgBufs& hb, char* smem) {
  const int tid = otid(), lane = tid & 63, wid = tid >> 6, fr = lane & 15, fq = lane >> 4;
  for (int item = blockIdx.x; item < 128; item += gridDim.x) {
    const int vg = item & 1, dir = (item >> 1) & 1, h = (item >> 2) & 7, b = item >> 5;
    const u16* QI = dir ? hb.QIb : hb.QIf; const u16* KIT = dir ? hb.KITb : hb.KITf;
    const float* DEC = dir ? hb.DECb : hb.DECf; u16* Oout = dir ? hb.OB : hb.OF;
    const int vs = vg * 4 + wid;
    u16* obase = Oout + ((size_t)b * 4096 + fq * 4) * 1024 + h * 128 + vs * 16 + fr;
    f32x4 S[8];
#pragma unroll
    for (int i = 0; i < 8; ++i) S[i] = zero4();
#pragma unroll
    for (int s = 0; s < SC_NS - 1; ++s) scan_issue(smem, s, QI, KIT, hb.VTc, DEC, b, h, vg, dir ? 255 - s : s, tid);
    asm volatile("s_waitcnt vmcnt(12)" ::: "memory");
    __builtin_amdgcn_s_barrier();
    asm volatile("" ::: "memory");
    ScanRegs ra, rb;
    scan_read(ra, smem, wid, fr, fq);
    int slot = 0;
#define SCAN_STEP(STEP, CUR, NXT) do { \
      const int step_ = (STEP); \
      if (step_ < 4) asm volatile("s_waitcnt vmcnt(9) lgkmcnt(0)" ::: "memory"); \
      else asm volatile("s_waitcnt vmcnt(25) lgkmcnt(0)" ::: "memory"); \
      __builtin_amdgcn_s_barrier(); \
      asm volatile("" ::: "memory"); \
      { const int ns_ = min(step_ + SC_NS - 1, 255); \
        int is_ = slot + SC_NS - 1; if (is_ >= SC_NS) is_ -= SC_NS; \
        scan_issue(smem, is_, QI, KIT, hb.VTc, DEC, b, h, vg, dir ? 255 - ns_ : ns_, tid); } \
      f32x4 dc_[8]; \
      { const char* st_ = smem + slot * SC_STAGE + 8192 + 2048 + fq * 16; \
        _Pragma("unroll") for (int dt = 0; dt < 8; ++dt) dc_[dt] = *(const f32x4*)(st_ + dt * 64); } \
      int nslot_ = slot + 1; if (nslot_ == SC_NS) nslot_ = 0; \
      if (step_ + 1 < 256) scan_read(NXT, smem + nslot_ * SC_STAGE, wid, fr, fq); \
      { const int n_ = dir ? 255 - step_ : step_; \
        scan_compute(S, CUR, dc_, obase + (size_t)n_ * 16 * 1024, fq); } \
      slot = nslot_; } while (0)
    for (int step = 0; step < 256; step += 2) {
      SCAN_STEP(step, ra, rb);
      SCAN_STEP(step + 1, rb, ra);
    }
#undef SCAN_STEP
    asm volatile("s_waitcnt vmcnt(0)" ::: "memory");
    __syncthreads();
  }
}

DI void hg_combine_phase(const HgBufs& hb, const float* __restrict__ gnorm, int rows) {
  const int lane = otid() & 63, wid = otid() >> 6;
  const int h = lane >> 3, c16 = (lane & 7) * 16;
  const int stride = gridDim.x * 4;
  f32x4 gn[4];
#pragma unroll
  for (int i = 0; i < 4; ++i) gn[i] = *(const f32x4*)(gnorm + c16 + i * 4);
  for (int row = blockIdx.x * 4 + wid; row < rows; row += stride * 2) {
    u32x4 ra[2][2], rf[2][2], rb[2][2], rg[2][2];
#pragma unroll
    for (int j = 0; j < 2; ++j) {
      const int rj = row + j * stride;
      if (rj < rows) {
        const size_t g = (size_t)rj * 1024 + h * 128 + c16;
#pragma unroll
        for (int half = 0; half < 2; ++half) {
          ra[j][half] = *(const u32x4*)(hb.OI + g + half * 8); rf[j][half] = *(const u32x4*)(hb.OF + g + half * 8);
          rb[j][half] = *(const u32x4*)(hb.OB + g + half * 8); rg[j][half] = *(const u32x4*)(hb.G + g + half * 8);
        }
      }
    }
#pragma unroll
    for (int j = 0; j < 2; ++j) {
      const int rj = row + j * stride;
      if (rj < rows) {
        const size_t g = (size_t)rj * 1024 + h * 128 + c16;
        float o[16]; float ss = 0.f;
#pragma unroll
        for (int half = 0; half < 2; ++half)
#pragma unroll
          for (int e = 0; e < 8; ++e) { float v = bfget(ra[j][half], e) + bfget(rf[j][half], e) + bfget(rb[j][half], e); o[half * 8 + e] = v; ss += v * v; }
        ss += __shfl_xor(ss, 1); ss += __shfl_xor(ss, 2); ss += __shfl_xor(ss, 4);
        const float rstd = rsqrtf(ss * (1.f / 128.f) + EPS);
#pragma unroll
        for (int half = 0; half < 2; ++half) {
          u32x4 r;
#pragma unroll
          for (int e2 = 0; e2 < 4; ++e2) {
            const int e = half * 8 + 2 * e2;
            r[e2] = pack2(o[e] * rstd * gn[e >> 2][e & 3] * bfget(rg[j][half], 2 * e2), o[e + 1] * rstd * gn[(e + 1) >> 2][(e + 1) & 3] * bfget(rg[j][half], 2 * e2 + 1));
          }
          *(u32x4*)(hb.Y + g + half * 8) = r;
        }
      }
    }
  }
}

DI void na_attn_item(const u16* __restrict__ Q, const u16* __restrict__ K, const u16* __restrict__ VT, const float* __restrict__ rpb, u16* __restrict__ O, int item, int fr, int fq) {
  const int qt = item & 3, h = (item >> 2) & 15, r = (item >> 6) & 63, b = item >> 12;
  const int r0 = min(max(r - 4, 0), 56);
  const int cw0 = qt == 0 ? 0 : qt == 1 ? 8 : qt == 2 ? 24 : 32;
  const size_t tokq = (size_t)b * 4096 + r * 64 + qt * 16 + fr;
  bf16x8 qf[2];
#pragma unroll
  for (int ks = 0; ks < 2; ++ks) qf[ks] = *(const bf16x8*)(Q + tokq * 1024 + h * 64 + ks * 32 + fq * 8);
  f32x4 s[8][2];
#pragma unroll
  for (int kr = 0; kr < 8; ++kr)
#pragma unroll
    for (int hf = 0; hf < 2; ++hf) {
      const size_t tokk = (size_t)b * 4096 + (r0 + kr) * 64 + cw0 + hf * 16 + fr;
      const bf16x8 k0 = *(const bf16x8*)(K + tokk * 1024 + h * 64 + fq * 8);
      const bf16x8 k1 = *(const bf16x8*)(K + tokk * 1024 + h * 64 + 32 + fq * 8);
      f32x4 a = MFMA32(k0, qf[0], zero4());
      s[kr][hf] = MFMA32(k1, qf[1], a);
    }
  const int qc = qt * 16 + fr;
  const int cs = min(max(qc - 8, 0), 48);
  float mx = -1e30f;
#pragma unroll
  for (int kr = 0; kr < 8; ++kr) {
    const float* rp = rpb + (h * 15 + (r0 + kr - r + 7)) * 31;
#pragma unroll
    for (int hf = 0; hf < 2; ++hf)
#pragma unroll
      for (int j = 0; j < 4; ++j) {
        const int kc = cw0 + hf * 16 + fq * 4 + j;
        const bool valid = (kc >= cs) && (kc < cs + 16);
        const int ci = min(max(kc - qc + 15, 0), 30);
        const float v = valid ? s[kr][hf][j] + rp[ci] * LOG2E : -1e30f;
        s[kr][hf][j] = v; mx = fmaxf(mx, v);
      }
  }
  mx = fmaxf(mx, __shfl_xor(mx, 16)); mx = fmaxf(mx, __shfl_xor(mx, 32));
  float l = 0.f;
#pragma unroll
  for (int kr = 0; kr < 8; ++kr)
#pragma unroll
    for (int hf = 0; hf < 2; ++hf)
#pragma unroll
      for (int j = 0; j < 4; ++j) { const float pv = __builtin_amdgcn_exp2f(s[kr][hf][j] - mx); s[kr][hf][j] = pv; l += pv; }
  l += __shfl_xor(l, 16); l += __shfl_xor(l, 32);
  f32x4 o[4];
#pragma unroll
  for (int dt = 0; dt < 4; ++dt) o[dt] = zero4();
#pragma unroll
  for (int kr = 0; kr < 8; ++kr) {
    const bf16x8 pp = pack8(s[kr][0], s[kr][1]);
#pragma unroll
    for (int dt = 0; dt < 4; ++dt) {
      const u16* vp = VT + ((size_t)((b * 16 + h) * 64 + dt * 16 + fr)) * 4096 + (r0 + kr) * 64 + cw0 + fq * 4;
      const bf16x8 vf = cat4(*(const bf16x4*)vp, *(const bf16x4*)(vp + 16));
      o[dt] = MFMA32(vf, pp, o[dt]);
    }
  }
  const float inv = 1.f / l;
#pragma unroll
  for (int dt = 0; dt < 4; ++dt) *(u32x2*)(O + tokq * 1024 + h * 64 + dt * 16 + fq * 4) = pack4(o[dt] * inv);
}

DI void mla_norm_phase(const u16* __restrict__ CRAW, const float* __restrict__ gq, const float* __restrict__ gkv, u16* __restrict__ CQN, u16* __restrict__ CKVN, float* __restrict__ KROPE) {
  const int lane = otid() & 63, wid = otid() >> 6;
  for (int row = blockIdx.x * 4 + wid; row < MTOK; row += gridDim.x * 4) {
    const u16* c = CRAW + (size_t)row * 1056;
    f32x4 v[3]; float ss = 0.f;
#pragma unroll
    for (int i = 0; i < 3; ++i) {
      const u32x2 w = *(const u32x2*)(c + i * 256 + lane * 4);
      v[i][0] = bflo(w[0]); v[i][1] = bfhi(w[0]); v[i][2] = bflo(w[1]); v[i][3] = bfhi(w[1]);
      ss += v[i][0] * v[i][0] + v[i][1] * v[i][1] + v[i][2] * v[i][2] + v[i][3] * v[i][3];
    }
    ss = wave_sum(ss);
    const float rq = rsqrtf(ss * (1.f / 768.f) + EPS);
#pragma unroll
    for (int i = 0; i < 3; ++i) {
      const f32x4 g4 = *(const f32x4*)(gq + i * 256 + lane * 4);
      *(u32x2*)(CQN + (size_t)row * 768 + i * 256 + lane * 4) = pack4(v[i] * rq * g4);
    }
    {
      const u32x2 w = *(const u32x2*)(c + 768 + lane * 4);
      f32x4 k; k[0] = bflo(w[0]); k[1] = bfhi(w[0]); k[2] = bflo(w[1]); k[3] = bfhi(w[1]);
      float s2 = wave_sum(k[0] * k[0] + k[1] * k[1] + k[2] * k[2] + k[3] * k[3]);
      const float rk = rsqrtf(s2 * (1.f / 256.f) + EPS);
      const f32x4 g4 = *(const f32x4*)(gkv + lane * 4);
      *(u32x2*)(CKVN + (size_t)row * 256 + lane * 4) = pack4(k * rk * g4);
    }
    if (lane < 8) {
      const u32x2 w = *(const u32x2*)(c + 1024 + lane * 4);
      f32x4 k; k[0] = bflo(w[0]); k[1] = bfhi(w[0]); k[2] = bflo(w[1]); k[3] = bfhi(w[1]);
      *(f32x4*)(KROPE + (size_t)row * 32 + lane * 4) = k;
    }
  }
}

DI void mla_prep_phase(u16* __restrict__ Q, const u16* __restrict__ KVRAW, const float* __restrict__ KROPE, u16* __restrict__ Kout,
                       const float* __restrict__ gq, const float* __restrict__ gk, const float* __restrict__ RC, const float* __restrict__ RS) {
  const int lane = otid() & 63, wid = otid() >> 6;
  const int h = lane >> 2, sub = lane & 3;
  const float QS = 0.10206207261596577f * LOG2E;
  for (int m = blockIdx.x * 4 + wid; m < MTOK; m += gridDim.x * 4) {
    const int t = m & 4095;
    const f32x4 cs = *(const f32x4*)(RC + t * 16 + sub * 4), sn = *(const f32x4*)(RS + t * 16 + sub * 4);
#pragma unroll
    for (int which = 0; which < 2; ++which) {
      float nope[16]; f32x4 ra, rb;
      u16* dstp = (which == 0 ? Q : Kout) + (size_t)m * 1536 + h * 96;
      const float* gn = which == 0 ? gq : gk;
      if (which == 0) {
        const u32x4 w0 = *(const u32x4*)(dstp + sub * 16), w1 = *(const u32x4*)(dstp + sub * 16 + 8);
#pragma unroll
        for (int e = 0; e < 8; ++e) { nope[e] = bfget(w0, e); nope[8 + e] = bfget(w1, e); }
        const u32x2 a2 = *(const u32x2*)(dstp + 64 + sub * 4), b2 = *(const u32x2*)(dstp + 80 + sub * 4);
        ra[0] = bflo(a2[0]); ra[1] = bfhi(a2[0]); ra[2] = bflo(a2[1]); ra[3] = bfhi(a2[1]);
        rb[0] = bflo(b2[0]); rb[1] = bfhi(b2[0]); rb[2] = bflo(b2[1]); rb[3] = bfhi(b2[1]);
      } else {
        const u16* kp = KVRAW + (size_t)m * 2048 + h * 128 + sub * 16;
        const u32x4 w0 = *(const u32x4*)kp, w1 = *(const u32x4*)(kp + 8);
#pragma unroll
        for (int e = 0; e < 8; ++e) { nope[e] = bfget(w0, e); nope[8 + e] = bfget(w1, e); }
        ra = *(const f32x4*)(KROPE + (size_t)m * 32 + sub * 4);
        rb = *(const f32x4*)(KROPE + (size_t)m * 32 + 16 + sub * 4);
      }
      float ss = 0.f;
#pragma unroll
      for (int e = 0; e < 16; ++e) ss += nope[e] * nope[e];
#pragma unroll
      for (int e = 0; e < 4; ++e) ss += ra[e] * ra[e] + rb[e] * rb[e];
      ss += __shfl_xor(ss, 1); ss += __shfl_xor(ss, 2);
      const float rstd = rsqrtf(ss * (1.f / 96.f) + EPS) * (which == 0 ? QS : 1.f);
      u32x4 o0, o1;
#pragma unroll
      for (int e2 = 0; e2 < 4; ++e2) {
        o0[e2] = pack2(nope[2 * e2] * rstd * gn[sub * 16 + 2 * e2], nope[2 * e2 + 1] * rstd * gn[sub * 16 + 2 * e2 + 1]);
        o1[e2] = pack2(nope[8 + 2 * e2] * rstd * gn[sub * 16 + 8 + 2 * e2], nope[9 + 2 * e2] * rstd * gn[sub * 16 + 9 + 2 * e2]);
      }
      f32x4 oa, ob;
#pragma unroll
      for (int e = 0; e < 4; ++e) {
        const float a = ra[e] * rstd * gn[64 + sub * 4 + e], bq = rb[e] * rstd * gn[80 + sub * 4 + e];
        oa[e] = a * cs[e] - bq * sn[e];
        ob[e] = bq * cs[e] + a * sn[e];
      }
      *(u32x4*)(dstp + sub * 16) = o0; *(u32x4*)(dstp + sub * 16 + 8) = o1;
      *(u32x2*)(dstp + 64 + sub * 4) = pack4(oa); *(u32x2*)(dstp + 80 + sub * 4) = pack4(ob);
    }
  }
}

DI void mla_vt_phase(const u16* __restrict__ KVRAW, u16* __restrict__ VT, char* smem) {
  u16* tile = (u16*)smem;
  const int tid = otid();
  for (int item = blockIdx.x; item < 8192; item += gridDim.x) {
    const int tt = item & 63, bh = item >> 6, b = bh >> 4, h = bh & 15;
    {
      const int row = tid >> 2, part = tid & 3;
      const u16* src = KVRAW + ((size_t)b * 4096 + tt * 64 + row) * 2048 + h * 128 + 64 + part * 16;
      const u32x4 w0 = *(const u32x4*)src, w1 = *(const u32x4*)(src + 8);
      u32* d32 = (u32*)(tile + row * 66 + part * 16);
#pragma unroll
      for (int e = 0; e < 4; ++e) { d32[e] = w0[e]; d32[4 + e] = w1[e]; }
    }
    __syncthreads();
    {
      const int d = tid >> 2, tp = (tid & 3) * 16;
      u32x4 o0, o1;
#pragma unroll
      for (int e2 = 0; e2 < 4; ++e2) {
        o0[e2] = (u32)tile[(tp + 2 * e2) * 66 + d] | ((u32)tile[(tp + 2 * e2 + 1) * 66 + d] << 16);
        o1[e2] = (u32)tile[(tp + 8 + 2 * e2) * 66 + d] | ((u32)tile[(tp + 9 + 2 * e2) * 66 + d] << 16);
      }
      u16* dst = VT + ((size_t)(bh * 64 + d)) * 4096 + tt * 64 + tp;
      *(u32x4*)dst = o0; *(u32x4*)(dst + 8) = o1;
    }
    __syncthreads();
  }
}

constexpr int FA_KROW = 208, FA_VROW = 144, FA_KT = 64 * FA_KROW, FA_BUF = FA_KT + 64 * FA_VROW;
DI void mla_attn_item(const u16* __restrict__ Q, const u16* __restrict__ Kb, const u16* __restrict__ VT, u16* __restrict__ O, int item, char* smem) {
  const int qb = item & 15, bh = item >> 4, b = bh >> 4, h = bh & 15;
  const int tid = otid(), lane = tid & 63, wid = tid >> 6, fr = lane & 15, fq = lane >> 4;
  bf16x8 qf[4][3];
#pragma unroll
  for (int qt = 0; qt < 4; ++qt) {
    const size_t tq = (size_t)b * 4096 + qb * 256 + wid * 64 + qt * 16 + fr;
#pragma unroll
    for (int ks = 0; ks < 3; ++ks) qf[qt][ks] = *(const bf16x8*)(Q + tq * 1536 + h * 96 + ks * 32 + fq * 8);
  }
  f32x4 o[4][4];
#pragma unroll
  for (int i = 0; i < 4; ++i)
#pragma unroll
    for (int j = 0; j < 4; ++j) o[i][j] = zero4();
  float mrun[4] = {-1e30f, -1e30f, -1e30f, -1e30f}, lrun[4] = {0.f, 0.f, 0.f, 0.f};
  const u16* kg[3]; int ks_off[3];
#pragma unroll
  for (int i = 0; i < 3; ++i) {
    const int c = tid + 256 * i, row = c / 12, kc = c % 12;
    kg[i] = Kb + ((size_t)b * 4096 + row) * 1536 + h * 96 + kc * 8;
    ks_off[i] = row * FA_KROW + kc * 16;
  }
  const u16* vg[2]; int vs_off[2];
#pragma unroll
  for (int i = 0; i < 2; ++i) {
    const int c = tid + 256 * i, d = c >> 3, kc = c & 7;
    vg[i] = VT + ((size_t)(bh * 64 + d)) * 4096 + kc * 8;
    vs_off[i] = FA_KT + d * FA_VROW + kc * 16;
  }
  u32x4 rk[3], rv[2];
#pragma unroll
  for (int i = 0; i < 3; ++i) rk[i] = *(const u32x4*)(kg[i]);
#pragma unroll
  for (int i = 0; i < 2; ++i) rv[i] = *(const u32x4*)(vg[i]);
#pragma unroll
  for (int i = 0; i < 3; ++i) *(u32x4*)(smem + ks_off[i]) = rk[i];
#pragma unroll
  for (int i = 0; i < 2; ++i) *(u32x4*)(smem + vs_off[i]) = rv[i];
#pragma unroll
  for (int qt = 0; qt < 4; ++qt)
#pragma unroll
    for (int ks = 0; ks < 3; ++ks) asm volatile("" :: "v"(qf[qt][ks]));
  __syncthreads();
  for (int kt = 0; kt < 64; ++kt) {
    const int cur = (kt & 1) * FA_BUF, nxt = FA_BUF - cur;
    if (kt + 1 < 64) {
      const size_t key0 = (size_t)(kt + 1) * 64;
#pragma unroll
      for (int i = 0; i < 3; ++i) rk[i] = *(const u32x4*)(kg[i] + key0 * 1536);
#pragma unroll
      for (int i = 0; i < 2; ++i) rv[i] = *(const u32x4*)(vg[i] + key0);
    }
#pragma unroll
    for (int kh = 0; kh < 2; ++kh) {
      f32x4 s[2][4];
#pragma unroll
      for (int kl = 0; kl < 2; ++kl) {
#pragma unroll
        for (int qt = 0; qt < 4; ++qt) s[kl][qt] = zero4();
#pragma unroll
        for (int ks = 0; ks < 3; ++ks) {
          const bf16x8 kf = *(const bf16x8*)(smem + cur + ((kh * 2 + kl) * 16 + fr) * FA_KROW + ks * 64 + fq * 16);
#pragma unroll
          for (int qt = 0; qt < 4; ++qt) s[kl][qt] = MFMA32(kf, qf[qt][ks], s[kl][qt]);
        }
      }
      bf16x8 pp[4];
      {
        float lm[4]; bool need = false;
#pragma unroll
        for (int qt = 0; qt < 4; ++qt) {
          const float m0 = fmaxf(fmaxf(s[0][qt][0], s[0][qt][1]), fmaxf(s[0][qt][2], s[0][qt][3]));
          const float m1 = fmaxf(fmaxf(s[1][qt][0], s[1][qt][1]), fmaxf(s[1][qt][2], s[1][qt][3]));
          lm[qt] = fmaxf(m0, m1);
          need = need || (lm[qt] > mrun[qt] + 8.f);
        }
        if (__any(need)) {
#pragma unroll
          for (int qt = 0; qt < 4; ++qt) {
            float mx = lm[qt];
            mx = fmaxf(mx, __shfl_xor(mx, 16)); mx = fmaxf(mx, __shfl_xor(mx, 32));
            const float mnew = fmaxf(mrun[qt], mx);
            const float alpha = __builtin_amdgcn_exp2f(mrun[qt] - mnew);
            mrun[qt] = mnew;
            lrun[qt] *= alpha;
#pragma unroll
            for (int dt = 0; dt < 4; ++dt) o[dt][qt] = o[dt][qt] * alpha;
          }
        }
#pragma unroll
        for (int qt = 0; qt < 4; ++qt) {
          const float mr = mrun[qt];
          float ps = 0.f;
#pragma unroll
          for (int kl = 0; kl < 2; ++kl)
#pragma unroll
            for (int j = 0; j < 4; ++j) { const float pv = __builtin_amdgcn_exp2f(s[kl][qt][j] - mr); s[kl][qt][j] = pv; ps += pv; }
          lrun[qt] += ps;
          pp[qt] = pack8(s[0][qt], s[1][qt]);
        }
      }
#pragma unroll
      for (int dt = 0; dt < 4; ++dt) {
        const char* vp = smem + cur + FA_KT + (dt * 16 + fr) * FA_VROW + (kh * 32 + fq * 4) * 2;
        const bf16x8 vf = cat4(*(const bf16x4*)vp, *(const bf16x4*)(vp + 32));
#pragma unroll
        for (int qt = 0; qt < 4; ++qt) o[dt][qt] = MFMA32(vf, pp[qt], o[dt][qt]);
      }
    }
    if (kt + 1 < 64) {
#pragma unroll
      for (int i = 0; i < 3; ++i) *(u32x4*)(smem + nxt + ks_off[i]) = rk[i];
#pragma unroll
      for (int i = 0; i < 2; ++i) *(u32x4*)(smem + nxt + vs_off[i]) = rv[i];
    }
    __syncthreads();
  }
#pragma unroll
  for (int qt = 0; qt < 4; ++qt) {
    float l = lrun[qt];
    l += __shfl_xor(l, 16); l += __shfl_xor(l, 32);
    const float inv = 1.f / l;
    const size_t tq = (size_t)b * 4096 + qb * 256 + wid * 64 + qt * 16 + fr;
#pragma unroll
    for (int dt = 0; dt < 4; ++dt) *(u32x2*)(O + tq * 1024 + h * 64 + dt * 16 + fq * 4) = pack4(o[dt][qt] * inv);
  }
}

#define XB_TMO      128
#define XB_XCNT(j)  (256  + 64 * (j))
#define XB_XSUB(j)  (1280 + 64 * (j))
#define XB_XGEN(j)  (2304 + 64 * (j))
#define XB_TOP      3328
#define XB_TOPGEN   3392
#define XCD_BAR_WORDS 3456
#define XB_SPIN_CAP (1u << 22)
DI unsigned xb_ld(unsigned* p) { return __hip_atomic_load(p, __ATOMIC_RELAXED, __HIP_MEMORY_SCOPE_AGENT); }
DI unsigned xb_add(unsigned* p, unsigned v) { return __hip_atomic_fetch_add(p, v, __ATOMIC_RELAXED, __HIP_MEMORY_SCOPE_AGENT); }
DI unsigned xb_xcc_id() { return (unsigned)__builtin_amdgcn_s_getreg((3 << 11) | 20) & 0xFu; }
#define XB_SPIN(cond, bar) do { unsigned _sp = 0; while (cond) { __builtin_amdgcn_s_sleep(1); \
    if ((++_sp & 255u) == 0u) { if (xb_ld(&(bar)[XB_TMO])) break; if (_sp > XB_SPIN_CAP) { atomicAdd(&(bar)[XB_TMO], 1u); break; } } } } while (0)

DI void xcd_barrier_complete(unsigned* bar, unsigned x, unsigned& nloc, unsigned& nx) {
  const unsigned G = gridDim.x;
  unsigned sum, cnt, mine, sp = 0u;
  for (;;) {
    sum = 0u; cnt = 0u; mine = 0u;
#pragma unroll
    for (unsigned j = 0; j < 16; ++j) { const unsigned c = xb_ld(&bar[XB_XCNT(j)]); sum += c; cnt += (c > 0u) ? 1u : 0u; mine = (j == x) ? c : mine; }
    if (sum == G) break;
    __builtin_amdgcn_s_sleep(1);
    if ((++sp & 255u) == 0u) { if (xb_ld(&bar[XB_TMO])) break; if (sp > XB_SPIN_CAP) { atomicAdd(&bar[XB_TMO], 1u); break; } }
  }
  nloc = mine > 0u ? mine : 1u; nx = cnt > 0u ? cnt : 1u;
}

DI void xcd_barrier(unsigned* bar, volatile unsigned* st) {
  asm volatile("s_waitcnt vmcnt(0)" ::: "memory");
  __syncthreads();
  if (threadIdx.x == 0) {
    __builtin_amdgcn_s_waitcnt(0);
    const unsigned x = xb_xcc_id();
    unsigned nloc = st[0], nx = st[1];
    if (nloc == 0u) { xcd_barrier_complete(bar, x, nloc, nx); st[0] = nloc; st[1] = nx; }
    const unsigned old = xb_add(&bar[XB_XSUB(x)], 1u);
    const unsigned gen = old / nloc;
    if (old + 1u == (gen + 1u) * nloc) {
      __builtin_amdgcn_fence(__ATOMIC_RELEASE, "agent");
      asm volatile("s_waitcnt vmcnt(0)" ::: "memory");
      const unsigned og = xb_add(&bar[XB_TOP], 1u);
      const unsigned tg = og / nx;
      if (og + 1u == (tg + 1u) * nx) xb_add(&bar[XB_TOPGEN], 1u);
      else XB_SPIN(xb_ld(&bar[XB_TOPGEN]) == tg, bar);
      __builtin_amdgcn_fence(__ATOMIC_ACQUIRE, "agent");
      xb_add(&bar[XB_XGEN(x)], 1u);
      asm volatile("s_waitcnt vmcnt(0)" ::: "memory");
    } else {
      XB_SPIN(xb_ld(&bar[XB_XGEN(x)]) == gen, bar);
      __builtin_amdgcn_fence(__ATOMIC_ACQUIRE, "agent");
      asm volatile("s_waitcnt vmcnt(0)" ::: "memory");
    }
  }
  __syncthreads();
}

#ifndef ENMASK
#define ENMASK 0xffffffffu
#endif
#define EN(i) ((ENMASK >> (i)) & 1u)
#ifndef DUPMASK
#define DUPMASK 0u
#endif
#define DUP(i) ((DUPMASK >> (i)) & 1u)
#ifndef BAR2
#define BAR2 0
#endif
#define PHASE_BEGIN(i) if (EN(i) && pc >= p.lo && pc < p.hi) for (int rep_ = 0; rep_ < 1 + (int)DUP(i); ++rep_) {
#define PHASE_END } { if (pc >= p.lo && pc + 1 < p.hi) { if (pc == p.lo) grid.sync(); else { xcd_barrier(bar, st); if (BAR2) xcd_barrier(bar, st); } } ++pc; }

__global__ void __launch_bounds__(256, 2) mega(Params p) {
  __shared__ __attribute__((aligned(16))) char smem[73728 + 16];
  cg::grid_group grid = cg::this_grid();
  int pc = 0;
  char* ws = p.ws;
  unsigned* bar = (unsigned*)(ws + OFF_BAR);
  volatile unsigned* st = (volatile unsigned*)(smem + 73728);
  if (threadIdx.x == 0) { st[0] = 0u; st[1] = 0u; (void)xb_add(&bar[XB_XCNT(xb_xcc_id())], 1u); }
  __syncthreads();
  u16* H = (u16*)(ws + OFF_H);
  char* R = ws + OFF_R;
  const float* LB = (const float*)(ws + OFF_TAB);
  const float* RC = LB + 4096; const float* RS = RC + 65536;
  for (int layer = 0; layer < 4; ++layer) {
    const int kind = layer % 3, mi = layer / 3;
    for (int stage = 0; stage < 3; ++stage) {
      if (stage != 1) {
        const float* ng = (stage == 0 ? p.ffn1_norm : p.ffn2_norm) + layer * 1024;
        const u16* wgu = (const u16*)(ws + (stage == 0 ? OFF_WGU1 : OFF_WGU2));
        const u16* wdn = (const u16*)(ws + (stage == 0 ? OFF_WDN1 : OFF_WDN2));
        u16* ACT = (u16*)R;
        PHASE_BEGIN(0)
          const bool first = (layer == 0 && stage == 0);
          if (stage == 0) { if (layer == 0) init_tables(p); cvt_layer(p, layer, smem); }
          norm_phase(first ? p.x : p.X, ng, H, first ? p.X : nullptr, MTOK);
        PHASE_END
        PHASE_BEGIN(1)
          gemm_phase(H, 1024, wgu, 1024, MTOK, 5632, EpiSwiglu{ACT}, smem);
        PHASE_END
        PHASE_BEGIN(2)
          gemm_phase(ACT, 2816, wdn, 2816, MTOK, 1024, EpiResid{p.X, 0.5f}, smem);
        PHASE_END
      } else {
        PHASE_BEGIN(3)
          norm_phase(p.X, p.mix_norm + layer * 1024, H, nullptr, MTOK);
        PHASE_END
        if (kind == 0) {
          constexpr size_t SZ = 32 * MiB;
          HgBufs hb;
          hb.Q = (u16*)(R + 0 * SZ); hb.LFf = (u16*)(R + 1 * SZ); hb.LFb = (u16*)(R + 2 * SZ); hb.V = (u16*)(R + 3 * SZ); hb.G = (u16*)(R + 4 * SZ);
          hb.QIf = (u16*)(R + 5 * SZ); hb.QIb = (u16*)(R + 6 * SZ); hb.KITf = (u16*)(R + 7 * SZ); hb.KITb = (u16*)(R + 8 * SZ);
          hb.VTc = (u16*)(R + 9 * SZ); hb.OI = (u16*)(R + 10 * SZ); hb.OF = hb.Q; hb.OB = hb.LFf; hb.Y = hb.LFb;
          hb.DECf = (float*)(R + 11 * SZ); hb.DECb = (float*)(R + 11 * SZ + 4 * MiB);
          const u16* w_in = (const u16*)(ws + OFF_WMIX); const u16* w_out = (const u16*)(ws + OFF_WMIX + 10485760);
          for (int half = 0; half < 2; ++half) {
            PHASE_BEGIN(4)
              gemm_phase(H + (size_t)half * 16384 * 1024, 1024, w_in, 1024, 16384, 5120, EpiHgIn{hb.Q, hb.LFf, hb.LFb, hb.V, hb.G, LB + layer * 1024}, smem);
            PHASE_END
            PHASE_BEGIN(5)
              hg_prep_phase(hb, smem);
            PHASE_END
            PHASE_BEGIN(6)
              hg_scan_phase(hb, smem);
            PHASE_END
            PHASE_BEGIN(7)
              hg_combine_phase(hb, p.hg_g_norm + mi * 128, 16384);
            PHASE_END
            PHASE_BEGIN(8)
              gemm_phase(hb.Y, 1024, w_out, 1024, 16384, 1024, EpiResid{p.X + (size_t)half * 16384 * 1024, 1.0f}, smem);
            PHASE_END
          }
        } else if (kind == 1) {
          u16* Qn = (u16*)R; u16* Kn = (u16*)(R + 64 * MiB); u16* VT = (u16*)(R + 128 * MiB); u16* On = (u16*)(R + 192 * MiB);
          const u16* w_in = (const u16*)(ws + OFF_WMIX); const u16* w_out = (const u16*)(ws + OFF_WMIX + 6291456);
          PHASE_BEGIN(9)
            gemm_phase(H, 1024, w_in, 1024, MTOK, 3072, EpiNaIn{Qn, Kn, VT, p.na_q_norm + mi * 64, p.na_k_norm + mi * 64}, smem);
          PHASE_END
          PHASE_BEGIN(10)
            const int tid_ = otid(), lane = tid_ & 63, wid = tid_ >> 6, fr = lane & 15, fq = lane >> 4;
            for (int item = blockIdx.x * 4 + wid; item < 32768; item += gridDim.x * 4)
              na_attn_item(Qn, Kn, VT, p.na_rpb + (size_t)mi * 16 * 15 * 31, On, item, fr, fq);
          PHASE_END
          PHASE_BEGIN(11)
            gemm_phase(On, 1024, w_out, 1024, MTOK, 1024, EpiResid{p.X, 1.0f}, smem);
          PHASE_END
        } else {
          u16* VT = H;
          u16* CRAW = (u16*)R; u16* On = (u16*)R;
          u16* CQN = (u16*)(R + 66 * MiB); u16* CKVN = (u16*)(R + 114 * MiB); u16* Kk = (u16*)(R + 66 * MiB);
          float* KROPE = (float*)(R + 162 * MiB);
          u16* Qq = (u16*)(R + 166 * MiB); u16* KVRAW = (u16*)(R + 262 * MiB);
          const u16* w_in = (const u16*)(ws + OFF_WMIX); const u16* w_uq = (const u16*)(ws + OFF_WMIX + 2359296);
          const u16* w_ukv = (const u16*)(ws + OFF_WMIX + 4718592); const u16* w_out = (const u16*)(ws + OFF_WMIX + 5767168);
          PHASE_BEGIN(12)
            gemm_phase(H, 1024, w_in, 1024, MTOK, 1152, EpiStore{CRAW, 1056, 1056}, smem);
          PHASE_END
          PHASE_BEGIN(13)
            mla_norm_phase(CRAW, p.mla_q_a_norm + mi * 768, p.mla_kv_a_norm + mi * 256, CQN, CKVN, KROPE);
          PHASE_END
          PHASE_BEGIN(14)
            gemm_phase(CQN, 768, w_uq, 768, MTOK, 1536, EpiStore{Qq, 1536, 1536}, smem);
            gemm_phase(CKVN, 256, w_ukv, 256, MTOK, 2048, EpiStore{KVRAW, 2048, 2048}, smem);
          PHASE_END
          PHASE_BEGIN(15)
            mla_prep_phase(Qq, KVRAW, KROPE, Kk, p.mla_q_norm + mi * 96, p.mla_k_norm + mi * 96, RC, RS);
            mla_vt_phase(KVRAW, VT, smem);
          PHASE_END
          PHASE_BEGIN(16)
            for (int item = blockIdx.x; item < 2048; item += gridDim.x) mla_attn_item(Qq, Kk, VT, On, item, smem);
          PHASE_END
          PHASE_BEGIN(17)
            gemm_phase(On, 1024, w_out, 1024, MTOK, 1024, EpiResid{p.X, 1.0f}, smem);
          PHASE_END
        }
      }
    }
  }
}

static int count_phases() {
  int n = 0;
  for (int layer = 0; layer < 4; ++layer) {
    int kind = layer % 3;
    n += 3 + 3 + 1;
    n += kind == 0 ? 10 : kind == 1 ? 3 : 6;
  }
  return n;
}

extern "C" void kernel_launch(void* const* d_in, const int* in_sizes, int n_in, void* d_out, int out_size, void* d_ws, size_t ws_size, hipStream_t stream) {
  if (ws_size < WS_NEED) { fprintf(stderr, "workspace too small: %zu < %zu\n", ws_size, WS_NEED); return; }
  static int grid_blocks = 0;
  if (!grid_blocks) {
    int dev = 0, cus = 0, per_cu = 0;
    hipGetDevice(&dev);
    hipDeviceGetAttribute(&cus, hipDeviceAttributeMultiprocessorCount, dev);
    hipOccupancyMaxActiveBlocksPerMultiprocessor(&per_cu, mega, 256, 0);
    if (per_cu > 2) per_cu = 2;
    grid_blocks = cus * per_cu;
  }
  Params p{};
  const float** pf = (const float**)&p;
  for (int i = 0; i < 25; ++i) pf[i] = (const float*)d_in[i];
  p.X = (float*)d_out; p.ws = (char*)d_ws;
  const int total = count_phases();
#if MULTI_LAUNCH
  for (int ph = 0; ph < total; ++ph) {
    p.lo = ph; p.hi = ph + 1;
    hipLaunchKernelGGL(mega, dim3(grid_blocks), dim3(256), 0, stream, p);
  }
#else
  hipMemsetAsync((char*)d_ws + OFF_BAR, 0, 16384, stream);
  p.lo = 0; p.hi = total;
  void* args[] = {&p};
  hipError_t e = hipLaunchCooperativeKernel((void*)mega, dim3(grid_blocks), dim3(256), args, 0, stream);
  if (e != hipSuccess) fprintf(stderr, "cooperative launch failed: %s (grid %d)\n", hipGetErrorString(e), grid_blocks);
#endif
}
```

```cpp
#include <hip/hip_runtime.h>
#include <hip/hip_cooperative_groups.h>
#include <cstdio>
#include <cstdint>
namespace cg = cooperative_groups;

#ifndef MULTI_LAUNCH
#define MULTI_LAUNCH 0
#endif

typedef unsigned short u16;
typedef unsigned int u32;
using bf16x8 = __attribute__((ext_vector_type(8))) short;
using bf16x4 = __attribute__((ext_vector_type(4))) short;
using f32x4 = __attribute__((ext_vector_type(4))) float;
using u32x2 = __attribute__((ext_vector_type(2))) unsigned int;
using u32x4 = __attribute__((ext_vector_type(4))) unsigned int;

#define DI __device__ __forceinline__
#define MFMA32(a, b, c) __builtin_amdgcn_mfma_f32_16x16x32_bf16((a), (b), (c), 0, 0, 0)

constexpr int MTOK = 32768;
constexpr float EPS = 1e-6f;
constexpr float LOG2E = 1.4426950408889634f;

constexpr size_t MiB = 1048576;
constexpr size_t OFF_WGU1 = 0;
constexpr size_t OFF_WDN1 = 11534336;
constexpr size_t OFF_WGU2 = 17301504;
constexpr size_t OFF_WDN2 = 28835840;
constexpr size_t OFF_WMIX = 34603008;
constexpr size_t OFF_TAB = 47185920;
constexpr size_t OFF_BAR = OFF_TAB + 786432;
constexpr size_t OFF_H = 46 * MiB;
constexpr size_t OFF_R = 110 * MiB;
constexpr size_t WS_NEED = 500 * MiB;

struct Params {
  const float* x; const float* ffn1_norm; const float* ffn1_w_gu; const float* ffn1_w_down;
  const float* mix_norm; const float* ffn2_norm; const float* ffn2_w_gu; const float* ffn2_w_down;
  const float* hg_lb_logits; const float* hg_w_in; const float* hg_g_norm; const float* hg_w_out;
  const float* na_w_in; const float* na_q_norm; const float* na_k_norm; const float* na_rpb; const float* na_w_out;
  const float* mla_w_in; const float* mla_q_a_norm; const float* mla_w_uq; const float* mla_kv_a_norm; const float* mla_w_ukv;
  const float* mla_q_norm; const float* mla_k_norm; const float* mla_w_out;
  float* X; char* ws; int lo; int hi;
};

DI u32 f2bf(float x) { u32 u = __float_as_uint(x); u += 0x7fffu + ((u >> 16) & 1u); return u >> 16; }
typedef __bf16 bf16v2 __attribute__((ext_vector_type(2)));
typedef float f32v2 __attribute__((ext_vector_type(2)));
DI u32 pack2(float a, float b) { f32v2 v = {a, b}; bf16v2 r = __builtin_convertvector(v, bf16v2); return __builtin_bit_cast(u32, r); }
DI float bflo(u32 w) { return __uint_as_float(w << 16); }
DI float bfhi(u32 w) { return __uint_as_float(w & 0xffff0000u); }
DI float bfget(const u32x4& v, int e) { u32 w = v[e >> 1]; return (e & 1) ? bfhi(w) : bflo(w); }
DI u32x2 pack4(const f32x4& v) { u32x2 r; r[0] = pack2(v[0], v[1]); r[1] = pack2(v[2], v[3]); return r; }
DI bf16x8 pack8(const f32x4& a, const f32x4& b) {
  u32x4 r; r[0] = pack2(a[0], a[1]); r[1] = pack2(a[2], a[3]); r[2] = pack2(b[0], b[1]); r[3] = pack2(b[2], b[3]);
  return __builtin_bit_cast(bf16x8, r);
}
DI bf16x8 cat4(const bf16x4& lo, const bf16x4& hi) { return __builtin_shufflevector(lo, hi, 0, 1, 2, 3, 4, 5, 6, 7); }
DI float wave_sum(float v) {
#pragma unroll
  for (int o = 32; o > 0; o >>= 1) v += __shfl_xor(v, o);
  return v;
}
DI float sigmoidf_(float z) { return __builtin_amdgcn_rcpf(1.f + __expf(-z)); }
DI float siluf_(float z) { return z * __builtin_amdgcn_rcpf(1.f + __expf(-z)); }
DI int otid() { int t = threadIdx.x; asm volatile("" : "+v"(t)); return t; }
DI f32x4 zero4() { f32x4 z = {0.f, 0.f, 0.f, 0.f}; return z; }

DI void init_tables(const Params& p) {
  float* LB = (float*)(p.ws + OFF_TAB); float* RC = LB + 4096; float* RS = RC + 65536;
  const int gt = blockIdx.x * 256 + otid(), gs = gridDim.x * 256;
  for (int c = gt; c < 1024; c += gs) {
    float l0 = p.hg_lb_logits[c], l1 = p.hg_lb_logits[1024 + c], l2 = p.hg_lb_logits[2048 + c], l3 = p.hg_lb_logits[3072 + c];
    float mx = fmaxf(fmaxf(l0, l1), fmaxf(l2, l3));
    float e0 = expf(l0 - mx), e1 = expf(l1 - mx), e2 = expf(l2 - mx), e3 = expf(l3 - mx);
    float inv = 1.f / (e0 + e1 + e2 + e3);
    LB[c] = 0.f; LB[1024 + c] = e1 * inv; LB[2048 + c] = (e1 + e2) * inv; LB[3072 + c] = (e1 + e2 + e3) * inv;
  }
  for (int i = gt; i < 65536; i += gs) {
    int t = i >> 4, j = i & 15;
    float inv = exp2f(-(float)j * (13.287712379549449f / 16.f));
    float ang = (float)t * inv;
    double a = (double)ang;
    double k = rint(a * 0.15915494309189535);
    float r = (float)(a - k * 6.283185307179586);
    RC[i] = __cosf(r); RS[i] = __sinf(r);
  }
}

DI void cvt_tiles(const float* __restrict__ src, u16* __restrict__ dst, int K, int N, int Nd, int mode, char* smem) {
  float* tile = (float*)smem;
  const int tk = K >> 6, tn = Nd >> 6, tid = otid();
  for (int t = blockIdx.x; t < tk * tn; t += gridDim.x) {
    const int k0 = (t % tk) << 6, n0 = (t / tk) << 6;
    {
      const int nl = tid & 63, kq = tid >> 6;
      const int nd = n0 + nl;
      int col = nd;
      if (mode == 1) { int a = nd >> 5, r = nd & 31; col = a * 16 + (r & 15) + ((r >= 16) ? 2816 : 0); }
      const bool ok = col < N;
#pragma unroll
      for (int i = 0; i < 16; ++i) {
        int kl = kq + 4 * i;
        tile[kl * 65 + nl] = ok ? src[(size_t)(k0 + kl) * N + col] : 0.f;
      }
    }
    __syncthreads();
    {
      const int kp = (tid & 31) * 2, nq = tid >> 5;
#pragma unroll
      for (int i = 0; i < 8; ++i) {
        int n = nq + 8 * i;
        *(u32*)(dst + (size_t)(n0 + n) * K + k0 + kp) = pack2(tile[kp * 65 + n], tile[(kp + 1) * 65 + n]);
      }
    }
    __syncthreads();
  }
}

DI void cvt_layer(const Params& p, int layer, char* smem) {
  const int kind = layer % 3, mi = layer / 3;
  char* ws = p.ws;
  for (int task = 0; task < 8; ++task) {
    const float* src = nullptr; size_t off = 0; int K = 0, N = 0, Nd = 0, mode = 0;
    if (task == 0) { src = p.ffn1_w_gu + (size_t)layer * 1024 * 5632; off = OFF_WGU1; K = 1024; N = 5632; Nd = 5632; mode = 1; }
    else if (task == 1) { src = p.ffn1_w_down + (size_t)layer * 2816 * 1024; off = OFF_WDN1; K = 2816; N = 1024; Nd = 1024; }
    else if (task == 2) { src = p.ffn2_w_gu + (size_t)layer * 1024 * 5632; off = OFF_WGU2; K = 1024; N = 5632; Nd = 5632; mode = 1; }
    else if (task == 3) { src = p.ffn2_w_down + (size_t)layer * 2816 * 1024; off = OFF_WDN2; K = 2816; N = 1024; Nd = 1024; }
    else if (kind == 0) {
      if (task == 4) { src = p.hg_w_in + (size_t)mi * 1024 * 5120; off = OFF_WMIX; K = 1024; N = 5120; Nd = 5120; }
      else if (task == 5) { src = p.hg_w_out + (size_t)mi * 1024 * 1024; off = OFF_WMIX + 10485760; K = 1024; N = 1024; Nd = 1024; }
    } else if (kind == 1) {
      if (task == 4) { src = p.na_w_in + (size_t)mi * 1024 * 3072; off = OFF_WMIX; K = 1024; N = 3072; Nd = 3072; }
      else if (task == 5) { src = p.na_w_out + (size_t)mi * 1024 * 1024; off = OFF_WMIX + 6291456; K = 1024; N = 1024; Nd = 1024; }
    } else {
      if (task == 4) { src = p.mla_w_in + (size_t)mi * 1024 * 1056; off = OFF_WMIX; K = 1024; N = 1056; Nd = 1152; }
      else if (task == 5) { src = p.mla_w_uq + (size_t)mi * 768 * 1536; off = OFF_WMIX + 2359296; K = 768; N = 1536; Nd = 1536; }
      else if (task == 6) { src = p.mla_w_ukv + (size_t)mi * 256 * 2048; off = OFF_WMIX + 4718592; K = 256; N = 2048; Nd = 2048; }
      else if (task == 7) { src = p.mla_w_out + (size_t)mi * 1024 * 1024; off = OFF_WMIX + 5767168; K = 1024; N = 1024; Nd = 1024; }
    }
    if (src) cvt_tiles(src, (u16*)(ws + off), K, N, Nd, mode, smem);
  }
}

DI void norm_phase(const float* __restrict__ src, const float* __restrict__ gain, u16* __restrict__ dst, float* copy_dst, int rows) {
  const int lane = otid() & 63, wid = otid() >> 6;
  f32x4 g[4];
#pragma unroll
  for (int i = 0; i < 4; ++i) g[i] = *(const f32x4*)(gain + i * 256 + lane * 4);
  const int stride = gridDim.x * 4;
  for (int row = blockIdx.x * 4 + wid; row < rows; row += stride * 4) {
    f32x4 v[4][4];
#pragma unroll
    for (int j = 0; j < 4; ++j) {
      const int rj = row + j * stride;
      if (rj < rows) {
#pragma unroll
        for (int i = 0; i < 4; ++i) v[j][i] = *(const f32x4*)(src + (size_t)rj * 1024 + i * 256 + lane * 4);
      }
    }
#pragma unroll
    for (int j = 0; j < 4; ++j) {
      const int rj = row + j * stride;
      if (rj < rows) {
        float ss = 0.f;
#pragma unroll
        for (int i = 0; i < 4; ++i) ss += v[j][i][0] * v[j][i][0] + v[j][i][1] * v[j][i][1] + v[j][i][2] * v[j][i][2] + v[j][i][3] * v[j][i][3];
        ss = wave_sum(ss);
        const float rstd = rsqrtf(ss * (1.f / 1024.f) + EPS);
#pragma unroll
        for (int i = 0; i < 4; ++i) {
          f32x4 y = v[j][i] * rstd * g[i];
          *(u32x2*)(dst + (size_t)rj * 1024 + i * 256 + lane * 4) = pack4(y);
          if (copy_dst) *(f32x4*)(copy_dst + (size_t)rj * 1024 + i * 256 + lane * 4) = v[j][i];
        }
      }
    }
  }
}

#define GLDS16(gp, lp) __builtin_amdgcn_global_load_lds((const unsigned*)(gp), (unsigned*)(lp), 16, 0, 0)

constexpr int G_STAGE = 24576, G_WOFF = 16384, G_NS = 3, G_MT = 8;

template <class Epi>
DI void gemm_phase(const u16* __restrict__ A, int lda, const u16* __restrict__ W, int K, int Mrows, int Ncols, const Epi& epi, char* smem) {
  const int mtn = Mrows >> 8, ntn = Ncols >> 7;
  const int ntiles = mtn * ntn, nk = K >> 5;
  constexpr int GM = 16;
  const int bid = blockIdx.x, gsz = gridDim.x;
  const int my_tiles = bid < ntiles ? (ntiles - bid + gsz - 1) / gsz : 0;
  const int total = my_tiles * nk;
  if (total > 0) {
    const int tid = otid(), lane = tid & 63, wid = tid >> 6;
    const int wm = wid >> 1, wn = wid & 1, fr = lane & 15, fq = lane >> 4;
    f32x4 acc[4][G_MT];
#pragma unroll
    for (int i = 0; i < 4; ++i)
#pragma unroll
      for (int j = 0; j < G_MT; ++j) acc[i][j] = zero4();
    const int lrow = tid >> 2, lc = (tid & 3) ^ ((tid >> 4) & 3);
    char* sdst = smem + tid * 16;
    const int ro = (fq ^ (fr >> 2)) * 16;
    const char* sa_rd = smem + (wm * 128 + fr) * 64 + ro;
    const char* sw_rd = smem + G_WOFF + (wn * 64 + fr) * 64 + ro;
    int ij = 0, ik = 0;
    const u16 *ga, *gw;
    {
      const int tile = bid, group = tile / (GM * ntn), rem = tile % (GM * ntn);
      const int mt = group * GM + (rem % GM), nt = rem / GM;
      ga = A + ((size_t)mt * 256 + lrow) * lda + lc * 8; gw = W + ((size_t)nt * 128 + lrow) * K + lc * 8;
    }
    __builtin_amdgcn_s_barrier();
    asm volatile("" ::: "memory");
#define G_ISSUE(SLOT) do { \
      const int k0_ = ik << 5; char* sd_ = sdst + (SLOT) * G_STAGE; \
      _Pragma("unroll") for (int i = 0; i < 4; ++i) GLDS16(ga + (size_t)(64 * i) * lda + k0_, sd_ + i * 4096); \
      _Pragma("unroll") for (int i = 0; i < 2; ++i) GLDS16(gw + (size_t)(64 * i) * K + k0_, sd_ + G_WOFF + i * 4096); \
      if (++ik == nk) { ik = 0; ++ij; if (ij < my_tiles) { \
        const int tile = bid + ij * gsz, group = tile / (GM * ntn), rem = tile % (GM * ntn); \
        const int mt = group * GM + (rem % GM), nt = rem / GM; \
        ga = A + ((size_t)mt * 256 + lrow) * lda + lc * 8; gw = W + ((size_t)nt * 128 + lrow) * K + lc * 8; } } } while (0)
    G_ISSUE(0);
    if (total > 1) G_ISSUE(1);
    int slot = 0, ck = 0, cj = 0;
    for (int step = 0; step < total; ++step) {
      if (step + 1 < total) asm volatile("s_waitcnt vmcnt(6)" ::: "memory");
      else asm volatile("s_waitcnt vmcnt(0)" ::: "memory");
      __builtin_amdgcn_s_barrier();
      asm volatile("" ::: "memory");
      const bool doiss = step + 2 < total;
      int isl = slot + 2; if (isl >= G_NS) isl -= G_NS;
      char* sd2 = sdst + isl * G_STAGE;
      const int k02 = ik << 5;
#define G_PA(i) do { if (doiss) GLDS16(ga + (size_t)(64 * (i)) * lda + k02, sd2 + (i) * 4096); } while (0)
#define G_PW(i) do { if (doiss) GLDS16(gw + (size_t)(64 * (i)) * K + k02, sd2 + G_WOFF + (i) * 4096); } while (0)
      const int cur = slot * G_STAGE;
      bf16x8 af[G_MT], wf[4];
#pragma unroll
      for (int i = 0; i < 4; ++i) wf[i] = *(const bf16x8*)(sw_rd + cur + i * 1024);
#pragma unroll
      for (int i = 0; i < 4; ++i) af[i] = *(const bf16x8*)(sa_rd + cur + i * 1024);
      G_PA(0); G_PA(1);
      __builtin_amdgcn_sched_barrier(0);
      acc[0][0] = MFMA32(wf[0], af[0], acc[0][0]);
      __builtin_amdgcn_sched_barrier(0);
#pragma unroll
      for (int i = 4; i < G_MT; ++i) af[i] = *(const bf16x8*)(sa_rd + cur + i * 1024);
      __builtin_amdgcn_sched_barrier(0);
#pragma unroll
      for (int mt = 0; mt < 2; ++mt)
#pragma unroll
        for (int nt = 0; nt < 4; ++nt) if (mt + nt > 0) acc[nt][mt] = MFMA32(wf[nt], af[mt], acc[nt][mt]);
      __builtin_amdgcn_sched_barrier(0);
      G_PA(2);
      __builtin_amdgcn_sched_barrier(0);
#pragma unroll
      for (int mt = 2; mt < 4; ++mt)
#pragma unroll
        for (int nt = 0; nt < 4; ++nt) acc[nt][mt] = MFMA32(wf[nt], af[mt], acc[nt][mt]);
      __builtin_amdgcn_sched_barrier(0);
      G_PA(3);
      __builtin_amdgcn_sched_barrier(0);
#pragma unroll
      for (int mt = 4; mt < 6; ++mt)
#pragma unroll
        for (int nt = 0; nt < 4; ++nt) acc[nt][mt] = MFMA32(wf[nt], af[mt], acc[nt][mt]);
      __builtin_amdgcn_sched_barrier(0);
      G_PW(0);
      __builtin_amdgcn_sched_barrier(0);
#pragma unroll
      for (int mt = 6; mt < G_MT; ++mt)
#pragma unroll
        for (int nt = 0; nt < 4; ++nt) acc[nt][mt] = MFMA32(wf[nt], af[mt], acc[nt][mt]);
      __builtin_amdgcn_sched_barrier(0);
      G_PW(1);
#undef G_PA
#undef G_PW
      if (doiss) {
        if (++ik == nk) { ik = 0; ++ij; if (ij < my_tiles) {
          const int tile = bid + ij * gsz, group = tile / (GM * ntn), rem = tile % (GM * ntn);
          const int mt = group * GM + (rem % GM), nt = rem / GM;
          ga = A + ((size_t)mt * 256 + lrow) * lda + lc * 8; gw = W + ((size_t)nt * 128 + lrow) * K + lc * 8; } }
      }
      if (++slot == G_NS) slot = 0;
      if (++ck == nk) {
        const int tile = bid + cj * gsz, group = tile / (GM * ntn), rem = tile % (GM * ntn);
        const int mt = group * GM + (rem % GM), nt = rem / GM;
        epi(acc, mt * 256 + wm * 128, nt * 128 + wn * 64, fr, fq);
#pragma unroll
        for (int i = 0; i < 4; ++i)
#pragma unroll
          for (int j = 0; j < G_MT; ++j) acc[i][j] = zero4();
        ck = 0; ++cj;
      }
    }
#undef G_ISSUE
  }
  __syncthreads();
}

struct EpiSwiglu {
  u16* act;
  DI void operator()(f32x4 (&acc)[4][G_MT], int mb, int nb, int fr, int fq) const {
#pragma unroll
    for (int mt = 0; mt < G_MT; ++mt) {
      const int m = mb + mt * 16 + fr;
#pragma unroll
      for (int np = 0; np < 2; ++np) {
        const f32x4 g = acc[2 * np][mt], u = acc[2 * np + 1][mt];
        f32x4 r;
#pragma unroll
        for (int j = 0; j < 4; ++j) r[j] = siluf_(g[j]) * u[j];
        const int jc = (nb >> 1) + np * 16 + fq * 4;
        *(u32x2*)(act + (size_t)m * 2816 + jc) = pack4(r);
      }
    }
  }
};

struct EpiResid {
  float* X; float scale;
  DI void operator()(f32x4 (&acc)[4][G_MT], int mb, int nb, int fr, int fq) const {
#pragma unroll
    for (int mt = 0; mt < G_MT; ++mt) {
      const int m = mb + mt * 16 + fr;
#pragma unroll
      for (int nt = 0; nt < 4; ++nt) {
        f32x4* ptr = (f32x4*)(X + (size_t)m * 1024 + nb + nt * 16 + fq * 4);
        f32x4 v = *ptr;
        v += acc[nt][mt] * scale;
        *ptr = v;
      }
    }
  }
};

struct EpiStore {
  u16* out; int ldo; int nmax;
  DI void operator()(f32x4 (&acc)[4][G_MT], int mb, int nb, int fr, int fq) const {
#pragma unroll
    for (int mt = 0; mt < G_MT; ++mt) {
      const int m = mb + mt * 16 + fr;
#pragma unroll
      for (int nt = 0; nt < 4; ++nt) {
        const int n = nb + nt * 16 + fq * 4;
        if (n < nmax) *(u32x2*)(out + (size_t)m * ldo + n) = pack4(acc[nt][mt]);
      }
    }
  }
};

struct EpiHgIn {
  u16 *Q, *LFf, *LFb, *V, *G; const float* lb;
  DI void operator()(f32x4 (&acc)[4][G_MT], int mb, int nb, int fr, int fq) const {
    const int seg = nb >> 10, c0 = nb & 1023;
    u16* dst = seg == 0 ? Q : seg == 1 ? LFf : seg == 2 ? LFb : seg == 3 ? V : G;
#pragma unroll
    for (int mt = 0; mt < G_MT; ++mt) {
      const int m = mb + mt * 16 + fr;
#pragma unroll
      for (int nt = 0; nt < 4; ++nt) {
        const int c = c0 + nt * 16 + fq * 4;
        f32x4 a = acc[nt][mt], r;
        if (seg == 0) r = a * 0.08838834764831845f;
        else if (seg == 3) r = a;
        else if (seg == 4) {
#pragma unroll
          for (int j = 0; j < 4; ++j) r[j] = siluf_(a[j]);
        } else {
          const f32x4 l4 = *(const f32x4*)(lb + c);
#pragma unroll
          for (int j = 0; j < 4; ++j) {
            float z = fminf(fmaxf(a[j], -30.f), 30.f);
            float f = l4[j] + (1.f - l4[j]) * sigmoidf_(z);
            r[j] = __logf(f);
          }
        }
        *(u32x2*)(dst + (size_t)m * 1024 + c) = pack4(r);
      }
    }
  }
};

struct EpiNaIn {
  u16 *Q, *K, *VT; const float *qn, *kn;
  DI void operator()(f32x4 (&acc)[4][G_MT], int mb, int nb, int fr, int fq) const {
    const int seg = nb >> 10, h = (nb & 1023) >> 6;
    if (seg < 2) {
      u16* dst = seg == 0 ? Q : K;
      const float* gn = seg == 0 ? qn : kn;
      const float sc = seg == 0 ? 0.125f * LOG2E : 1.f;
#pragma unroll
      for (int mt = 0; mt < G_MT; ++mt) {
        const int m = mb + mt * 16 + fr;
        float ss = 0.f;
#pragma unroll
        for (int nt = 0; nt < 4; ++nt)
#pragma unroll
          for (int j = 0; j < 4; ++j) ss += acc[nt][mt][j] * acc[nt][mt][j];
        ss += __shfl_xor(ss, 16); ss += __shfl_xor(ss, 32);
        const float rstd = rsqrtf(ss * (1.f / 64.f) + EPS) * sc;
#pragma unroll
        for (int nt = 0; nt < 4; ++nt) {
          const int d = nt * 16 + fq * 4;
          const f32x4 g4 = *(const f32x4*)(gn + d);
          f32x4 r = acc[nt][mt] * rstd * g4;
          *(u32x2*)(dst + (size_t)m * 1024 + h * 64 + d) = pack4(r);
        }
      }
    } else {
#pragma unroll
      for (int mt = 0; mt < G_MT; ++mt) {
        const int m = mb + mt * 16 + fr;
        const int b = m >> 12, t = m & 4095;
#pragma unroll
        for (int nt = 0; nt < 4; ++nt)
#pragma unroll
          for (int j = 0; j < 4; ++j) {
            const int d = nt * 16 + fq * 4 + j;
            VT[((size_t)((b * 16 + h) * 64 + d)) * 4096 + t] = (u16)f2bf(acc[nt][mt][j]);
          }
      }
    }
  }
};

struct HgBufs {
  u16 *Q, *LFf, *LFb, *V, *G, *QIf, *QIb, *KITf, *KITb, *VTc, *OI, *OF, *OB, *Y;
  float *DECf, *DECb;
};

DI void hg_prep_phase(const HgBufs& hb, char* smem) {
  u32x4 rq, rf, rb, rv;
  {
    const int item0 = blockIdx.x, tid0 = otid();
    if (item0 < 8192) {
      const size_t g0 = ((size_t)(item0 >> 11) * 4096 + ((item0 >> 3) & 255) * 16 + (tid0 >> 4)) * 1024 + (item0 & 7) * 128 + (tid0 & 15) * 8;
      rq = *(const u32x4*)(hb.Q + g0); rf = *(const u32x4*)(hb.LFf + g0); rb = *(const u32x4*)(hb.LFb + g0); rv = *(const u32x4*)(hb.V + g0);
    }
  }
  for (int item = blockIdx.x; item < 8192; item += gridDim.x) {
  const int h = item & 7, n = (item >> 3) & 255, b = item >> 11;
  float* sq = (float*)smem; float* sbf = sq + 2112; float* sbb = sbf + 2112; float* skf = sbb + 2112;
  float* skb = skf + 2112; float* sv = skb + 2112; float* sP = sv + 2112; float* sA = sP + 5120;
  const int tid = otid();
  const int row = tid >> 4, c8 = (tid & 15) * 8;
  const size_t tok0 = (size_t)b * 4096 + n * 16;
  const size_t gidx = (tok0 + row) * 1024 + h * 128 + c8;
  {
#pragma unroll
    for (int e = 0; e < 8; ++e) {
      const int o = row * 132 + c8 + e;
      const float lf = bfget(rf, e), lb_ = bfget(rb, e);
      sq[o] = bfget(rq, e); sbf[o] = lf; sbb[o] = lb_;
      skf[o] = 1.f - __expf(lf); skb[o] = 1.f - __expf(lb_); sv[o] = bfget(rv, e);
    }
  }
  {
    const int nx = item + gridDim.x;
    if (nx < 8192) {
      const size_t g1 = ((size_t)(nx >> 11) * 4096 + ((nx >> 3) & 255) * 16 + row) * 1024 + (nx & 7) * 128 + c8;
      rq = *(const u32x4*)(hb.Q + g1); rf = *(const u32x4*)(hb.LFf + g1); rb = *(const u32x4*)(hb.LFb + g1); rv = *(const u32x4*)(hb.V + g1);
    }
  }
  __syncthreads();
  if (tid < 128) {
    const int d = tid; float a = 0.f;
#pragma unroll
    for (int t = 0; t < 16; ++t) { a += sbf[t * 132 + d]; sbf[t * 132 + d] = a; }
    hb.DECf[((size_t)b * 256 + n) * 1024 + h * 128 + d] = __expf(a);
  } else {
    const int d = tid - 128; float a = 0.f;
#pragma unroll
    for (int t = 15; t >= 0; --t) { a += sbb[t * 132 + d]; sbb[t * 132 + d] = a; }
    hb.DECb[((size_t)b * 256 + n) * 1024 + h * 128 + d] = __expf(a);
  }
  __syncthreads();
  {
    u32x4 of, ob;
#pragma unroll
    for (int e2 = 0; e2 < 4; ++e2) {
      const int o = row * 132 + c8 + 2 * e2;
      const float q0 = sq[o], q1 = sq[o + 1];
      of[e2] = pack2(q0 * __expf(sbf[o]), q1 * __expf(sbf[o + 1]));
      ob[e2] = pack2(q0 * __expf(sbb[o]), q1 * __expf(sbb[o + 1]));
    }
    *(u32x4*)(hb.QIf + gidx) = of; *(u32x4*)(hb.QIb + gidx) = ob;
  }
  {
    const int d = tid >> 1, t8 = (tid & 1) * 8;
    const float blf = sbf[15 * 132 + d], blb = sbb[d];
    u32x4 kf, kb, vv;
#pragma unroll
    for (int e2 = 0; e2 < 4; ++e2) {
      const int o0 = (t8 + 2 * e2) * 132 + d, o1 = o0 + 132;
      kf[e2] = pack2(skf[o0] * __expf(blf - sbf[o0]), skf[o1] * __expf(blf - sbf[o1]));
      kb[e2] = pack2(skb[o0] * __expf(blb - sbb[o0]), skb[o1] * __expf(blb - sbb[o1]));
      vv[e2] = pack2(sv[o0], sv[o1]);
    }
    const size_t cidx = (((size_t)(b * 8 + h) * 256 + n) * 128 + d) * 16 + t8;
    *(u32x4*)(hb.KITf + cidx) = kf; *(u32x4*)(hb.KITb + cidx) = kb; *(u32x4*)(hb.VTc + cidx) = vv;
  }
  {
    const int s = tid >> 4, dg = tid & 15, d0 = dg * 8, sw0 = (tid >> 6) * 4;
    float w[8];
    {
      const f32x4 a = *(const f32x4*)(skf + s * 132 + d0), b2 = *(const f32x4*)(skf + s * 132 + d0 + 4);
#pragma unroll
      for (int e = 0; e < 4; ++e) { w[e] = a[e]; w[4 + e] = b2[e]; }
    }
    float pdiag = 0.f;
    for (int t = sw0; t < 16; ++t) {
      if (t > s) {
        const f32x4 a = *(const f32x4*)(skf + t * 132 + d0), b2 = *(const f32x4*)(skf + t * 132 + d0 + 4);
#pragma unroll
        for (int e = 0; e < 4; ++e) { w[e] = fmaf(-w[e], a[e], w[e]); w[4 + e] = fmaf(-w[4 + e], b2[e], w[4 + e]); }
      }
      const f32x4 q0 = *(const f32x4*)(sq + t * 132 + d0), q1 = *(const f32x4*)(sq + t * 132 + d0 + 4);
      float part = 0.f;
#pragma unroll
      for (int e = 0; e < 4; ++e) part += q0[e] * w[e] + q1[e] * w[4 + e];
      if (t == s) pdiag = part;
      else if (t > s) sP[(t * 16 + s) * 20 + dg] = part;
    }
    {
      const f32x4 a = *(const f32x4*)(skb + s * 132 + d0), b2 = *(const f32x4*)(skb + s * 132 + d0 + 4);
#pragma unroll
      for (int e = 0; e < 4; ++e) { w[e] = a[e]; w[4 + e] = b2[e]; }
    }
    for (int t = sw0 + 3; t >= 0; --t) {
      if (t < s) {
        const f32x4 a = *(const f32x4*)(skb + t * 132 + d0), b2 = *(const f32x4*)(skb + t * 132 + d0 + 4);
#pragma unroll
        for (int e = 0; e < 4; ++e) { w[e] = fmaf(-w[e], a[e], w[e]); w[4 + e] = fmaf(-w[4 + e], b2[e], w[4 + e]); }
      }
      const f32x4 q0 = *(const f32x4*)(sq + t * 132 + d0), q1 = *(const f32x4*)(sq + t * 132 + d0 + 4);
      float part = 0.f;
#pragma unroll
      for (int e = 0; e < 4; ++e) part += q0[e] * w[e] + q1[e] * w[4 + e];
      if (t == s) sP[(s * 16 + s) * 20 + dg] = pdiag + part;
      else if (t < s) sP[(t * 16 + s) * 20 + dg] = part;
    }
  }
  __syncthreads();
  {
    const int t = tid >> 4, s = tid & 15;
    const float* pp = sP + (t * 16 + s) * 20;
    const f32x4 p0 = *(const f32x4*)pp, p1 = *(const f32x4*)(pp + 4), p2 = *(const f32x4*)(pp + 8), p3 = *(const f32x4*)(pp + 12);
    const f32x4 ps = (p0 + p1) + (p2 + p3);
    sA[t * 17 + s] = (ps[0] + ps[1]) + (ps[2] + ps[3]);
  }
  __syncthreads();
  {
    float o[8];
#pragma unroll
    for (int e = 0; e < 8; ++e) o[e] = 0.f;
#pragma unroll
    for (int s = 0; s < 16; ++s) {
      const float a = sA[row * 17 + s];
      const f32x4 v0 = *(const f32x4*)(sv + s * 132 + c8), v1 = *(const f32x4*)(sv + s * 132 + c8 + 4);
#pragma unroll
      for (int e = 0; e < 4; ++e) { o[e] += a * v0[e]; o[4 + e] += a * v1[e]; }
    }
    u32x4 r; r[0] = pack2(o[0], o[1]); r[1] = pack2(o[2], o[3]); r[2] = pack2(o[4], o[5]); r[3] = pack2(o[6], o[7]);
    *(u32x4*)(hb.OI + gidx) = r;
  }
  __syncthreads();
  }
}

constexpr int SC_NS = 6, SC_STAGE = 12288;
DI void scan_issue(char* smem, int slot, const u16* QI, const u16* KIT, const u16* VTc, const float* DEC, int b, int h, int vg, int n, int tid) {
  char* st = smem + slot * SC_STAGE + tid * 16;
  const size_t tok0 = (size_t)b * 4096 + n * 16;
  const int row = tid >> 4, lc = (tid & 15) ^ row;
  GLDS16(QI + (tok0 + row) * 1024 + h * 128 + lc * 8, st);
  const size_t cb = ((size_t)(b * 8 + h) * 256 + n) * 2048;
  GLDS16(KIT + cb + tid * 8, st + 4096);
  const float* dp = DEC + ((size_t)b * 256 + n) * 1024 + h * 128;
  const void* g3 = tid < 128 ? (const void*)(VTc + cb + vg * 1024 + tid * 8) : (const void*)(dp + ((tid - 128) & 31) * 4);
  GLDS16(g3, st + 8192);
}

struct ScanRegs { bf16x8 qa[4]; bf16x8 ka[8]; bf16x8 vb; };

DI void scan_read(ScanRegs& r, const char* st, int wid, int fr, int fq) {
#pragma unroll
  for (int ks = 0; ks < 4; ++ks) {
    const int l0 = 4 * ks + (fq >> 1), l1 = l0 + 2;
    const bf16x4 lo = *(const bf16x4*)(st + fr * 256 + ((l0 ^ fr) * 16) + (fq & 1) * 8);
    const bf16x4 hi = *(const bf16x4*)(st + fr * 256 + ((l1 ^ fr) * 16) + (fq & 1) * 8);
    r.qa[ks] = cat4(lo, hi);
  }
  r.vb = *(const bf16x8*)(st + 8192 + (wid * 16 + fr) * 32 + (fq & 1) * 16);
#pragma unroll
  for (int dt = 0; dt < 8; ++dt) r.ka[dt] = *(const bf16x8*)(st + 4096 + (dt * 16 + fr) * 32 + (fq & 1) * 16);
}

DI void scan_compute(f32x4 (&S)[8], ScanRegs& r, const f32x4 (&dc)[8], u16* op, int fq) {
  const bf16x8 z8 = {0, 0, 0, 0, 0, 0, 0, 0};
  if (fq >= 2) r.vb = z8;
  f32x4 o0 = zero4(), o1 = zero4();
  o0 = MFMA32(r.qa[0], pack8(S[0], S[1]), o0);
  o1 = MFMA32(r.qa[1], pack8(S[2], S[3]), o1);
  o0 = MFMA32(r.qa[2], pack8(S[4], S[5]), o0);
  o1 = MFMA32(r.qa[3], pack8(S[6], S[7]), o1);
#pragma unroll
  for (int dt = 0; dt < 8; ++dt) {
    if (fq >= 2) r.ka[dt] = z8;
    S[dt] = S[dt] * dc[dt];
    S[dt] = MFMA32(r.ka[dt], r.vb, S[dt]);
  }
  const f32x4 o = o0 + o1;
  const u32 w0 = pack2(o[0], o[1]), w1 = pack2(o[2], o[3]);
  asm volatile("global_store_short %0, %1, off" :: "v"(op), "v"(w0) : "memory");
  asm volatile("global_store_short_d16_hi %0, %1, off" :: "v"(op + 1024), "v"(w0) : "memory");
  asm volatile("global_store_short %0, %1, off" :: "v"(op + 2048), "v"(w1) : "memory");
  asm volatile("global_store_short_d16_hi %0, %1, off" :: "v"(op + 3072), "v"(w1) : "memory");
}

DI void hg_scan_phase(const HgBufs& hb, char* smem) {
  const int tid = otid(), lane = tid & 63, wid = tid >> 6, fr = lane & 15, fq = lane >> 4;
  for (int item = blockIdx.x; item < 128; item += gridDim.x) {
    const int vg = item & 1, dir = (item >> 1) & 1, h = (item >> 2) & 7, b = item >> 5;
    const u16* QI = dir ? hb.QIb : hb.QIf; const u16* KIT = dir ? hb.KITb : hb.KITf;
    const float* DEC = dir ? hb.DECb : hb.DECf; u16* Oout = dir ? hb.OB : hb.OF;
    const int vs = vg * 4 + wid;
    u16* obase = Oout + ((size_t)b * 4096 + fq * 4) * 1024 + h * 128 + vs * 16 + fr;
    f32x4 S[8];
#pragma unroll
    for (int i = 0; i < 8; ++i) S[i] = zero4();
#pragma unroll
    for (int s = 0; s < SC_NS - 1; ++s) scan_issue(smem, s, QI, KIT, hb.VTc, DEC, b, h, vg, dir ? 255 - s : s, tid);
    asm volatile("s_waitcnt vmcnt(12)" ::: "memory");
    __builtin_amdgcn_s_barrier();
    asm volatile("" ::: "memory");
    ScanRegs ra, rb;
    scan_read(ra, smem, wid, fr, fq);
    int slot = 0;
#define SCAN_STEP(STEP, CUR, NXT) do { \
      const int step_ = (STEP); \
      if (step_ < 4) asm volatile("s_waitcnt vmcnt(9) lgkmcnt(0)" ::: "memory"); \
      else asm volatile("s_waitcnt vmcnt(25) lgkmcnt(0)" ::: "memory"); \
      __builtin_amdgcn_s_barrier(); \
      asm volatile("" ::: "memory"); \
      { const int ns_ = min(step_ + SC_NS - 1, 255); \
        int is_ = slot + SC_NS - 1; if (is_ >= SC_NS) is_ -= SC_NS; \
        scan_issue(smem, is_, QI, KIT, hb.VTc, DEC, b, h, vg, dir ? 255 - ns_ : ns_, tid); } \
      f32x4 dc_[8]; \
      { const char* st_ = smem + slot * SC_STAGE + 8192 + 2048 + fq * 16; \
        _Pragma("unroll") for (int dt = 0; dt < 8; ++dt) dc_[dt] = *(const f32x4*)(st_ + dt * 64); } \
      int nslot_ = slot + 1; if (nslot_ == SC_NS) nslot_ = 0; \
      if (step_ + 1 < 256) scan_read(NXT, smem + nslot_ * SC_STAGE, wid, fr, fq); \
      { const int n_ = dir ? 255 - step_ : step_; \
        scan_compute(S, CUR, dc_, obase + (size_t)n_ * 16 * 1024, fq); } \
      slot = nslot_; } while (0)
    for (int step = 0; step < 256; step += 2) {
      SCAN_STEP(step, ra, rb);
      SCAN_STEP(step + 1, rb, ra);
    }
#undef SCAN_STEP
    asm volatile("s_waitcnt vmcnt(0)" ::: "memory");
    __syncthreads();
  }
}

DI void hg_combine_phase(const HgBufs& hb, const float* __restrict__ gnorm, int rows) {
  const int lane = otid() & 63, wid = otid() >> 6;
  const int h = lane >> 3, c16 = (lane & 7) * 16;
  const int stride = gridDim.x * 4;
  f32x4 gn[4];
#pragma unroll
  for (int i = 0; i < 4; ++i) gn[i] = *(const f32x4*)(gnorm + c16 + i * 4);
  for (int row = blockIdx.x * 4 + wid; row < rows; row += stride * 2) {
    u32x4 ra[2][2], rf[2][2], rb[2][2], rg[2][2];
#pragma unroll
    for (int j = 0; j < 2; ++j) {
      const int rj = row + j * stride;
      if (rj < rows) {
        const size_t g = (size_t)rj * 1024 + h * 128 + c16;
#pragma unroll
        for (int half = 0; half < 2; ++half) {
          ra[j][half] = *(const u32x4*)(hb.OI + g + half * 8); rf[j][half] = *(const u32x4*)(hb.OF + g + half * 8);
          rb[j][half] = *(const u32x4*)(hb.OB + g + half * 8); rg[j][half] = *(const u32x4*)(hb.G + g + half * 8);
        }
      }
    }
#pragma unroll
    for (int j = 0; j < 2; ++j) {
      const int rj = row + j * stride;
      if (rj < rows) {
        const size_t g = (size_t)rj * 1024 + h * 128 + c16;
        float o[16]; float ss = 0.f;
#pragma unroll
        for (int half = 0; half < 2; ++half)
#pragma unroll
          for (int e = 0; e < 8; ++e) { float v = bfget(ra[j][half], e) + bfget(rf[j][half], e) + bfget(rb[j][half], e); o[half * 8 + e] = v; ss += v * v; }
        ss += __shfl_xor(ss, 1); ss += __shfl_xor(ss, 2); ss += __shfl_xor(ss, 4);
        const float rstd = rsqrtf(ss * (1.f / 128.f) + EPS);
#pragma unroll
        for (int half = 0; half < 2; ++half) {
          u32x4 r;
#pragma unroll
          for (int e2 = 0; e2 < 4; ++e2) {
            const int e = half * 8 + 2 * e2;
            r[e2] = pack2(o[e] * rstd * gn[e >> 2][e & 3] * bfget(rg[j][half], 2 * e2), o[e + 1] * rstd * gn[(e + 1) >> 2][(e + 1) & 3] * bfget(rg[j][half], 2 * e2 + 1));
          }
          *(u32x4*)(hb.Y + g + half * 8) = r;
        }
      }
    }
  }
}

DI void na_attn_item(const u16* __restrict__ Q, const u16* __restrict__ K, const u16* __restrict__ VT, const float* __restrict__ rpb, u16* __restrict__ O, int item, int fr, int fq) {
  const int qt = item & 3, h = (item >> 2) & 15, r = (item >> 6) & 63, b = item >> 12;
  const int r0 = min(max(r - 4, 0), 56);
  const int cw0 = qt == 0 ? 0 : qt == 1 ? 8 : qt == 2 ? 24 : 32;
  const size_t tokq = (size_t)b * 4096 + r * 64 + qt * 16 + fr;
  bf16x8 qf[2];
#pragma unroll
  for (int ks = 0; ks < 2; ++ks) qf[ks] = *(const bf16x8*)(Q + tokq * 1024 + h * 64 + ks * 32 + fq * 8);
  f32x4 s[8][2];
#pragma unroll
  for (int kr = 0; kr < 8; ++kr)
#pragma unroll
    for (int hf = 0; hf < 2; ++hf) {
      const size_t tokk = (size_t)b * 4096 + (r0 + kr) * 64 + cw0 + hf * 16 + fr;
      const bf16x8 k0 = *(const bf16x8*)(K + tokk * 1024 + h * 64 + fq * 8);
      const bf16x8 k1 = *(const bf16x8*)(K + tokk * 1024 + h * 64 + 32 + fq * 8);
      f32x4 a = MFMA32(k0, qf[0], zero4());
      s[kr][hf] = MFMA32(k1, qf[1], a);
    }
  const int qc = qt * 16 + fr;
  const int cs = min(max(qc - 8, 0), 48);
  float mx = -1e30f;
#pragma unroll
  for (int kr = 0; kr < 8; ++kr) {
    const float* rp = rpb + (h * 15 + (r0 + kr - r + 7)) * 31;
#pragma unroll
    for (int hf = 0; hf < 2; ++hf)
#pragma unroll
      for (int j = 0; j < 4; ++j) {
        const int kc = cw0 + hf * 16 + fq * 4 + j;
        const bool valid = (kc >= cs) && (kc < cs + 16);
        const int ci = min(max(kc - qc + 15, 0), 30);
        const float v = valid ? s[kr][hf][j] + rp[ci] * LOG2E : -1e30f;
        s[kr][hf][j] = v; mx = fmaxf(mx, v);
      }
  }
  mx = fmaxf(mx, __shfl_xor(mx, 16)); mx = fmaxf(mx, __shfl_xor(mx, 32));
  float l = 0.f;
#pragma unroll
  for (int kr = 0; kr < 8; ++kr)
#pragma unroll
    for (int hf = 0; hf < 2; ++hf)
#pragma unroll
      for (int j = 0; j < 4; ++j) { const float pv = __builtin_amdgcn_exp2f(s[kr][hf][j] - mx); s[kr][hf][j] = pv; l += pv; }
  l += __shfl_xor(l, 16); l += __shfl_xor(l, 32);
  f32x4 o[4];
#pragma unroll
  for (int dt = 0; dt < 4; ++dt) o[dt] = zero4();
#pragma unroll
  for (int kr = 0; kr < 8; ++kr) {
    const bf16x8 pp = pack8(s[kr][0], s[kr][1]);
#pragma unroll
    for (int dt = 0; dt < 4; ++dt) {
      const u16* vp = VT + ((size_t)((b * 16 + h) * 64 + dt * 16 + fr)) * 4096 + (r0 + kr) * 64 + cw0 + fq * 4;
      const bf16x8 vf = cat4(*(const bf16x4*)vp, *(const bf16x4*)(vp + 16));
      o[dt] = MFMA32(vf, pp, o[dt]);
    }
  }
  const float inv = 1.f / l;
#pragma unroll
  for (int dt = 0; dt < 4; ++dt) *(u32x2*)(O + tokq * 1024 + h * 64 + dt * 16 + fq * 4) = pack4(o[dt] * inv);
}

DI void mla_norm_phase(const u16* __restrict__ CRAW, const float* __restrict__ gq, const float* __restrict__ gkv, u16* __restrict__ CQN, u16* __restrict__ CKVN, float* __restrict__ KROPE) {
  const int lane = otid() & 63, wid = otid() >> 6;
  for (int row = blockIdx.x * 4 + wid; row < MTOK; row += gridDim.x * 4) {
    const u16* c = CRAW + (size_t)row * 1056;
    f32x4 v[3]; float ss = 0.f;
#pragma unroll
    for (int i = 0; i < 3; ++i) {
      const u32x2 w = *(const u32x2*)(c + i * 256 + lane * 4);
      v[i][0] = bflo(w[0]); v[i][1] = bfhi(w[0]); v[i][2] = bflo(w[1]); v[i][3] = bfhi(w[1]);
      ss += v[i][0] * v[i][0] + v[i][1] * v[i][1] + v[i][2] * v[i][2] + v[i][3] * v[i][3];
    }
    ss = wave_sum(ss);
    const float rq = rsqrtf(ss * (1.f / 768.f) + EPS);
#pragma unroll
    for (int i = 0; i < 3; ++i) {
      const f32x4 g4 = *(const f32x4*)(gq + i * 256 + lane * 4);
      *(u32x2*)(CQN + (size_t)row * 768 + i * 256 + lane * 4) = pack4(v[i] * rq * g4);
    }
    {
      const u32x2 w = *(const u32x2*)(c + 768 + lane * 4);
      f32x4 k; k[0] = bflo(w[0]); k[1] = bfhi(w[0]); k[2] = bflo(w[1]); k[3] = bfhi(w[1]);
      float s2 = wave_sum(k[0] * k[0] + k[1] * k[1] + k[2] * k[2] + k[3] * k[3]);
      const float rk = rsqrtf(s2 * (1.f / 256.f) + EPS);
      const f32x4 g4 = *(const f32x4*)(gkv + lane * 4);
      *(u32x2*)(CKVN + (size_t)row * 256 + lane * 4) = pack4(k * rk * g4);
    }
    if (lane < 8) {
      const u32x2 w = *(const u32x2*)(c + 1024 + lane * 4);
      f32x4 k; k[0] = bflo(w[0]); k[1] = bfhi(w[0]); k[2] = bflo(w[1]); k[3] = bfhi(w[1]);
      *(f32x4*)(KROPE + (size_t)row * 32 + lane * 4) = k;
    }
  }
}

DI void mla_prep_phase(u16* __restrict__ Q, const u16* __restrict__ KVRAW, const float* __restrict__ KROPE, u16* __restrict__ Kout,
                       const float* __restrict__ gq, const float* __restrict__ gk, const float* __restrict__ RC, const float* __restrict__ RS) {
  const int lane = otid() & 63, wid = otid() >> 6;
  const int h = lane >> 2, sub = lane & 3;
  const float QS = 0.10206207261596577f * LOG2E;
  for (int m = blockIdx.x * 4 + wid; m < MTOK; m += gridDim.x * 4) {
    const int t = m & 4095;
    const f32x4 cs = *(const f32x4*)(RC + t * 16 + sub * 4), sn = *(const f32x4*)(RS + t * 16 + sub * 4);
#pragma unroll
    for (int which = 0; which < 2; ++which) {
      float nope[16]; f32x4 ra, rb;
      u16* dstp = (which == 0 ? Q : Kout) + (size_t)m * 1536 + h * 96;
      const float* gn = which == 0 ? gq : gk;
      if (which == 0) {
        const u32x4 w0 = *(const u32x4*)(dstp + sub * 16), w1 = *(const u32x4*)(dstp + sub * 16 + 8);
#pragma unroll
        for (int e = 0; e < 8; ++e) { nope[e] = bfget(w0, e); nope[8 + e] = bfget(w1, e); }
        const u32x2 a2 = *(const u32x2*)(dstp + 64 + sub * 4), b2 = *(const u32x2*)(dstp + 80 + sub * 4);
        ra[0] = bflo(a2[0]); ra[1] = bfhi(a2[0]); ra[2] = bflo(a2[1]); ra[3] = bfhi(a2[1]);
        rb[0] = bflo(b2[0]); rb[1] = bfhi(b2[0]); rb[2] = bflo(b2[1]); rb[3] = bfhi(b2[1]);
      } else {
        const u16* kp = KVRAW + (size_t)m * 2048 + h * 128 + sub * 16;
        const u32x4 w0 = *(const u32x4*)kp, w1 = *(const u32x4*)(kp + 8);
#pragma unroll
        for (int e = 0; e < 8; ++e) { nope[e] = bfget(w0, e); nope[8 + e] = bfget(w1, e); }
        ra = *(const f32x4*)(KROPE + (size_t)m * 32 + sub * 4);
        rb = *(const f32x4*)(KROPE + (size_t)m * 32 + 16 + sub * 4);
      }
      float ss = 0.f;
#pragma unroll
      for (int e = 0; e < 16; ++e) ss += nope[e] * nope[e];
#pragma unroll
      for (int e = 0; e < 4; ++e) ss += ra[e] * ra[e] + rb[e] * rb[e];
      ss += __shfl_xor(ss, 1); ss += __shfl_xor(ss, 2);
      const float rstd = rsqrtf(ss * (1.f / 96.f) + EPS) * (which == 0 ? QS : 1.f);
      u32x4 o0, o1;
#pragma unroll
      for (int e2 = 0; e2 < 4; ++e2) {
        o0[e2] = pack2(nope[2 * e2] * rstd * gn[sub * 16 + 2 * e2], nope[2 * e2 + 1] * rstd * gn[sub * 16 + 2 * e2 + 1]);
        o1[e2] = pack2(nope[8 + 2 * e2] * rstd * gn[sub * 16 + 8 + 2 * e2], nope[9 + 2 * e2] * rstd * gn[sub * 16 + 9 + 2 * e2]);
      }
      f32x4 oa, ob;
#pragma unroll
      for (int e = 0; e < 4; ++e) {
        const float a = ra[e] * rstd * gn[64 + sub * 4 + e], bq = rb[e] * rstd * gn[80 + sub * 4 + e];
        oa[e] = a * cs[e] - bq * sn[e];
        ob[e] = bq * cs[e] + a * sn[e];
      }
      *(u32x4*)(dstp + sub * 16) = o0; *(u32x4*)(dstp + sub * 16 + 8) = o1;
      *(u32x2*)(dstp + 64 + sub * 4) = pack4(oa); *(u32x2*)(dstp + 80 + sub * 4) = pack4(ob);
    }
  }
}

DI void mla_vt_phase(const u16* __restrict__ KVRAW, u16* __restrict__ VT, char* smem) {
  u16* tile = (u16*)smem;
  const int tid = otid();
  for (int item = blockIdx.x; item < 8192; item += gridDim.x) {
    const int tt = item & 63, bh = item >> 6, b = bh >> 4, h = bh & 15;
    {
      const int row = tid >> 2, part = tid & 3;
      const u16* src = KVRAW + ((size_t)b * 4096 + tt * 64 + row) * 2048 + h * 128 + 64 + part * 16;
      const u32x4 w0 = *(const u32x4*)src, w1 = *(const u32x4*)(src + 8);
      u32* d32 = (u32*)(tile + row * 66 + part * 16);
#pragma unroll
      for (int e = 0; e < 4; ++e) { d32[e] = w0[e]; d32[4 + e] = w1[e]; }
    }
    __syncthreads();
    {
      const int d = tid >> 2, tp = (tid & 3) * 16;
      u32x4 o0, o1;
#pragma unroll
      for (int e2 = 0; e2 < 4; ++e2) {
        o0[e2] = (u32)tile[(tp + 2 * e2) * 66 + d] | ((u32)tile[(tp + 2 * e2 + 1) * 66 + d] << 16);
        o1[e2] = (u32)tile[(tp + 8 + 2 * e2) * 66 + d] | ((u32)tile[(tp + 9 + 2 * e2) * 66 + d] << 16);
      }
      u16* dst = VT + ((size_t)(bh * 64 + d)) * 4096 + tt * 64 + tp;
      *(u32x4*)dst = o0; *(u32x4*)(dst + 8) = o1;
    }
    __syncthreads();
  }
}

constexpr int FA_KROW = 208, FA_VROW = 144, FA_KT = 64 * FA_KROW, FA_BUF = FA_KT + 64 * FA_VROW;
DI void mla_attn_item(const u16* __restrict__ Q, const u16* __restrict__ Kb, const u16* __restrict__ VT, u16* __restrict__ O, int item, char* smem) {
  const int qb = item & 15, bh = item >> 4, b = bh >> 4, h = bh & 15;
  const int tid = otid(), lane = tid & 63, wid = tid >> 6, fr = lane & 15, fq = lane >> 4;
  bf16x8 qf[4][3];
#pragma unroll
  for (int qt = 0; qt < 4; ++qt) {
    const size_t tq = (size_t)b * 4096 + qb * 256 + wid * 64 + qt * 16 + fr;
#pragma unroll
    for (int ks = 0; ks < 3; ++ks) qf[qt][ks] = *(const bf16x8*)(Q + tq * 1536 + h * 96 + ks * 32 + fq * 8);
  }
  f32x4 o[4][4];
#pragma unroll
  for (int i = 0; i < 4; ++i)
#pragma unroll
    for (int j = 0; j < 4; ++j) o[i][j] = zero4();
  float mrun[4] = {-1e30f, -1e30f, -1e30f, -1e30f}, lrun[4] = {0.f, 0.f, 0.f, 0.f};
  const u16* kg[3]; int ks_off[3];
#pragma unroll
  for (int i = 0; i < 3; ++i) {
    const int c = tid + 256 * i, row = c / 12, kc = c % 12;
    kg[i] = Kb + ((size_t)b * 4096 + row) * 1536 + h * 96 + kc * 8;
    ks_off[i] = row * FA_KROW + kc * 16;
  }
  const u16* vg[2]; int vs_off[2];
#pragma unroll
  for (int i = 0; i < 2; ++i) {
    const int c = tid + 256 * i, d = c >> 3, kc = c & 7;
    vg[i] = VT + ((size_t)(bh * 64 + d)) * 4096 + kc * 8;
    vs_off[i] = FA_KT + d * FA_VROW + kc * 16;
  }
  u32x4 rk[3], rv[2];
#pragma unroll
  for (int i = 0; i < 3; ++i) rk[i] = *(const u32x4*)(kg[i]);
#pragma unroll
  for (int i = 0; i < 2; ++i) rv[i] = *(const u32x4*)(vg[i]);
#pragma unroll
  for (int i = 0; i < 3; ++i) *(u32x4*)(smem + ks_off[i]) = rk[i];
#pragma unroll
  for (int i = 0; i < 2; ++i) *(u32x4*)(smem + vs_off[i]) = rv[i];
#pragma unroll
  for (int qt = 0; qt < 4; ++qt)
#pragma unroll
    for (int ks = 0; ks < 3; ++ks) asm volatile("" :: "v"(qf[qt][ks]));
  __syncthreads();
  for (int kt = 0; kt < 64; ++kt) {
    const int cur = (kt & 1) * FA_BUF, nxt = FA_BUF - cur;
    if (kt + 1 < 64) {
      const size_t key0 = (size_t)(kt + 1) * 64;
#pragma unroll
      for (int i = 0; i < 3; ++i) rk[i] = *(const u32x4*)(kg[i] + key0 * 1536);
#pragma unroll
      for (int i = 0; i < 2; ++i) rv[i] = *(const u32x4*)(vg[i] + key0);
    }
#pragma unroll
    for (int kh = 0; kh < 2; ++kh) {
      f32x4 s[2][4];
#pragma unroll
      for (int kl = 0; kl < 2; ++kl) {
#pragma unroll
        for (int qt = 0; qt < 4; ++qt) s[kl][qt] = zero4();
#pragma unroll
        for (int ks = 0; ks < 3; ++ks) {
          const bf16x8 kf = *(const bf16x8*)(smem + cur + ((kh * 2 + kl) * 16 + fr) * FA_KROW + ks * 64 + fq * 16);
#pragma unroll
          for (int qt = 0; qt < 4; ++qt) s[kl][qt] = MFMA32(kf, qf[qt][ks], s[kl][qt]);
        }
      }
      bf16x8 pp[4];
      {
        float lm[4]; bool need = false;
#pragma unroll
        for (int qt = 0; qt < 4; ++qt) {
          const float m0 = fmaxf(fmaxf(s[0][qt][0], s[0][qt][1]), fmaxf(s[0][qt][2], s[0][qt][3]));
          const float m1 = fmaxf(fmaxf(s[1][qt][0], s[1][qt][1]), fmaxf(s[1][qt][2], s[1][qt][3]));
          lm[qt] = fmaxf(m0, m1);
          need = need || (lm[qt] > mrun[qt] + 8.f);
        }
        if (__any(need)) {
#pragma unroll
          for (int qt = 0; qt < 4; ++qt) {
            float mx = lm[qt];
            mx = fmaxf(mx, __shfl_xor(mx, 16)); mx = fmaxf(mx, __shfl_xor(mx, 32));
            const float mnew = fmaxf(mrun[qt], mx);
            const float alpha = __builtin_amdgcn_exp2f(mrun[qt] - mnew);
            mrun[qt] = mnew;
            lrun[qt] *= alpha;
#pragma unroll
            for (int dt = 0; dt < 4; ++dt) o[dt][qt] = o[dt][qt] * alpha;
          }
        }
#pragma unroll
        for (int qt = 0; qt < 4; ++qt) {
          const float mr = mrun[qt];
          float ps = 0.f;
#pragma unroll
          for (int kl = 0; kl < 2; ++kl)
#pragma unroll
            for (int j = 0; j < 4; ++j) { const float pv = __builtin_amdgcn_exp2f(s[kl][qt][j] - mr); s[kl][qt][j] = pv; ps += pv; }
          lrun[qt] += ps;
          pp[qt] = pack8(s[0][qt], s[1][qt]);
        }
      }
#pragma unroll
      for (int dt = 0; dt < 4; ++dt) {
        const char* vp = smem + cur + FA_KT + (dt * 16 + fr) * FA_VROW + (kh * 32 + fq * 4) * 2;
        const bf16x8 vf = cat4(*(const bf16x4*)vp, *(const bf16x4*)(vp + 32));
#pragma unroll
        for (int qt = 0; qt < 4; ++qt) o[dt][qt] = MFMA32(vf, pp[qt], o[dt][qt]);
      }
    }
    if (kt + 1 < 64) {
#pragma unroll
      for (int i = 0; i < 3; ++i) *(u32x4*)(smem + nxt + ks_off[i]) = rk[i];
#pragma unroll
      for (int i = 0; i < 2; ++i) *(u32x4*)(smem + nxt + vs_off[i]) = rv[i];
    }
    __syncthreads();
  }
#pragma unroll
  for (int qt = 0; qt < 4; ++qt) {
    float l = lrun[qt];
    l += __shfl_xor(l, 16); l += __shfl_xor(l, 32);
    const float inv = 1.f / l;
    const size_t tq = (size_t)b * 4096 + qb * 256 + wid * 64 + qt * 16 + fr;
#pragma unroll
    for (int dt = 0; dt < 4; ++dt) *(u32x2*)(O + tq * 1024 + h * 64 + dt * 16 + fq * 4) = pack4(o[dt][qt] * inv);
  }
}

#define XB_TMO      128
#define XB_XCNT(j)  (256  + 64 * (j))
#define XB_XSUB(j)  (1280 + 64 * (j))
#define XB_XGEN(j)  (2304 + 64 * (j))
#define XB_TOP      3328
#define XB_TOPGEN   3392
#define XCD_BAR_WORDS 3456
#define XB_SPIN_CAP (1u << 22)
DI unsigned xb_ld(unsigned* p) { return __hip_atomic_load(p, __ATOMIC_RELAXED, __HIP_MEMORY_SCOPE_AGENT); }
DI unsigned xb_add(unsigned* p, unsigned v) { return __hip_atomic_fetch_add(p, v, __ATOMIC_RELAXED, __HIP_MEMORY_SCOPE_AGENT); }
DI unsigned xb_xcc_id() { return (unsigned)__builtin_amdgcn_s_getreg((3 << 11) | 20) & 0xFu; }
#define XB_SPIN(cond, bar) do { unsigned _sp = 0; while (cond) { __builtin_amdgcn_s_sleep(1); \
    if ((++_sp & 255u) == 0u) { if (xb_ld(&(bar)[XB_TMO])) break; if (_sp > XB_SPIN_CAP) { atomicAdd(&(bar)[XB_TMO], 1u); break; } } } } while (0)

DI void xcd_barrier_complete(unsigned* bar, unsigned x, unsigned& nloc, unsigned& nx) {
  const unsigned G = gridDim.x;
  unsigned sum, cnt, mine, sp = 0u;
  for (;;) {
    sum = 0u; cnt = 0u; mine = 0u;
#pragma unroll
    for (unsigned j = 0; j < 16; ++j) { const unsigned c = xb_ld(&bar[XB_XCNT(j)]); sum += c; cnt += (c > 0u) ? 1u : 0u; mine = (j == x) ? c : mine; }
    if (sum == G) break;
    __builtin_amdgcn_s_sleep(1);
    if ((++sp & 255u) == 0u) { if (xb_ld(&bar[XB_TMO])) break; if (sp > XB_SPIN_CAP) { atomicAdd(&bar[XB_TMO], 1u); break; } }
  }
  nloc = mine > 0u ? mine : 1u; nx = cnt > 0u ? cnt : 1u;
}

DI void xcd_barrier(unsigned* bar, volatile unsigned* st) {
  asm volatile("s_waitcnt vmcnt(0)" ::: "memory");
  __syncthreads();
  if (threadIdx.x == 0) {
    __builtin_amdgcn_s_waitcnt(0);
    const unsigned x = xb_xcc_id();
    unsigned nloc = st[0], nx = st[1];
    if (nloc == 0u) { xcd_barrier_complete(bar, x, nloc, nx); st[0] = nloc; st[1] = nx; }
    const unsigned old = xb_add(&bar[XB_XSUB(x)], 1u);
    const unsigned gen = old / nloc;
    if (old + 1u == (gen + 1u) * nloc) {
      __builtin_amdgcn_fence(__ATOMIC_RELEASE, "agent");
      asm volatile("s_waitcnt vmcnt(0)" ::: "memory");
      const unsigned og = xb_add(&bar[XB_TOP], 1u);
      const unsigned tg = og / nx;
      if (og + 1u == (tg + 1u) * nx) xb_add(&bar[XB_TOPGEN], 1u);
      else XB_SPIN(xb_ld(&bar[XB_TOPGEN]) == tg, bar);
      __builtin_amdgcn_fence(__ATOMIC_ACQUIRE, "agent");
      xb_add(&bar[XB_XGEN(x)], 1u);
      asm volatile("s_waitcnt vmcnt(0)" ::: "memory");
    } else {
      XB_SPIN(xb_ld(&bar[XB_XGEN(x)]) == gen, bar);
      __builtin_amdgcn_fence(__ATOMIC_ACQUIRE, "agent");
      asm volatile("s_waitcnt vmcnt(0)" ::: "memory");
    }
  }
  __syncthreads();
}

#ifndef ENMASK
#define ENMASK 0xffffffffu
#endif
#define EN(i) ((ENMASK >> (i)) & 1u)
#ifndef DUPMASK
#define DUPMASK 0u
#endif
#define DUP(i) ((DUPMASK >> (i)) & 1u)
#ifndef BAR2
#define BAR2 0
#endif
#define PHASE_BEGIN(i) if (EN(i) && pc >= p.lo && pc < p.hi) for (int rep_ = 0; rep_ < 1 + (int)DUP(i); ++rep_) {
#define PHASE_END } { if (pc >= p.lo && pc + 1 < p.hi) { if (pc == p.lo) grid.sync(); else { xcd_barrier(bar, st); if (BAR2) xcd_barrier(bar, st); } } ++pc; }

__global__ void __launch_bounds__(256, 2) mega(Params p) {
  __shared__ __attribute__((aligned(16))) char smem[73728 + 16];
  cg::grid_group grid = cg::this_grid();
  int pc = 0;
  char* ws = p.ws;
  unsigned* bar = (unsigned*)(ws + OFF_BAR);
  volatile unsigned* st = (volatile unsigned*)(smem + 73728);
  if (threadIdx.x == 0) { st[0] = 0u; st[1] = 0u; (void)xb_add(&bar[XB_XCNT(xb_xcc_id())], 1u); }
  __syncthreads();
  u16* H = (u16*)(ws + OFF_H);
  char* R = ws + OFF_R;
  const float* LB = (const float*)(ws + OFF_TAB);
  const float* RC = LB + 4096; const float* RS = RC + 65536;
  for (int layer = 0; layer < 4; ++layer) {
    const int kind = layer % 3, mi = layer / 3;
    for (int stage = 0; stage < 3; ++stage) {
      if (stage != 1) {
        const float* ng = (stage == 0 ? p.ffn1_norm : p.ffn2_norm) + layer * 1024;
        const u16* wgu = (const u16*)(ws + (stage == 0 ? OFF_WGU1 : OFF_WGU2));
        const u16* wdn = (const u16*)(ws + (stage == 0 ? OFF_WDN1 : OFF_WDN2));
        u16* ACT = (u16*)R;
        PHASE_BEGIN(0)
          const bool first = (layer == 0 && stage == 0);
          if (stage == 0) { if (layer == 0) init_tables(p); cvt_layer(p, layer, smem); }
          norm_phase(first ? p.x : p.X, ng, H, first ? p.X : nullptr, MTOK);
        PHASE_END
        PHASE_BEGIN(1)
          gemm_phase(H, 1024, wgu, 1024, MTOK, 5632, EpiSwiglu{ACT}, smem);
        PHASE_END
        PHASE_BEGIN(2)
          gemm_phase(ACT, 2816, wdn, 2816, MTOK, 1024, EpiResid{p.X, 0.5f}, smem);
        PHASE_END
      } else {
        PHASE_BEGIN(3)
          norm_phase(p.X, p.mix_norm + layer * 1024, H, nullptr, MTOK);
        PHASE_END
        if (kind == 0) {
          constexpr size_t SZ = 32 * MiB;
          HgBufs hb;
          hb.Q = (u16*)(R + 0 * SZ); hb.LFf = (u16*)(R + 1 * SZ); hb.LFb = (u16*)(R + 2 * SZ); hb.V = (u16*)(R + 3 * SZ); hb.G = (u16*)(R + 4 * SZ);
          hb.QIf = (u16*)(R + 5 * SZ); hb.QIb = (u16*)(R + 6 * SZ); hb.KITf = (u16*)(R + 7 * SZ); hb.KITb = (u16*)(R + 8 * SZ);
          hb.VTc = (u16*)(R + 9 * SZ); hb.OI = (u16*)(R + 10 * SZ); hb.OF = hb.Q; hb.OB = hb.LFf; hb.Y = hb.LFb;
          hb.DECf = (float*)(R + 11 * SZ); hb.DECb = (float*)(R + 11 * SZ + 4 * MiB);
          const u16* w_in = (const u16*)(ws + OFF_WMIX); const u16* w_out = (const u16*)(ws + OFF_WMIX + 10485760);
          for (int half = 0; half < 2; ++half) {
            PHASE_BEGIN(4)
              gemm_phase(H + (size_t)half * 16384 * 1024, 1024, w_in, 1024, 16384, 5120, EpiHgIn{hb.Q, hb.LFf, hb.LFb, hb.V, hb.G, LB + layer * 1024}, smem);
            PHASE_END
            PHASE_BEGIN(5)
              hg_prep_phase(hb, smem);
            PHASE_END
            PHASE_BEGIN(6)
              hg_scan_phase(hb, smem);
            PHASE_END
            PHASE_BEGIN(7)
              hg_combine_phase(hb, p.hg_g_norm + mi * 128, 16384);
            PHASE_END
            PHASE_BEGIN(8)
              gemm_phase(hb.Y, 1024, w_out, 1024, 16384, 1024, EpiResid{p.X + (size_t)half * 16384 * 1024, 1.0f}, smem);
            PHASE_END
          }
        } else if (kind == 1) {
          u16* Qn = (u16*)R; u16* Kn = (u16*)(R + 64 * MiB); u16* VT = (u16*)(R + 128 * MiB); u16* On = (u16*)(R + 192 * MiB);
          const u16* w_in = (const u16*)(ws + OFF_WMIX); const u16* w_out = (const u16*)(ws + OFF_WMIX + 6291456);
          PHASE_BEGIN(9)
            gemm_phase(H, 1024, w_in, 1024, MTOK, 3072, EpiNaIn{Qn, Kn, VT, p.na_q_norm + mi * 64, p.na_k_norm + mi * 64}, smem);
          PHASE_END
          PHASE_BEGIN(10)
            const int tid_ = otid(), lane = tid_ & 63, wid = tid_ >> 6, fr = lane & 15, fq = lane >> 4;
            for (int item = blockIdx.x * 4 + wid; item < 32768; item += gridDim.x * 4)
              na_attn_item(Qn, Kn, VT, p.na_rpb + (size_t)mi * 16 * 15 * 31, On, item, fr, fq);
          PHASE_END
          PHASE_BEGIN(11)
            gemm_phase(On, 1024, w_out, 1024, MTOK, 1024, EpiResid{p.X, 1.0f}, smem);
          PHASE_END
        } else {
          u16* VT = H;
          u16* CRAW = (u16*)R; u16* On = (u16*)R;
          u16* CQN = (u16*)(R + 66 * MiB); u16* CKVN = (u16*)(R + 114 * MiB); u16* Kk = (u16*)(R + 66 * MiB);
          float* KROPE = (float*)(R + 162 * MiB);
          u16* Qq = (u16*)(R + 166 * MiB); u16* KVRAW = (u16*)(R + 262 * MiB);
          const u16* w_in = (const u16*)(ws + OFF_WMIX); const u16* w_uq = (const u16*)(ws + OFF_WMIX + 2359296);
          const u16* w_ukv = (const u16*)(ws + OFF_WMIX + 4718592); const u16* w_out = (const u16*)(ws + OFF_WMIX + 5767168);
          PHASE_BEGIN(12)
            gemm_phase(H, 1024, w_in, 1024, MTOK, 1152, EpiStore{CRAW, 1056, 1056}, smem);
          PHASE_END
          PHASE_BEGIN(13)
            mla_norm_phase(CRAW, p.mla_q_a_norm + mi * 768, p.mla_kv_a_norm + mi * 256, CQN, CKVN, KROPE);
          PHASE_END
          PHASE_BEGIN(14)
            gemm_phase(CQN, 768, w_uq, 768, MTOK, 1536, EpiStore{Qq, 1536, 1536}, smem);
            gemm_phase(CKVN, 256, w_ukv, 256, MTOK, 2048, EpiStore{KVRAW, 2048, 2048}, smem);
          PHASE_END
          PHASE_BEGIN(15)
            mla_prep_phase(Qq, KVRAW, KROPE, Kk, p.mla_q_norm + mi * 96, p.mla_k_norm + mi * 96, RC, RS);
            mla_vt_phase(KVRAW, VT, smem);
          PHASE_END
          PHASE_BEGIN(16)
            for (int item = blockIdx.x; item < 2048; item += gridDim.x) mla_attn_item(Qq, Kk, VT, On, item, smem);
          PHASE_END
          PHASE_BEGIN(17)
            gemm_phase(On, 1024, w_out, 1024, MTOK, 1024, EpiResid{p.X, 1.0f}, smem);
          PHASE_END
        }
      }
    }
  }
}

static int count_phases() {
  int n = 0;
  for (int layer = 0; layer < 4; ++layer) {
    int kind = layer % 3;
    n += 3 + 3 + 1;
    n += kind == 0 ? 10 : kind == 1 ? 3 : 6;
  }
  return n;
}

extern "C" void kernel_launch(void* const* d_in, const int* in_sizes, int n_in, void* d_out, int out_size, void* d_ws, size_t ws_size, hipStream_t stream) {
  if (ws_size < WS_NEED) { fprintf(stderr, "workspace too small: %zu < %zu\n", ws_size, WS_NEED); return; }
  static int grid_blocks = 0;
  if (!grid_blocks) {
    int dev = 0, cus = 0, per_cu = 0;
    hipGetDevice(&dev);
    hipDeviceGetAttribute(&cus, hipDeviceAttributeMultiprocessorCount, dev);
    hipOccupancyMaxActiveBlocksPerMultiprocessor(&per_cu, mega, 256, 0);
    if (per_cu > 2) per_cu = 2;
    grid_blocks = cus * per_cu;
  }
  Params p{};
  const float** pf = (const float**)&p;
  for (int i = 0; i < 25; ++i) pf[i] = (const float*)d_in[i];
  p.X = (float*)d_out; p.ws = (char*)d_ws;
  const int total = count_phases();
#if MULTI_LAUNCH
  for (int ph = 0; ph < total; ++ph) {
    p.lo = ph; p.hi = ph + 1;
    hipLaunchKernelGGL(mega, dim3(grid_blocks), dim3(256), 0, stream, p);
  }
#else
  hipMemsetAsync((char*)d_ws + OFF_BAR, 0, 16384, stream);
  p.lo = 0; p.hi = total;
  void* args[] = {&p};
  hipError_t e = hipLaunchCooperativeKernel((void*)mega, dim3(grid_blocks), dim3(256), args, 0, stream);
  if (e != hipSuccess) fprintf(stderr, "cooperative launch failed: %s (grid %d)\n", hipGetErrorString(e), grid_blocks);
#endif
}
```

```cpp
#include <hip/hip_runtime.h>
#include <hip/hip_cooperative_groups.h>
#include <cstdio>
#include <cstdint>
namespace cg = cooperative_groups;

#ifndef MULTI_LAUNCH
#define MULTI_LAUNCH 0
#endif

typedef unsigned short u16;
typedef unsigned int u32;
using bf16x8 = __attribute__((ext_vector_type(8))) short;
using bf16x4 = __attribute__((ext_vector_type(4))) short;
using f32x4 = __attribute__((ext_vector_type(4))) float;
using u32x2 = __attribute__((ext_vector_type(2))) unsigned int;
using u32x4 = __attribute__((ext_vector_type(4))) unsigned int;

#define DI __device__ __forceinline__
#define MFMA32(a, b, c) __builtin_amdgcn_mfma_f32_16x16x32_bf16((a), (b), (c), 0, 0, 0)

constexpr int MTOK = 32768;
constexpr float EPS = 1e-6f;
constexpr float LOG2E = 1.4426950408889634f;

constexpr size_t MiB = 1048576;
constexpr size_t OFF_WGU1 = 0;
constexpr size_t OFF_WDN1 = 11534336;
constexpr size_t OFF_WGU2 = 17301504;
constexpr size_t OFF_WDN2 = 28835840;
constexpr size_t OFF_WMIX = 34603008;
constexpr size_t OFF_TAB = 47185920;
constexpr size_t OFF_BAR = OFF_TAB + 786432;
constexpr size_t OFF_H = 46 * MiB;
constexpr size_t OFF_R = 110 * MiB;
constexpr size_t WS_NEED = 500 * MiB;

struct Params {
  const float* x; const float* ffn1_norm; const float* ffn1_w_gu; const float* ffn1_w_down;
  const float* mix_norm; const float* ffn2_norm; const float* ffn2_w_gu; const float* ffn2_w_down;
  const float* hg_lb_logits; const float* hg_w_in; const float* hg_g_norm; const float* hg_w_out;
  const float* na_w_in; const float* na_q_norm; const float* na_k_norm; const float* na_rpb; const float* na_w_out;
  const float* mla_w_in; const float* mla_q_a_norm; const float* mla_w_uq; const float* mla_kv_a_norm; const float* mla_w_ukv;
  const float* mla_q_norm; const float* mla_k_norm; const float* mla_w_out;
  float* X; char* ws; int lo; int hi;
};

DI u32 f2bf(float x) { u32 u = __float_as_uint(x); u += 0x7fffu + ((u >> 16) & 1u); return u >> 16; }
typedef __bf16 bf16v2 __attribute__((ext_vector_type(2)));
typedef float f32v2 __attribute__((ext_vector_type(2)));
DI u32 pack2(float a, float b) { f32v2 v = {a, b}; bf16v2 r = __builtin_convertvector(v, bf16v2); return __builtin_bit_cast(u32, r); }
DI float bflo(u32 w) { return __uint_as_float(w << 16); }
DI float bfhi(u32 w) { return __uint_as_float(w & 0xffff0000u); }
DI float bfget(const u32x4& v, int e) { u32 w = v[e >> 1]; return (e & 1) ? bfhi(w) : bflo(w); }
DI u32x2 pack4(const f32x4& v) { u32x2 r; r[0] = pack2(v[0], v[1]); r[1] = pack2(v[2], v[3]); return r; }
DI bf16x8 pack8(const f32x4& a, const f32x4& b) {
  u32x4 r; r[0] = pack2(a[0], a[1]); r[1] = pack2(a[2], a[3]); r[2] = pack2(b[0], b[1]); r[3] = pack2(b[2], b[3]);
  return __builtin_bit_cast(bf16x8, r);
}
DI bf16x8 cat4(const bf16x4& lo, const bf16x4& hi) { return __builtin_shufflevector(lo, hi, 0, 1, 2, 3, 4, 5, 6, 7); }
DI float wave_sum(float v) {
#pragma unroll
  for (int o = 32; o > 0; o >>= 1) v += __shfl_xor(v, o);
  return v;
}
DI float sigmoidf_(float z) { return __builtin_amdgcn_rcpf(1.f + __expf(-z)); }
DI float siluf_(float z) { return z * __builtin_amdgcn_rcpf(1.f + __expf(-z)); }
DI int otid() { int t = threadIdx.x; asm volatile("" : "+v"(t)); return t; }
DI int vtid() { return otid() & 255; }
DI int vbid() { return blockIdx.x * 2 + (otid() >> 8); }
DI int vgrid() { return gridDim.x * 2; }
DI f32x4 zero4() { f32x4 z = {0.f, 0.f, 0.f, 0.f}; return z; }

DI void init_tables(const Params& p) {
  float* LB = (float*)(p.ws + OFF_TAB); float* RC = LB + 4096; float* RS = RC + 65536;
  const int gt = vbid() * 256 + vtid(), gs = vgrid() * 256;
  for (int c = gt; c < 1024; c += gs) {
    float l0 = p.hg_lb_logits[c], l1 = p.hg_lb_logits[1024 + c], l2 = p.hg_lb_logits[2048 + c], l3 = p.hg_lb_logits[3072 + c];
    float mx = fmaxf(fmaxf(l0, l1), fmaxf(l2, l3));
    float e0 = expf(l0 - mx), e1 = expf(l1 - mx), e2 = expf(l2 - mx), e3 = expf(l3 - mx);
    float inv = 1.f / (e0 + e1 + e2 + e3);
    LB[c] = 0.f; LB[1024 + c] = e1 * inv; LB[2048 + c] = (e1 + e2) * inv; LB[3072 + c] = (e1 + e2 + e3) * inv;
  }
  for (int i = gt; i < 65536; i += gs) {
    int t = i >> 4, j = i & 15;
    float inv = exp2f(-(float)j * (13.287712379549449f / 16.f));
    float ang = (float)t * inv;
    double a = (double)ang;
    double k = rint(a * 0.15915494309189535);
    float r = (float)(a - k * 6.283185307179586);
    RC[i] = __cosf(r); RS[i] = __sinf(r);
  }
}

DI void cvt_tiles(const float* __restrict__ src, u16* __restrict__ dst, int K, int N, int Nd, int mode, char* smem) {
  float* tile = (float*)smem;
  const int tk = K >> 6, tn = Nd >> 6, tid = vtid();
  for (int t = vbid(); t < tk * tn; t += vgrid()) {
    const int k0 = (t % tk) << 6, n0 = (t / tk) << 6;
    {
      const int nl = tid & 63, kq = tid >> 6;
      const int nd = n0 + nl;
      int col = nd;
      if (mode == 1) { int a = nd >> 5, r = nd & 31; col = a * 16 + (r & 15) + ((r >= 16) ? 2816 : 0); }
      const bool ok = col < N;
#pragma unroll
      for (int i = 0; i < 16; ++i) {
        int kl = kq + 4 * i;
        tile[kl * 65 + nl] = ok ? src[(size_t)(k0 + kl) * N + col] : 0.f;
      }
    }
    __syncthreads();
    {
      const int kp = (tid & 31) * 2, nq = tid >> 5;
#pragma unroll
      for (int i = 0; i < 8; ++i) {
        int n = nq + 8 * i;
        *(u32*)(dst + (size_t)(n0 + n) * K + k0 + kp) = pack2(tile[kp * 65 + n], tile[(kp + 1) * 65 + n]);
      }
    }
    __syncthreads();
  }
}

DI void cvt_layer(const Params& p, int layer, char* smem) {
  const int kind = layer % 3, mi = layer / 3;
  char* ws = p.ws;
  for (int task = 0; task < 8; ++task) {
    const float* src = nullptr; size_t off = 0; int K = 0, N = 0, Nd = 0, mode = 0;
    if (task == 0) { src = p.ffn1_w_gu + (size_t)layer * 1024 * 5632; off = OFF_WGU1; K = 1024; N = 5632; Nd = 5632; mode = 1; }
    else if (task == 1) { src = p.ffn1_w_down + (size_t)layer * 2816 * 1024; off = OFF_WDN1; K = 2816; N = 1024; Nd = 1024; }
    else if (task == 2) { src = p.ffn2_w_gu + (size_t)layer * 1024 * 5632; off = OFF_WGU2; K = 1024; N = 5632; Nd = 5632; mode = 1; }
    else if (task == 3) { src = p.ffn2_w_down + (size_t)layer * 2816 * 1024; off = OFF_WDN2; K = 2816; N = 1024; Nd = 1024; }
    else if (kind == 0) {
      if (task == 4) { src = p.hg_w_in + (size_t)mi * 1024 * 5120; off = OFF_WMIX; K = 1024; N = 5120; Nd = 5120; }
      else if (task == 5) { src = p.hg_w_out + (size_t)mi * 1024 * 1024; off = OFF_WMIX + 10485760; K = 1024; N = 1024; Nd = 1024; }
    } else if (kind == 1) {
      if (task == 4) { src = p.na_w_in + (size_t)mi * 1024 * 3072; off = OFF_WMIX; K = 1024; N = 3072; Nd = 3072; }
      else if (task == 5) { src = p.na_w_out + (size_t)mi * 1024 * 1024; off = OFF_WMIX + 6291456; K = 1024; N = 1024; Nd = 1024; }
    } else {
      if (task == 4) { src = p.mla_w_in + (size_t)mi * 1024 * 1056; off = OFF_WMIX; K = 1024; N = 1056; Nd = 1280; }
      else if (task == 5) { src = p.mla_w_uq + (size_t)mi * 768 * 1536; off = OFF_WMIX + 2621440; K = 768; N = 1536; Nd = 1536; }
      else if (task == 6) { src = p.mla_w_ukv + (size_t)mi * 256 * 2048; off = OFF_WMIX + 4980736; K = 256; N = 2048; Nd = 2048; }
      else if (task == 7) { src = p.mla_w_out + (size_t)mi * 1024 * 1024; off = OFF_WMIX + 6029312; K = 1024; N = 1024; Nd = 1024; }
    }
    if (src) cvt_tiles(src, (u16*)(ws + off), K, N, Nd, mode, smem);
  }
}

DI void norm_phase(const float* __restrict__ src, const float* __restrict__ gain, u16* __restrict__ dst, float* copy_dst, int rows) {
  const int lane = vtid() & 63, wid = vtid() >> 6;
  f32x4 g[4];
#pragma unroll
  for (int i = 0; i < 4; ++i) g[i] = *(const f32x4*)(gain + i * 256 + lane * 4);
  const int stride = vgrid() * 4;
  for (int row = vbid() * 4 + wid; row < rows; row += stride * 4) {
    f32x4 v[4][4];
#pragma unroll
    for (int j = 0; j < 4; ++j) {
      const int rj = row + j * stride;
      if (rj < rows) {
#pragma unroll
        for (int i = 0; i < 4; ++i) v[j][i] = *(const f32x4*)(src + (size_t)rj * 1024 + i * 256 + lane * 4);
      }
    }
#pragma unroll
    for (int j = 0; j < 4; ++j) {
      const int rj = row + j * stride;
      if (rj < rows) {
        float ss = 0.f;
#pragma unroll
        for (int i = 0; i < 4; ++i) ss += v[j][i][0] * v[j][i][0] + v[j][i][1] * v[j][i][1] + v[j][i][2] * v[j][i][2] + v[j][i][3] * v[j][i][3];
        ss = wave_sum(ss);
        const float rstd = rsqrtf(ss * (1.f / 1024.f) + EPS);
#pragma unroll
        for (int i = 0; i < 4; ++i) {
          f32x4 y = v[j][i] * rstd * g[i];
          *(u32x2*)(dst + (size_t)rj * 1024 + i * 256 + lane * 4) = pack4(y);
          if (copy_dst) *(f32x4*)(copy_dst + (size_t)rj * 1024 + i * 256 + lane * 4) = v[j][i];
        }
      }
    }
  }
}

#define GLDS16(gp, lp) __builtin_amdgcn_global_load_lds((const unsigned*)(gp), (unsigned*)(lp), 16, 0, 0)

constexpr int G_STAGE = 32768, G_WOFF = 16384, G_NS = 4, G_MT = 8;

template <class Epi>
DI void gemm_phase(const u16* __restrict__ A, int lda, const u16* __restrict__ W, int K, int Mrows, int Ncols, const Epi& epi, char* smem) {
  const int mtn = Mrows >> 8, ntn = Ncols >> 8;
  const int ntiles = mtn * ntn, nk = K >> 5;
  constexpr int GM = 16;
  const int bid = blockIdx.x, gsz = gridDim.x;
  const int my_tiles = bid < ntiles ? (ntiles - bid + gsz - 1) / gsz : 0;
  const int total = my_tiles * nk;
  if (total > 0) {
    const int tid = otid(), lane = tid & 63, wid = tid >> 6;
    const int wm = wid >> 2, wn = wid & 3, fr = lane & 15, fq = lane >> 4;
    f32x4 acc[4][G_MT];
#pragma unroll
    for (int i = 0; i < 4; ++i)
#pragma unroll
      for (int j = 0; j < G_MT; ++j) acc[i][j] = zero4();
    const int lrow = tid >> 2, lc = (tid & 3) ^ ((tid >> 4) & 3);
    char* sdst = smem + tid * 16;
    const int ro = (fq ^ (fr >> 2)) * 16;
    const char* sa_rd = smem + (wm * 128 + fr) * 64 + ro;
    const char* sw_rd = smem + G_WOFF + (wn * 64 + fr) * 64 + ro;
    int ij = 0, ik = 0;
    const u16 *ga, *gw;
    {
      const int tile = bid, group = tile / (GM * ntn), rem = tile % (GM * ntn);
      const int mt = group * GM + (rem % GM), nt = rem / GM;
      ga = A + ((size_t)mt * 256 + lrow) * lda + lc * 8; gw = W + ((size_t)nt * 256 + lrow) * K + lc * 8;
    }
    __builtin_amdgcn_s_barrier();
    asm volatile("" ::: "memory");
#define G_ADV() do { if (++ik == nk) { ik = 0; ++ij; if (ij < my_tiles) { \
        const int tile = bid + ij * gsz, group = tile / (GM * ntn), rem = tile % (GM * ntn); \
        const int mt = group * GM + (rem % GM), nt = rem / GM; \
        ga = A + ((size_t)mt * 256 + lrow) * lda + lc * 8; gw = W + ((size_t)nt * 256 + lrow) * K + lc * 8; } } } while (0)
#define G_ISSUE(SLOT) do { \
      const int k0_ = ik << 5; char* sd_ = sdst + (SLOT) * G_STAGE; \
      GLDS16(ga + k0_, sd_); GLDS16(ga + (size_t)128 * lda + k0_, sd_ + 8192); \
      GLDS16(gw + k0_, sd_ + G_WOFF); GLDS16(gw + (size_t)128 * K + k0_, sd_ + G_WOFF + 8192); \
      G_ADV(); } while (0)
    G_ISSUE(0);
    if (total > 1) G_ISSUE(1);
    if (total > 2) G_ISSUE(2);
    int slot = 0, ck = 0, cj = 0;
    for (int step = 0; step < total; ++step) {
      const int remn = total - 1 - step;
      if (remn >= 2) asm volatile("s_waitcnt vmcnt(8)" ::: "memory");
      else if (remn == 1) asm volatile("s_waitcnt vmcnt(4)" ::: "memory");
      else asm volatile("s_waitcnt vmcnt(0)" ::: "memory");
      __builtin_amdgcn_s_barrier();
      asm volatile("" ::: "memory");
      const bool doiss = step + 3 < total;
      int isl = slot + 3; if (isl >= G_NS) isl -= G_NS;
      char* sd2 = sdst + isl * G_STAGE;
      const int k02 = ik << 5;
      const int cur = slot * G_STAGE;
      bf16x8 af[G_MT], wf[4];
#pragma unroll
      for (int i = 0; i < 4; ++i) wf[i] = *(const bf16x8*)(sw_rd + cur + i * 1024);
#pragma unroll
      for (int i = 0; i < 4; ++i) af[i] = *(const bf16x8*)(sa_rd + cur + i * 1024);
      if (doiss) { GLDS16(ga + k02, sd2); GLDS16(ga + (size_t)128 * lda + k02, sd2 + 8192); }
      __builtin_amdgcn_sched_barrier(0);
      acc[0][0] = MFMA32(wf[0], af[0], acc[0][0]);
      __builtin_amdgcn_sched_barrier(0);
#pragma unroll
      for (int i = 4; i < G_MT; ++i) af[i] = *(const bf16x8*)(sa_rd + cur + i * 1024);
      __builtin_amdgcn_sched_barrier(0);
#pragma unroll
      for (int mt = 0; mt < 4; ++mt)
#pragma unroll
        for (int nt = 0; nt < 4; ++nt) if (mt + nt > 0) acc[nt][mt] = MFMA32(wf[nt], af[mt], acc[nt][mt]);
      __builtin_amdgcn_sched_barrier(0);
      if (doiss) { GLDS16(gw + k02, sd2 + G_WOFF); GLDS16(gw + (size_t)128 * K + k02, sd2 + G_WOFF + 8192); }
      __builtin_amdgcn_sched_barrier(0);
#pragma unroll
      for (int mt = 4; mt < G_MT; ++mt)
#pragma unroll
        for (int nt = 0; nt < 4; ++nt) acc[nt][mt] = MFMA32(wf[nt], af[mt], acc[nt][mt]);
      if (doiss) G_ADV();
      if (++slot == G_NS) slot = 0;
      if (++ck == nk) {
        const int tile = bid + cj * gsz, group = tile / (GM * ntn), rem = tile % (GM * ntn);
        const int mt = group * GM + (rem % GM), nt = rem / GM;
        epi(acc, mt * 256 + wm * 128, nt * 256 + wn * 64, fr, fq);
#pragma unroll
        for (int i = 0; i < 4; ++i)
#pragma unroll
          for (int j = 0; j < G_MT; ++j) acc[i][j] = zero4();
        ck = 0; ++cj;
      }
    }
#undef G_ISSUE
#undef G_ADV
  }
  __syncthreads();
}

struct EpiSwiglu {
  u16* act;
  DI void operator()(f32x4 (&acc)[4][G_MT], int mb, int nb, int fr, int fq) const {
#pragma unroll
    for (int mt = 0; mt < G_MT; ++mt) {
      const int m = mb + mt * 16 + fr;
#pragma unroll
      for (int np = 0; np < 2; ++np) {
        const f32x4 g = acc[2 * np][mt], u = acc[2 * np + 1][mt];
        f32x4 r;
#pragma unroll
        for (int j = 0; j < 4; ++j) r[j] = siluf_(g[j]) * u[j];
        const int jc = (nb >> 1) + np * 16 + fq * 4;
        *(u32x2*)(act + (size_t)m * 2816 + jc) = pack4(r);
      }
    }
  }
};

struct EpiResid {
  float* X; float scale;
  DI void operator()(f32x4 (&acc)[4][G_MT], int mb, int nb, int fr, int fq) const {
#pragma unroll
    for (int mt = 0; mt < G_MT; ++mt) {
      const int m = mb + mt * 16 + fr;
#pragma unroll
      for (int nt = 0; nt < 4; ++nt) {
        f32x4* ptr = (f32x4*)(X + (size_t)m * 1024 + nb + nt * 16 + fq * 4);
        f32x4 v = *ptr;
        v += acc[nt][mt] * scale;
        *ptr = v;
      }
    }
  }
};

struct EpiStore {
  u16* out; int ldo; int nmax;
  DI void operator()(f32x4 (&acc)[4][G_MT], int mb, int nb, int fr, int fq) const {
#pragma unroll
    for (int mt = 0; mt < G_MT; ++mt) {
      const int m = mb + mt * 16 + fr;
#pragma unroll
      for (int nt = 0; nt < 4; ++nt) {
        const int n = nb + nt * 16 + fq * 4;
        if (n < nmax) *(u32x2*)(out + (size_t)m * ldo + n) = pack4(acc[nt][mt]);
      }
    }
  }
};

struct EpiHgIn {
  u16 *Q, *LFf, *LFb, *V, *G; const float* lb;
  DI void operator()(f32x4 (&acc)[4][G_MT], int mb, int nb, int fr, int fq) const {
    const int seg = nb >> 10, c0 = nb & 1023;
    u16* dst = seg == 0 ? Q : seg == 1 ? LFf : seg == 2 ? LFb : seg == 3 ? V : G;
#pragma unroll
    for (int mt = 0; mt < G_MT; ++mt) {
      const int m = mb + mt * 16 + fr;
#pragma unroll
      for (int nt = 0; nt < 4; ++nt) {
        const int c = c0 + nt * 16 + fq * 4;
        f32x4 a = acc[nt][mt], r;
        if (seg == 0) r = a * 0.08838834764831845f;
        else if (seg == 3) r = a;
        else if (seg == 4) {
#pragma unroll
          for (int j = 0; j < 4; ++j) r[j] = siluf_(a[j]);
        } else {
          const f32x4 l4 = *(const f32x4*)(lb + c);
#pragma unroll
          for (int j = 0; j < 4; ++j) {
            float z = fminf(fmaxf(a[j], -30.f), 30.f);
            float f = l4[j] + (1.f - l4[j]) * sigmoidf_(z);
            r[j] = __logf(f);
          }
        }
        *(u32x2*)(dst + (size_t)m * 1024 + c) = pack4(r);
      }
    }
  }
};

struct EpiNaIn {
  u16 *Q, *K, *VT; const float *qn, *kn;
  DI void operator()(f32x4 (&acc)[4][G_MT], int mb, int nb, int fr, int fq) const {
    const int seg = nb >> 10, h = (nb & 1023) >> 6;
    if (seg < 2) {
      u16* dst = seg == 0 ? Q : K;
      const float* gn = seg == 0 ? qn : kn;
      const float sc = seg == 0 ? 0.125f * LOG2E : 1.f;
#pragma unroll
      for (int mt = 0; mt < G_MT; ++mt) {
        const int m = mb + mt * 16 + fr;
        float ss = 0.f;
#pragma unroll
        for (int nt = 0; nt < 4; ++nt)
#pragma unroll
          for (int j = 0; j < 4; ++j) ss += acc[nt][mt][j] * acc[nt][mt][j];
        ss += __shfl_xor(ss, 16); ss += __shfl_xor(ss, 32);
        const float rstd = rsqrtf(ss * (1.f / 64.f) + EPS) * sc;
#pragma unroll
        for (int nt = 0; nt < 4; ++nt) {
          const int d = nt * 16 + fq * 4;
          const f32x4 g4 = *(const f32x4*)(gn + d);
          f32x4 r = acc[nt][mt] * rstd * g4;
          *(u32x2*)(dst + (size_t)m * 1024 + h * 64 + d) = pack4(r);
        }
      }
    } else {
#pragma unroll
      for (int mt = 0; mt < G_MT; ++mt) {
        const int m = mb + mt * 16 + fr;
        const int b = m >> 12, t = m & 4095;
#pragma unroll
        for (int nt = 0; nt < 4; ++nt)
#pragma unroll
          for (int j = 0; j < 4; ++j) {
            const int d = nt * 16 + fq * 4 + j;
            VT[((size_t)((b * 16 + h) * 64 + d)) * 4096 + t] = (u16)f2bf(acc[nt][mt][j]);
          }
      }
    }
  }
};

struct HgBufs {
  u16 *Q, *LFf, *LFb, *V, *G, *QIf, *QIb, *KITf, *KITb, *VTc, *OI, *OF, *OB, *Y;
  float *DECf, *DECb;
};

DI void hg_prep_phase(const HgBufs& hb, char* smem) {
  u32x4 rq, rf, rb, rv;
  {
    const int item0 = vbid(), tid0 = vtid();
    if (item0 < 8192) {
      const size_t g0 = ((size_t)(item0 >> 11) * 4096 + ((item0 >> 3) & 255) * 16 + (tid0 >> 4)) * 1024 + (item0 & 7) * 128 + (tid0 & 15) * 8;
      rq = *(const u32x4*)(hb.Q + g0); rf = *(const u32x4*)(hb.LFf + g0); rb = *(const u32x4*)(hb.LFb + g0); rv = *(const u32x4*)(hb.V + g0);
    }
  }
  for (int item = vbid(); item < 8192; item += vgrid()) {
  const int h = item & 7, n = (item >> 3) & 255, b = item >> 11;
  float* sq = (float*)smem; float* sbf = sq + 2112; float* sbb = sbf + 2112; float* skf = sbb + 2112;
  float* skb = skf + 2112; float* sv = skb + 2112; float* sP = sv + 2112; float* sA = sP + 5120;
  const int tid = vtid();
  const int row = tid >> 4, c8 = (tid & 15) * 8;
  const size_t tok0 = (size_t)b * 4096 + n * 16;
  const size_t gidx = (tok0 + row) * 1024 + h * 128 + c8;
  {
#pragma unroll
    for (int e = 0; e < 8; ++e) {
      const int o = row * 132 + c8 + e;
      const float lf = bfget(rf, e), lb_ = bfget(rb, e);
      sq[o] = bfget(rq, e); sbf[o] = lf; sbb[o] = lb_;
      skf[o] = 1.f - __expf(lf); skb[o] = 1.f - __expf(lb_); sv[o] = bfget(rv, e);
    }
  }
  {
    const int nx = item + vgrid();
    if (nx < 8192) {
      const size_t g1 = ((size_t)(nx >> 11) * 4096 + ((nx >> 3) & 255) * 16 + row) * 1024 + (nx & 7) * 128 + c8;
      rq = *(const u32x4*)(hb.Q + g1); rf = *(const u32x4*)(hb.LFf + g1); rb = *(const u32x4*)(hb.LFb + g1); rv = *(const u32x4*)(hb.V + g1);
    }
  }
  __syncthreads();
  if (tid < 128) {
    const int d = tid; float a = 0.f;
#pragma unroll
    for (int t = 0; t < 16; ++t) { a += sbf[t * 132 + d]; sbf[t * 132 + d] = a; }
    hb.DECf[((size_t)b * 256 + n) * 1024 + h * 128 + d] = __expf(a);
  } else {
    const int d = tid - 128; float a = 0.f;
#pragma unroll
    for (int t = 15; t >= 0; --t) { a += sbb[t * 132 + d]; sbb[t * 132 + d] = a; }
    hb.DECb[((size_t)b * 256 + n) * 1024 + h * 128 + d] = __expf(a);
  }
  __syncthreads();
  {
    u32x4 of, ob;
#pragma unroll
    for (int e2 = 0; e2 < 4; ++e2) {
      const int o = row * 132 + c8 + 2 * e2;
      const float q0 = sq[o], q1 = sq[o + 1];
      of[e2] = pack2(q0 * __expf(sbf[o]), q1 * __expf(sbf[o + 1]));
      ob[e2] = pack2(q0 * __expf(sbb[o]), q1 * __expf(sbb[o + 1]));
    }
    *(u32x4*)(hb.QIf + gidx) = of; *(u32x4*)(hb.QIb + gidx) = ob;
  }
  {
    const int d = tid >> 1, t8 = (tid & 1) * 8;
    const float blf = sbf[15 * 132 + d], blb = sbb[d];
    u32x4 kf, kb, vv;
#pragma unroll
    for (int e2 = 0; e2 < 4; ++e2) {
      const int o0 = (t8 + 2 * e2) * 132 + d, o1 = o0 + 132;
      kf[e2] = pack2(skf[o0] * __expf(blf - sbf[o0]), skf[o1] * __expf(blf - sbf[o1]));
      kb[e2] = pack2(skb[o0] * __expf(blb - sbb[o0]), skb[o1] * __expf(blb - sbb[o1]));
      vv[e2] = pack2(sv[o0], sv[o1]);
    }
    const size_t cidx = (((size_t)(b * 8 + h) * 256 + n) * 128 + d) * 16 + t8;
    *(u32x4*)(hb.KITf + cidx) = kf; *(u32x4*)(hb.KITb + cidx) = kb; *(u32x4*)(hb.VTc + cidx) = vv;
  }
  {
    const int s = tid >> 4, dg = tid & 15, d0 = dg * 8, sw0 = (tid >> 6) * 4;
    float w[8];
    {
      const f32x4 a = *(const f32x4*)(skf + s * 132 + d0), b2 = *(const f32x4*)(skf + s * 132 + d0 + 4);
#pragma unroll
      for (int e = 0; e < 4; ++e) { w[e] = a[e]; w[4 + e] = b2[e]; }
    }
    float pdiag = 0.f;
    for (int t = sw0; t < 16; ++t) {
      if (t > s) {
        const f32x4 a = *(const f32x4*)(skf + t * 132 + d0), b2 = *(const f32x4*)(skf + t * 132 + d0 + 4);
#pragma unroll
        for (int e = 0; e < 4; ++e) { w[e] = fmaf(-w[e], a[e], w[e]); w[4 + e] = fmaf(-w[4 + e], b2[e], w[4 + e]); }
      }
      const f32x4 q0 = *(const f32x4*)(sq + t * 132 + d0), q1 = *(const f32x4*)(sq + t * 132 + d0 + 4);
      float part = 0.f;
#pragma unroll
      for (int e = 0; e < 4; ++e) part += q0[e] * w[e] + q1[e] * w[4 + e];
      if (t == s) pdiag = part;
      else if (t > s) sP[(t * 16 + s) * 20 + dg] = part;
    }
    {
      const f32x4 a = *(const f32x4*)(skb + s * 132 + d0), b2 = *(const f32x4*)(skb + s * 132 + d0 + 4);
#pragma unroll
      for (int e = 0; e < 4; ++e) { w[e] = a[e]; w[4 + e] = b2[e]; }
    }
    for (int t = sw0 + 3; t >= 0; --t) {
      if (t < s) {
        const f32x4 a = *(const f32x4*)(skb + t * 132 + d0), b2 = *(const f32x4*)(skb + t * 132 + d0 + 4);
#pragma unroll
        for (int e = 0; e < 4; ++e) { w[e] = fmaf(-w[e], a[e], w[e]); w[4 + e] = fmaf(-w[4 + e], b2[e], w[4 + e]); }
      }
      const f32x4 q0 = *(const f32x4*)(sq + t * 132 + d0), q1 = *(const f32x4*)(sq + t * 132 + d0 + 4);
      float part = 0.f;
#pragma unroll
      for (int e = 0; e < 4; ++e) part += q0[e] * w[e] + q1[e] * w[4 + e];
      if (t == s) sP[(s * 16 + s) * 20 + dg] = pdiag + part;
      else if (t < s) sP[(t * 16 + s) * 20 + dg] = part;
    }
  }
  __syncthreads();
  {
    const int t = tid >> 4, s = tid & 15;
    const float* pp = sP + (t * 16 + s) * 20;
    const f32x4 p0 = *(const f32x4*)pp, p1 = *(const f32x4*)(pp + 4), p2 = *(const f32x4*)(pp + 8), p3 = *(const f32x4*)(pp + 12);
    const f32x4 ps = (p0 + p1) + (p2 + p3);
    sA[t * 17 + s] = (ps[0] + ps[1]) + (ps[2] + ps[3]);
  }
  __syncthreads();
  {
    float o[8];
#pragma unroll
    for (int e = 0; e < 8; ++e) o[e] = 0.f;
#pragma unroll
    for (int s = 0; s < 16; ++s) {
      const float a = sA[row * 17 + s];
      const f32x4 v0 = *(const f32x4*)(sv + s * 132 + c8), v1 = *(const f32x4*)(sv + s * 132 + c8 + 4);
#pragma unroll
      for (int e = 0; e < 4; ++e) { o[e] += a * v0[e]; o[4 + e] += a * v1[e]; }
    }
    u32x4 r; r[0] = pack2(o[0], o[1]); r[1] = pack2(o[2], o[3]); r[2] = pack2(o[4], o[5]); r[3] = pack2(o[6], o[7]);
    *(u32x4*)(hb.OI + gidx) = r;
  }
  __syncthreads();
  }
}

constexpr int SC_NS = 6, SC_STAGE = 12288;
DI void scan_issue(char* smem, int slot, const u16* QI, const u16* KIT, const u16* VTc, const float* DEC, int b, int h, int vg, int n, int tid) {
  char* st = smem + slot * SC_STAGE + tid * 16;
  const size_t tok0 = (size_t)b * 4096 + n * 16;
  const int row = tid >> 4, lc = (tid & 15) ^ row;
  GLDS16(QI + (tok0 + row) * 1024 + h * 128 + lc * 8, st);
  const size_t cb = ((size_t)(b * 8 + h) * 256 + n) * 2048;
  GLDS16(KIT + cb + tid * 8, st + 4096);
  const float* dp = DEC + ((size_t)b * 256 + n) * 1024 + h * 128;
  const void* g3 = tid < 128 ? (const void*)(VTc + cb + vg * 1024 + tid * 8) : (const void*)(dp + ((tid - 128) & 31) * 4);
  GLDS16(g3, st + 8192);
}

struct ScanRegs { bf16x8 qa[4]; bf16x8 ka[8]; bf16x8 vb; };

DI void scan_read(ScanRegs& r, const char* st, int wid, int fr, int fq) {
#pragma unroll
  for (int ks = 0; ks < 4; ++ks) {
    const int l0 = 4 * ks + (fq >> 1), l1 = l0 + 2;
    const bf16x4 lo = *(const bf16x4*)(st + fr * 256 + ((l0 ^ fr) * 16) + (fq & 1) * 8);
    const bf16x4 hi = *(const bf16x4*)(st + fr * 256 + ((l1 ^ fr) * 16) + (fq & 1) * 8);
    r.qa[ks] = cat4(lo, hi);
  }
  r.vb = *(const bf16x8*)(st + 8192 + (wid * 16 + fr) * 32 + (fq & 1) * 16);
#pragma unroll
  for (int dt = 0; dt < 8; ++dt) r.ka[dt] = *(const bf16x8*)(st + 4096 + (dt * 16 + fr) * 32 + (fq & 1) * 16);
}

DI void scan_compute(f32x4 (&S)[8], ScanRegs& r, const f32x4 (&dc)[8], u16* op, int fq) {
  const bf16x8 z8 = {0, 0, 0, 0, 0, 0, 0, 0};
  if (fq >= 2) r.vb = z8;
  f32x4 o0 = zero4(), o1 = zero4();
  o0 = MFMA32(r.qa[0], pack8(S[0], S[1]), o0);
  o1 = MFMA32(r.qa[1], pack8(S[2], S[3]), o1);
  o0 = MFMA32(r.qa[2], pack8(S[4], S[5]), o0);
  o1 = MFMA32(r.qa[3], pack8(S[6], S[7]), o1);
#pragma unroll
  for (int dt = 0; dt < 8; ++dt) {
    if (fq >= 2) r.ka[dt] = z8;
    S[dt] = S[dt] * dc[dt];
    S[dt] = MFMA32(r.ka[dt], r.vb, S[dt]);
  }
  const f32x4 o = o0 + o1;
  const u32 w0 = pack2(o[0], o[1]), w1 = pack2(o[2], o[3]);
  asm volatile("global_store_short %0, %1, off" :: "v"(op), "v"(w0) : "memory");
  asm volatile("global_store_short_d16_hi %0, %1, off" :: "v"(op + 1024), "v"(w0) : "memory");
  asm volatile("global_store_short %0, %1, off" :: "v"(op + 2048), "v"(w1) : "memory");
  asm volatile("global_store_short_d16_hi %0, %1, off" :: "v"(op + 3072), "v"(w1) : "memory");
}

DI void hg_scan_phase(const HgBufs& hb, char* smem) {
  const int tid = vtid(), lane = tid & 63, wid = tid >> 6, fr = lane & 15, fq = lane >> 4;
  for (int item = vbid(); item < 128; item += vgrid()) {
    const int vg = item & 1, dir = (item >> 1) & 1, h = (item >> 2) & 7, b = item >> 5;
    const u16* QI = dir ? hb.QIb : hb.QIf; const u16* KIT = dir ? hb.KITb : hb.KITf;
    const float* DEC = dir ? hb.DECb : hb.DECf; u16* Oout = dir ? hb.OB : hb.OF;
    const int vs = vg * 4 + wid;
    u16* obase = Oout + ((size_t)b * 4096 + fq * 4) * 1024 + h * 128 + vs * 16 + fr;
    f32x4 S[8];
#pragma unroll
    for (int i = 0; i < 8; ++i) S[i] = zero4();
#pragma unroll
    for (int s = 0; s < SC_NS - 1; ++s) scan_issue(smem, s, QI, KIT, hb.VTc, DEC, b, h, vg, dir ? 255 - s : s, tid);
    asm volatile("s_waitcnt vmcnt(12)" ::: "memory");
    __builtin_amdgcn_s_barrier();
    asm volatile("" ::: "memory");
    ScanRegs ra, rb;
    scan_read(ra, smem, wid, fr, fq);
    int slot = 0;
#define SCAN_STEP(STEP, CUR, NXT) do { \
      const int step_ = (STEP); \
      if (step_ < 4) asm volatile("s_waitcnt vmcnt(9) lgkmcnt(0)" ::: "memory"); \
      else asm volatile("s_waitcnt vmcnt(25) lgkmcnt(0)" ::: "memory"); \
      __builtin_amdgcn_s_barrier(); \
      asm volatile("" ::: "memory"); \
      { const int ns_ = min(step_ + SC_NS - 1, 255); \
        int is_ = slot + SC_NS - 1; if (is_ >= SC_NS) is_ -= SC_NS; \
        scan_issue(smem, is_, QI, KIT, hb.VTc, DEC, b, h, vg, dir ? 255 - ns_ : ns_, tid); } \
      f32x4 dc_[8]; \
      { const char* st_ = smem + slot * SC_STAGE + 8192 + 2048 + fq * 16; \
        _Pragma("unroll") for (int dt = 0; dt < 8; ++dt) dc_[dt] = *(const f32x4*)(st_ + dt * 64); } \
      int nslot_ = slot + 1; if (nslot_ == SC_NS) nslot_ = 0; \
      if (step_ + 1 < 256) scan_read(NXT, smem + nslot_ * SC_STAGE, wid, fr, fq); \
      { const int n_ = dir ? 255 - step_ : step_; \
        scan_compute(S, CUR, dc_, obase + (size_t)n_ * 16 * 1024, fq); } \
      slot = nslot_; } while (0)
    for (int step = 0; step < 256; step += 2) {
      SCAN_STEP(step, ra, rb);
      SCAN_STEP(step + 1, rb, ra);
    }
#undef SCAN_STEP
    asm volatile("s_waitcnt vmcnt(0)" ::: "memory");
    __syncthreads();
  }
}

DI void hg_combine_phase(const HgBufs& hb, const float* __restrict__ gnorm, int rows) {
  const int lane = vtid() & 63, wid = vtid() >> 6;
  const int h = lane >> 3, c16 = (lane & 7) * 16;
  const int stride = vgrid() * 4;
  f32x4 gn[4];
#pragma unroll
  for (int i = 0; i < 4; ++i) gn[i] = *(const f32x4*)(gnorm + c16 + i * 4);
  for (int row = vbid() * 4 + wid; row < rows; row += stride * 2) {
    u32x4 ra[2][2], rf[2][2], rb[2][2], rg[2][2];
#pragma unroll
    for (int j = 0; j < 2; ++j) {
      const int rj = row + j * stride;
      if (rj < rows) {
        const size_t g = (size_t)rj * 1024 + h * 128 + c16;
#pragma unroll
        for (int half = 0; half < 2; ++half) {
          ra[j][half] = *(const u32x4*)(hb.OI + g + half * 8); rf[j][half] = *(const u32x4*)(hb.OF + g + half * 8);
          rb[j][half] = *(const u32x4*)(hb.OB + g + half * 8); rg[j][half] = *(const u32x4*)(hb.G + g + half * 8);
        }
      }
    }
#pragma unroll
    for (int j = 0; j < 2; ++j) {
      const int rj = row + j * stride;
      if (rj < rows) {
        const size_t g = (size_t)rj * 1024 + h * 128 + c16;
        float o[16]; float ss = 0.f;
#pragma unroll
        for (int half = 0; half < 2; ++half)
#pragma unroll
          for (int e = 0; e < 8; ++e) { float v = bfget(ra[j][half], e) + bfget(rf[j][half], e) + bfget(rb[j][half], e); o[half * 8 + e] = v; ss += v * v; }
        ss += __shfl_xor(ss, 1); ss += __shfl_xor(ss, 2); ss += __shfl_xor(ss, 4);
        const float rstd = rsqrtf(ss * (1.f / 128.f) + EPS);
#pragma unroll
        for (int half = 0; half < 2; ++half) {
          u32x4 r;
#pragma unroll
          for (int e2 = 0; e2 < 4; ++e2) {
            const int e = half * 8 + 2 * e2;
            r[e2] = pack2(o[e] * rstd * gn[e >> 2][e & 3] * bfget(rg[j][half], 2 * e2), o[e + 1] * rstd * gn[(e + 1) >> 2][(e + 1) & 3] * bfget(rg[j][half], 2 * e2 + 1));
          }
          *(u32x4*)(hb.Y + g + half * 8) = r;
        }
      }
    }
  }
}

DI void na_attn_item(const u16* __restrict__ Q, const u16* __restrict__ K, const u16* __restrict__ VT, const float* __restrict__ rpb, u16* __restrict__ O, int item, int fr, int fq) {
  const int qt = item & 3, h = (item >> 2) & 15, r = (item >> 6) & 63, b = item >> 12;
  const int r0 = min(max(r - 4, 0), 56);
  const int cw0 = qt == 0 ? 0 : qt == 1 ? 8 : qt == 2 ? 24 : 32;
  const size_t tokq = (size_t)b * 4096 + r * 64 + qt * 16 + fr;
  bf16x8 qf[2];
#pragma unroll
  for (int ks = 0; ks < 2; ++ks) qf[ks] = *(const bf16x8*)(Q + tokq * 1024 + h * 64 + ks * 32 + fq * 8);
  f32x4 s[8][2];
#pragma unroll
  for (int kr = 0; kr < 8; ++kr)
#pragma unroll
    for (int hf = 0; hf < 2; ++hf) {
      const size_t tokk = (size_t)b * 4096 + (r0 + kr) * 64 + cw0 + hf * 16 + fr;
      const bf16x8 k0 = *(const bf16x8*)(K + tokk * 1024 + h * 64 + fq * 8);
      const bf16x8 k1 = *(const bf16x8*)(K + tokk * 1024 + h * 64 + 32 + fq * 8);
      f32x4 a = MFMA32(k0, qf[0], zero4());
      s[kr][hf] = MFMA32(k1, qf[1], a);
    }
  const int qc = qt * 16 + fr;
  const int cs = min(max(qc - 8, 0), 48);
  float mx = -1e30f;
#pragma unroll
  for (int kr = 0; kr < 8; ++kr) {
    const float* rp = rpb + (h * 15 + (r0 + kr - r + 7)) * 31;
#pragma unroll
    for (int hf = 0; hf < 2; ++hf)
#pragma unroll
      for (int j = 0; j < 4; ++j) {
        const int kc = cw0 + hf * 16 + fq * 4 + j;
        const bool valid = (kc >= cs) && (kc < cs + 16);
        const int ci = min(max(kc - qc + 15, 0), 30);
        const float v = valid ? s[kr][hf][j] + rp[ci] * LOG2E : -1e30f;
        s[kr][hf][j] = v; mx = fmaxf(mx, v);
      }
  }
  mx = fmaxf(mx, __shfl_xor(mx, 16)); mx = fmaxf(mx, __shfl_xor(mx, 32));
  float l = 0.f;
#pragma unroll
  for (int kr = 0; kr < 8; ++kr)
#pragma unroll
    for (int hf = 0; hf < 2; ++hf)
#pragma unroll
      for (int j = 0; j < 4; ++j) { const float pv = __builtin_amdgcn_exp2f(s[kr][hf][j] - mx); s[kr][hf][j] = pv; l += pv; }
  l += __shfl_xor(l, 16); l += __shfl_xor(l, 32);
  f32x4 o[4];
#pragma unroll
  for (int dt = 0; dt < 4; ++dt) o[dt] = zero4();
#pragma unroll
  for (int kr = 0; kr < 8; ++kr) {
    const bf16x8 pp = pack8(s[kr][0], s[kr][1]);
#pragma unroll
    for (int dt = 0; dt < 4; ++dt) {
      const u16* vp = VT + ((size_t)((b * 16 + h) * 64 + dt * 16 + fr)) * 4096 + (r0 + kr) * 64 + cw0 + fq * 4;
      const bf16x8 vf = cat4(*(const bf16x4*)vp, *(const bf16x4*)(vp + 16));
      o[dt] = MFMA32(vf, pp, o[dt]);
    }
  }
  const float inv = 1.f / l;
#pragma unroll
  for (int dt = 0; dt < 4; ++dt) *(u32x2*)(O + tokq * 1024 + h * 64 + dt * 16 + fq * 4) = pack4(o[dt] * inv);
}

DI void mla_norm_phase(const u16* __restrict__ CRAW, const float* __restrict__ gq, const float* __restrict__ gkv, u16* __restrict__ CQN, u16* __restrict__ CKVN, float* __restrict__ KROPE) {
  const int lane = vtid() & 63, wid = vtid() >> 6;
  for (int row = vbid() * 4 + wid; row < MTOK; row += vgrid() * 4) {
    const u16* c = CRAW + (size_t)row * 1056;
    f32x4 v[3]; float ss = 0.f;
#pragma unroll
    for (int i = 0; i < 3; ++i) {
      const u32x2 w = *(const u32x2*)(c + i * 256 + lane * 4);
      v[i][0] = bflo(w[0]); v[i][1] = bfhi(w[0]); v[i][2] = bflo(w[1]); v[i][3] = bfhi(w[1]);
      ss += v[i][0] * v[i][0] + v[i][1] * v[i][1] + v[i][2] * v[i][2] + v[i][3] * v[i][3];
    }
    ss = wave_sum(ss);
    const float rq = rsqrtf(ss * (1.f / 768.f) + EPS);
#pragma unroll
    for (int i = 0; i < 3; ++i) {
      const f32x4 g4 = *(const f32x4*)(gq + i * 256 + lane * 4);
      *(u32x2*)(CQN + (size_t)row * 768 + i * 256 + lane * 4) = pack4(v[i] * rq * g4);
    }
    {
      const u32x2 w = *(const u32x2*)(c + 768 + lane * 4);
      f32x4 k; k[0] = bflo(w[0]); k[1] = bfhi(w[0]); k[2] = bflo(w[1]); k[3] = bfhi(w[1]);
      float s2 = wave_sum(k[0] * k[0] + k[1] * k[1] + k[2] * k[2] + k[3] * k[3]);
      const float rk = rsqrtf(s2 * (1.f / 256.f) + EPS);
      const f32x4 g4 = *(const f32x4*)(gkv + lane * 4);
      *(u32x2*)(CKVN + (size_t)row * 256 + lane * 4) = pack4(k * rk * g4);
    }
    if (lane < 8) {
      const u32x2 w = *(const u32x2*)(c + 1024 + lane * 4);
      f32x4 k; k[0] = bflo(w[0]); k[1] = bfhi(w[0]); k[2] = bflo(w[1]); k[3] = bfhi(w[1]);
      *(f32x4*)(KROPE + (size_t)row * 32 + lane * 4) = k;
    }
  }
}

DI void mla_prep_phase(u16* __restrict__ Q, const u16* __restrict__ KVRAW, const float* __restrict__ KROPE, u16* __restrict__ Kout,
                       const float* __restrict__ gq, const float* __restrict__ gk, const float* __restrict__ RC, const float* __restrict__ RS) {
  const int lane = vtid() & 63, wid = vtid() >> 6;
  const int h = lane >> 2, sub = lane & 3;
  const float QS = 0.10206207261596577f * LOG2E;
  for (int m = vbid() * 4 + wid; m < MTOK; m += vgrid() * 4) {
    const int t = m & 4095;
    const f32x4 cs = *(const f32x4*)(RC + t * 16 + sub * 4), sn = *(const f32x4*)(RS + t * 16 + sub * 4);
#pragma unroll
    for (int which = 0; which < 2; ++which) {
      float nope[16]; f32x4 ra, rb;
      u16* dstp = (which == 0 ? Q : Kout) + (size_t)m * 1536 + h * 96;
      const float* gn = which == 0 ? gq : gk;
      if (which == 0) {
        const u32x4 w0 = *(const u32x4*)(dstp + sub * 16), w1 = *(const u32x4*)(dstp + sub * 16 + 8);
#pragma unroll
        for (int e = 0; e < 8; ++e) { nope[e] = bfget(w0, e); nope[8 + e] = bfget(w1, e); }
        const u32x2 a2 = *(const u32x2*)(dstp + 64 + sub * 4), b2 = *(const u32x2*)(dstp + 80 + sub * 4);
        ra[0] = bflo(a2[0]); ra[1] = bfhi(a2[0]); ra[2] = bflo(a2[1]); ra[3] = bfhi(a2[1]);
        rb[0] = bflo(b2[0]); rb[1] = bfhi(b2[0]); rb[2] = bflo(b2[1]); rb[3] = bfhi(b2[1]);
      } else {
        const u16* kp = KVRAW + (size_t)m * 2048 + h * 128 + sub * 16;
        const u32x4 w0 = *(const u32x4*)kp, w1 = *(const u32x4*)(kp + 8);
#pragma unroll
        for (int e = 0; e < 8; ++e) { nope[e] = bfget(w0, e); nope[8 + e] = bfget(w1, e); }
        ra = *(const f32x4*)(KROPE + (size_t)m * 32 + sub * 4);
        rb = *(const f32x4*)(KROPE + (size_t)m * 32 + 16 + sub * 4);
      }
      float ss = 0.f;
#pragma unroll
      for (int e = 0; e < 16; ++e) ss += nope[e] * nope[e];
#pragma unroll
      for (int e = 0; e < 4; ++e) ss += ra[e] * ra[e] + rb[e] * rb[e];
      ss += __shfl_xor(ss, 1); ss += __shfl_xor(ss, 2);
      const float rstd = rsqrtf(ss * (1.f / 96.f) + EPS) * (which == 0 ? QS : 1.f);
      u32x4 o0, o1;
#pragma unroll
      for (int e2 = 0; e2 < 4; ++e2) {
        o0[e2] = pack2(nope[2 * e2] * rstd * gn[sub * 16 + 2 * e2], nope[2 * e2 + 1] * rstd * gn[sub * 16 + 2 * e2 + 1]);
        o1[e2] = pack2(nope[8 + 2 * e2] * rstd * gn[sub * 16 + 8 + 2 * e2], nope[9 + 2 * e2] * rstd * gn[sub * 16 + 9 + 2 * e2]);
      }
      f32x4 oa, ob;
#pragma unroll
      for (int e = 0; e < 4; ++e) {
        const float a = ra[e] * rstd * gn[64 + sub * 4 + e], bq = rb[e] * rstd * gn[80 + sub * 4 + e];
        oa[e] = a * cs[e] - bq * sn[e];
        ob[e] = bq * cs[e] + a * sn[e];
      }
      *(u32x4*)(dstp + sub * 16) = o0; *(u32x4*)(dstp + sub * 16 + 8) = o1;
      *(u32x2*)(dstp + 64 + sub * 4) = pack4(oa); *(u32x2*)(dstp + 80 + sub * 4) = pack4(ob);
    }
  }
}

DI void mla_vt_phase(const u16* __restrict__ KVRAW, u16* __restrict__ VT, char* smem) {
  u16* tile = (u16*)smem;
  const int tid = vtid();
  for (int item = vbid(); item < 8192; item += vgrid()) {
    const int tt = item & 63, bh = item >> 6, b = bh >> 4, h = bh & 15;
    {
      const int row = tid >> 2, part = tid & 3;
      const u16* src = KVRAW + ((size_t)b * 4096 + tt * 64 + row) * 2048 + h * 128 + 64 + part * 16;
      const u32x4 w0 = *(const u32x4*)src, w1 = *(const u32x4*)(src + 8);
      u32* d32 = (u32*)(tile + row * 66 + part * 16);
#pragma unroll
      for (int e = 0; e < 4; ++e) { d32[e] = w0[e]; d32[4 + e] = w1[e]; }
    }
    __syncthreads();
    {
      const int d = tid >> 2, tp = (tid & 3) * 16;
      u32x4 o0, o1;
#pragma unroll
      for (int e2 = 0; e2 < 4; ++e2) {
        o0[e2] = (u32)tile[(tp + 2 * e2) * 66 + d] | ((u32)tile[(tp + 2 * e2 + 1) * 66 + d] << 16);
        o1[e2] = (u32)tile[(tp + 8 + 2 * e2) * 66 + d] | ((u32)tile[(tp + 9 + 2 * e2) * 66 + d] << 16);
      }
      u16* dst = VT + ((size_t)(bh * 64 + d)) * 4096 + tt * 64 + tp;
      *(u32x4*)dst = o0; *(u32x4*)(dst + 8) = o1;
    }
    __syncthreads();
  }
}

constexpr int FA_KROW = 208, FA_VROW = 144, FA_KT = 64 * FA_KROW, FA_BUF = FA_KT + 64 * FA_VROW;
DI void mla_attn_item(const u16* __restrict__ Q, const u16* __restrict__ Kb, const u16* __restrict__ VT, u16* __restrict__ O, int item, char* smem) {
  const int qb = item & 15, bh = item >> 4, b = bh >> 4, h = bh & 15;
  const int tid = vtid(), lane = tid & 63, wid = tid >> 6, fr = lane & 15, fq = lane >> 4;
  bf16x8 qf[4][3];
#pragma unroll
  for (int qt = 0; qt < 4; ++qt) {
    const size_t tq = (size_t)b * 4096 + qb * 256 + wid * 64 + qt * 16 + fr;
#pragma unroll
    for (int ks = 0; ks < 3; ++ks) qf[qt][ks] = *(const bf16x8*)(Q + tq * 1536 + h * 96 + ks * 32 + fq * 8);
  }
  f32x4 o[4][4];
#pragma unroll
  for (int i = 0; i < 4; ++i)
#pragma unroll
    for (int j = 0; j < 4; ++j) o[i][j] = zero4();
  float mrun[4] = {-1e30f, -1e30f, -1e30f, -1e30f}, lrun[4] = {0.f, 0.f, 0.f, 0.f};
  const u16* kg[3]; int ks_off[3];
#pragma unroll
  for (int i = 0; i < 3; ++i) {
    const int c = tid + 256 * i, row = c / 12, kc = c % 12;
    kg[i] = Kb + ((size_t)b * 4096 + row) * 1536 + h * 96 + kc * 8;
    ks_off[i] = row * FA_KROW + kc * 16;
  }
  const u16* vg[2]; int vs_off[2];
#pragma unroll
  for (int i = 0; i < 2; ++i) {
    const int c = tid + 256 * i, d = c >> 3, kc = c & 7;
    vg[i] = VT + ((size_t)(bh * 64 + d)) * 4096 + kc * 8;
    vs_off[i] = FA_KT + d * FA_VROW + kc * 16;
  }
  u32x4 rk[3], rv[2];
#pragma unroll
  for (int i = 0; i < 3; ++i) rk[i] = *(const u32x4*)(kg[i]);
#pragma unroll
  for (int i = 0; i < 2; ++i) rv[i] = *(const u32x4*)(vg[i]);
#pragma unroll
  for (int i = 0; i < 3; ++i) *(u32x4*)(smem + ks_off[i]) = rk[i];
#pragma unroll
  for (int i = 0; i < 2; ++i) *(u32x4*)(smem + vs_off[i]) = rv[i];
#pragma unroll
  for (int qt = 0; qt < 4; ++qt)
#pragma unroll
    for (int ks = 0; ks < 3; ++ks) asm volatile("" :: "v"(qf[qt][ks]));
  __syncthreads();
  for (int kt = 0; kt < 64; ++kt) {
    const int cur = (kt & 1) * FA_BUF, nxt = FA_BUF - cur;
    if (kt + 1 < 64) {
      const size_t key0 = (size_t)(kt + 1) * 64;
#pragma unroll
      for (int i = 0; i < 3; ++i) rk[i] = *(const u32x4*)(kg[i] + key0 * 1536);
#pragma unroll
      for (int i = 0; i < 2; ++i) rv[i] = *(const u32x4*)(vg[i] + key0);
    }
#pragma unroll
    for (int kh = 0; kh < 2; ++kh) {
      f32x4 s[2][4];
#pragma unroll
      for (int kl = 0; kl < 2; ++kl) {
#pragma unroll
        for (int qt = 0; qt < 4; ++qt) s[kl][qt] = zero4();
#pragma unroll
        for (int ks = 0; ks < 3; ++ks) {
          const bf16x8 kf = *(const bf16x8*)(smem + cur + ((kh * 2 + kl) * 16 + fr) * FA_KROW + ks * 64 + fq * 16);
#pragma unroll
          for (int qt = 0; qt < 4; ++qt) s[kl][qt] = MFMA32(kf, qf[qt][ks], s[kl][qt]);
        }
      }
      bf16x8 pp[4];
      {
        float lm[4]; bool need = false;
#pragma unroll
        for (int qt = 0; qt < 4; ++qt) {
          const float m0 = fmaxf(fmaxf(s[0][qt][0], s[0][qt][1]), fmaxf(s[0][qt][2], s[0][qt][3]));
          const float m1 = fmaxf(fmaxf(s[1][qt][0], s[1][qt][1]), fmaxf(s[1][qt][2], s[1][qt][3]));
          lm[qt] = fmaxf(m0, m1);
          need = need || (lm[qt] > mrun[qt] + 8.f);
        }
        if (__any(need)) {
#pragma unroll
          for (int qt = 0; qt < 4; ++qt) {
            float mx = lm[qt];
            mx = fmaxf(mx, __shfl_xor(mx, 16)); mx = fmaxf(mx, __shfl_xor(mx, 32));
            const float mnew = fmaxf(mrun[qt], mx);
            const float alpha = __builtin_amdgcn_exp2f(mrun[qt] - mnew);
            mrun[qt] = mnew;
            lrun[qt] *= alpha;
#pragma unroll
            for (int dt = 0; dt < 4; ++dt) o[dt][qt] = o[dt][qt] * alpha;
          }
        }
#pragma unroll
        for (int qt = 0; qt < 4; ++qt) {
          const float mr = mrun[qt];
          float ps = 0.f;
#pragma unroll
          for (int kl = 0; kl < 2; ++kl)
#pragma unroll
            for (int j = 0; j < 4; ++j) { const float pv = __builtin_amdgcn_exp2f(s[kl][qt][j] - mr); s[kl][qt][j] = pv; ps += pv; }
          lrun[qt] += ps;
          pp[qt] = pack8(s[0][qt], s[1][qt]);
        }
      }
#pragma unroll
      for (int dt = 0; dt < 4; ++dt) {
        const char* vp = smem + cur + FA_KT + (dt * 16 + fr) * FA_VROW + (kh * 32 + fq * 4) * 2;
        const bf16x8 vf = cat4(*(const bf16x4*)vp, *(const bf16x4*)(vp + 32));
#pragma unroll
        for (int qt = 0; qt < 4; ++qt) o[dt][qt] = MFMA32(vf, pp[qt], o[dt][qt]);
      }
    }
    if (kt + 1 < 64) {
#pragma unroll
      for (int i = 0; i < 3; ++i) *(u32x4*)(smem + nxt + ks_off[i]) = rk[i];
#pragma unroll
      for (int i = 0; i < 2; ++i) *(u32x4*)(smem + nxt + vs_off[i]) = rv[i];
    }
    __syncthreads();
  }
#pragma unroll
  for (int qt = 0; qt < 4; ++qt) {
    float l = lrun[qt];
    l += __shfl_xor(l, 16); l += __shfl_xor(l, 32);
    const float inv = 1.f / l;
    const size_t tq = (size_t)b * 4096 + qb * 256 + wid * 64 + qt * 16 + fr;
#pragma unroll
    for (int dt = 0; dt < 4; ++dt) *(u32x2*)(O + tq * 1024 + h * 64 + dt * 16 + fq * 4) = pack4(o[dt][qt] * inv);
  }
}

#define XB_TMO      128
#define XB_XCNT(j)  (256  + 64 * (j))
#define XB_XSUB(j)  (1280 + 64 * (j))
#define XB_XGEN(j)  (2304 + 64 * (j))
#define XB_TOP      3328
#define XB_TOPGEN   3392
#define XCD_BAR_WORDS 3456
#define XB_SPIN_CAP (1u << 22)
DI unsigned xb_ld(unsigned* p) { return __hip_atomic_load(p, __ATOMIC_RELAXED, __HIP_MEMORY_SCOPE_AGENT); }
DI unsigned xb_add(unsigned* p, unsigned v) { return __hip_atomic_fetch_add(p, v, __ATOMIC_RELAXED, __HIP_MEMORY_SCOPE_AGENT); }
DI unsigned xb_xcc_id() { return (unsigned)__builtin_amdgcn_s_getreg((3 << 11) | 20) & 0xFu; }
#define XB_SPIN(cond, bar) do { unsigned _sp = 0; while (cond) { __builtin_amdgcn_s_sleep(1); \
    if ((++_sp & 255u) == 0u) { if (xb_ld(&(bar)[XB_TMO])) break; if (_sp > XB_SPIN_CAP) { atomicAdd(&(bar)[XB_TMO], 1u); break; } } } } while (0)

DI void xcd_barrier_complete(unsigned* bar, unsigned x, unsigned& nloc, unsigned& nx) {
  const unsigned G = gridDim.x;
  unsigned sum, cnt, mine, sp = 0u;
  for (;;) {
    sum = 0u; cnt = 0u; mine = 0u;
#pragma unroll
    for (unsigned j = 0; j < 16; ++j) { const unsigned c = xb_ld(&bar[XB_XCNT(j)]); sum += c; cnt += (c > 0u) ? 1u : 0u; mine = (j == x) ? c : mine; }
    if (sum == G) break;
    __builtin_amdgcn_s_sleep(1);
    if ((++sp & 255u) == 0u) { if (xb_ld(&bar[XB_TMO])) break; if (sp > XB_SPIN_CAP) { atomicAdd(&bar[XB_TMO], 1u); break; } }
  }
  nloc = mine > 0u ? mine : 1u; nx = cnt > 0u ? cnt : 1u;
}

DI void xcd_barrier(unsigned* bar, volatile unsigned* st) {
  asm volatile("s_waitcnt vmcnt(0)" ::: "memory");
  __syncthreads();
  if (threadIdx.x == 0) {
    __builtin_amdgcn_s_waitcnt(0);
    const unsigned x = xb_xcc_id();
    unsigned nloc = st[0], nx = st[1];
    if (nloc == 0u) { xcd_barrier_complete(bar, x, nloc, nx); st[0] = nloc; st[1] = nx; }
    const unsigned old = xb_add(&bar[XB_XSUB(x)], 1u);
    const unsigned gen = old / nloc;
    if (old + 1u == (gen + 1u) * nloc) {
      __builtin_amdgcn_fence(__ATOMIC_RELEASE, "agent");
      asm volatile("s_waitcnt vmcnt(0)" ::: "memory");
      const unsigned og = xb_add(&bar[XB_TOP], 1u);
      const unsigned tg = og / nx;
      if (og + 1u == (tg + 1u) * nx) xb_add(&bar[XB_TOPGEN], 1u);
      else XB_SPIN(xb_ld(&bar[XB_TOPGEN]) == tg, bar);
      __builtin_amdgcn_fence(__ATOMIC_ACQUIRE, "agent");
      xb_add(&bar[XB_XGEN(x)], 1u);
      asm volatile("s_waitcnt vmcnt(0)" ::: "memory");
    } else {
      XB_SPIN(xb_ld(&bar[XB_XGEN(x)]) == gen, bar);
      __builtin_amdgcn_fence(__ATOMIC_ACQUIRE, "agent");
      asm volatile("s_waitcnt vmcnt(0)" ::: "memory");
    }
  }
  __syncthreads();
}

#ifndef ENMASK
#define ENMASK 0xffffffffu
#endif
#define EN(i) ((ENMASK >> (i)) & 1u)
#ifndef DUPMASK
#define DUPMASK 0u
#endif
#define DUP(i) ((DUPMASK >> (i)) & 1u)
#ifndef BAR2
#define BAR2 0
#endif
#define PHASE_BEGIN(i) if (EN(i) && pc >= p.lo && pc < p.hi) for (int rep_ = 0; rep_ < 1 + (int)DUP(i); ++rep_) {
#define PHASE_END } { if (pc >= p.lo && pc + 1 < p.hi) { if (pc == p.lo) grid.sync(); else { xcd_barrier(bar, st); if (BAR2) xcd_barrier(bar, st); } } ++pc; }

__global__ void __launch_bounds__(512) mega(Params p) {
  __shared__ __attribute__((aligned(16))) char smem[147456 + 16];
  cg::grid_group grid = cg::this_grid();
  int pc = 0;
  char* ws = p.ws;
  unsigned* bar = (unsigned*)(ws + OFF_BAR);
  volatile unsigned* st = (volatile unsigned*)(smem + 147456);
  char* vsmem = smem + (otid() >> 8) * 73728;
  if (threadIdx.x == 0) { st[0] = 0u; st[1] = 0u; (void)xb_add(&bar[XB_XCNT(xb_xcc_id())], 1u); }
  __syncthreads();
  u16* H = (u16*)(ws + OFF_H);
  char* R = ws + OFF_R;
  const float* LB = (const float*)(ws + OFF_TAB);
  const float* RC = LB + 4096; const float* RS = RC + 65536;
  for (int layer = 0; layer < 4; ++layer) {
    const int kind = layer % 3, mi = layer / 3;
    for (int stage = 0; stage < 3; ++stage) {
      if (stage != 1) {
        const float* ng = (stage == 0 ? p.ffn1_norm : p.ffn2_norm) + layer * 1024;
        const u16* wgu = (const u16*)(ws + (stage == 0 ? OFF_WGU1 : OFF_WGU2));
        const u16* wdn = (const u16*)(ws + (stage == 0 ? OFF_WDN1 : OFF_WDN2));
        u16* ACT = (u16*)R;
        PHASE_BEGIN(0)
          const bool first = (layer == 0 && stage == 0);
          if (stage == 0) { if (layer == 0) init_tables(p); cvt_layer(p, layer, vsmem); }
          norm_phase(first ? p.x : p.X, ng, H, first ? p.X : nullptr, MTOK);
        PHASE_END
        PHASE_BEGIN(1)
          gemm_phase(H, 1024, wgu, 1024, MTOK, 5632, EpiSwiglu{ACT}, smem);
        PHASE_END
        PHASE_BEGIN(2)
          gemm_phase(ACT, 2816, wdn, 2816, MTOK, 1024, EpiResid{p.X, 0.5f}, smem);
        PHASE_END
      } else {
        PHASE_BEGIN(3)
          norm_phase(p.X, p.mix_norm + layer * 1024, H, nullptr, MTOK);
        PHASE_END
        if (kind == 0) {
          constexpr size_t SZ = 32 * MiB;
          HgBufs hb;
          hb.Q = (u16*)(R + 0 * SZ); hb.LFf = (u16*)(R + 1 * SZ); hb.LFb = (u16*)(R + 2 * SZ); hb.V = (u16*)(R + 3 * SZ); hb.G = (u16*)(R + 4 * SZ);
          hb.QIf = (u16*)(R + 5 * SZ); hb.QIb = (u16*)(R + 6 * SZ); hb.KITf = (u16*)(R + 7 * SZ); hb.KITb = (u16*)(R + 8 * SZ);
          hb.VTc = (u16*)(R + 9 * SZ); hb.OI = (u16*)(R + 10 * SZ); hb.OF = hb.Q; hb.OB = hb.LFf; hb.Y = hb.LFb;
          hb.DECf = (float*)(R + 11 * SZ); hb.DECb = (float*)(R + 11 * SZ + 4 * MiB);
          const u16* w_in = (const u16*)(ws + OFF_WMIX); const u16* w_out = (const u16*)(ws + OFF_WMIX + 10485760);
          for (int half = 0; half < 2; ++half) {
            PHASE_BEGIN(4)
              gemm_phase(H + (size_t)half * 16384 * 1024, 1024, w_in, 1024, 16384, 5120, EpiHgIn{hb.Q, hb.LFf, hb.LFb, hb.V, hb.G, LB + layer * 1024}, smem);
            PHASE_END
            PHASE_BEGIN(5)
              hg_prep_phase(hb, vsmem);
            PHASE_END
            PHASE_BEGIN(6)
              hg_scan_phase(hb, vsmem);
            PHASE_END
            PHASE_BEGIN(7)
              hg_combine_phase(hb, p.hg_g_norm + mi * 128, 16384);
            PHASE_END
            PHASE_BEGIN(8)
              gemm_phase(hb.Y, 1024, w_out, 1024, 16384, 1024, EpiResid{p.X + (size_t)half * 16384 * 1024, 1.0f}, smem);
            PHASE_END
          }
        } else if (kind == 1) {
          u16* Qn = (u16*)R; u16* Kn = (u16*)(R + 64 * MiB); u16* VT = (u16*)(R + 128 * MiB); u16* On = (u16*)(R + 192 * MiB);
          const u16* w_in = (const u16*)(ws + OFF_WMIX); const u16* w_out = (const u16*)(ws + OFF_WMIX + 6291456);
          PHASE_BEGIN(9)
            gemm_phase(H, 1024, w_in, 1024, MTOK, 3072, EpiNaIn{Qn, Kn, VT, p.na_q_norm + mi * 64, p.na_k_norm + mi * 64}, smem);
          PHASE_END
          PHASE_BEGIN(10)
            const int tid_ = vtid(), lane = tid_ & 63, wid = tid_ >> 6, fr = lane & 15, fq = lane >> 4;
            for (int item = vbid() * 4 + wid; item < 32768; item += vgrid() * 4)
              na_attn_item(Qn, Kn, VT, p.na_rpb + (size_t)mi * 16 * 15 * 31, On, item, fr, fq);
          PHASE_END
          PHASE_BEGIN(11)
            gemm_phase(On, 1024, w_out, 1024, MTOK, 1024, EpiResid{p.X, 1.0f}, smem);
          PHASE_END
        } else {
          u16* VT = H;
          u16* CRAW = (u16*)R; u16* On = (u16*)R;
          u16* CQN = (u16*)(R + 66 * MiB); u16* CKVN = (u16*)(R + 114 * MiB); u16* Kk = (u16*)(R + 66 * MiB);
          float* KROPE = (float*)(R + 162 * MiB);
          u16* Qq = (u16*)(R + 166 * MiB); u16* KVRAW = (u16*)(R + 262 * MiB);
          const u16* w_in = (const u16*)(ws + OFF_WMIX); const u16* w_uq = (const u16*)(ws + OFF_WMIX + 2621440);
          const u16* w_ukv = (const u16*)(ws + OFF_WMIX + 4980736); const u16* w_out = (const u16*)(ws + OFF_WMIX + 6029312);
          PHASE_BEGIN(12)
            gemm_phase(H, 1024, w_in, 1024, MTOK, 1280, EpiStore{CRAW, 1056, 1056}, smem);
          PHASE_END
          PHASE_BEGIN(13)
            mla_norm_phase(CRAW, p.mla_q_a_norm + mi * 768, p.mla_kv_a_norm + mi * 256, CQN, CKVN, KROPE);
          PHASE_END
          PHASE_BEGIN(14)
            gemm_phase(CQN, 768, w_uq, 768, MTOK, 1536, EpiStore{Qq, 1536, 1536}, smem);
            gemm_phase(CKVN, 256, w_ukv, 256, MTOK, 2048, EpiStore{KVRAW, 2048, 2048}, smem);
          PHASE_END
          PHASE_BEGIN(15)
            mla_prep_phase(Qq, KVRAW, KROPE, Kk, p.mla_q_norm + mi * 96, p.mla_k_norm + mi * 96, RC, RS);
            mla_vt_phase(KVRAW, VT, vsmem);
          PHASE_END
          PHASE_BEGIN(16)
            for (int item = vbid(); item < 2048; item += vgrid()) mla_attn_item(Qq, Kk, VT, On, item, vsmem);
          PHASE_END
          PHASE_BEGIN(17)
            gemm_phase(On, 1024, w_out, 1024, MTOK, 1024, EpiResid{p.X, 1.0f}, smem);
          PHASE_END
        }
      }
    }
  }
}

static int count_phases() {
  int n = 0;
  for (int layer = 0; layer < 4; ++layer) {
    int kind = layer % 3;
    n += 3 + 3 + 1;
    n += kind == 0 ? 10 : kind == 1 ? 3 : 6;
  }
  return n;
}

extern "C" void kernel_launch(void* const* d_in, const int* in_sizes, int n_in, void* d_out, int out_size, void* d_ws, size_t ws_size, hipStream_t stream) {
  if (ws_size < WS_NEED) { fprintf(stderr, "workspace too small: %zu < %zu\n", ws_size, WS_NEED); return; }
  static int grid_blocks = 0;
  if (!grid_blocks) {
    int dev = 0, cus = 0, per_cu = 0;
    hipGetDevice(&dev);
    hipDeviceGetAttribute(&cus, hipDeviceAttributeMultiprocessorCount, dev);
    hipOccupancyMaxActiveBlocksPerMultiprocessor(&per_cu, mega, 512, 0);
    if (per_cu > 1) per_cu = 1;
    grid_blocks = cus * per_cu;
  }
  Params p{};
  const float** pf = (const float**)&p;
  for (int i = 0; i < 25; ++i) pf[i] = (const float*)d_in[i];
  p.X = (float*)d_out; p.ws = (char*)d_ws;
  const int total = count_phases();
#if MULTI_LAUNCH
  for (int ph = 0; ph < total; ++ph) {
    p.lo = ph; p.hi = ph + 1;
    hipLaunchKernelGGL(mega, dim3(grid_blocks), dim3(512), 0, stream, p);
  }
#else
  hipMemsetAsync((char*)d_ws + OFF_BAR, 0, 16384, stream);
  p.lo = 0; p.hi = total;
  void* args[] = {&p};
  hipError_t e = hipLaunchCooperativeKernel((void*)mega, dim3(grid_blocks), dim3(512), args, 0, stream);
  if (e != hipSuccess) fprintf(stderr, "cooperative launch failed: %s (grid %d)\n", hipGetErrorString(e), grid_blocks);
#endif
}
```

```cpp
#include <hip/hip_runtime.h>
#include <hip/hip_cooperative_groups.h>
#include <cstdio>
#include <cstdint>
namespace cg = cooperative_groups;

#ifndef MULTI_LAUNCH
#define MULTI_LAUNCH 0
#endif

typedef unsigned short u16;
typedef unsigned int u32;
using bf16x8 = __attribute__((ext_vector_type(8))) short;
using bf16x4 = __attribute__((ext_vector_type(4))) short;
using f32x4 = __attribute__((ext_vector_type(4))) float;
using u32x2 = __attribute__((ext_vector_type(2))) unsigned int;
using u32x4 = __attribute__((ext_vector_type(4))) unsigned int;

#define DI __device__ __forceinline__
#define MFMA32(a, b, c) __builtin_amdgcn_mfma_f32_16x16x32_bf16((a), (b), (c), 0, 0, 0)

constexpr int MTOK = 32768;
constexpr float EPS = 1e-6f;
constexpr float LOG2E = 1.4426950408889634f;

constexpr size_t MiB = 1048576;
constexpr size_t OFF_WGU1 = 0;
constexpr size_t OFF_WDN1 = 11534336;
constexpr size_t OFF_WGU2 = 17301504;
constexpr size_t OFF_WDN2 = 28835840;
constexpr size_t OFF_WMIX = 34603008;
constexpr size_t OFF_TAB = 47185920;
constexpr size_t OFF_BAR = OFF_TAB + 786432;
constexpr size_t OFF_H = 46 * MiB;
constexpr size_t OFF_R = 110 * MiB;
constexpr size_t WS_NEED = 500 * MiB;

struct Params {
  const float* x; const float* ffn1_norm; const float* ffn1_w_gu; const float* ffn1_w_down;
  const float* mix_norm; const float* ffn2_norm; const float* ffn2_w_gu; const float* ffn2_w_down;
  const float* hg_lb_logits; const float* hg_w_in; const float* hg_g_norm; const float* hg_w_out;
  const float* na_w_in; const float* na_q_norm; const float* na_k_norm; const float* na_rpb; const float* na_w_out;
  const float* mla_w_in; const float* mla_q_a_norm; const float* mla_w_uq; const float* mla_kv_a_norm; const float* mla_w_ukv;
  const float* mla_q_norm; const float* mla_k_norm; const float* mla_w_out;
  float* X; char* ws; int lo; int hi;
};

DI u32 f2bf(float x) { u32 u = __float_as_uint(x); u += 0x7fffu + ((u >> 16) & 1u); return u >> 16; }
typedef __bf16 bf16v2 __attribute__((ext_vector_type(2)));
typedef float f32v2 __attribute__((ext_vector_type(2)));
DI u32 pack2(float a, float b) { f32v2 v = {a, b}; bf16v2 r = __builtin_convertvector(v, bf16v2); return __builtin_bit_cast(u32, r); }
DI float bflo(u32 w) { return __uint_as_float(w << 16); }
DI float bfhi(u32 w) { return __uint_as_float(w & 0xffff0000u); }
DI float bfget(const u32x4& v, int e) { u32 w = v[e >> 1]; return (e & 1) ? bfhi(w) : bflo(w); }
DI u32x2 pack4(const f32x4& v) { u32x2 r; r[0] = pack2(v[0], v[1]); r[1] = pack2(v[2], v[3]); return r; }
DI bf16x8 pack8(const f32x4& a, const f32x4& b) {
  u32x4 r; r[0] = pack2(a[0], a[1]); r[1] = pack2(a[2], a[3]); r[2] = pack2(b[0], b[1]); r[3] = pack2(b[2], b[3]);
  return __builtin_bit_cast(bf16x8, r);
}
DI bf16x8 cat4(const bf16x4& lo, const bf16x4& hi) { return __builtin_shufflevector(lo, hi, 0, 1, 2, 3, 4, 5, 6, 7); }
DI int otid() { int t = threadIdx.x; asm volatile("" : "+v"(t)); return t; }
DI float sx(float v, int k) {
  const int l = otid() & 63;
  return __int_as_float(__builtin_amdgcn_ds_bpermute((l ^ k) << 2, __float_as_int(v)));
}
DI float wave_sum(float v) {
#pragma unroll
  for (int o = 32; o > 0; o >>= 1) v += sx(v, o);
  return v;
}
DI float sigmoidf_(float z) { return __builtin_amdgcn_rcpf(1.f + __expf(-z)); }
DI float siluf_(float z) { return z * __builtin_amdgcn_rcpf(1.f + __expf(-z)); }
DI int vtid() { return otid() & 255; }
DI int vbid() { return blockIdx.x * 2 + (otid() >> 8); }
DI int vgrid() { return gridDim.x * 2; }
DI f32x4 zero4() { f32x4 z = {0.f, 0.f, 0.f, 0.f}; return z; }

DI void init_tables(const Params& p) {
  float* LB = (float*)(p.ws + OFF_TAB); float* RC = LB + 4096; float* RS = RC + 65536;
  const int gt = vbid() * 256 + vtid(), gs = vgrid() * 256;
  for (int c = gt; c < 1024; c += gs) {
    float l0 = p.hg_lb_logits[c], l1 = p.hg_lb_logits[1024 + c], l2 = p.hg_lb_logits[2048 + c], l3 = p.hg_lb_logits[3072 + c];
    float mx = fmaxf(fmaxf(l0, l1), fmaxf(l2, l3));
    float e0 = expf(l0 - mx), e1 = expf(l1 - mx), e2 = expf(l2 - mx), e3 = expf(l3 - mx);
    float inv = 1.f / (e0 + e1 + e2 + e3);
    LB[c] = 0.f; LB[1024 + c] = e1 * inv; LB[2048 + c] = (e1 + e2) * inv; LB[3072 + c] = (e1 + e2 + e3) * inv;
  }
  for (int i = gt; i < 65536; i += gs) {
    int t = i >> 4, j = i & 15;
    float inv = exp2f(-(float)j * (13.287712379549449f / 16.f));
    float ang = (float)t * inv;
    double a = (double)ang;
    double k = rint(a * 0.15915494309189535);
    float r = (float)(a - k * 6.283185307179586);
    RC[i] = __cosf(r); RS[i] = __sinf(r);
  }
}

DI void cvt_tiles(const float* __restrict__ src, u16* __restrict__ dst, int K, int N, int Nd, int mode, char* smem) {
  float* tile = (float*)smem;
  const int tk = K >> 6, tn = Nd >> 6, tid = vtid();
  for (int t = vbid(); t < tk * tn; t += vgrid()) {
    const int k0 = (t % tk) << 6, n0 = (t / tk) << 6;
    {
      const int nl = tid & 63, kq = tid >> 6;
      const int nd = n0 + nl;
      int col = nd;
      if (mode == 1) { int a = nd >> 5, r = nd & 31; col = a * 16 + (r & 15) + ((r >= 16) ? 2816 : 0); }
      const bool ok = col < N;
#pragma unroll
      for (int i = 0; i < 16; ++i) {
        int kl = kq + 4 * i;
        tile[kl * 65 + nl] = ok ? src[(size_t)(k0 + kl) * N + col] : 0.f;
      }
    }
    __syncthreads();
    {
      const int kp = (tid & 31) * 2, nq = tid >> 5;
#pragma unroll
      for (int i = 0; i < 8; ++i) {
        int n = nq + 8 * i;
        *(u32*)(dst + (size_t)(n0 + n) * K + k0 + kp) = pack2(tile[kp * 65 + n], tile[(kp + 1) * 65 + n]);
      }
    }
    __syncthreads();
  }
}

DI void cvt_layer(const Params& p, int layer, char* smem) {
  const int kind = layer % 3, mi = layer / 3;
  char* ws = p.ws;
  for (int task = 0; task < 8; ++task) {
    const float* src = nullptr; size_t off = 0; int K = 0, N = 0, Nd = 0, mode = 0;
    if (task == 0) { src = p.ffn1_w_gu + (size_t)layer * 1024 * 5632; off = OFF_WGU1; K = 1024; N = 5632; Nd = 5632; mode = 1; }
    else if (task == 1) { src = p.ffn1_w_down + (size_t)layer * 2816 * 1024; off = OFF_WDN1; K = 2816; N = 1024; Nd = 1024; }
    else if (task == 2) { src = p.ffn2_w_gu + (size_t)layer * 1024 * 5632; off = OFF_WGU2; K = 1024; N = 5632; Nd = 5632; mode = 1; }
    else if (task == 3) { src = p.ffn2_w_down + (size_t)layer * 2816 * 1024; off = OFF_WDN2; K = 2816; N = 1024; Nd = 1024; }
    else if (kind == 0) {
      if (task == 4) { src = p.hg_w_in + (size_t)mi * 1024 * 5120; off = OFF_WMIX; K = 1024; N = 5120; Nd = 5120; }
      else if (task == 5) { src = p.hg_w_out + (size_t)mi * 1024 * 1024; off = OFF_WMIX + 10485760; K = 1024; N = 1024; Nd = 1024; }
    } else if (kind == 1) {
      if (task == 4) { src = p.na_w_in + (size_t)mi * 1024 * 3072; off = OFF_WMIX; K = 1024; N = 3072; Nd = 3072; }
      else if (task == 5) { src = p.na_w_out + (size_t)mi * 1024 * 1024; off = OFF_WMIX + 6291456; K = 1024; N = 1024; Nd = 1024; }
    } else {
      if (task == 4) { src = p.mla_w_in + (size_t)mi * 1024 * 1056; off = OFF_WMIX; K = 1024; N = 1056; Nd = 1280; }
      else if (task == 5) { src = p.mla_w_uq + (size_t)mi * 768 * 1536; off = OFF_WMIX + 2621440; K = 768; N = 1536; Nd = 1536; }
      else if (task == 6) { src = p.mla_w_ukv + (size_t)mi * 256 * 2048; off = OFF_WMIX + 4980736; K = 256; N = 2048; Nd = 2048; }
      else if (task == 7) { src = p.mla_w_out + (size_t)mi * 1024 * 1024; off = OFF_WMIX + 6029312; K = 1024; N = 1024; Nd = 1024; }
    }
    if (src) cvt_tiles(src, (u16*)(ws + off), K, N, Nd, mode, smem);
  }
}

DI void norm_phase(const float* __restrict__ src, const float* __restrict__ gain, u16* __restrict__ dst, float* copy_dst, int rows) {
  const int lane = vtid() & 63, wid = vtid() >> 6;
  f32x4 g[4];
#pragma unroll
  for (int i = 0; i < 4; ++i) g[i] = *(const f32x4*)(gain + i * 256 + lane * 4);
  const int stride = vgrid() * 4;
  for (int row = vbid() * 4 + wid; row < rows; row += stride * 4) {
    f32x4 v[4][4];
#pragma unroll
    for (int j = 0; j < 4; ++j) {
      const int rj = row + j * stride;
      if (rj < rows) {
#pragma unroll
        for (int i = 0; i < 4; ++i) v[j][i] = *(const f32x4*)(src + (size_t)rj * 1024 + i * 256 + lane * 4);
      }
    }
#pragma unroll
    for (int j = 0; j < 4; ++j) {
      const int rj = row + j * stride;
      if (rj < rows) {
        float ss = 0.f;
#pragma unroll
        for (int i = 0; i < 4; ++i) ss += v[j][i][0] * v[j][i][0] + v[j][i][1] * v[j][i][1] + v[j][i][2] * v[j][i][2] + v[j][i][3] * v[j][i][3];
        ss = wave_sum(ss);
        const float rstd = rsqrtf(ss * (1.f / 1024.f) + EPS);
#pragma unroll
        for (int i = 0; i < 4; ++i) {
          f32x4 y = v[j][i] * rstd * g[i];
          *(u32x2*)(dst + (size_t)rj * 1024 + i * 256 + lane * 4) = pack4(y);
          if (copy_dst) *(f32x4*)(copy_dst + (size_t)rj * 1024 + i * 256 + lane * 4) = v[j][i];
        }
      }
    }
  }
}

#define GLDS16(gp, lp) __builtin_amdgcn_global_load_lds((const unsigned*)(gp), (unsigned*)(lp), 16, 0, 0)

constexpr int G_MT = 2;
constexpr int HTB = 16384;

DI const char* uniform_ptr(const void* p) {
  const unsigned long long v = (unsigned long long)p;
  const unsigned lo = __builtin_amdgcn_readfirstlane((unsigned)v), hi = __builtin_amdgcn_readfirstlane((unsigned)(v >> 32));
  return (const char*)(((unsigned long long)hi << 32) | lo);
}
DI void glds_sv(const char* sbase, unsigned voff, unsigned ldsaddr) {
  unsigned keep;
  asm volatile("s_mov_b32 %0, m0\n\ts_mov_b32 m0, %3\n\ts_nop 0\n\tglobal_load_lds_dwordx4 %1, %2\n\ts_mov_b32 m0, %0"
               : "=&s"(keep) : "v"(voff), "s"(sbase), "s"(ldsaddr) : "memory");
}
DI int lds_byte(int r, int c) {
  const int st = (r >> 4) * 2 + (c >> 5), rr = r & 15, cc = c & 31, ob = rr * 64 + cc * 2;
  return st * 1024 + (ob ^ (((ob >> 9) & 1) << 5));
}
DI void stage_rc(int b, int& R, int& C) {
  const int st = b / 1024, sb = b % 1024, swz = sb ^ (((sb >> 9) & 1) << 5);
  R = (st >> 1) * 16 + swz / 64; C = (st & 1) * 32 + (swz % 64) / 2;
}

template <class Epi>
DI void gemm_phase(const u16* __restrict__ Act, int lda, const u16* __restrict__ Wt, int Kc, int Mrows, int Ncols, const Epi& epi, char* smem) {
  int K = Kc; asm volatile("" : "+s"(K));
  const int mtn = Mrows >> 8, ntn = Ncols >> 8;
  const int ntiles = mtn * ntn;
  constexpr int GM = 16;
  const int tid = otid(), lane = tid & 63, wid = tid >> 6;
  const int wr = wid >> 2, wc = wid & 3, fr = lane & 15, fq = lane >> 4;
  int R0, C0;
  stage_rc(tid * 16, R0, C0);
  const unsigned vo0 = (unsigned)(R0 * K + C0) * 2u;
  const unsigned sl = (unsigned)(size_t)(__attribute__((address_space(3))) char*)smem + __builtin_amdgcn_readfirstlane(tid >> 6) * 1024;
  const int nt = K >> 6;
#define SA_(b, h) (((b) * 2 + (h)) * HTB)
#define SB_(b, h) ((4 + (b) * 2 + (h)) * HTB)
#define STAGE_(POFF, BASE, br, kt) do { const char* ub_ = uniform_ptr((const char*)(BASE) + ((size_t)(br) * K + (size_t)(kt) * 64) * 2); \
    glds_sv(ub_, vo0, sl + (POFF)); glds_sv(ub_ + (size_t)K * 128, vo0, sl + (POFF) + 8192); } while (0)
  const char* la_rd = smem + (((fr * 64 + fq * 16) ^ ((fr >> 3) << 5)) + wr * 8192);
  const char* lb_rd = smem + (((fr * 64 + fq * 16) ^ ((fr >> 3) << 5)) + wc * 4096 + 65536);
#define LDA_(dst, b, h) do { _Pragma("unroll") for (int m = 0; m < 4; ++m) _Pragma("unroll") for (int k = 0; k < 2; ++k) \
    dst[m][k] = *(const bf16x8*)(la_rd + SA_(b, h) + (m * 2 + k) * 1024); } while (0)
#define LDB_(dst, b, h) do { _Pragma("unroll") for (int n = 0; n < 2; ++n) _Pragma("unroll") for (int k = 0; k < 2; ++k) \
    dst[n][k] = *(const bf16x8*)(lb_rd + SA_(b, h) + (n * 2 + k) * 1024); } while (0)
#define MMA_(ai, bj, At, Bt) do { __builtin_amdgcn_s_setprio(1); \
    _Pragma("unroll") for (int m = 0; m < 4; ++m) _Pragma("unroll") for (int n = 0; n < 2; ++n) _Pragma("unroll") for (int k = 0; k < 2; ++k) \
      acc[ai][bj][m][n] = MFMA32(At[m][k], Bt[n][k], acc[ai][bj][m][n]); \
    __builtin_amdgcn_s_setprio(0); } while (0)
#define WAIT_V(n) asm volatile("s_waitcnt vmcnt(" #n ")" ::: "memory")
#define WAIT_L(n) asm volatile("s_waitcnt lgkmcnt(" #n ")" ::: "memory")
#define BAR_ __builtin_amdgcn_s_barrier()
#define SCHED_ __builtin_amdgcn_sched_barrier(0)
  for (int tile = blockIdx.x; tile < ntiles; tile += gridDim.x) {
    const int group = tile / (GM * ntn), rem = tile % (GM * ntn);
    const int mt_ = group * GM + (rem % GM), nt_ = rem / GM;
    const u16* A = Wt + (size_t)nt_ * 256 * K;
    const u16* Bt = Act + (size_t)mt_ * 256 * K;
    f32x4 acc[2][2][4][2];
#pragma unroll
    for (int a_ = 0; a_ < 2; ++a_)
#pragma unroll
      for (int b_ = 0; b_ < 2; ++b_)
#pragma unroll
        for (int m = 0; m < 4; ++m) { acc[a_][b_][m][0] = zero4(); acc[a_][b_][m][1] = zero4(); }
    bf16x8 At[4][2], B0[2][2], B1[2][2];
    STAGE_(SB_(0, 0), Bt, 0, 0); STAGE_(SA_(0, 0), A, 0, 0);
    STAGE_(SB_(0, 1), Bt, 128, 0); STAGE_(SA_(0, 1), A, 128, 0);
    if (wr == 1) BAR_;
    WAIT_V(4); BAR_;
    STAGE_(SB_(1, 0), Bt, 0, 1); STAGE_(SA_(1, 0), A, 0, 1); STAGE_(SB_(1, 1), Bt, 128, 1);
    WAIT_V(6); BAR_;
    for (int t = 0; t < nt - 2; t += 2) {
      LDB_(B0, 0, 0); SCHED_; LDA_(At, 0, 0); STAGE_(SA_(1, 1), A, 128, t + 1);
      WAIT_L(8); BAR_; WAIT_L(0); MMA_(0, 0, At, B0); BAR_; SCHED_;
      LDB_(B1, 0, 1); STAGE_(SB_(0, 0), Bt, 0, t + 2);
      BAR_; WAIT_L(0); MMA_(0, 1, At, B1); BAR_;
      LDA_(At, 0, 1); STAGE_(SA_(0, 0), A, 0, t + 2);
      BAR_; WAIT_L(0); MMA_(1, 0, At, B0); BAR_; SCHED_;
      STAGE_(SB_(0, 1), Bt, 128, t + 2);
      WAIT_V(6); BAR_; MMA_(1, 1, At, B1); BAR_;
      LDB_(B0, 1, 0); SCHED_; LDA_(At, 1, 0); STAGE_(SA_(0, 1), A, 128, t + 2);
      WAIT_L(8); BAR_; WAIT_L(0); MMA_(0, 0, At, B0); BAR_; SCHED_;
      LDB_(B1, 1, 1); STAGE_(SB_(1, 0), Bt, 0, t + 3);
      BAR_; WAIT_L(0); MMA_(0, 1, At, B1); BAR_;
      LDA_(At, 1, 1); STAGE_(SA_(1, 0), A, 0, t + 3);
      BAR_; WAIT_L(0); MMA_(1, 0, At, B0); BAR_; SCHED_;
      STAGE_(SB_(1, 1), Bt, 128, t + 3);
      WAIT_V(6); BAR_; MMA_(1, 1, At, B1); BAR_;
    }
    {
      LDB_(B0, 0, 0); LDA_(At, 0, 0); STAGE_(SA_(1, 1), A, 128, nt - 1);
      BAR_; WAIT_L(0); MMA_(0, 0, At, B0); BAR_;
      LDB_(B1, 0, 1); BAR_; WAIT_L(0); MMA_(0, 1, At, B1); BAR_;
      LDA_(At, 0, 1); WAIT_V(4); BAR_; WAIT_L(0); MMA_(1, 0, At, B0); MMA_(1, 1, At, B1); BAR_;
    }
    {
      LDB_(B0, 1, 0); LDA_(At, 1, 0); WAIT_V(2); BAR_; WAIT_L(0); MMA_(0, 0, At, B0); BAR_;
      LDB_(B1, 1, 1); WAIT_V(0); BAR_; WAIT_L(0); MMA_(0, 1, At, B1); BAR_;
      LDA_(At, 1, 1); BAR_; WAIT_L(0); MMA_(1, 0, At, B0); MMA_(1, 1, At, B1); BAR_;
    }
    if (wr == 0) BAR_;
    const int t2 = otid();
    const int fr2 = t2 & 15, fq2 = (t2 >> 4) & 3, wc2 = (t2 >> 6) & 3, wr2 = t2 >> 8;
#pragma unroll
    for (int ai = 0; ai < 2; ++ai)
#pragma unroll
      for (int bj = 0; bj < 2; ++bj)
        epi(acc[ai][bj], mt_ * 256 + bj * 128 + wc2 * 32, nt_ * 256 + ai * 128 + wr2 * 64, fr2, fq2);
  }
#undef SA_
#undef SB_
#undef STAGE_
#undef LDA_
#undef LDB_
#undef MMA_
#undef WAIT_V
#undef WAIT_L
#undef BAR_
#undef SCHED_
  __syncthreads();
}

struct EpiSwiglu {
  u16* act;
  DI void operator()(f32x4 (&acc)[4][G_MT], int mb, int nb, int fr, int fq) const {
#pragma unroll
    for (int mt = 0; mt < G_MT; ++mt) {
      const int m = mb + mt * 16 + fr;
#pragma unroll
      for (int np = 0; np < 2; ++np) {
        const f32x4 g = acc[2 * np][mt], u = acc[2 * np + 1][mt];
        f32x4 r;
#pragma unroll
        for (int j = 0; j < 4; ++j) r[j] = siluf_(g[j]) * u[j];
        const int jc = (nb >> 1) + np * 16 + fq * 4;
        *(u32x2*)(act + (size_t)m * 2816 + jc) = pack4(r);
      }
    }
  }
};

struct EpiResid {
  float* X; float scale;
  DI void operator()(f32x4 (&acc)[4][G_MT], int mb, int nb, int fr, int fq) const {
#pragma unroll
    for (int mt = 0; mt < G_MT; ++mt) {
      const int m = mb + mt * 16 + fr;
#pragma unroll
      for (int nt = 0; nt < 4; ++nt) {
        f32x4* ptr = (f32x4*)(X + (size_t)m * 1024 + nb + nt * 16 + fq * 4);
        f32x4 v = *ptr;
        v += acc[nt][mt] * scale;
        *ptr = v;
      }
    }
  }
};

struct EpiStore {
  u16* out; int ldo; int nmax;
  DI void operator()(f32x4 (&acc)[4][G_MT], int mb, int nb, int fr, int fq) const {
#pragma unroll
    for (int mt = 0; mt < G_MT; ++mt) {
      const int m = mb + mt * 16 + fr;
#pragma unroll
      for (int nt = 0; nt < 4; ++nt) {
        const int n = nb + nt * 16 + fq * 4;
        if (n < nmax) *(u32x2*)(out + (size_t)m * ldo + n) = pack4(acc[nt][mt]);
      }
    }
  }
};

struct EpiHgIn {
  u16 *Q, *LFf, *LFb, *V, *G; const float* lb;
  DI void operator()(f32x4 (&acc)[4][G_MT], int mb, int nb, int fr, int fq) const {
    const int seg = nb >> 10, c0 = nb & 1023;
    u16* dst = seg == 0 ? Q : seg == 1 ? LFf : seg == 2 ? LFb : seg == 3 ? V : G;
#pragma unroll
    for (int mt = 0; mt < G_MT; ++mt) {
      const int m = mb + mt * 16 + fr;
#pragma unroll
      for (int nt = 0; nt < 4; ++nt) {
        const int c = c0 + nt * 16 + fq * 4;
        f32x4 a = acc[nt][mt], r;
        if (seg == 0) r = a * 0.08838834764831845f;
        else if (seg == 3) r = a;
        else if (seg == 4) {
#pragma unroll
          for (int j = 0; j < 4; ++j) r[j] = siluf_(a[j]);
        } else {
          const f32x4 l4 = *(const f32x4*)(lb + c);
#pragma unroll
          for (int j = 0; j < 4; ++j) {
            float z = fminf(fmaxf(a[j], -30.f), 30.f);
            float f = l4[j] + (1.f - l4[j]) * sigmoidf_(z);
            r[j] = __logf(f);
          }
        }
        *(u32x2*)(dst + (size_t)m * 1024 + c) = pack4(r);
      }
    }
  }
};

struct EpiNaIn {
  u16 *Q, *K, *VT; const float *qn, *kn;
  DI void operator()(f32x4 (&acc)[4][G_MT], int mb, int nb, int fr, int fq) const {
    const int seg = nb >> 10, h = (nb & 1023) >> 6;
    if (seg < 2) {
      u16* dst = seg == 0 ? Q : K;
      const float* gn = seg == 0 ? qn : kn;
      const float sc = seg == 0 ? 0.125f * LOG2E : 1.f;
#pragma unroll
      for (int mt = 0; mt < G_MT; ++mt) {
        const int m = mb + mt * 16 + fr;
        float ss = 0.f;
#pragma unroll
        for (int nt = 0; nt < 4; ++nt)
#pragma unroll
          for (int j = 0; j < 4; ++j) ss += acc[nt][mt][j] * acc[nt][mt][j];
        ss += sx(ss, 16); ss += sx(ss, 32);
        const float rstd = rsqrtf(ss * (1.f / 64.f) + EPS) * sc;
#pragma unroll
        for (int nt = 0; nt < 4; ++nt) {
          const int d = nt * 16 + fq * 4;
          const f32x4 g4 = *(const f32x4*)(gn + d);
          f32x4 r = acc[nt][mt] * rstd * g4;
          *(u32x2*)(dst + (size_t)m * 1024 + h * 64 + d) = pack4(r);
        }
      }
    } else {
#pragma unroll
      for (int mt = 0; mt < G_MT; ++mt) {
        const int m = mb + mt * 16 + fr;
        const int b = m >> 12, t = m & 4095;
#pragma unroll
        for (int nt = 0; nt < 4; ++nt)
#pragma unroll
          for (int j = 0; j < 4; ++j) {
            const int d = nt * 16 + fq * 4 + j;
            VT[((size_t)((b * 16 + h) * 64 + d)) * 4096 + t] = (u16)f2bf(acc[nt][mt][j]);
          }
      }
    }
  }
};

struct HgBufs {
  u16 *Q, *LFf, *LFb, *V, *G, *QIf, *QIb, *KITf, *KITb, *VTc, *OI, *OF, *OB, *Y;
  float *DECf, *DECb;
};

DI void hg_prep_phase(const HgBufs& hb, char* smem) {
  u32x4 rq, rf, rb, rv;
  {
    const int item0 = vbid(), tid0 = vtid();
    if (item0 < 8192) {
      const size_t g0 = ((size_t)(item0 >> 11) * 4096 + ((item0 >> 3) & 255) * 16 + (tid0 >> 4)) * 1024 + (item0 & 7) * 128 + (tid0 & 15) * 8;
      rq = *(const u32x4*)(hb.Q + g0); rf = *(const u32x4*)(hb.LFf + g0); rb = *(const u32x4*)(hb.LFb + g0); rv = *(const u32x4*)(hb.V + g0);
    }
  }
  for (int item = vbid(); item < 8192; item += vgrid()) {
  const int h = item & 7, n = (item >> 3) & 255, b = item >> 11;
  float* sq = (float*)smem; float* sbf = sq + 2112; float* sbb = sbf + 2112; float* skf = sbb + 2112;
  float* skb = skf + 2112; float* sv = skb + 2112; float* sP = sv + 2112; float* sA = sP + 5120;
  const int tid = vtid();
  const int row = tid >> 4, c8 = (tid & 15) * 8;
  const size_t tok0 = (size_t)b * 4096 + n * 16;
  const size_t gidx = (tok0 + row) * 1024 + h * 128 + c8;
  {
#pragma unroll
    for (int e = 0; e < 8; ++e) {
      const int o = row * 132 + c8 + e;
      const float lf = bfget(rf, e), lb_ = bfget(rb, e);
      sq[o] = bfget(rq, e); sbf[o] = lf; sbb[o] = lb_;
      skf[o] = 1.f - __expf(lf); skb[o] = 1.f - __expf(lb_); sv[o] = bfget(rv, e);
    }
  }
  {
    const int nx = item + vgrid();
    if (nx < 8192) {
      const size_t g1 = ((size_t)(nx >> 11) * 4096 + ((nx >> 3) & 255) * 16 + row) * 1024 + (nx & 7) * 128 + c8;
      rq = *(const u32x4*)(hb.Q + g1); rf = *(const u32x4*)(hb.LFf + g1); rb = *(const u32x4*)(hb.LFb + g1); rv = *(const u32x4*)(hb.V + g1);
    }
  }
  __syncthreads();
  if (tid < 128) {
    const int d = tid; float a = 0.f;
#pragma unroll
    for (int t = 0; t < 16; ++t) { a += sbf[t * 132 + d]; sbf[t * 132 + d] = a; }
    hb.DECf[((size_t)b * 256 + n) * 1024 + h * 128 + d] = __expf(a);
  } else {
    const int d = tid - 128; float a = 0.f;
#pragma unroll
    for (int t = 15; t >= 0; --t) { a += sbb[t * 132 + d]; sbb[t * 132 + d] = a; }
    hb.DECb[((size_t)b * 256 + n) * 1024 + h * 128 + d] = __expf(a);
  }
  __syncthreads();
  {
    u32x4 of, ob;
#pragma unroll
    for (int e2 = 0; e2 < 4; ++e2) {
      const int o = row * 132 + c8 + 2 * e2;
      const float q0 = sq[o], q1 = sq[o + 1];
      of[e2] = pack2(q0 * __expf(sbf[o]), q1 * __expf(sbf[o + 1]));
      ob[e2] = pack2(q0 * __expf(sbb[o]), q1 * __expf(sbb[o + 1]));
    }
    *(u32x4*)(hb.QIf + gidx) = of; *(u32x4*)(hb.QIb + gidx) = ob;
  }
  {
    const int d = tid >> 1, t8 = (tid & 1) * 8;
    const float blf = sbf[15 * 132 + d], blb = sbb[d];
    u32x4 kf, kb, vv;
#pragma unroll
    for (int e2 = 0; e2 < 4; ++e2) {
      const int o0 = (t8 + 2 * e2) * 132 + d, o1 = o0 + 132;
      kf[e2] = pack2(skf[o0] * __expf(blf - sbf[o0]), skf[o1] * __expf(blf - sbf[o1]));
      kb[e2] = pack2(skb[o0] * __expf(blb - sbb[o0]), skb[o1] * __expf(blb - sbb[o1]));
      vv[e2] = pack2(sv[o0], sv[o1]);
    }
    const size_t cidx = (((size_t)(b * 8 + h) * 256 + n) * 128 + d) * 16 + t8;
    *(u32x4*)(hb.KITf + cidx) = kf; *(u32x4*)(hb.KITb + cidx) = kb; *(u32x4*)(hb.VTc + cidx) = vv;
  }
  {
    const int s = tid >> 4, dg = tid & 15, d0 = dg * 8, sw0 = (tid >> 6) * 4;
    float w[8];
    {
      const f32x4 a = *(const f32x4*)(skf + s * 132 + d0), b2 = *(const f32x4*)(skf + s * 132 + d0 + 4);
#pragma unroll
      for (int e = 0; e < 4; ++e) { w[e] = a[e]; w[4 + e] = b2[e]; }
    }
    float pdiag = 0.f;
    for (int t = sw0; t < 16; ++t) {
      if (t > s) {
        const f32x4 a = *(const f32x4*)(skf + t * 132 + d0), b2 = *(const f32x4*)(skf + t * 132 + d0 + 4);
#pragma unroll
        for (int e = 0; e < 4; ++e) { w[e] = fmaf(-w[e], a[e], w[e]); w[4 + e] = fmaf(-w[4 + e], b2[e], w[4 + e]); }
      }
      const f32x4 q0 = *(const f32x4*)(sq + t * 132 + d0), q1 = *(const f32x4*)(sq + t * 132 + d0 + 4);
      float part = 0.f;
#pragma unroll
      for (int e = 0; e < 4; ++e) part += q0[e] * w[e] + q1[e] * w[4 + e];
      if (t == s) pdiag = part;
      else if (t > s) sP[(t * 16 + s) * 20 + dg] = part;
    }
    {
      const f32x4 a = *(const f32x4*)(skb + s * 132 + d0), b2 = *(const f32x4*)(skb + s * 132 + d0 + 4);
#pragma unroll
      for (int e = 0; e < 4; ++e) { w[e] = a[e]; w[4 + e] = b2[e]; }
    }
    for (int t = sw0 + 3; t >= 0; --t) {
      if (t < s) {
        const f32x4 a = *(const f32x4*)(skb + t * 132 + d0), b2 = *(const f32x4*)(skb + t * 132 + d0 + 4);
#pragma unroll
        for (int e = 0; e < 4; ++e) { w[e] = fmaf(-w[e], a[e], w[e]); w[4 + e] = fmaf(-w[4 + e], b2[e], w[4 + e]); }
      }
      const f32x4 q0 = *(const f32x4*)(sq + t * 132 + d0), q1 = *(const f32x4*)(sq + t * 132 + d0 + 4);
      float part = 0.f;
#pragma unroll
      for (int e = 0; e < 4; ++e) part += q0[e] * w[e] + q1[e] * w[4 + e];
      if (t == s) sP[(s * 16 + s) * 20 + dg] = pdiag + part;
      else if (t < s) sP[(t * 16 + s) * 20 + dg] = part;
    }
  }
  __syncthreads();
  {
    const int t = tid >> 4, s = tid & 15;
    const float* pp = sP + (t * 16 + s) * 20;
    const f32x4 p0 = *(const f32x4*)pp, p1 = *(const f32x4*)(pp + 4), p2 = *(const f32x4*)(pp + 8), p3 = *(const f32x4*)(pp + 12);
    const f32x4 ps = (p0 + p1) + (p2 + p3);
    sA[t * 17 + s] = (ps[0] + ps[1]) + (ps[2] + ps[3]);
  }
  __syncthreads();
  {
    float o[8];
#pragma unroll
    for (int e = 0; e < 8; ++e) o[e] = 0.f;
#pragma unroll
    for (int s = 0; s < 16; ++s) {
      const float a = sA[row * 17 + s];
      const f32x4 v0 = *(const f32x4*)(sv + s * 132 + c8), v1 = *(const f32x4*)(sv + s * 132 + c8 + 4);
#pragma unroll
      for (int e = 0; e < 4; ++e) { o[e] += a * v0[e]; o[4 + e] += a * v1[e]; }
    }
    u32x4 r; r[0] = pack2(o[0], o[1]); r[1] = pack2(o[2], o[3]); r[2] = pack2(o[4], o[5]); r[3] = pack2(o[6], o[7]);
    *(u32x4*)(hb.OI + gidx) = r;
  }
  __syncthreads();
  }
}

constexpr int SC_NS = 6, SC_STAGE = 12288;
DI void scan_issue(char* smem, int slot, const u16* QI, const u16* KIT, const u16* VTc, const float* DEC, int b, int h, int vg, int n, int tid) {
  char* st = smem + slot * SC_STAGE + tid * 16;
  const size_t tok0 = (size_t)b * 4096 + n * 16;
  const int row = tid >> 4, lc = (tid & 15) ^ row;
  GLDS16(QI + (tok0 + row) * 1024 + h * 128 + lc * 8, st);
  const size_t cb = ((size_t)(b * 8 + h) * 256 + n) * 2048;
  GLDS16(KIT + cb + tid * 8, st + 4096);
  const float* dp = DEC + ((size_t)b * 256 + n) * 1024 + h * 128;
  const void* g3 = tid < 128 ? (const void*)(VTc + cb + vg * 1024 + tid * 8) : (const void*)(dp + ((tid - 128) & 31) * 4);
  GLDS16(g3, st + 8192);
}

struct ScanRegs { bf16x8 qa[4]; bf16x8 ka[8]; bf16x8 vb; };

DI void scan_read(ScanRegs& r, const char* st, int wid, int fr, int fq) {
#pragma unroll
  for (int ks = 0; ks < 4; ++ks) {
    const int l0 = 4 * ks + (fq >> 1), l1 = l0 + 2;
    const bf16x4 lo = *(const bf16x4*)(st + fr * 256 + ((l0 ^ fr) * 16) + (fq & 1) * 8);
    const bf16x4 hi = *(const bf16x4*)(st + fr * 256 + ((l1 ^ fr) * 16) + (fq & 1) * 8);
    r.qa[ks] = cat4(lo, hi);
  }
  r.vb = *(const bf16x8*)(st + 8192 + (wid * 16 + fr) * 32 + (fq & 1) * 16);
#pragma unroll
  for (int dt = 0; dt < 8; ++dt) r.ka[dt] = *(const bf16x8*)(st + 4096 + (dt * 16 + fr) * 32 + (fq & 1) * 16);
}

DI void scan_compute(f32x4 (&S)[8], ScanRegs& r, const f32x4 (&dc)[8], u16* op, int fq) {
  const bf16x8 z8 = {0, 0, 0, 0, 0, 0, 0, 0};
  if (fq >= 2) r.vb = z8;
  f32x4 o0 = zero4(), o1 = zero4();
  o0 = MFMA32(r.qa[0], pack8(S[0], S[1]), o0);
  o1 = MFMA32(r.qa[1], pack8(S[2], S[3]), o1);
  o0 = MFMA32(r.qa[2], pack8(S[4], S[5]), o0);
  o1 = MFMA32(r.qa[3], pack8(S[6], S[7]), o1);
#pragma unroll
  for (int dt = 0; dt < 8; ++dt) {
    if (fq >= 2) r.ka[dt] = z8;
    S[dt] = S[dt] * dc[dt];
    S[dt] = MFMA32(r.ka[dt], r.vb, S[dt]);
  }
  const f32x4 o = o0 + o1;
  const u32 w0 = pack2(o[0], o[1]), w1 = pack2(o[2], o[3]);
  asm volatile("global_store_short %0, %1, off" :: "v"(op), "v"(w0) : "memory");
  asm volatile("global_store_short_d16_hi %0, %1, off" :: "v"(op + 1024), "v"(w0) : "memory");
  asm volatile("global_store_short %0, %1, off" :: "v"(op + 2048), "v"(w1) : "memory");
  asm volatile("global_store_short_d16_hi %0, %1, off" :: "v"(op + 3072), "v"(w1) : "memory");
}

DI void hg_scan_phase(const HgBufs& hb, char* smem) {
  const int tid = vtid(), lane = tid & 63, wid = tid >> 6, fr = lane & 15, fq = lane >> 4;
  for (int item = vbid(); item < 128; item += vgrid()) {
    const int vg = item & 1, dir = (item >> 1) & 1, h = (item >> 2) & 7, b = item >> 5;
    const u16* QI = dir ? hb.QIb : hb.QIf; const u16* KIT = dir ? hb.KITb : hb.KITf;
    const float* DEC = dir ? hb.DECb : hb.DECf; u16* Oout = dir ? hb.OB : hb.OF;
    const int vs = vg * 4 + wid;
    u16* obase = Oout + ((size_t)b * 4096 + fq * 4) * 1024 + h * 128 + vs * 16 + fr;
    f32x4 S[8];
#pragma unroll
    for (int i = 0; i < 8; ++i) S[i] = zero4();
#pragma unroll
    for (int s = 0; s < SC_NS - 1; ++s) scan_issue(smem, s, QI, KIT, hb.VTc, DEC, b, h, vg, dir ? 255 - s : s, tid);
    asm volatile("s_waitcnt vmcnt(12)" ::: "memory");
    __builtin_amdgcn_s_barrier();
    asm volatile("" ::: "memory");
    ScanRegs ra, rb;
    scan_read(ra, smem, wid, fr, fq);
    int slot = 0;
#define SCAN_STEP(STEP, CUR, NXT) do { \
      const int step_ = (STEP); \
      if (step_ < 4) asm volatile("s_waitcnt vmcnt(9) lgkmcnt(0)" ::: "memory"); \
      else asm volatile("s_waitcnt vmcnt(25) lgkmcnt(0)" ::: "memory"); \
      __builtin_amdgcn_s_barrier(); \
      asm volatile("" ::: "memory"); \
      { const int ns_ = min(step_ + SC_NS - 1, 255); \
        int is_ = slot + SC_NS - 1; if (is_ >= SC_NS) is_ -= SC_NS; \
        scan_issue(smem, is_, QI, KIT, hb.VTc, DEC, b, h, vg, dir ? 255 - ns_ : ns_, tid); } \
      f32x4 dc_[8]; \
      { const char* st_ = smem + slot * SC_STAGE + 8192 + 2048 + fq * 16; \
        _Pragma("unroll") for (int dt = 0; dt < 8; ++dt) dc_[dt] = *(const f32x4*)(st_ + dt * 64); } \
      int nslot_ = slot + 1; if (nslot_ == SC_NS) nslot_ = 0; \
      if (step_ + 1 < 256) scan_read(NXT, smem + nslot_ * SC_STAGE, wid, fr, fq); \
      { const int n_ = dir ? 255 - step_ : step_; \
        scan_compute(S, CUR, dc_, obase + (size_t)n_ * 16 * 1024, fq); } \
      slot = nslot_; } while (0)
    for (int step = 0; step < 256; step += 2) {
      SCAN_STEP(step, ra, rb);
      SCAN_STEP(step + 1, rb, ra);
    }
#undef SCAN_STEP
    asm volatile("s_waitcnt vmcnt(0)" ::: "memory");
    __syncthreads();
  }
}

DI void hg_combine_phase(const HgBufs& hb, const float* __restrict__ gnorm, int rows) {
  const int lane = vtid() & 63, wid = vtid() >> 6;
  const int h = lane >> 3, c16 = (lane & 7) * 16;
  const int stride = vgrid() * 4;
  f32x4 gn[4];
#pragma unroll
  for (int i = 0; i < 4; ++i) gn[i] = *(const f32x4*)(gnorm + c16 + i * 4);
  for (int row = vbid() * 4 + wid; row < rows; row += stride * 2) {
    u32x4 ra[2][2], rf[2][2], rb[2][2], rg[2][2];
#pragma unroll
    for (int j = 0; j < 2; ++j) {
      const int rj = row + j * stride;
      if (rj < rows) {
        const size_t g = (size_t)rj * 1024 + h * 128 + c16;
#pragma unroll
        for (int half = 0; half < 2; ++half) {
          ra[j][half] = *(const u32x4*)(hb.OI + g + half * 8); rf[j][half] = *(const u32x4*)(hb.OF + g + half * 8);
          rb[j][half] = *(const u32x4*)(hb.OB + g + half * 8); rg[j][half] = *(const u32x4*)(hb.G + g + half * 8);
        }
      }
    }
#pragma unroll
    for (int j = 0; j < 2; ++j) {
      const int rj = row + j * stride;
      if (rj < rows) {
        const size_t g = (size_t)rj * 1024 + h * 128 + c16;
        float o[16]; float ss = 0.f;
#pragma unroll
        for (int half = 0; half < 2; ++half)
#pragma unroll
          for (int e = 0; e < 8; ++e) { float v = bfget(ra[j][half], e) + bfget(rf[j][half], e) + bfget(rb[j][half], e); o[half * 8 + e] = v; ss += v * v; }
        ss += sx(ss, 1); ss += sx(ss, 2); ss += sx(ss, 4);
        const float rstd = rsqrtf(ss * (1.f / 128.f) + EPS);
#pragma unroll
        for (int half = 0; half < 2; ++half) {
          u32x4 r;
#pragma unroll
          for (int e2 = 0; e2 < 4; ++e2) {
            const int e = half * 8 + 2 * e2;
            r[e2] = pack2(o[e] * rstd * gn[e >> 2][e & 3] * bfget(rg[j][half], 2 * e2), o[e + 1] * rstd * gn[(e + 1) >> 2][(e + 1) & 3] * bfget(rg[j][half], 2 * e2 + 1));
          }
          *(u32x4*)(hb.Y + g + half * 8) = r;
        }
      }
    }
  }
}

DI void na_attn_item(const u16* __restrict__ Q, const u16* __restrict__ K, const u16* __restrict__ VT, const float* __restrict__ rpb, u16* __restrict__ O, int item, int fr, int fq) {
  const int qt = item & 3, h = (item >> 2) & 15, r = (item >> 6) & 63, b = item >> 12;
  const int r0 = min(max(r - 4, 0), 56);
  const int cw0 = qt == 0 ? 0 : qt == 1 ? 8 : qt == 2 ? 24 : 32;
  const size_t tokq = (size_t)b * 4096 + r * 64 + qt * 16 + fr;
  bf16x8 qf[2];
#pragma unroll
  for (int ks = 0; ks < 2; ++ks) qf[ks] = *(const bf16x8*)(Q + tokq * 1024 + h * 64 + ks * 32 + fq * 8);
  f32x4 s[8][2];
#pragma unroll
  for (int kr = 0; kr < 8; ++kr)
#pragma unroll
    for (int hf = 0; hf < 2; ++hf) {
      const size_t tokk = (size_t)b * 4096 + (r0 + kr) * 64 + cw0 + hf * 16 + fr;
      const bf16x8 k0 = *(const bf16x8*)(K + tokk * 1024 + h * 64 + fq * 8);
      const bf16x8 k1 = *(const bf16x8*)(K + tokk * 1024 + h * 64 + 32 + fq * 8);
      f32x4 a = MFMA32(k0, qf[0], zero4());
      s[kr][hf] = MFMA32(k1, qf[1], a);
    }
  const int qc = qt * 16 + fr;
  const int cs = min(max(qc - 8, 0), 48);
  float mx = -1e30f;
#pragma unroll
  for (int kr = 0; kr < 8; ++kr) {
    const float* rp = rpb + (h * 15 + (r0 + kr - r + 7)) * 31;
#pragma unroll
    for (int hf = 0; hf < 2; ++hf)
#pragma unroll
      for (int j = 0; j < 4; ++j) {
        const int kc = cw0 + hf * 16 + fq * 4 + j;
        const bool valid = (kc >= cs) && (kc < cs + 16);
        const int ci = min(max(kc - qc + 15, 0), 30);
        const float v = valid ? s[kr][hf][j] + rp[ci] * LOG2E : -1e30f;
        s[kr][hf][j] = v; mx = fmaxf(mx, v);
      }
  }
  mx = fmaxf(mx, sx(mx, 16)); mx = fmaxf(mx, sx(mx, 32));
  float l = 0.f;
#pragma unroll
  for (int kr = 0; kr < 8; ++kr)
#pragma unroll
    for (int hf = 0; hf < 2; ++hf)
#pragma unroll
      for (int j = 0; j < 4; ++j) { const float pv = __builtin_amdgcn_exp2f(s[kr][hf][j] - mx); s[kr][hf][j] = pv; l += pv; }
  l += sx(l, 16); l += sx(l, 32);
  f32x4 o[4];
#pragma unroll
  for (int dt = 0; dt < 4; ++dt) o[dt] = zero4();
#pragma unroll
  for (int kr = 0; kr < 8; ++kr) {
    const bf16x8 pp = pack8(s[kr][0], s[kr][1]);
#pragma unroll
    for (int dt = 0; dt < 4; ++dt) {
      const u16* vp = VT + ((size_t)((b * 16 + h) * 64 + dt * 16 + fr)) * 4096 + (r0 + kr) * 64 + cw0 + fq * 4;
      const bf16x8 vf = cat4(*(const bf16x4*)vp, *(const bf16x4*)(vp + 16));
      o[dt] = MFMA32(vf, pp, o[dt]);
    }
  }
  const float inv = 1.f / l;
#pragma unroll
  for (int dt = 0; dt < 4; ++dt) *(u32x2*)(O + tokq * 1024 + h * 64 + dt * 16 + fq * 4) = pack4(o[dt] * inv);
}

DI void mla_norm_phase(const u16* __restrict__ CRAW, const float* __restrict__ gq, const float* __restrict__ gkv, u16* __restrict__ CQN, u16* __restrict__ CKVN, float* __restrict__ KROPE) {
  const int lane = vtid() & 63, wid = vtid() >> 6;
  for (int row = vbid() * 4 + wid; row < MTOK; row += vgrid() * 4) {
    const u16* c = CRAW + (size_t)row * 1056;
    f32x4 v[3]; float ss = 0.f;
#pragma unroll
    for (int i = 0; i < 3; ++i) {
      const u32x2 w = *(const u32x2*)(c + i * 256 + lane * 4);
      v[i][0] = bflo(w[0]); v[i][1] = bfhi(w[0]); v[i][2] = bflo(w[1]); v[i][3] = bfhi(w[1]);
      ss += v[i][0] * v[i][0] + v[i][1] * v[i][1] + v[i][2] * v[i][2] + v[i][3] * v[i][3];
    }
    ss = wave_sum(ss);
    const float rq = rsqrtf(ss * (1.f / 768.f) + EPS);
#pragma unroll
    for (int i = 0; i < 3; ++i) {
      const f32x4 g4 = *(const f32x4*)(gq + i * 256 + lane * 4);
      *(u32x2*)(CQN + (size_t)row * 768 + i * 256 + lane * 4) = pack4(v[i] * rq * g4);
    }
    {
      const u32x2 w = *(const u32x2*)(c + 768 + lane * 4);
      f32x4 k; k[0] = bflo(w[0]); k[1] = bfhi(w[0]); k[2] = bflo(w[1]); k[3] = bfhi(w[1]);
      float s2 = wave_sum(k[0] * k[0] + k[1] * k[1] + k[2] * k[2] + k[3] * k[3]);
      const float rk = rsqrtf(s2 * (1.f / 256.f) + EPS);
      const f32x4 g4 = *(const f32x4*)(gkv + lane * 4);
      *(u32x2*)(CKVN + (size_t)row * 256 + lane * 4) = pack4(k * rk * g4);
    }
    if (lane < 8) {
      const u32x2 w = *(const u32x2*)(c + 1024 + lane * 4);
      f32x4 k; k[0] = bflo(w[0]); k[1] = bfhi(w[0]); k[2] = bflo(w[1]); k[3] = bfhi(w[1]);
      *(f32x4*)(KROPE + (size_t)row * 32 + lane * 4) = k;
    }
  }
}

DI void mla_prep_phase(u16* __restrict__ Q, const u16* __restrict__ KVRAW, const float* __restrict__ KROPE, u16* __restrict__ Kout,
                       const float* __restrict__ gq, const float* __restrict__ gk, const float* __restrict__ RC, const float* __restrict__ RS) {
  const int lane = vtid() & 63, wid = vtid() >> 6;
  const int h = lane >> 2, sub = lane & 3;
  const float QS = 0.10206207261596577f * LOG2E;
  for (int m = vbid() * 4 + wid; m < MTOK; m += vgrid() * 4) {
    const int t = m & 4095;
    const f32x4 cs = *(const f32x4*)(RC + t * 16 + sub * 4), sn = *(const f32x4*)(RS + t * 16 + sub * 4);
#pragma unroll
    for (int which = 0; which < 2; ++which) {
      float nope[16]; f32x4 ra, rb;
      u16* dstp = (which == 0 ? Q : Kout) + (size_t)m * 1536 + h * 96;
      const float* gn = which == 0 ? gq : gk;
      if (which == 0) {
        const u32x4 w0 = *(const u32x4*)(dstp + sub * 16), w1 = *(const u32x4*)(dstp + sub * 16 + 8);
#pragma unroll
        for (int e = 0; e < 8; ++e) { nope[e] = bfget(w0, e); nope[8 + e] = bfget(w1, e); }
        const u32x2 a2 = *(const u32x2*)(dstp + 64 + sub * 4), b2 = *(const u32x2*)(dstp + 80 + sub * 4);
        ra[0] = bflo(a2[0]); ra[1] = bfhi(a2[0]); ra[2] = bflo(a2[1]); ra[3] = bfhi(a2[1]);
        rb[0] = bflo(b2[0]); rb[1] = bfhi(b2[0]); rb[2] = bflo(b2[1]); rb[3] = bfhi(b2[1]);
      } else {
        const u16* kp = KVRAW + (size_t)m * 2048 + h * 128 + sub * 16;
        const u32x4 w0 = *(const u32x4*)kp, w1 = *(const u32x4*)(kp + 8);
#pragma unroll
        for (int e = 0; e < 8; ++e) { nope[e] = bfget(w0, e); nope[8 + e] = bfget(w1, e); }
        ra = *(const f32x4*)(KROPE + (size_t)m * 32 + sub * 4);
        rb = *(const f32x4*)(KROPE + (size_t)m * 32 + 16 + sub * 4);
      }
      float ss = 0.f;
#pragma unroll
      for (int e = 0; e < 16; ++e) ss += nope[e] * nope[e];
#pragma unroll
      for (int e = 0; e < 4; ++e) ss += ra[e] * ra[e] + rb[e] * rb[e];
      ss += sx(ss, 1); ss += sx(ss, 2);
      const float rstd = rsqrtf(ss * (1.f / 96.f) + EPS) * (which == 0 ? QS : 1.f);
      u32x4 o0, o1;
#pragma unroll
      for (int e2 = 0; e2 < 4; ++e2) {
        o0[e2] = pack2(nope[2 * e2] * rstd * gn[sub * 16 + 2 * e2], nope[2 * e2 + 1] * rstd * gn[sub * 16 + 2 * e2 + 1]);
        o1[e2] = pack2(nope[8 + 2 * e2] * rstd * gn[sub * 16 + 8 + 2 * e2], nope[9 + 2 * e2] * rstd * gn[sub * 16 + 9 + 2 * e2]);
      }
      f32x4 oa, ob;
#pragma unroll
      for (int e = 0; e < 4; ++e) {
        const float a = ra[e] * rstd * gn[64 + sub * 4 + e], bq = rb[e] * rstd * gn[80 + sub * 4 + e];
        oa[e] = a * cs[e] - bq * sn[e];
        ob[e] = bq * cs[e] + a * sn[e];
      }
      *(u32x4*)(dstp + sub * 16) = o0; *(u32x4*)(dstp + sub * 16 + 8) = o1;
      *(u32x2*)(dstp + 64 + sub * 4) = pack4(oa); *(u32x2*)(dstp + 80 + sub * 4) = pack4(ob);
    }
  }
}

DI void mla_vt_phase(const u16* __restrict__ KVRAW, u16* __restrict__ VT, char* smem) {
  u16* tile = (u16*)smem;
  const int tid = vtid();
  for (int item = vbid(); item < 8192; item += vgrid()) {
    const int tt = item & 63, bh = item >> 6, b = bh >> 4, h = bh & 15;
    {
      const int row = tid >> 2, part = tid & 3;
      const u16* src = KVRAW + ((size_t)b * 4096 + tt * 64 + row) * 2048 + h * 128 + 64 + part * 16;
      const u32x4 w0 = *(const u32x4*)src, w1 = *(const u32x4*)(src + 8);
      u32* d32 = (u32*)(tile + row * 66 + part * 16);
#pragma unroll
      for (int e = 0; e < 4; ++e) { d32[e] = w0[e]; d32[4 + e] = w1[e]; }
    }
    __syncthreads();
    {
      const int d = tid >> 2, tp = (tid & 3) * 16;
      u32x4 o0, o1;
#pragma unroll
      for (int e2 = 0; e2 < 4; ++e2) {
        o0[e2] = (u32)tile[(tp + 2 * e2) * 66 + d] | ((u32)tile[(tp + 2 * e2 + 1) * 66 + d] << 16);
        o1[e2] = (u32)tile[(tp + 8 + 2 * e2) * 66 + d] | ((u32)tile[(tp + 9 + 2 * e2) * 66 + d] << 16);
      }
      u16* dst = VT + ((size_t)(bh * 64 + d)) * 4096 + tt * 64 + tp;
      *(u32x4*)dst = o0; *(u32x4*)(dst + 8) = o1;
    }
    __syncthreads();
  }
}

constexpr int FA_KROW = 208, FA_VROW = 144, FA_KT = 64 * FA_KROW, FA_BUF = FA_KT + 64 * FA_VROW;
DI void mla_attn_item(const u16* __restrict__ Q, const u16* __restrict__ Kb, const u16* __restrict__ VT, u16* __restrict__ O, int item, char* smem) {
  const int qb = item & 15, bh = item >> 4, b = bh >> 4, h = bh & 15;
  const int tid = vtid(), lane = tid & 63, wid = tid >> 6, fr = lane & 15, fq = lane >> 4;
  bf16x8 qf[4][3];
#pragma unroll
  for (int qt = 0; qt < 4; ++qt) {
    const size_t tq = (size_t)b * 4096 + qb * 256 + wid * 64 + qt * 16 + fr;
#pragma unroll
    for (int ks = 0; ks < 3; ++ks) qf[qt][ks] = *(const bf16x8*)(Q + tq * 1536 + h * 96 + ks * 32 + fq * 8);
  }
  f32x4 o[4][4];
#pragma unroll
  for (int i = 0; i < 4; ++i)
#pragma unroll
    for (int j = 0; j < 4; ++j) o[i][j] = zero4();
  float mrun[4] = {-1e30f, -1e30f, -1e30f, -1e30f}, lrun[4] = {0.f, 0.f, 0.f, 0.f};
  const u16* kg[3]; int ks_off[3];
#pragma unroll
  for (int i = 0; i < 3; ++i) {
    const int c = tid + 256 * i, row = c / 12, kc = c % 12;
    kg[i] = Kb + ((size_t)b * 4096 + row) * 1536 + h * 96 + kc * 8;
    ks_off[i] = row * FA_KROW + kc * 16;
  }
  const u16* vg[2]; int vs_off[2];
#pragma unroll
  for (int i = 0; i < 2; ++i) {
    const int c = tid + 256 * i, d = c >> 3, kc = c & 7;
    vg[i] = VT + ((size_t)(bh * 64 + d)) * 4096 + kc * 8;
    vs_off[i] = FA_KT + d * FA_VROW + kc * 16;
  }
  u32x4 rk[3], rv[2];
#pragma unroll
  for (int i = 0; i < 3; ++i) rk[i] = *(const u32x4*)(kg[i]);
#pragma unroll
  for (int i = 0; i < 2; ++i) rv[i] = *(const u32x4*)(vg[i]);
#pragma unroll
  for (int i = 0; i < 3; ++i) *(u32x4*)(smem + ks_off[i]) = rk[i];
#pragma unroll
  for (int i = 0; i < 2; ++i) *(u32x4*)(smem + vs_off[i]) = rv[i];
#pragma unroll
  for (int qt = 0; qt < 4; ++qt)
#pragma unroll
    for (int ks = 0; ks < 3; ++ks) asm volatile("" :: "v"(qf[qt][ks]));
  __syncthreads();
  for (int kt = 0; kt < 64; ++kt) {
    const int cur = (kt & 1) * FA_BUF, nxt = FA_BUF - cur;
    if (kt + 1 < 64) {
      const size_t key0 = (size_t)(kt + 1) * 64;
#pragma unroll
      for (int i = 0; i < 3; ++i) rk[i] = *(const u32x4*)(kg[i] + key0 * 1536);
#pragma unroll
      for (int i = 0; i < 2; ++i) rv[i] = *(const u32x4*)(vg[i] + key0);
    }
#pragma unroll
    for (int kh = 0; kh < 2; ++kh) {
      f32x4 s[2][4];
#pragma unroll
      for (int kl = 0; kl < 2; ++kl) {
#pragma unroll
        for (int qt = 0; qt < 4; ++qt) s[kl][qt] = zero4();
#pragma unroll
        for (int ks = 0; ks < 3; ++ks) {
          const bf16x8 kf = *(const bf16x8*)(smem + cur + ((kh * 2 + kl) * 16 + fr) * FA_KROW + ks * 64 + fq * 16);
#pragma unroll
          for (int qt = 0; qt < 4; ++qt) s[kl][qt] = MFMA32(kf, qf[qt][ks], s[kl][qt]);
        }
      }
      bf16x8 pp[4];
      {
        float lm[4]; bool need = false;
#pragma unroll
        for (int qt = 0; qt < 4; ++qt) {
          const float m0 = fmaxf(fmaxf(s[0][qt][0], s[0][qt][1]), fmaxf(s[0][qt][2], s[0][qt][3]));
          const float m1 = fmaxf(fmaxf(s[1][qt][0], s[1][qt][1]), fmaxf(s[1][qt][2], s[1][qt][3]));
          lm[qt] = fmaxf(m0, m1);
          need = need || (lm[qt] > mrun[qt] + 8.f);
        }
        if (__any(need)) {
#pragma unroll
          for (int qt = 0; qt < 4; ++qt) {
            float mx = lm[qt];
            mx = fmaxf(mx, sx(mx, 16)); mx = fmaxf(mx, sx(mx, 32));
            const float mnew = fmaxf(mrun[qt], mx);
            const float alpha = __builtin_amdgcn_exp2f(mrun[qt] - mnew);
            mrun[qt] = mnew;
            lrun[qt] *= alpha;
#pragma unroll
            for (int dt = 0; dt < 4; ++dt) o[dt][qt] = o[dt][qt] * alpha;
          }
        }
#pragma unroll
        for (int qt = 0; qt < 4; ++qt) {
          const float mr = mrun[qt];
          float ps = 0.f;
#pragma unroll
          for (int kl = 0; kl < 2; ++kl)
#pragma unroll
            for (int j = 0; j < 4; ++j) { const float pv = __builtin_amdgcn_exp2f(s[kl][qt][j] - mr); s[kl][qt][j] = pv; ps += pv; }
          lrun[qt] += ps;
          pp[qt] = pack8(s[0][qt], s[1][qt]);
        }
      }
#pragma unroll
      for (int dt = 0; dt < 4; ++dt) {
        const char* vp = smem + cur + FA_KT + (dt * 16 + fr) * FA_VROW + (kh * 32 + fq * 4) * 2;
        const bf16x8 vf = cat4(*(const bf16x4*)vp, *(const bf16x4*)(vp + 32));
#pragma unroll
        for (int qt = 0; qt < 4; ++qt) o[dt][qt] = MFMA32(vf, pp[qt], o[dt][qt]);
      }
    }
    if (kt + 1 < 64) {
#pragma unroll
      for (int i = 0; i < 3; ++i) *(u32x4*)(smem + nxt + ks_off[i]) = rk[i];
#pragma unroll
      for (int i = 0; i < 2; ++i) *(u32x4*)(smem + nxt + vs_off[i]) = rv[i];
    }
    __syncthreads();
  }
#pragma unroll
  for (int qt = 0; qt < 4; ++qt) {
    float l = lrun[qt];
    l += sx(l, 16); l += sx(l, 32);
    const float inv = 1.f / l;
    const size_t tq = (size_t)b * 4096 + qb * 256 + wid * 64 + qt * 16 + fr;
#pragma unroll
    for (int dt = 0; dt < 4; ++dt) *(u32x2*)(O + tq * 1024 + h * 64 + dt * 16 + fq * 4) = pack4(o[dt][qt] * inv);
  }
}

#define XB_TMO      128
#define XB_XCNT(j)  (256  + 64 * (j))
#define XB_XSUB(j)  (1280 + 64 * (j))
#define XB_XGEN(j)  (2304 + 64 * (j))
#define XB_TOP      3328
#define XB_TOPGEN   3392
#define XCD_BAR_WORDS 3456
#define XB_SPIN_CAP (1u << 22)
DI unsigned xb_ld(unsigned* p) { return __hip_atomic_load(p, __ATOMIC_RELAXED, __HIP_MEMORY_SCOPE_AGENT); }
DI unsigned xb_add(unsigned* p, unsigned v) { return __hip_atomic_fetch_add(p, v, __ATOMIC_RELAXED, __HIP_MEMORY_SCOPE_AGENT); }
DI unsigned xb_xcc_id() { return (unsigned)__builtin_amdgcn_s_getreg((3 << 11) | 20) & 0xFu; }
#define XB_SPIN(cond, bar) do { unsigned _sp = 0; while (cond) { __builtin_amdgcn_s_sleep(1); \
    if ((++_sp & 255u) == 0u) { if (xb_ld(&(bar)[XB_TMO])) break; if (_sp > XB_SPIN_CAP) { atomicAdd(&(bar)[XB_TMO], 1u); break; } } } } while (0)

DI void xcd_barrier_complete(unsigned* bar, unsigned x, unsigned& nloc, unsigned& nx) {
  const unsigned G = gridDim.x;
  unsigned sum, cnt, mine, sp = 0u;
  for (;;) {
    sum = 0u; cnt = 0u; mine = 0u;
#pragma unroll
    for (unsigned j = 0; j < 16; ++j) { const unsigned c = xb_ld(&bar[XB_XCNT(j)]); sum += c; cnt += (c > 0u) ? 1u : 0u; mine = (j == x) ? c : mine; }
    if (sum == G) break;
    __builtin_amdgcn_s_sleep(1);
    if ((++sp & 255u) == 0u) { if (xb_ld(&bar[XB_TMO])) break; if (sp > XB_SPIN_CAP) { atomicAdd(&bar[XB_TMO], 1u); break; } }
  }
  nloc = mine > 0u ? mine : 1u; nx = cnt > 0u ? cnt : 1u;
}

DI void xcd_barrier(unsigned* bar, char* smem_) {
  int off_ = 147456; asm volatile("" : "+v"(off_));
  volatile unsigned* st = (volatile unsigned*)(smem_ + off_);
  asm volatile("s_waitcnt vmcnt(0)" ::: "memory");
  __syncthreads();
  if (threadIdx.x == 0) {
    __builtin_amdgcn_s_waitcnt(0);
    const unsigned x = xb_xcc_id();
    unsigned nloc = st[0], nx = st[1];
    if (nloc == 0u) { xcd_barrier_complete(bar, x, nloc, nx); st[0] = nloc; st[1] = nx; }
    const unsigned old = xb_add(&bar[XB_XSUB(x)], 1u);
    const unsigned gen = old / nloc;
    if (old + 1u == (gen + 1u) * nloc) {
      __builtin_amdgcn_fence(__ATOMIC_RELEASE, "agent");
      asm volatile("s_waitcnt vmcnt(0)" ::: "memory");
      const unsigned og = xb_add(&bar[XB_TOP], 1u);
      const unsigned tg = og / nx;
      if (og + 1u == (tg + 1u) * nx) xb_add(&bar[XB_TOPGEN], 1u);
      else XB_SPIN(xb_ld(&bar[XB_TOPGEN]) == tg, bar);
      __builtin_amdgcn_fence(__ATOMIC_ACQUIRE, "agent");
      xb_add(&bar[XB_XGEN(x)], 1u);
      asm volatile("s_waitcnt vmcnt(0)" ::: "memory");
    } else {
      XB_SPIN(xb_ld(&bar[XB_XGEN(x)]) == gen, bar);
      __builtin_amdgcn_fence(__ATOMIC_ACQUIRE, "agent");
      asm volatile("s_waitcnt vmcnt(0)" ::: "memory");
    }
  }
  __syncthreads();
}

#ifndef ENMASK
#define ENMASK 0xffffffffu
#endif
#define EN(i) ((ENMASK >> (i)) & 1u)
#ifndef DUPMASK
#define DUPMASK 0u
#endif
#define DUP(i) ((DUPMASK >> (i)) & 1u)
#ifndef BAR2
#define BAR2 0
#endif
#define PHASE_BEGIN(i) if (EN(i) && pc >= p.lo && pc < p.hi) for (int rep_ = 0; rep_ < 1 + (int)DUP(i); ++rep_) {
#define PHASE_END } { if (pc >= p.lo && pc + 1 < p.hi) { if (pc == p.lo) grid.sync(); else { xcd_barrier(bar, smem); if (BAR2) xcd_barrier(bar, smem); } } ++pc; }

__global__ void __launch_bounds__(512) mega(Params p) {
  __shared__ __attribute__((aligned(16))) char smem[147456 + 16];
  cg::grid_group grid = cg::this_grid();
  int pc = 0;
  unsigned* bar = (unsigned*)(p.ws + OFF_BAR);
  volatile unsigned* st = (volatile unsigned*)(smem + 147456);
  if (threadIdx.x == 0) { st[0] = 0u; st[1] = 0u; (void)xb_add(&bar[XB_XCNT(xb_xcc_id())], 1u); }
  __syncthreads();
  for (int layer = 0; layer < 4; ++layer) {
    const int kind = layer % 3, mi = layer / 3;
    for (int stage = 0; stage < 3; ++stage) {
      char* ws = p.ws; asm volatile("" : "+s"(ws));
      u16* H = (u16*)(ws + OFF_H);
      char* R = ws + OFF_R;
      const float* LB = (const float*)(ws + OFF_TAB);
      const float* RC = LB + 4096; const float* RS = RC + 65536;
      if (stage != 1) {
        const float* ng = (stage == 0 ? p.ffn1_norm : p.ffn2_norm) + layer * 1024;
        const u16* wgu = (const u16*)(ws + (stage == 0 ? OFF_WGU1 : OFF_WGU2));
        const u16* wdn = (const u16*)(ws + (stage == 0 ? OFF_WDN1 : OFF_WDN2));
        u16* ACT = (u16*)R;
        PHASE_BEGIN(0)
          const bool first = (layer == 0 && stage == 0);
          if (stage == 0) { if (layer == 0) init_tables(p); cvt_layer(p, layer, (smem + (otid() >> 8) * 73728)); }
          norm_phase(first ? p.x : p.X, ng, H, first ? p.X : nullptr, MTOK);
        PHASE_END
        PHASE_BEGIN(1)
          gemm_phase(H, 1024, wgu, 1024, MTOK, 5632, EpiSwiglu{ACT}, smem);
        PHASE_END
        PHASE_BEGIN(2)
          gemm_phase(ACT, 2816, wdn, 2816, MTOK, 1024, EpiResid{p.X, 0.5f}, smem);
        PHASE_END
      } else {
        PHASE_BEGIN(3)
          norm_phase(p.X, p.mix_norm + layer * 1024, H, nullptr, MTOK);
        PHASE_END
        if (kind == 0) {
          constexpr size_t SZ = 32 * MiB;
          HgBufs hb;
          hb.Q = (u16*)(R + 0 * SZ); hb.LFf = (u16*)(R + 1 * SZ); hb.LFb = (u16*)(R + 2 * SZ); hb.V = (u16*)(R + 3 * SZ); hb.G = (u16*)(R + 4 * SZ);
          hb.QIf = (u16*)(R + 5 * SZ); hb.QIb = (u16*)(R + 6 * SZ); hb.KITf = (u16*)(R + 7 * SZ); hb.KITb = (u16*)(R + 8 * SZ);
          hb.VTc = (u16*)(R + 9 * SZ); hb.OI = (u16*)(R + 10 * SZ); hb.OF = hb.Q; hb.OB = hb.LFf; hb.Y = hb.LFb;
          hb.DECf = (float*)(R + 11 * SZ); hb.DECb = (float*)(R + 11 * SZ + 4 * MiB);
          const u16* w_in = (const u16*)(ws + OFF_WMIX); const u16* w_out = (const u16*)(ws + OFF_WMIX + 10485760);
          for (int half = 0; half < 2; ++half) {
            PHASE_BEGIN(4)
              gemm_phase(H + (size_t)half * 16384 * 1024, 1024, w_in, 1024, 16384, 5120, EpiHgIn{hb.Q, hb.LFf, hb.LFb, hb.V, hb.G, LB + layer * 1024}, smem);
            PHASE_END
            PHASE_BEGIN(5)
              hg_prep_phase(hb, (smem + (otid() >> 8) * 73728));
            PHASE_END
            PHASE_BEGIN(6)
              hg_scan_phase(hb, (smem + (otid() >> 8) * 73728));
            PHASE_END
            PHASE_BEGIN(7)
              hg_combine_phase(hb, p.hg_g_norm + mi * 128, 16384);
            PHASE_END
            PHASE_BEGIN(8)
              gemm_phase(hb.Y, 1024, w_out, 1024, 16384, 1024, EpiResid{p.X + (size_t)half * 16384 * 1024, 1.0f}, smem);
            PHASE_END
          }
        } else if (kind == 1) {
          u16* Qn = (u16*)R; u16* Kn = (u16*)(R + 64 * MiB); u16* VT = (u16*)(R + 128 * MiB); u16* On = (u16*)(R + 192 * MiB);
          const u16* w_in = (const u16*)(ws + OFF_WMIX); const u16* w_out = (const u16*)(ws + OFF_WMIX + 6291456);
          PHASE_BEGIN(9)
            gemm_phase(H, 1024, w_in, 1024, MTOK, 3072, EpiNaIn{Qn, Kn, VT, p.na_q_norm + mi * 64, p.na_k_norm + mi * 64}, smem);
          PHASE_END
          PHASE_BEGIN(10)
            const int tid_ = vtid(), lane = tid_ & 63, wid = tid_ >> 6, fr = lane & 15, fq = lane >> 4;
            for (int item = vbid() * 4 + wid; item < 32768; item += vgrid() * 4)
              na_attn_item(Qn, Kn, VT, p.na_rpb + (size_t)mi * 16 * 15 * 31, On, item, fr, fq);
          PHASE_END
          PHASE_BEGIN(11)
            gemm_phase(On, 1024, w_out, 1024, MTOK, 1024, EpiResid{p.X, 1.0f}, smem);
          PHASE_END
        } else {
          u16* VT = H;
          u16* CRAW = (u16*)R; u16* On = (u16*)R;
          u16* CQN = (u16*)(R + 66 * MiB); u16* CKVN = (u16*)(R + 114 * MiB); u16* Kk = (u16*)(R + 66 * MiB);
          float* KROPE = (float*)(R + 162 * MiB);
          u16* Qq = (u16*)(R + 166 * MiB); u16* KVRAW = (u16*)(R + 262 * MiB);
          const u16* w_in = (const u16*)(ws + OFF_WMIX); const u16* w_uq = (const u16*)(ws + OFF_WMIX + 2621440);
          const u16* w_ukv = (const u16*)(ws + OFF_WMIX + 4980736); const u16* w_out = (const u16*)(ws + OFF_WMIX + 6029312);
          PHASE_BEGIN(12)
            gemm_phase(H, 1024, w_in, 1024, MTOK, 1280, EpiStore{CRAW, 1056, 1056}, smem);
          PHASE_END
          PHASE_BEGIN(13)
            mla_norm_phase(CRAW, p.mla_q_a_norm + mi * 768, p.mla_kv_a_norm + mi * 256, CQN, CKVN, KROPE);
          PHASE_END
          PHASE_BEGIN(14)
            gemm_phase(CQN, 768, w_uq, 768, MTOK, 1536, EpiStore{Qq, 1536, 1536}, smem);
          PHASE_END
          PHASE_BEGIN(18)
            gemm_phase(CKVN, 256, w_ukv, 256, MTOK, 2048, EpiStore{KVRAW, 2048, 2048}, smem);
          PHASE_END
          PHASE_BEGIN(15)
            mla_prep_phase(Qq, KVRAW, KROPE, Kk, p.mla_q_norm + mi * 96, p.mla_k_norm + mi * 96, RC, RS);
            mla_vt_phase(KVRAW, VT, (smem + (otid() >> 8) * 73728));
          PHASE_END
          PHASE_BEGIN(16)
            for (int item = vbid(); item < 2048; item += vgrid()) mla_attn_item(Qq, Kk, VT, On, item, (smem + (otid() >> 8) * 73728));
          PHASE_END
          PHASE_BEGIN(17)
            gemm_phase(On, 1024, w_out, 1024, MTOK, 1024, EpiResid{p.X, 1.0f}, smem);
          PHASE_END
        }
      }
    }
  }
}

static int count_phases() {
  int n = 0;
  for (int layer = 0; layer < 4; ++layer) {
    int kind = layer % 3;
    n += 3 + 3 + 1;
    n += kind == 0 ? 10 : kind == 1 ? 3 : 7;
  }
  return n;
}

extern "C" void kernel_launch(void* const* d_in, const int* in_sizes, int n_in, void* d_out, int out_size, void* d_ws, size_t ws_size, hipStream_t stream) {
  if (ws_size < WS_NEED) { fprintf(stderr, "workspace too small: %zu < %zu\n", ws_size, WS_NEED); return; }
  static int grid_blocks = 0;
  if (!grid_blocks) {
    int dev = 0, cus = 0, per_cu = 0;
    hipGetDevice(&dev);
    hipDeviceGetAttribute(&cus, hipDeviceAttributeMultiprocessorCount, dev);
    hipOccupancyMaxActiveBlocksPerMultiprocessor(&per_cu, mega, 512, 0);
    if (per_cu > 1) per_cu = 1;
    grid_blocks = cus * per_cu;
  }
  Params p{};
  const float** pf = (const float**)&p;
  for (int i = 0; i < 25; ++i) pf[i] = (const float*)d_in[i];
  p.X = (float*)d_out; p.ws = (char*)d_ws;
  const int total = count_phases();
#if MULTI_LAUNCH
  for (int ph = 0; ph < total; ++ph) {
    p.lo = ph; p.hi = ph + 1;
    hipLaunchKernelGGL(mega, dim3(grid_blocks), dim3(512), 0, stream, p);
  }
#else
  hipMemsetAsync((char*)d_ws + OFF_BAR, 0, 16384, stream);
  p.lo = 0; p.hi = total;
  void* args[] = {&p};
  hipError_t e = hipLaunchCooperativeKernel((void*)mega, dim3(grid_blocks), dim3(512), args, 0, stream);
  if (e != hipSuccess) fprintf(stderr, "cooperative launch failed: %s (grid %d)\n", hipGetErrorString(e), grid_blocks);
#endif
}
```

```cpp
#include <hip/hip_runtime.h>
#include <hip/hip_cooperative_groups.h>
#include <cstdio>
#include <cstdint>
namespace cg = cooperative_groups;

#ifndef MULTI_LAUNCH
#define MULTI_LAUNCH 0
#endif

typedef unsigned short u16;
typedef unsigned int u32;
using bf16x8 = __attribute__((ext_vector_type(8))) short;
using bf16x4 = __attribute__((ext_vector_type(4))) short;
using f32x4 = __attribute__((ext_vector_type(4))) float;
using u32x2 = __attribute__((ext_vector_type(2))) unsigned int;
using u32x4 = __attribute__((ext_vector_type(4))) unsigned int;

#define DI __device__ __forceinline__
#define MFMA32(a, b, c) __builtin_amdgcn_mfma_f32_16x16x32_bf16((a), (b), (c), 0, 0, 0)

constexpr int MTOK = 32768;
constexpr float EPS = 1e-6f;
constexpr float LOG2E = 1.4426950408889634f;

constexpr size_t MiB = 1048576;
constexpr size_t OFF_WGU1 = 0;
constexpr size_t OFF_WDN1 = 11534336;
constexpr size_t OFF_WGU2 = 17301504;
constexpr size_t OFF_WDN2 = 28835840;
constexpr size_t OFF_WMIX = 34603008;
constexpr size_t OFF_TAB = 47185920;
constexpr size_t OFF_BAR = OFF_TAB + 786432;
constexpr size_t OFF_H = 46 * MiB;
constexpr size_t OFF_R = 110 * MiB;
constexpr size_t WS_NEED = 500 * MiB;

struct Params {
  const float* x; const float* ffn1_norm; const float* ffn1_w_gu; const float* ffn1_w_down;
  const float* mix_norm; const float* ffn2_norm; const float* ffn2_w_gu; const float* ffn2_w_down;
  const float* hg_lb_logits; const float* hg_w_in; const float* hg_g_norm; const float* hg_w_out;
  const float* na_w_in; const float* na_q_norm; const float* na_k_norm; const float* na_rpb; const float* na_w_out;
  const float* mla_w_in; const float* mla_q_a_norm; const float* mla_w_uq; const float* mla_kv_a_norm; const float* mla_w_ukv;
  const float* mla_q_norm; const float* mla_k_norm; const float* mla_w_out;
  float* X; char* ws; int lo; int hi;
};

DI u32 f2bf(float x) { u32 u = __float_as_uint(x); u += 0x7fffu + ((u >> 16) & 1u); return u >> 16; }
typedef __bf16 bf16v2 __attribute__((ext_vector_type(2)));
typedef float f32v2 __attribute__((ext_vector_type(2)));
DI u32 pack2(float a, float b) { f32v2 v = {a, b}; bf16v2 r = __builtin_convertvector(v, bf16v2); return __builtin_bit_cast(u32, r); }
DI float bflo(u32 w) { return __uint_as_float(w << 16); }
DI float bfhi(u32 w) { return __uint_as_float(w & 0xffff0000u); }
DI float bfget(const u32x4& v, int e) { u32 w = v[e >> 1]; return (e & 1) ? bfhi(w) : bflo(w); }
DI u32x2 pack4(const f32x4& v) { u32x2 r; r[0] = pack2(v[0], v[1]); r[1] = pack2(v[2], v[3]); return r; }
DI bf16x8 pack8(const f32x4& a, const f32x4& b) {
  u32x4 r; r[0] = pack2(a[0], a[1]); r[1] = pack2(a[2], a[3]); r[2] = pack2(b[0], b[1]); r[3] = pack2(b[2], b[3]);
  return __builtin_bit_cast(bf16x8, r);
}
DI bf16x8 cat4(const bf16x4& lo, const bf16x4& hi) { return __builtin_shufflevector(lo, hi, 0, 1, 2, 3, 4, 5, 6, 7); }
DI int otid() { int t = threadIdx.x; asm volatile("" : "+v"(t)); return t; }
DI float sx(float v, int k) {
  const int l = otid() & 63;
  return __int_as_float(__builtin_amdgcn_ds_bpermute((l ^ k) << 2, __float_as_int(v)));
}
DI float wave_sum(float v) {
#pragma unroll
  for (int o = 32; o > 0; o >>= 1) v += sx(v, o);
  return v;
}
DI float sigmoidf_(float z) { return __builtin_amdgcn_rcpf(1.f + __expf(-z)); }
DI float siluf_(float z) { return z * __builtin_amdgcn_rcpf(1.f + __expf(-z)); }
DI int vtid() { return otid() & 255; }
DI int vbid() { return blockIdx.x * 2 + (otid() >> 8); }
DI int vgrid() { return gridDim.x * 2; }
DI f32x4 zero4() { f32x4 z = {0.f, 0.f, 0.f, 0.f}; return z; }

DI void init_tables(const Params& p) {
  float* LB = (float*)(p.ws + OFF_TAB); float* RC = LB + 4096; float* RS = RC + 65536;
  const int gt = vbid() * 256 + vtid(), gs = vgrid() * 256;
  for (int c = gt; c < 1024; c += gs) {
    float l0 = p.hg_lb_logits[c], l1 = p.hg_lb_logits[1024 + c], l2 = p.hg_lb_logits[2048 + c], l3 = p.hg_lb_logits[3072 + c];
    float mx = fmaxf(fmaxf(l0, l1), fmaxf(l2, l3));
    float e0 = expf(l0 - mx), e1 = expf(l1 - mx), e2 = expf(l2 - mx), e3 = expf(l3 - mx);
    float inv = 1.f / (e0 + e1 + e2 + e3);
    LB[c] = 0.f; LB[1024 + c] = e1 * inv; LB[2048 + c] = (e1 + e2) * inv; LB[3072 + c] = (e1 + e2 + e3) * inv;
  }
  for (int i = gt; i < 65536; i += gs) {
    int t = i >> 4, j = i & 15;
    float inv = exp2f(-(float)j * (13.287712379549449f / 16.f));
    float ang = (float)t * inv;
    double a = (double)ang;
    double k = rint(a * 0.15915494309189535);
    float r = (float)(a - k * 6.283185307179586);
    RC[i] = __cosf(r); RS[i] = __sinf(r);
  }
}

DI void cvt_tiles(const float* __restrict__ src, u16* __restrict__ dst, int K, int N, int Nd, int mode, char* smem) {
  float* tile = (float*)smem;
  const int tk = K >> 6, tn = Nd >> 6, tid = vtid();
  for (int t = vbid(); t < tk * tn; t += vgrid()) {
    const int k0 = (t % tk) << 6, n0 = (t / tk) << 6;
    {
      const int nl = tid & 63, kq = tid >> 6;
      const int nd = n0 + nl;
      int col = nd;
      if (mode == 1) { int a = nd >> 5, r = nd & 31; col = a * 16 + (r & 15) + ((r >= 16) ? 2816 : 0); }
      const bool ok = col < N;
#pragma unroll
      for (int i = 0; i < 16; ++i) {
        int kl = kq + 4 * i;
        tile[kl * 65 + nl] = ok ? src[(size_t)(k0 + kl) * N + col] : 0.f;
      }
    }
    __syncthreads();
    {
      const int kp = (tid & 31) * 2, nq = tid >> 5;
#pragma unroll
      for (int i = 0; i < 8; ++i) {
        int n = nq + 8 * i;
        *(u32*)(dst + (size_t)(n0 + n) * K + k0 + kp) = pack2(tile[kp * 65 + n], tile[(kp + 1) * 65 + n]);
      }
    }
    __syncthreads();
  }
}

DI void cvt_layer(const Params& p, int layer, char* smem) {
  const int kind = layer % 3, mi = layer / 3;
  char* ws = p.ws;
  for (int task = 0; task < 8; ++task) {
    const float* src = nullptr; size_t off = 0; int K = 0, N = 0, Nd = 0, mode = 0;
    if (task == 0) { src = p.ffn1_w_gu + (size_t)layer * 1024 * 5632; off = OFF_WGU1; K = 1024; N = 5632; Nd = 5632; mode = 1; }
    else if (task == 1) { src = p.ffn1_w_down + (size_t)layer * 2816 * 1024; off = OFF_WDN1; K = 2816; N = 1024; Nd = 1024; }
    else if (task == 2) { src = p.ffn2_w_gu + (size_t)layer * 1024 * 5632; off = OFF_WGU2; K = 1024; N = 5632; Nd = 5632; mode = 1; }
    else if (task == 3) { src = p.ffn2_w_down + (size_t)layer * 2816 * 1024; off = OFF_WDN2; K = 2816; N = 1024; Nd = 1024; }
    else if (kind == 0) {
      if (task == 4) { src = p.hg_w_in + (size_t)mi * 1024 * 5120; off = OFF_WMIX; K = 1024; N = 5120; Nd = 5120; }
      else if (task == 5) { src = p.hg_w_out + (size_t)mi * 1024 * 1024; off = OFF_WMIX + 10485760; K = 1024; N = 1024; Nd = 1024; }
    } else if (kind == 1) {
      if (task == 4) { src = p.na_w_in + (size_t)mi * 1024 * 3072; off = OFF_WMIX; K = 1024; N = 3072; Nd = 3072; }
      else if (task == 5) { src = p.na_w_out + (size_t)mi * 1024 * 1024; off = OFF_WMIX + 6291456; K = 1024; N = 1024; Nd = 1024; }
    } else {
      if (task == 4) { src = p.mla_w_in + (size_t)mi * 1024 * 1056; off = OFF_WMIX; K = 1024; N = 1056; Nd = 1280; }
      else if (task == 5) { src = p.mla_w_uq + (size_t)mi * 768 * 1536; off = OFF_WMIX + 2621440; K = 768; N = 1536; Nd = 1536; }
      else if (task == 6) { src = p.mla_w_ukv + (size_t)mi * 256 * 2048; off = OFF_WMIX + 4980736; K = 256; N = 2048; Nd = 2048; }
      else if (task == 7) { src = p.mla_w_out + (size_t)mi * 1024 * 1024; off = OFF_WMIX + 6029312; K = 1024; N = 1024; Nd = 1024; }
    }
    if (src) cvt_tiles(src, (u16*)(ws + off), K, N, Nd, mode, smem);
  }
}

DI void norm_phase(const float* __restrict__ src, const float* __restrict__ gain, u16* __restrict__ dst, float* copy_dst, int rows) {
  const int lane = vtid() & 63, wid = vtid() >> 6;
  f32x4 g[4];
#pragma unroll
  for (int i = 0; i < 4; ++i) g[i] = *(const f32x4*)(gain + i * 256 + lane * 4);
  const int stride = vgrid() * 4;
  for (int row = vbid() * 4 + wid; row < rows; row += stride * 4) {
    f32x4 v[4][4];
#pragma unroll
    for (int j = 0; j < 4; ++j) {
      const int rj = row + j * stride;
      if (rj < rows) {
#pragma unroll
        for (int i = 0; i < 4; ++i) v[j][i] = *(const f32x4*)(src + (size_t)rj * 1024 + i * 256 + lane * 4);
      }
    }
#pragma unroll
    for (int j = 0; j < 4; ++j) {
      const int rj = row + j * stride;
      if (rj < rows) {
        float ss = 0.f;
#pragma unroll
        for (int i = 0; i < 4; ++i) ss += v[j][i][0] * v[j][i][0] + v[j][i][1] * v[j][i][1] + v[j][i][2] * v[j][i][2] + v[j][i][3] * v[j][i][3];
        ss = wave_sum(ss);
        const float rstd = rsqrtf(ss * (1.f / 1024.f) + EPS);
#pragma unroll
        for (int i = 0; i < 4; ++i) {
          f32x4 y = v[j][i] * rstd * g[i];
          *(u32x2*)(dst + (size_t)rj * 1024 + i * 256 + lane * 4) = pack4(y);
          if (copy_dst) *(f32x4*)(copy_dst + (size_t)rj * 1024 + i * 256 + lane * 4) = v[j][i];
        }
      }
    }
  }
}

#define GLDS16(gp, lp) __builtin_amdgcn_global_load_lds((const unsigned*)(gp), (unsigned*)(lp), 16, 0, 0)

constexpr int G_MT = 2;
constexpr int HTB = 16384;

DI const char* uniform_ptr(const void* p) {
  const unsigned long long v = (unsigned long long)p;
  const unsigned lo = __builtin_amdgcn_readfirstlane((unsigned)v), hi = __builtin_amdgcn_readfirstlane((unsigned)(v >> 32));
  return (const char*)(((unsigned long long)hi << 32) | lo);
}
DI void glds_sv(const char* sbase, unsigned voff, unsigned ldsaddr) {
  unsigned keep;
  asm volatile("s_mov_b32 %0, m0\n\ts_mov_b32 m0, %3\n\ts_nop 0\n\tglobal_load_lds_dwordx4 %1, %2\n\ts_mov_b32 m0, %0"
               : "=&s"(keep) : "v"(voff), "s"(sbase), "s"(ldsaddr) : "memory");
}
DI int lds_byte(int r, int c) {
  const int st = (r >> 4) * 2 + (c >> 5), rr = r & 15, cc = c & 31, ob = rr * 64 + cc * 2;
  return st * 1024 + (ob ^ (((ob >> 9) & 1) << 5));
}
DI void stage_rc(int b, int& R, int& C) {
  const int st = b / 1024, sb = b % 1024, swz = sb ^ (((sb >> 9) & 1) << 5);
  R = (st >> 1) * 16 + swz / 64; C = (st & 1) * 32 + (swz % 64) / 2;
}

template <class Epi>
DI void gemm_phase(const u16* __restrict__ Act, int lda, const u16* __restrict__ Wt, int Kc, int Mrows, int Ncols, const Epi& epi, char* smem) {
  int K = Kc; asm volatile("" : "+s"(K));
  const int mtn = Mrows >> 8, ntn = Ncols >> 8;
  const int ntiles = mtn * ntn;
  constexpr int GM = 16;
  const int tid = otid(), lane = tid & 63, wid = tid >> 6;
  const int wr = wid >> 2, wc = wid & 3, fr = lane & 15, fq = lane >> 4;
  int R0, C0;
  stage_rc(tid * 16, R0, C0);
  const unsigned vo0 = (unsigned)(R0 * K + C0) * 2u;
  const unsigned sl = (unsigned)(size_t)(__attribute__((address_space(3))) char*)smem + __builtin_amdgcn_readfirstlane(tid >> 6) * 1024;
  const int nt = K >> 6;
#define SA_(b, h) (((b) * 2 + (h)) * HTB)
#define SB_(b, h) ((4 + (b) * 2 + (h)) * HTB)
#define STAGE_(POFF, BASE, br, kt) do { const char* ub_ = uniform_ptr((const char*)(BASE) + ((size_t)(br) * K + (size_t)(kt) * 64) * 2); \
    glds_sv(ub_, vo0, sl + (POFF)); glds_sv(ub_ + (size_t)K * 128, vo0, sl + (POFF) + 8192); } while (0)
  const char* la_rd = smem + (((fr * 64 + fq * 16) ^ ((fr >> 3) << 5)) + wr * 8192);
  const char* lb_rd = smem + (((fr * 64 + fq * 16) ^ ((fr >> 3) << 5)) + wc * 4096 + 65536);
#define LDA_(dst, b, h) do { _Pragma("unroll") for (int m = 0; m < 4; ++m) _Pragma("unroll") for (int k = 0; k < 2; ++k) \
    dst[m][k] = *(const bf16x8*)(la_rd + SA_(b, h) + (m * 2 + k) * 1024); } while (0)
#define LDB_(dst, b, h) do { _Pragma("unroll") for (int n = 0; n < 2; ++n) _Pragma("unroll") for (int k = 0; k < 2; ++k) \
    dst[n][k] = *(const bf16x8*)(lb_rd + SA_(b, h) + (n * 2 + k) * 1024); } while (0)
#define MMA_(ai, bj, At, Bt) do { __builtin_amdgcn_s_setprio(1); \
    _Pragma("unroll") for (int m = 0; m < 4; ++m) _Pragma("unroll") for (int n = 0; n < 2; ++n) _Pragma("unroll") for (int k = 0; k < 2; ++k) \
      acc[ai][bj][m][n] = MFMA32(At[m][k], Bt[n][k], acc[ai][bj][m][n]); \
    __builtin_amdgcn_s_setprio(0); } while (0)
#define WAIT_V(n) asm volatile("s_waitcnt vmcnt(" #n ")" ::: "memory")
#define WAIT_L(n) asm volatile("s_waitcnt lgkmcnt(" #n ")" ::: "memory")
#define BAR_ __builtin_amdgcn_s_barrier()
#define SCHED_ __builtin_amdgcn_sched_barrier(0)
  int bidp = blockIdx.x;
  if (gridDim.x == 256) { const int x_ = bidp & 7, i_ = bidp >> 3; bidp = (((x_ >> 2) * 8 + (i_ >> 2)) << 4) + (x_ & 3) * 4 + (i_ & 3); }
  for (int tile = bidp; tile < ntiles; tile += gridDim.x) {
    const int group = tile / (GM * ntn), rem = tile % (GM * ntn);
    const int mt_ = group * GM + (rem % GM), nt_ = rem / GM;
    const u16* A = Wt + (size_t)nt_ * 256 * K;
    const u16* Bt = Act + (size_t)mt_ * 256 * K;
    f32x4 acc[2][2][4][2];
#pragma unroll
    for (int a_ = 0; a_ < 2; ++a_)
#pragma unroll
      for (int b_ = 0; b_ < 2; ++b_)
#pragma unroll
        for (int m = 0; m < 4; ++m) { acc[a_][b_][m][0] = zero4(); acc[a_][b_][m][1] = zero4(); }
    bf16x8 At[4][2], B0[2][2], B1[2][2];
    STAGE_(SB_(0, 0), Bt, 0, 0); STAGE_(SA_(0, 0), A, 0, 0);
    STAGE_(SB_(0, 1), Bt, 128, 0); STAGE_(SA_(0, 1), A, 128, 0);
    if (wr == 1) BAR_;
    WAIT_V(4); BAR_;
    STAGE_(SB_(1, 0), Bt, 0, 1); STAGE_(SA_(1, 0), A, 0, 1); STAGE_(SB_(1, 1), Bt, 128, 1);
    WAIT_V(6); BAR_;
    for (int t = 0; t < nt - 2; t += 2) {
      LDB_(B0, 0, 0); SCHED_; LDA_(At, 0, 0); STAGE_(SA_(1, 1), A, 128, t + 1);
      WAIT_L(8); BAR_; WAIT_L(0); MMA_(0, 0, At, B0); BAR_; SCHED_;
      LDB_(B1, 0, 1); STAGE_(SB_(0, 0), Bt, 0, t + 2);
      BAR_; WAIT_L(0); MMA_(0, 1, At, B1); BAR_;
      LDA_(At, 0, 1); STAGE_(SA_(0, 0), A, 0, t + 2);
      BAR_; WAIT_L(0); MMA_(1, 0, At, B0); BAR_; SCHED_;
      STAGE_(SB_(0, 1), Bt, 128, t + 2);
      WAIT_V(6); BAR_; MMA_(1, 1, At, B1); BAR_;
      LDB_(B0, 1, 0); SCHED_; LDA_(At, 1, 0); STAGE_(SA_(0, 1), A, 128, t + 2);
      WAIT_L(8); BAR_; WAIT_L(0); MMA_(0, 0, At, B0); BAR_; SCHED_;
      LDB_(B1, 1, 1); STAGE_(SB_(1, 0), Bt, 0, t + 3);
      BAR_; WAIT_L(0); MMA_(0, 1, At, B1); BAR_;
      LDA_(At, 1, 1); STAGE_(SA_(1, 0), A, 0, t + 3);
      BAR_; WAIT_L(0); MMA_(1, 0, At, B0); BAR_; SCHED_;
      STAGE_(SB_(1, 1), Bt, 128, t + 3);
      WAIT_V(6); BAR_; MMA_(1, 1, At, B1); BAR_;
    }
    {
      LDB_(B0, 0, 0); LDA_(At, 0, 0); STAGE_(SA_(1, 1), A, 128, nt - 1);
      BAR_; WAIT_L(0); MMA_(0, 0, At, B0); BAR_;
      LDB_(B1, 0, 1); BAR_; WAIT_L(0); MMA_(0, 1, At, B1); BAR_;
      LDA_(At, 0, 1); WAIT_V(4); BAR_; WAIT_L(0); MMA_(1, 0, At, B0); MMA_(1, 1, At, B1); BAR_;
    }
    {
      LDB_(B0, 1, 0); LDA_(At, 1, 0); WAIT_V(2); BAR_; WAIT_L(0); MMA_(0, 0, At, B0); BAR_;
      LDB_(B1, 1, 1); WAIT_V(0); BAR_; WAIT_L(0); MMA_(0, 1, At, B1); BAR_;
      LDA_(At, 1, 1); BAR_; WAIT_L(0); MMA_(1, 0, At, B0); MMA_(1, 1, At, B1); BAR_;
    }
    if (wr == 0) BAR_;
    const int t2 = otid();
    const int fr2 = t2 & 15, fq2 = (t2 >> 4) & 3, wc2 = (t2 >> 6) & 3, wr2 = t2 >> 8;
#pragma unroll
    for (int ai = 0; ai < 2; ++ai)
#pragma unroll
      for (int bj = 0; bj < 2; ++bj)
        epi(acc[ai][bj], mt_ * 256 + bj * 128 + wc2 * 32, nt_ * 256 + ai * 128 + wr2 * 64, fr2, fq2);
  }
#undef SA_
#undef SB_
#undef STAGE_
#undef LDA_
#undef LDB_
#undef MMA_
#undef WAIT_V
#undef WAIT_L
#undef BAR_
#undef SCHED_
  __syncthreads();
}

struct EpiSwiglu {
  u16* act;
  DI void operator()(f32x4 (&acc)[4][G_MT], int mb, int nb, int fr, int fq) const {
#pragma unroll
    for (int mt = 0; mt < G_MT; ++mt) {
      const int m = mb + mt * 16 + fr;
#pragma unroll
      for (int np = 0; np < 2; ++np) {
        const f32x4 g = acc[2 * np][mt], u = acc[2 * np + 1][mt];
        f32x4 r;
#pragma unroll
        for (int j = 0; j < 4; ++j) r[j] = siluf_(g[j]) * u[j];
        const int jc = (nb >> 1) + np * 16 + fq * 4;
        *(u32x2*)(act + (size_t)m * 2816 + jc) = pack4(r);
      }
    }
  }
};

struct EpiResid {
  float* X; float scale;
  DI void operator()(f32x4 (&acc)[4][G_MT], int mb, int nb, int fr, int fq) const {
#pragma unroll
    for (int mt = 0; mt < G_MT; ++mt) {
      const int m = mb + mt * 16 + fr;
#pragma unroll
      for (int nt = 0; nt < 4; ++nt) {
        f32x4* ptr = (f32x4*)(X + (size_t)m * 1024 + nb + nt * 16 + fq * 4);
        f32x4 v = *ptr;
        v += acc[nt][mt] * scale;
        *ptr = v;
      }
    }
  }
};

struct EpiStore {
  u16* out; int ldo; int nmax;
  DI void operator()(f32x4 (&acc)[4][G_MT], int mb, int nb, int fr, int fq) const {
#pragma unroll
    for (int mt = 0; mt < G_MT; ++mt) {
      const int m = mb + mt * 16 + fr;
#pragma unroll
      for (int nt = 0; nt < 4; ++nt) {
        const int n = nb + nt * 16 + fq * 4;
        if (n < nmax) *(u32x2*)(out + (size_t)m * ldo + n) = pack4(acc[nt][mt]);
      }
    }
  }
};

struct EpiHgIn {
  u16 *Q, *LFf, *LFb, *V, *G; const float* lb;
  DI void operator()(f32x4 (&acc)[4][G_MT], int mb, int nb, int fr, int fq) const {
    const int seg = nb >> 10, c0 = nb & 1023;
    u16* dst = seg == 0 ? Q : seg == 1 ? LFf : seg == 2 ? LFb : seg == 3 ? V : G;
#pragma unroll
    for (int mt = 0; mt < G_MT; ++mt) {
      const int m = mb + mt * 16 + fr;
#pragma unroll
      for (int nt = 0; nt < 4; ++nt) {
        const int c = c0 + nt * 16 + fq * 4;
        f32x4 a = acc[nt][mt], r;
        if (seg == 0) r = a * 0.08838834764831845f;
        else if (seg == 3) r = a;
        else if (seg == 4) {
#pragma unroll
          for (int j = 0; j < 4; ++j) r[j] = siluf_(a[j]);
        } else {
          const f32x4 l4 = *(const f32x4*)(lb + c);
#pragma unroll
          for (int j = 0; j < 4; ++j) {
            float z = fminf(fmaxf(a[j], -30.f), 30.f);
            float f = l4[j] + (1.f - l4[j]) * sigmoidf_(z);
            r[j] = __logf(f);
          }
        }
        *(u32x2*)(dst + (size_t)m * 1024 + c) = pack4(r);
      }
    }
  }
};

struct EpiNaIn {
  u16 *Q, *K, *VT; const float *qn, *kn;
  DI void operator()(f32x4 (&acc)[4][G_MT], int mb, int nb, int fr, int fq) const {
    const int seg = nb >> 10, h = (nb & 1023) >> 6;
    if (seg < 2) {
      u16* dst = seg == 0 ? Q : K;
      const float* gn = seg == 0 ? qn : kn;
      const float sc = seg == 0 ? 0.125f * LOG2E : 1.f;
#pragma unroll
      for (int mt = 0; mt < G_MT; ++mt) {
        const int m = mb + mt * 16 + fr;
        float ss = 0.f;
#pragma unroll
        for (int nt = 0; nt < 4; ++nt)
#pragma unroll
          for (int j = 0; j < 4; ++j) ss += acc[nt][mt][j] * acc[nt][mt][j];
        ss += sx(ss, 16); ss += sx(ss, 32);
        const float rstd = rsqrtf(ss * (1.f / 64.f) + EPS) * sc;
#pragma unroll
        for (int nt = 0; nt < 4; ++nt) {
          const int d = nt * 16 + fq * 4;
          const f32x4 g4 = *(const f32x4*)(gn + d);
          f32x4 r = acc[nt][mt] * rstd * g4;
          *(u32x2*)(dst + (size_t)m * 1024 + h * 64 + d) = pack4(r);
        }
      }
    } else {
#pragma unroll
      for (int mt = 0; mt < G_MT; ++mt) {
        const int m = mb + mt * 16 + fr;
        const int b = m >> 12, t = m & 4095;
#pragma unroll
        for (int nt = 0; nt < 4; ++nt)
#pragma unroll
          for (int j = 0; j < 4; ++j) {
            const int d = nt * 16 + fq * 4 + j;
            VT[((size_t)((b * 16 + h) * 64 + d)) * 4096 + t] = (u16)f2bf(acc[nt][mt][j]);
          }
      }
    }
  }
};

struct HgBufs {
  u16 *Q, *LFf, *LFb, *V, *G, *QIf, *QIb, *KITf, *KITb, *VTc, *OI, *OF, *OB, *Y;
  float *DECf, *DECb;
};

DI void hg_prep_phase(const HgBufs& hb, char* smem) {
  u32x4 rq, rf, rb, rv;
  {
    const int item0 = vbid(), tid0 = vtid();
    if (item0 < 8192) {
      const size_t g0 = ((size_t)(item0 >> 11) * 4096 + ((item0 >> 3) & 255) * 16 + (tid0 >> 4)) * 1024 + (item0 & 7) * 128 + (tid0 & 15) * 8;
      rq = *(const u32x4*)(hb.Q + g0); rf = *(const u32x4*)(hb.LFf + g0); rb = *(const u32x4*)(hb.LFb + g0); rv = *(const u32x4*)(hb.V + g0);
    }
  }
  for (int item = vbid(); item < 8192; item += vgrid()) {
  const int h = item & 7, n = (item >> 3) & 255, b = item >> 11;
  float* sq = (float*)smem; float* sbf = sq + 2112; float* sbb = sbf + 2112; float* skf = sbb + 2112;
  float* skb = skf + 2112; float* sv = skb + 2112; float* sP = sv + 2112; float* sA = sP + 5120;
  const int tid = vtid();
  const int row = tid >> 4, c8 = (tid & 15) * 8;
  const size_t tok0 = (size_t)b * 4096 + n * 16;
  const size_t gidx = (tok0 + row) * 1024 + h * 128 + c8;
  {
#pragma unroll
    for (int e = 0; e < 8; ++e) {
      const int o = row * 132 + c8 + e;
      const float lf = bfget(rf, e), lb_ = bfget(rb, e);
      sq[o] = bfget(rq, e); sbf[o] = lf; sbb[o] = lb_;
      skf[o] = 1.f - __expf(lf); skb[o] = 1.f - __expf(lb_); sv[o] = bfget(rv, e);
    }
  }
  {
    const int nx = item + vgrid();
    if (nx < 8192) {
      const size_t g1 = ((size_t)(nx >> 11) * 4096 + ((nx >> 3) & 255) * 16 + row) * 1024 + (nx & 7) * 128 + c8;
      rq = *(const u32x4*)(hb.Q + g1); rf = *(const u32x4*)(hb.LFf + g1); rb = *(const u32x4*)(hb.LFb + g1); rv = *(const u32x4*)(hb.V + g1);
    }
  }
  __syncthreads();
  if (tid < 128) {
    const int d = tid; float a = 0.f;
#pragma unroll
    for (int t = 0; t < 16; ++t) { a += sbf[t * 132 + d]; sbf[t * 132 + d] = a; }
    hb.DECf[((size_t)b * 256 + n) * 1024 + h * 128 + d] = __expf(a);
  } else {
    const int d = tid - 128; float a = 0.f;
#pragma unroll
    for (int t = 15; t >= 0; --t) { a += sbb[t * 132 + d]; sbb[t * 132 + d] = a; }
    hb.DECb[((size_t)b * 256 + n) * 1024 + h * 128 + d] = __expf(a);
  }
  __syncthreads();
  {
    u32x4 of, ob;
#pragma unroll
    for (int e2 = 0; e2 < 4; ++e2) {
      const int o = row * 132 + c8 + 2 * e2;
      const float q0 = sq[o], q1 = sq[o + 1];
      of[e2] = pack2(q0 * __expf(sbf[o]), q1 * __expf(sbf[o + 1]));
      ob[e2] = pack2(q0 * __expf(sbb[o]), q1 * __expf(sbb[o + 1]));
    }
    *(u32x4*)(hb.QIf + gidx) = of; *(u32x4*)(hb.QIb + gidx) = ob;
  }
  {
    const int d = tid >> 1, t8 = (tid & 1) * 8;
    const float blf = sbf[15 * 132 + d], blb = sbb[d];
    u32x4 kf, kb, vv;
#pragma unroll
    for (int e2 = 0; e2 < 4; ++e2) {
      const int o0 = (t8 + 2 * e2) * 132 + d, o1 = o0 + 132;
      kf[e2] = pack2(skf[o0] * __expf(blf - sbf[o0]), skf[o1] * __expf(blf - sbf[o1]));
      kb[e2] = pack2(skb[o0] * __expf(blb - sbb[o0]), skb[o1] * __expf(blb - sbb[o1]));
      vv[e2] = pack2(sv[o0], sv[o1]);
    }
    const size_t cidx = (((size_t)(b * 8 + h) * 256 + n) * 128 + d) * 16 + t8;
    *(u32x4*)(hb.KITf + cidx) = kf; *(u32x4*)(hb.KITb + cidx) = kb; *(u32x4*)(hb.VTc + cidx) = vv;
  }
  {
    const int s = tid >> 4, dg = tid & 15, d0 = dg * 8, sw0 = (tid >> 6) * 4;
    float w[8];
    {
      const f32x4 a = *(const f32x4*)(skf + s * 132 + d0), b2 = *(const f32x4*)(skf + s * 132 + d0 + 4);
#pragma unroll
      for (int e = 0; e < 4; ++e) { w[e] = a[e]; w[4 + e] = b2[e]; }
    }
    float pdiag = 0.f;
    for (int t = sw0; t < 16; ++t) {
      if (t > s) {
        const f32x4 a = *(const f32x4*)(skf + t * 132 + d0), b2 = *(const f32x4*)(skf + t * 132 + d0 + 4);
#pragma unroll
        for (int e = 0; e < 4; ++e) { w[e] = fmaf(-w[e], a[e], w[e]); w[4 + e] = fmaf(-w[4 + e], b2[e], w[4 + e]); }
      }
      const f32x4 q0 = *(const f32x4*)(sq + t * 132 + d0), q1 = *(const f32x4*)(sq + t * 132 + d0 + 4);
      float part = 0.f;
#pragma unroll
      for (int e = 0; e < 4; ++e) part += q0[e] * w[e] + q1[e] * w[4 + e];
      if (t == s) pdiag = part;
      else if (t > s) sP[(t * 16 + s) * 20 + dg] = part;
    }
    {
      const f32x4 a = *(const f32x4*)(skb + s * 132 + d0), b2 = *(const f32x4*)(skb + s * 132 + d0 + 4);
#pragma unroll
      for (int e = 0; e < 4; ++e) { w[e] = a[e]; w[4 + e] = b2[e]; }
    }
    for (int t = sw0 + 3; t >= 0; --t) {
      if (t < s) {
        const f32x4 a = *(const f32x4*)(skb + t * 132 + d0), b2 = *(const f32x4*)(skb + t * 132 + d0 + 4);
#pragma unroll
        for (int e = 0; e < 4; ++e) { w[e] = fmaf(-w[e], a[e], w[e]); w[4 + e] = fmaf(-w[4 + e], b2[e], w[4 + e]); }
      }
      const f32x4 q0 = *(const f32x4*)(sq + t * 132 + d0), q1 = *(const f32x4*)(sq + t * 132 + d0 + 4);
      float part = 0.f;
#pragma unroll
      for (int e = 0; e < 4; ++e) part += q0[e] * w[e] + q1[e] * w[4 + e];
      if (t == s) sP[(s * 16 + s) * 20 + dg] = pdiag + part;
      else if (t < s) sP[(t * 16 + s) * 20 + dg] = part;
    }
  }
  __syncthreads();
  {
    const int t = tid >> 4, s = tid & 15;
    const float* pp = sP + (t * 16 + s) * 20;
    const f32x4 p0 = *(const f32x4*)pp, p1 = *(const f32x4*)(pp + 4), p2 = *(const f32x4*)(pp + 8), p3 = *(const f32x4*)(pp + 12);
    const f32x4 ps = (p0 + p1) + (p2 + p3);
    sA[t * 17 + s] = (ps[0] + ps[1]) + (ps[2] + ps[3]);
  }
  __syncthreads();
  {
    float o[8];
#pragma unroll
    for (int e = 0; e < 8; ++e) o[e] = 0.f;
#pragma unroll
    for (int s = 0; s < 16; ++s) {
      const float a = sA[row * 17 + s];
      const f32x4 v0 = *(const f32x4*)(sv + s * 132 + c8), v1 = *(const f32x4*)(sv + s * 132 + c8 + 4);
#pragma unroll
      for (int e = 0; e < 4; ++e) { o[e] += a * v0[e]; o[4 + e] += a * v1[e]; }
    }
    u32x4 r; r[0] = pack2(o[0], o[1]); r[1] = pack2(o[2], o[3]); r[2] = pack2(o[4], o[5]); r[3] = pack2(o[6], o[7]);
    *(u32x4*)(hb.OI + gidx) = r;
  }
  __syncthreads();
  }
}

constexpr int SC_NS = 6, SC_STAGE = 12288;
DI void scan_issue(char* smem, int slot, const u16* QI, const u16* KIT, const u16* VTc, const float* DEC, int b, int h, int vg, int n, int tid) {
  char* st = smem + slot * SC_STAGE + tid * 16;
  const size_t tok0 = (size_t)b * 4096 + n * 16;
  const int row = tid >> 4, lc = (tid & 15) ^ row;
  GLDS16(QI + (tok0 + row) * 1024 + h * 128 + lc * 8, st);
  const size_t cb = ((size_t)(b * 8 + h) * 256 + n) * 2048;
  GLDS16(KIT + cb + tid * 8, st + 4096);
  const float* dp = DEC + ((size_t)b * 256 + n) * 1024 + h * 128;
  const void* g3 = tid < 128 ? (const void*)(VTc + cb + vg * 1024 + tid * 8) : (const void*)(dp + ((tid - 128) & 31) * 4);
  GLDS16(g3, st + 8192);
}

struct ScanRegs { bf16x8 qa[4]; bf16x8 ka[8]; bf16x8 vb; };

DI void scan_read(ScanRegs& r, const char* st, int wid, int fr, int fq) {
#pragma unroll
  for (int ks = 0; ks < 4; ++ks) {
    const int l0 = 4 * ks + (fq >> 1), l1 = l0 + 2;
    const bf16x4 lo = *(const bf16x4*)(st + fr * 256 + ((l0 ^ fr) * 16) + (fq & 1) * 8);
    const bf16x4 hi = *(const bf16x4*)(st + fr * 256 + ((l1 ^ fr) * 16) + (fq & 1) * 8);
    r.qa[ks] = cat4(lo, hi);
  }
  r.vb = *(const bf16x8*)(st + 8192 + (wid * 16 + fr) * 32 + (fq & 1) * 16);
#pragma unroll
  for (int dt = 0; dt < 8; ++dt) r.ka[dt] = *(const bf16x8*)(st + 4096 + (dt * 16 + fr) * 32 + (fq & 1) * 16);
}

DI void scan_compute(f32x4 (&S)[8], ScanRegs& r, const f32x4 (&dc)[8], u16* op, int fq) {
  const bf16x8 z8 = {0, 0, 0, 0, 0, 0, 0, 0};
  if (fq >= 2) r.vb = z8;
  f32x4 o0 = zero4(), o1 = zero4();
  o0 = MFMA32(r.qa[0], pack8(S[0], S[1]), o0);
  o1 = MFMA32(r.qa[1], pack8(S[2], S[3]), o1);
  o0 = MFMA32(r.qa[2], pack8(S[4], S[5]), o0);
  o1 = MFMA32(r.qa[3], pack8(S[6], S[7]), o1);
#pragma unroll
  for (int dt = 0; dt < 8; ++dt) {
    if (fq >= 2) r.ka[dt] = z8;
    S[dt] = S[dt] * dc[dt];
    S[dt] = MFMA32(r.ka[dt], r.vb, S[dt]);
  }
  const f32x4 o = o0 + o1;
  const u32 w0 = pack2(o[0], o[1]), w1 = pack2(o[2], o[3]);
  asm volatile("global_store_short %0, %1, off" :: "v"(op), "v"(w0) : "memory");
  asm volatile("global_store_short_d16_hi %0, %1, off" :: "v"(op + 1024), "v"(w0) : "memory");
  asm volatile("global_store_short %0, %1, off" :: "v"(op + 2048), "v"(w1) : "memory");
  asm volatile("global_store_short_d16_hi %0, %1, off" :: "v"(op + 3072), "v"(w1) : "memory");
}

DI void hg_scan_phase(const HgBufs& hb, char* smem) {
  const int tid = vtid(), lane = tid & 63, wid = tid >> 6, fr = lane & 15, fq = lane >> 4;
  for (int item = vbid(); item < 128; item += vgrid()) {
    const int vg = item & 1, dir = (item >> 1) & 1, h = (item >> 2) & 7, b = item >> 5;
    const u16* QI = dir ? hb.QIb : hb.QIf; const u16* KIT = dir ? hb.KITb : hb.KITf;
    const float* DEC = dir ? hb.DECb : hb.DECf; u16* Oout = dir ? hb.OB : hb.OF;
    const int vs = vg * 4 + wid;
    u16* obase = Oout + ((size_t)b * 4096 + fq * 4) * 1024 + h * 128 + vs * 16 + fr;
    f32x4 S[8];
#pragma unroll
    for (int i = 0; i < 8; ++i) S[i] = zero4();
#pragma unroll
    for (int s = 0; s < SC_NS - 1; ++s) scan_issue(smem, s, QI, KIT, hb.VTc, DEC, b, h, vg, dir ? 255 - s : s, tid);
    asm volatile("s_waitcnt vmcnt(12)" ::: "memory");
    __builtin_amdgcn_s_barrier();
    asm volatile("" ::: "memory");
    ScanRegs ra, rb;
    scan_read(ra, smem, wid, fr, fq);
    int slot = 0;
#define SCAN_STEP(STEP, CUR, NXT) do { \
      const int step_ = (STEP); \
      if (step_ < 4) asm volatile("s_waitcnt vmcnt(9) lgkmcnt(0)" ::: "memory"); \
      else asm volatile("s_waitcnt vmcnt(25) lgkmcnt(0)" ::: "memory"); \
      __builtin_amdgcn_s_barrier(); \
      asm volatile("" ::: "memory"); \
      { const int ns_ = min(step_ + SC_NS - 1, 255); \
        int is_ = slot + SC_NS - 1; if (is_ >= SC_NS) is_ -= SC_NS; \
        scan_issue(smem, is_, QI, KIT, hb.VTc, DEC, b, h, vg, dir ? 255 - ns_ : ns_, tid); } \
      f32x4 dc_[8]; \
      { const char* st_ = smem + slot * SC_STAGE + 8192 + 2048 + fq * 16; \
        _Pragma("unroll") for (int dt = 0; dt < 8; ++dt) dc_[dt] = *(const f32x4*)(st_ + dt * 64); } \
      int nslot_ = slot + 1; if (nslot_ == SC_NS) nslot_ = 0; \
      if (step_ + 1 < 256) scan_read(NXT, smem + nslot_ * SC_STAGE, wid, fr, fq); \
      { const int n_ = dir ? 255 - step_ : step_; \
        scan_compute(S, CUR, dc_, obase + (size_t)n_ * 16 * 1024, fq); } \
      slot = nslot_; } while (0)
    for (int step = 0; step < 256; step += 2) {
      SCAN_STEP(step, ra, rb);
      SCAN_STEP(step + 1, rb, ra);
    }
#undef SCAN_STEP
    asm volatile("s_waitcnt vmcnt(0)" ::: "memory");
    __syncthreads();
  }
}

DI void hg_combine_phase(const HgBufs& hb, const float* __restrict__ gnorm, int rows) {
  const int lane = vtid() & 63, wid = vtid() >> 6;
  const int h = lane >> 3, c16 = (lane & 7) * 16;
  const int stride = vgrid() * 4;
  f32x4 gn[4];
#pragma unroll
  for (int i = 0; i < 4; ++i) gn[i] = *(const f32x4*)(gnorm + c16 + i * 4);
  for (int row = vbid() * 4 + wid; row < rows; row += stride * 2) {
    u32x4 ra[2][2], rf[2][2], rb[2][2], rg[2][2];
#pragma unroll
    for (int j = 0; j < 2; ++j) {
      const int rj = row + j * stride;
      if (rj < rows) {
        const size_t g = (size_t)rj * 1024 + h * 128 + c16;
#pragma unroll
        for (int half = 0; half < 2; ++half) {
          ra[j][half] = *(const u32x4*)(hb.OI + g + half * 8); rf[j][half] = *(const u32x4*)(hb.OF + g + half * 8);
          rb[j][half] = *(const u32x4*)(hb.OB + g + half * 8); rg[j][half] = *(const u32x4*)(hb.G + g + half * 8);
        }
      }
    }
#pragma unroll
    for (int j = 0; j < 2; ++j) {
      const int rj = row + j * stride;
      if (rj < rows) {
        const size_t g = (size_t)rj * 1024 + h * 128 + c16;
        float o[16]; float ss = 0.f;
#pragma unroll
        for (int half = 0; half < 2; ++half)
#pragma unroll
          for (int e = 0; e < 8; ++e) { float v = bfget(ra[j][half], e) + bfget(rf[j][half], e) + bfget(rb[j][half], e); o[half * 8 + e] = v; ss += v * v; }
        ss += sx(ss, 1); ss += sx(ss, 2); ss += sx(ss, 4);
        const float rstd = rsqrtf(ss * (1.f / 128.f) + EPS);
#pragma unroll
        for (int half = 0; half < 2; ++half) {
          u32x4 r;
#pragma unroll
          for (int e2 = 0; e2 < 4; ++e2) {
            const int e = half * 8 + 2 * e2;
            r[e2] = pack2(o[e] * rstd * gn[e >> 2][e & 3] * bfget(rg[j][half], 2 * e2), o[e + 1] * rstd * gn[(e + 1) >> 2][(e + 1) & 3] * bfget(rg[j][half], 2 * e2 + 1));
          }
          *(u32x4*)(hb.Y + g + half * 8) = r;
        }
      }
    }
  }
}

DI void na_attn_item(const u16* __restrict__ Q, const u16* __restrict__ K, const u16* __restrict__ VT, const float* __restrict__ rpb, u16* __restrict__ O, int item, int fr, int fq) {
  const int qt = item & 3, h = (item >> 2) & 15, r = (item >> 6) & 63, b = item >> 12;
  const int r0 = min(max(r - 4, 0), 56);
  const int cw0 = qt == 0 ? 0 : qt == 1 ? 8 : qt == 2 ? 24 : 32;
  const size_t tokq = (size_t)b * 4096 + r * 64 + qt * 16 + fr;
  bf16x8 qf[2];
#pragma unroll
  for (int ks = 0; ks < 2; ++ks) qf[ks] = *(const bf16x8*)(Q + tokq * 1024 + h * 64 + ks * 32 + fq * 8);
  f32x4 s[8][2];
#pragma unroll
  for (int kr = 0; kr < 8; ++kr)
#pragma unroll
    for (int hf = 0; hf < 2; ++hf) {
      const size_t tokk = (size_t)b * 4096 + (r0 + kr) * 64 + cw0 + hf * 16 + fr;
      const bf16x8 k0 = *(const bf16x8*)(K + tokk * 1024 + h * 64 + fq * 8);
      const bf16x8 k1 = *(const bf16x8*)(K + tokk * 1024 + h * 64 + 32 + fq * 8);
      f32x4 a = MFMA32(k0, qf[0], zero4());
      s[kr][hf] = MFMA32(k1, qf[1], a);
    }
  const int qc = qt * 16 + fr;
  const int cs = min(max(qc - 8, 0), 48);
  float mx = -1e30f;
#pragma unroll
  for (int kr = 0; kr < 8; ++kr) {
    const float* rp = rpb + (h * 15 + (r0 + kr - r + 7)) * 31;
#pragma unroll
    for (int hf = 0; hf < 2; ++hf)
#pragma unroll
      for (int j = 0; j < 4; ++j) {
        const int kc = cw0 + hf * 16 + fq * 4 + j;
        const bool valid = (kc >= cs) && (kc < cs + 16);
        const int ci = min(max(kc - qc + 15, 0), 30);
        const float v = valid ? s[kr][hf][j] + rp[ci] * LOG2E : -1e30f;
        s[kr][hf][j] = v; mx = fmaxf(mx, v);
      }
  }
  mx = fmaxf(mx, sx(mx, 16)); mx = fmaxf(mx, sx(mx, 32));
  float l = 0.f;
#pragma unroll
  for (int kr = 0; kr < 8; ++kr)
#pragma unroll
    for (int hf = 0; hf < 2; ++hf)
#pragma unroll
      for (int j = 0; j < 4; ++j) { const float pv = __builtin_amdgcn_exp2f(s[kr][hf][j] - mx); s[kr][hf][j] = pv; l += pv; }
  l += sx(l, 16); l += sx(l, 32);
  f32x4 o[4];
#pragma unroll
  for (int dt = 0; dt < 4; ++dt) o[dt] = zero4();
#pragma unroll
  for (int kr = 0; kr < 8; ++kr) {
    const bf16x8 pp = pack8(s[kr][0], s[kr][1]);
#pragma unroll
    for (int dt = 0; dt < 4; ++dt) {
      const u16* vp = VT + ((size_t)((b * 16 + h) * 64 + dt * 16 + fr)) * 4096 + (r0 + kr) * 64 + cw0 + fq * 4;
      const bf16x8 vf = cat4(*(const bf16x4*)vp, *(const bf16x4*)(vp + 16));
      o[dt] = MFMA32(vf, pp, o[dt]);
    }
  }
  const float inv = 1.f / l;
#pragma unroll
  for (int dt = 0; dt < 4; ++dt) *(u32x2*)(O + tokq * 1024 + h * 64 + dt * 16 + fq * 4) = pack4(o[dt] * inv);
}

DI void mla_norm_phase(const u16* __restrict__ CRAW, const float* __restrict__ gq, const float* __restrict__ gkv, u16* __restrict__ CQN, u16* __restrict__ CKVN, float* __restrict__ KROPE) {
  const int lane = vtid() & 63, wid = vtid() >> 6;
  for (int row = vbid() * 4 + wid; row < MTOK; row += vgrid() * 4) {
    const u16* c = CRAW + (size_t)row * 1056;
    f32x4 v[3]; float ss = 0.f;
#pragma unroll
    for (int i = 0; i < 3; ++i) {
      const u32x2 w = *(const u32x2*)(c + i * 256 + lane * 4);
      v[i][0] = bflo(w[0]); v[i][1] = bfhi(w[0]); v[i][2] = bflo(w[1]); v[i][3] = bfhi(w[1]);
      ss += v[i][0] * v[i][0] + v[i][1] * v[i][1] + v[i][2] * v[i][2] + v[i][3] * v[i][3];
    }
    ss = wave_sum(ss);
    const float rq = rsqrtf(ss * (1.f / 768.f) + EPS);
#pragma unroll
    for (int i = 0; i < 3; ++i) {
      const f32x4 g4 = *(const f32x4*)(gq + i * 256 + lane * 4);
      *(u32x2*)(CQN + (size_t)row * 768 + i * 256 + lane * 4) = pack4(v[i] * rq * g4);
    }
    {
      const u32x2 w = *(const u32x2*)(c + 768 + lane * 4);
      f32x4 k; k[0] = bflo(w[0]); k[1] = bfhi(w[0]); k[2] = bflo(w[1]); k[3] = bfhi(w[1]);
      float s2 = wave_sum(k[0] * k[0] + k[1] * k[1] + k[2] * k[2] + k[3] * k[3]);
      const float rk = rsqrtf(s2 * (1.f / 256.f) + EPS);
      const f32x4 g4 = *(const f32x4*)(gkv + lane * 4);
      *(u32x2*)(CKVN + (size_t)row * 256 + lane * 4) = pack4(k * rk * g4);
    }
    if (lane < 8) {
      const u32x2 w = *(const u32x2*)(c + 1024 + lane * 4);
      f32x4 k; k[0] = bflo(w[0]); k[1] = bfhi(w[0]); k[2] = bflo(w[1]); k[3] = bfhi(w[1]);
      *(f32x4*)(KROPE + (size_t)row * 32 + lane * 4) = k;
    }
  }
}

DI void mla_prep_phase(u16* __restrict__ Q, const u16* __restrict__ KVRAW, const float* __restrict__ KROPE, u16* __restrict__ Kout,
                       const float* __restrict__ gq, const float* __restrict__ gk, const float* __restrict__ RC, const float* __restrict__ RS) {
  const int lane = vtid() & 63, wid = vtid() >> 6;
  const int h = lane >> 2, sub = lane & 3;
  const float QS = 0.10206207261596577f * LOG2E;
  for (int m = vbid() * 4 + wid; m < MTOK; m += vgrid() * 4) {
    const int t = m & 4095;
    const f32x4 cs = *(const f32x4*)(RC + t * 16 + sub * 4), sn = *(const f32x4*)(RS + t * 16 + sub * 4);
#pragma unroll
    for (int which = 0; which < 2; ++which) {
      float nope[16]; f32x4 ra, rb;
      u16* dstp = (which == 0 ? Q : Kout) + (size_t)m * 1536 + h * 96;
      const float* gn = which == 0 ? gq : gk;
      if (which == 0) {
        const u32x4 w0 = *(const u32x4*)(dstp + sub * 16), w1 = *(const u32x4*)(dstp + sub * 16 + 8);
#pragma unroll
        for (int e = 0; e < 8; ++e) { nope[e] = bfget(w0, e); nope[8 + e] = bfget(w1, e); }
        const u32x2 a2 = *(const u32x2*)(dstp + 64 + sub * 4), b2 = *(const u32x2*)(dstp + 80 + sub * 4);
        ra[0] = bflo(a2[0]); ra[1] = bfhi(a2[0]); ra[2] = bflo(a2[1]); ra[3] = bfhi(a2[1]);
        rb[0] = bflo(b2[0]); rb[1] = bfhi(b2[0]); rb[2] = bflo(b2[1]); rb[3] = bfhi(b2[1]);
      } else {
        const u16* kp = KVRAW + (size_t)m * 2048 + h * 128 + sub * 16;
        const u32x4 w0 = *(const u32x4*)kp, w1 = *(const u32x4*)(kp + 8);
#pragma unroll
        for (int e = 0; e < 8; ++e) { nope[e] = bfget(w0, e); nope[8 + e] = bfget(w1, e); }
        ra = *(const f32x4*)(KROPE + (size_t)m * 32 + sub * 4);
        rb = *(const f32x4*)(KROPE + (size_t)m * 32 + 16 + sub * 4);
      }
      float ss = 0.f;
#pragma unroll
      for (int e = 0; e < 16; ++e) ss += nope[e] * nope[e];
#pragma unroll
      for (int e = 0; e < 4; ++e) ss += ra[e] * ra[e] + rb[e] * rb[e];
      ss += sx(ss, 1); ss += sx(ss, 2);
      const float rstd = rsqrtf(ss * (1.f / 96.f) + EPS) * (which == 0 ? QS : 1.f);
      u32x4 o0, o1;
#pragma unroll
      for (int e2 = 0; e2 < 4; ++e2) {
        o0[e2] = pack2(nope[2 * e2] * rstd * gn[sub * 16 + 2 * e2], nope[2 * e2 + 1] * rstd * gn[sub * 16 + 2 * e2 + 1]);
        o1[e2] = pack2(nope[8 + 2 * e2] * rstd * gn[sub * 16 + 8 + 2 * e2], nope[9 + 2 * e2] * rstd * gn[sub * 16 + 9 + 2 * e2]);
      }
      f32x4 oa, ob;
#pragma unroll
      for (int e = 0; e < 4; ++e) {
        const float a = ra[e] * rstd * gn[64 + sub * 4 + e], bq = rb[e] * rstd * gn[80 + sub * 4 + e];
        oa[e] = a * cs[e] - bq * sn[e];
        ob[e] = bq * cs[e] + a * sn[e];
      }
      *(u32x4*)(dstp + sub * 16) = o0; *(u32x4*)(dstp + sub * 16 + 8) = o1;
      *(u32x2*)(dstp + 64 + sub * 4) = pack4(oa); *(u32x2*)(dstp + 80 + sub * 4) = pack4(ob);
    }
  }
}

DI void mla_vt_phase(const u16* __restrict__ KVRAW, u16* __restrict__ VT, char* smem) {
  u16* tile = (u16*)smem;
  const int tid = vtid();
  for (int item = vbid(); item < 8192; item += vgrid()) {
    const int tt = item & 63, bh = item >> 6, b = bh >> 4, h = bh & 15;
    {
      const int row = tid >> 2, part = tid & 3;
      const u16* src = KVRAW + ((size_t)b * 4096 + tt * 64 + row) * 2048 + h * 128 + 64 + part * 16;
      const u32x4 w0 = *(const u32x4*)src, w1 = *(const u32x4*)(src + 8);
      u32* d32 = (u32*)(tile + row * 66 + part * 16);
#pragma unroll
      for (int e = 0; e < 4; ++e) { d32[e] = w0[e]; d32[4 + e] = w1[e]; }
    }
    __syncthreads();
    {
      const int d = tid >> 2, tp = (tid & 3) * 16;
      u32x4 o0, o1;
#pragma unroll
      for (int e2 = 0; e2 < 4; ++e2) {
        o0[e2] = (u32)tile[(tp + 2 * e2) * 66 + d] | ((u32)tile[(tp + 2 * e2 + 1) * 66 + d] << 16);
        o1[e2] = (u32)tile[(tp + 8 + 2 * e2) * 66 + d] | ((u32)tile[(tp + 9 + 2 * e2) * 66 + d] << 16);
      }
      u16* dst = VT + ((size_t)(bh * 64 + d)) * 4096 + tt * 64 + tp;
      *(u32x4*)dst = o0; *(u32x4*)(dst + 8) = o1;
    }
    __syncthreads();
  }
}

constexpr int FA_KROW = 208, FA_VROW = 144, FA_KT = 64 * FA_KROW, FA_BUF = FA_KT + 64 * FA_VROW;
DI void mla_attn_item(const u16* __restrict__ Q, const u16* __restrict__ Kb, const u16* __restrict__ VT, u16* __restrict__ O, int item, char* smem) {
  const int qb = item & 15, bh = item >> 4, b = bh >> 4, h = bh & 15;
  const int tid = vtid(), lane = tid & 63, wid = tid >> 6, fr = lane & 15, fq = lane >> 4;
  bf16x8 qf[4][3];
#pragma unroll
  for (int qt = 0; qt < 4; ++qt) {
    const size_t tq = (size_t)b * 4096 + qb * 256 + wid * 64 + qt * 16 + fr;
#pragma unroll
    for (int ks = 0; ks < 3; ++ks) qf[qt][ks] = *(const bf16x8*)(Q + tq * 1536 + h * 96 + ks * 32 + fq * 8);
  }
  f32x4 o[4][4];
#pragma unroll
  for (int i = 0; i < 4; ++i)
#pragma unroll
    for (int j = 0; j < 4; ++j) o[i][j] = zero4();
  float mrun[4] = {-1e30f, -1e30f, -1e30f, -1e30f}, lrun[4] = {0.f, 0.f, 0.f, 0.f};
  const u16* kg[3]; int ks_off[3];
#pragma unroll
  for (int i = 0; i < 3; ++i) {
    const int c = tid + 256 * i, row = c / 12, kc = c % 12;
    kg[i] = Kb + ((size_t)b * 4096 + row) * 1536 + h * 96 + kc * 8;
    ks_off[i] = row * FA_KROW + kc * 16;
  }
  const u16* vg[2]; int vs_off[2];
#pragma unroll
  for (int i = 0; i < 2; ++i) {
    const int c = tid + 256 * i, d = c >> 3, kc = c & 7;
    vg[i] = VT + ((size_t)(bh * 64 + d)) * 4096 + kc * 8;
    vs_off[i] = FA_KT + d * FA_VROW + kc * 16;
  }
  u32x4 rk[3], rv[2];
#pragma unroll
  for (int i = 0; i < 3; ++i) rk[i] = *(const u32x4*)(kg[i]);
#pragma unroll
  for (int i = 0; i < 2; ++i) rv[i] = *(const u32x4*)(vg[i]);
#pragma unroll
  for (int i = 0; i < 3; ++i) *(u32x4*)(smem + ks_off[i]) = rk[i];
#pragma unroll
  for (int i = 0; i < 2; ++i) *(u32x4*)(smem + vs_off[i]) = rv[i];
#pragma unroll
  for (int qt = 0; qt < 4; ++qt)
#pragma unroll
    for (int ks = 0; ks < 3; ++ks) asm volatile("" :: "v"(qf[qt][ks]));
  __syncthreads();
  for (int kt = 0; kt < 64; ++kt) {
    const int cur = (kt & 1) * FA_BUF, nxt = FA_BUF - cur;
    if (kt + 1 < 64) {
      const size_t key0 = (size_t)(kt + 1) * 64;
#pragma unroll
      for (int i = 0; i < 3; ++i) rk[i] = *(const u32x4*)(kg[i] + key0 * 1536);
#pragma unroll
      for (int i = 0; i < 2; ++i) rv[i] = *(const u32x4*)(vg[i] + key0);
    }
#pragma unroll
    for (int kh = 0; kh < 2; ++kh) {
      f32x4 s[2][4];
#pragma unroll
      for (int kl = 0; kl < 2; ++kl) {
#pragma unroll
        for (int qt = 0; qt < 4; ++qt) s[kl][qt] = zero4();
#pragma unroll
        for (int ks = 0; ks < 3; ++ks) {
          const bf16x8 kf = *(const bf16x8*)(smem + cur + ((kh * 2 + kl) * 16 + fr) * FA_KROW + ks * 64 + fq * 16);
#pragma unroll
          for (int qt = 0; qt < 4; ++qt) s[kl][qt] = MFMA32(kf, qf[qt][ks], s[kl][qt]);
        }
      }
      bf16x8 pp[4];
      {
        float lm[4]; bool need = false;
#pragma unroll
        for (int qt = 0; qt < 4; ++qt) {
          const float m0 = fmaxf(fmaxf(s[0][qt][0], s[0][qt][1]), fmaxf(s[0][qt][2], s[0][qt][3]));
          const float m1 = fmaxf(fmaxf(s[1][qt][0], s[1][qt][1]), fmaxf(s[1][qt][2], s[1][qt][3]));
          lm[qt] = fmaxf(m0, m1);
          need = need || (lm[qt] > mrun[qt] + 8.f);
        }
        if (__any(need)) {
#pragma unroll
          for (int qt = 0; qt < 4; ++qt) {
            float mx = lm[qt];
            mx = fmaxf(mx, sx(mx, 16)); mx = fmaxf(mx, sx(mx, 32));
            const float mnew = fmaxf(mrun[qt], mx);
            const float alpha = __builtin_amdgcn_exp2f(mrun[qt] - mnew);
            mrun[qt] = mnew;
            lrun[qt] *= alpha;
#pragma unroll
            for (int dt = 0; dt < 4; ++dt) o[dt][qt] = o[dt][qt] * alpha;
          }
        }
#pragma unroll
        for (int qt = 0; qt < 4; ++qt) {
          const float mr = mrun[qt];
          float ps = 0.f;
#pragma unroll
          for (int kl = 0; kl < 2; ++kl)
#pragma unroll
            for (int j = 0; j < 4; ++j) { const float pv = __builtin_amdgcn_exp2f(s[kl][qt][j] - mr); s[kl][qt][j] = pv; ps += pv; }
          lrun[qt] += ps;
          pp[qt] = pack8(s[0][qt], s[1][qt]);
        }
      }
#pragma unroll
      for (int dt = 0; dt < 4; ++dt) {
        const char* vp = smem + cur + FA_KT + (dt * 16 + fr) * FA_VROW + (kh * 32 + fq * 4) * 2;
        const bf16x8 vf = cat4(*(const bf16x4*)vp, *(const bf16x4*)(vp + 32));
#pragma unroll
        for (int qt = 0; qt < 4; ++qt) o[dt][qt] = MFMA32(vf, pp[qt], o[dt][qt]);
      }
    }
    if (kt + 1 < 64) {
#pragma unroll
      for (int i = 0; i < 3; ++i) *(u32x4*)(smem + nxt + ks_off[i]) = rk[i];
#pragma unroll
      for (int i = 0; i < 2; ++i) *(u32x4*)(smem + nxt + vs_off[i]) = rv[i];
    }
    __syncthreads();
  }
#pragma unroll
  for (int qt = 0; qt < 4; ++qt) {
    float l = lrun[qt];
    l += sx(l, 16); l += sx(l, 32);
    const float inv = 1.f / l;
    const size_t tq = (size_t)b * 4096 + qb * 256 + wid * 64 + qt * 16 + fr;
#pragma unroll
    for (int dt = 0; dt < 4; ++dt) *(u32x2*)(O + tq * 1024 + h * 64 + dt * 16 + fq * 4) = pack4(o[dt][qt] * inv);
  }
}

#define XB_TMO      128
#define XB_XCNT(j)  (256  + 64 * (j))
#define XB_XSUB(j)  (1280 + 64 * (j))
#define XB_XGEN(j)  (2304 + 64 * (j))
#define XB_TOP      3328
#define XB_TOPGEN   3392
#define XCD_BAR_WORDS 3456
#define XB_SPIN_CAP (1u << 22)
DI unsigned xb_ld(unsigned* p) { return __hip_atomic_load(p, __ATOMIC_RELAXED, __HIP_MEMORY_SCOPE_AGENT); }
DI unsigned xb_add(unsigned* p, unsigned v) { return __hip_atomic_fetch_add(p, v, __ATOMIC_RELAXED, __HIP_MEMORY_SCOPE_AGENT); }
DI unsigned xb_xcc_id() { return (unsigned)__builtin_amdgcn_s_getreg((3 << 11) | 20) & 0xFu; }
#define XB_SPIN(cond, bar) do { unsigned _sp = 0; while (cond) { __builtin_amdgcn_s_sleep(1); \
    if ((++_sp & 255u) == 0u) { if (xb_ld(&(bar)[XB_TMO])) break; if (_sp > XB_SPIN_CAP) { atomicAdd(&(bar)[XB_TMO], 1u); break; } } } } while (0)

DI void xcd_barrier_complete(unsigned* bar, unsigned x, unsigned& nloc, unsigned& nx) {
  const unsigned G = gridDim.x;
  unsigned sum, cnt, mine, sp = 0u;
  for (;;) {
    sum = 0u; cnt = 0u; mine = 0u;
#pragma unroll
    for (unsigned j = 0; j < 16; ++j) { const unsigned c = xb_ld(&bar[XB_XCNT(j)]); sum += c; cnt += (c > 0u) ? 1u : 0u; mine = (j == x) ? c : mine; }
    if (sum == G) break;
    __builtin_amdgcn_s_sleep(1);
    if ((++sp & 255u) == 0u) { if (xb_ld(&bar[XB_TMO])) break; if (sp > XB_SPIN_CAP) { atomicAdd(&bar[XB_TMO], 1u); break; } }
  }
  nloc = mine > 0u ? mine : 1u; nx = cnt > 0u ? cnt : 1u;
}

DI void xcd_barrier(unsigned* bar, char* smem_) {
  int off_ = 147456; asm volatile("" : "+v"(off_));
  volatile unsigned* st = (volatile unsigned*)(smem_ + off_);
  asm volatile("s_waitcnt vmcnt(0)" ::: "memory");
  __syncthreads();
  if (threadIdx.x == 0) {
    __builtin_amdgcn_s_waitcnt(0);
    const unsigned x = xb_xcc_id();
    unsigned nloc = st[0], nx = st[1];
    if (nloc == 0u) { xcd_barrier_complete(bar, x, nloc, nx); st[0] = nloc; st[1] = nx; }
    const unsigned old = xb_add(&bar[XB_XSUB(x)], 1u);
    const unsigned gen = old / nloc;
    if (old + 1u == (gen + 1u) * nloc) {
      __builtin_amdgcn_fence(__ATOMIC_RELEASE, "agent");
      asm volatile("s_waitcnt vmcnt(0)" ::: "memory");
      const unsigned og = xb_add(&bar[XB_TOP], 1u);
      const unsigned tg = og / nx;
      if (og + 1u == (tg + 1u) * nx) xb_add(&bar[XB_TOPGEN], 1u);
      else XB_SPIN(xb_ld(&bar[XB_TOPGEN]) == tg, bar);
      __builtin_amdgcn_fence(__ATOMIC_ACQUIRE, "agent");
      xb_add(&bar[XB_XGEN(x)], 1u);
      asm volatile("s_waitcnt vmcnt(0)" ::: "memory");
    } else {
      XB_SPIN(xb_ld(&bar[XB_XGEN(x)]) == gen, bar);
      __builtin_amdgcn_fence(__ATOMIC_ACQUIRE, "agent");
      asm volatile("s_waitcnt vmcnt(0)" ::: "memory");
    }
  }
  __syncthreads();
}

#ifndef ENMASK
#define ENMASK 0xffffffffu
#endif
#define EN(i) ((ENMASK >> (i)) & 1u)
#ifndef DUPMASK
#define DUPMASK 0u
#endif
#define DUP(i) ((DUPMASK >> (i)) & 1u)
#ifndef BAR2
#define BAR2 0
#endif
#define PHASE_BEGIN(i) if (EN(i) && pc >= p.lo && pc < p.hi) for (int rep_ = 0; rep_ < 1 + (int)DUP(i); ++rep_) {
#define PHASE_END } { if (pc >= p.lo && pc + 1 < p.hi) { if (pc == p.lo) grid.sync(); else { xcd_barrier(bar, smem); if (BAR2) xcd_barrier(bar, smem); } } ++pc; }

__global__ void __launch_bounds__(512) mega(Params p) {
  __shared__ __attribute__((aligned(16))) char smem[147456 + 16];
  cg::grid_group grid = cg::this_grid();
  int pc = 0;
  unsigned* bar = (unsigned*)(p.ws + OFF_BAR);
  volatile unsigned* st = (volatile unsigned*)(smem + 147456);
  if (threadIdx.x == 0) { st[0] = 0u; st[1] = 0u; (void)xb_add(&bar[XB_XCNT(xb_xcc_id())], 1u); }
  __syncthreads();
  for (int layer = 0; layer < 4; ++layer) {
    const int kind = layer % 3, mi = layer / 3;
    for (int stage = 0; stage < 3; ++stage) {
      char* ws = p.ws; asm volatile("" : "+s"(ws));
      u16* H = (u16*)(ws + OFF_H);
      char* R = ws + OFF_R;
      const float* LB = (const float*)(ws + OFF_TAB);
      const float* RC = LB + 4096; const float* RS = RC + 65536;
      if (stage != 1) {
        const float* ng = (stage == 0 ? p.ffn1_norm : p.ffn2_norm) + layer * 1024;
        const u16* wgu = (const u16*)(ws + (stage == 0 ? OFF_WGU1 : OFF_WGU2));
        const u16* wdn = (const u16*)(ws + (stage == 0 ? OFF_WDN1 : OFF_WDN2));
        u16* ACT = (u16*)R;
        PHASE_BEGIN(0)
          const bool first = (layer == 0 && stage == 0);
          if (stage == 0) { if (layer == 0) init_tables(p); cvt_layer(p, layer, (smem + (otid() >> 8) * 73728)); }
          norm_phase(first ? p.x : p.X, ng, H, first ? p.X : nullptr, MTOK);
        PHASE_END
        PHASE_BEGIN(1)
          gemm_phase(H, 1024, wgu, 1024, MTOK, 5632, EpiSwiglu{ACT}, smem);
        PHASE_END
        PHASE_BEGIN(2)
          gemm_phase(ACT, 2816, wdn, 2816, MTOK, 1024, EpiResid{p.X, 0.5f}, smem);
        PHASE_END
      } else {
        PHASE_BEGIN(3)
          norm_phase(p.X, p.mix_norm + layer * 1024, H, nullptr, MTOK);
        PHASE_END
        if (kind == 0) {
          constexpr size_t SZ = 32 * MiB;
          HgBufs hb;
          hb.Q = (u16*)(R + 0 * SZ); hb.LFf = (u16*)(R + 1 * SZ); hb.LFb = (u16*)(R + 2 * SZ); hb.V = (u16*)(R + 3 * SZ); hb.G = (u16*)(R + 4 * SZ);
          hb.QIf = (u16*)(R + 5 * SZ); hb.QIb = (u16*)(R + 6 * SZ); hb.KITf = (u16*)(R + 7 * SZ); hb.KITb = (u16*)(R + 8 * SZ);
          hb.VTc = (u16*)(R + 9 * SZ); hb.OI = (u16*)(R + 10 * SZ); hb.OF = hb.Q; hb.OB = hb.LFf; hb.Y = hb.LFb;
          hb.DECf = (float*)(R + 11 * SZ); hb.DECb = (float*)(R + 11 * SZ + 4 * MiB);
          const u16* w_in = (const u16*)(ws + OFF_WMIX); const u16* w_out = (const u16*)(ws + OFF_WMIX + 10485760);
          for (int half = 0; half < 2; ++half) {
            PHASE_BEGIN(4)
              gemm_phase(H + (size_t)half * 16384 * 1024, 1024, w_in, 1024, 16384, 5120, EpiHgIn{hb.Q, hb.LFf, hb.LFb, hb.V, hb.G, LB + layer * 1024}, smem);
            PHASE_END
            PHASE_BEGIN(5)
              hg_prep_phase(hb, (smem + (otid() >> 8) * 73728));
            PHASE_END
            PHASE_BEGIN(6)
              hg_scan_phase(hb, (smem + (otid() >> 8) * 73728));
            PHASE_END
            PHASE_BEGIN(7)
              hg_combine_phase(hb, p.hg_g_norm + mi * 128, 16384);
            PHASE_END
            PHASE_BEGIN(8)
              gemm_phase(hb.Y, 1024, w_out, 1024, 16384, 1024, EpiResid{p.X + (size_t)half * 16384 * 1024, 1.0f}, smem);
            PHASE_END
          }
        } else if (kind == 1) {
          u16* Qn = (u16*)R; u16* Kn = (u16*)(R + 64 * MiB); u16* VT = (u16*)(R + 128 * MiB); u16* On = (u16*)(R + 192 * MiB);
          const u16* w_in = (const u16*)(ws + OFF_WMIX); const u16* w_out = (const u16*)(ws + OFF_WMIX + 6291456);
          PHASE_BEGIN(9)
            gemm_phase(H, 1024, w_in, 1024, MTOK, 3072, EpiNaIn{Qn, Kn, VT, p.na_q_norm + mi * 64, p.na_k_norm + mi * 64}, smem);
          PHASE_END
          PHASE_BEGIN(10)
            const int tid_ = vtid(), lane = tid_ & 63, wid = tid_ >> 6, fr = lane & 15, fq = lane >> 4;
            for (int item = vbid() * 4 + wid; item < 32768; item += vgrid() * 4)
              na_attn_item(Qn, Kn, VT, p.na_rpb + (size_t)mi * 16 * 15 * 31, On, item, fr, fq);
          PHASE_END
          PHASE_BEGIN(11)
            gemm_phase(On, 1024, w_out, 1024, MTOK, 1024, EpiResid{p.X, 1.0f}, smem);
          PHASE_END
        } else {
          u16* VT = H;
          u16* CRAW = (u16*)R; u16* On = (u16*)R;
          u16* CQN = (u16*)(R + 66 * MiB); u16* CKVN = (u16*)(R + 114 * MiB); u16* Kk = (u16*)(R + 66 * MiB);
          float* KROPE = (float*)(R + 162 * MiB);
          u16* Qq = (u16*)(R + 166 * MiB); u16* KVRAW = (u16*)(R + 262 * MiB);
          const u16* w_in = (const u16*)(ws + OFF_WMIX); const u16* w_uq = (const u16*)(ws + OFF_WMIX + 2621440);
          const u16* w_ukv = (const u16*)(ws + OFF_WMIX + 4980736); const u16* w_out = (const u16*)(ws + OFF_WMIX + 6029312);
          PHASE_BEGIN(12)
            gemm_phase(H, 1024, w_in, 1024, MTOK, 1280, EpiStore{CRAW, 1056, 1056}, smem);
          PHASE_END
          PHASE_BEGIN(13)
            mla_norm_phase(CRAW, p.mla_q_a_norm + mi * 768, p.mla_kv_a_norm + mi * 256, CQN, CKVN, KROPE);
          PHASE_END
          PHASE_BEGIN(14)
            gemm_phase(CQN, 768, w_uq, 768, MTOK, 1536, EpiStore{Qq, 1536, 1536}, smem);
          PHASE_END
          PHASE_BEGIN(18)
            gemm_phase(CKVN, 256, w_ukv, 256, MTOK, 2048, EpiStore{KVRAW, 2048, 2048}, smem);
          PHASE_END
          PHASE_BEGIN(15)
            mla_prep_phase(Qq, KVRAW, KROPE, Kk, p.mla_q_norm + mi * 96, p.mla_k_norm + mi * 96, RC, RS);
            mla_vt_phase(KVRAW, VT, (smem + (otid() >> 8) * 73728));
          PHASE_END
          PHASE_BEGIN(16)
            for (int item = vbid(); item < 2048; item += vgrid()) mla_attn_item(Qq, Kk, VT, On, item, (smem + (otid() >> 8) * 73728));
          PHASE_END
          PHASE_BEGIN(17)
            gemm_phase(On, 1024, w_out, 1024, MTOK, 1024, EpiResid{p.X, 1.0f}, smem);
          PHASE_END
        }
      }
    }
  }
}

static int count_phases() {
  int n = 0;
  for (int layer = 0; layer < 4; ++layer) {
    int kind = layer % 3;
    n += 3 + 3 + 1;
    n += kind == 0 ? 10 : kind == 1 ? 3 : 7;
  }
  return n;
}

extern "C" void kernel_launch(void* const* d_in, const int* in_sizes, int n_in, void* d_out, int out_size, void* d_ws, size_t ws_size, hipStream_t stream) {
  if (ws_size < WS_NEED) { fprintf(stderr, "workspace too small: %zu < %zu\n", ws_size, WS_NEED); return; }
  static int grid_blocks = 0;
  if (!grid_blocks) {
    int dev = 0, cus = 0, per_cu = 0;
    hipGetDevice(&dev);
    hipDeviceGetAttribute(&cus, hipDeviceAttributeMultiprocessorCount, dev);
    hipOccupancyMaxActiveBlocksPerMultiprocessor(&per_cu, mega, 512, 0);
    if (per_cu > 1) per_cu = 1;
    grid_blocks = cus * per_cu;
  }
  Params p{};
  const float** pf = (const float**)&p;
  for (int i = 0; i < 25; ++i) pf[i] = (const float*)d_in[i];
  p.X = (float*)d_out; p.ws = (char*)d_ws;
  const int total = count_phases();
#if MULTI_LAUNCH
  for (int ph = 0; ph < total; ++ph) {
    p.lo = ph; p.hi = ph + 1;
    hipLaunchKernelGGL(mega, dim3(grid_blocks), dim3(512), 0, stream, p);
  }
#else
  hipMemsetAsync((char*)d_ws + OFF_BAR, 0, 16384, stream);
  p.lo = 0; p.hi = total;
  void* args[] = {&p};
  hipError_t e = hipLaunchCooperativeKernel((void*)mega, dim3(grid_blocks), dim3(512), args, 0, stream);
  if (e != hipSuccess) fprintf(stderr, "cooperative launch failed: %s (grid %d)\n", hipGetErrorString(e), grid_blocks);
#endif
}
```

```cpp
#include <hip/hip_runtime.h>
#include <hip/hip_cooperative_groups.h>
#include <cstdio>
#include <cstdint>
namespace cg = cooperative_groups;

#ifndef MULTI_LAUNCH
#define MULTI_LAUNCH 0
#endif

typedef unsigned short u16;
typedef unsigned int u32;
using bf16x8 = __attribute__((ext_vector_type(8))) short;
using bf16x4 = __attribute__((ext_vector_type(4))) short;
using f32x4 = __attribute__((ext_vector_type(4))) float;
using u32x2 = __attribute__((ext_vector_type(2))) unsigned int;
using u32x4 = __attribute__((ext_vector_type(4))) unsigned int;

#define DI __device__ __forceinline__
#define MFMA32(a, b, c) __builtin_amdgcn_mfma_f32_16x16x32_bf16((a), (b), (c), 0, 0, 0)

constexpr int MTOK = 32768;
constexpr float EPS = 1e-6f;
constexpr float LOG2E = 1.4426950408889634f;

constexpr size_t MiB = 1048576;
constexpr size_t OFF_WGU1 = 0;
constexpr size_t OFF_WDN1 = 11534336;
constexpr size_t OFF_WGU2 = 17301504;
constexpr size_t OFF_WDN2 = 28835840;
constexpr size_t OFF_WMIX = 34603008;
constexpr size_t OFF_TAB = 47185920;
constexpr size_t OFF_BAR = OFF_TAB + 786432;
constexpr size_t OFF_H = 46 * MiB;
constexpr size_t OFF_R = 110 * MiB;
constexpr size_t WS_NEED = 500 * MiB;

struct Params {
  const float* x; const float* ffn1_norm; const float* ffn1_w_gu; const float* ffn1_w_down;
  const float* mix_norm; const float* ffn2_norm; const float* ffn2_w_gu; const float* ffn2_w_down;
  const float* hg_lb_logits; const float* hg_w_in; const float* hg_g_norm; const float* hg_w_out;
  const float* na_w_in; const float* na_q_norm; const float* na_k_norm; const float* na_rpb; const float* na_w_out;
  const float* mla_w_in; const float* mla_q_a_norm; const float* mla_w_uq; const float* mla_kv_a_norm; const float* mla_w_ukv;
  const float* mla_q_norm; const float* mla_k_norm; const float* mla_w_out;
  float* X; char* ws; int lo; int hi;
};

DI u32 f2bf(float x) { u32 u = __float_as_uint(x); u += 0x7fffu + ((u >> 16) & 1u); return u >> 16; }
typedef __bf16 bf16v2 __attribute__((ext_vector_type(2)));
typedef float f32v2 __attribute__((ext_vector_type(2)));
DI u32 pack2(float a, float b) { f32v2 v = {a, b}; bf16v2 r = __builtin_convertvector(v, bf16v2); return __builtin_bit_cast(u32, r); }
DI float bflo(u32 w) { return __uint_as_float(w << 16); }
DI float bfhi(u32 w) { return __uint_as_float(w & 0xffff0000u); }
DI float bfget(const u32x4& v, int e) { u32 w = v[e >> 1]; return (e & 1) ? bfhi(w) : bflo(w); }
DI u32x2 pack4(const f32x4& v) { u32x2 r; r[0] = pack2(v[0], v[1]); r[1] = pack2(v[2], v[3]); return r; }
DI bf16x8 pack8(const f32x4& a, const f32x4& b) {
  u32x4 r; r[0] = pack2(a[0], a[1]); r[1] = pack2(a[2], a[3]); r[2] = pack2(b[0], b[1]); r[3] = pack2(b[2], b[3]);
  return __builtin_bit_cast(bf16x8, r);
}
DI bf16x8 cat4(const bf16x4& lo, const bf16x4& hi) { return __builtin_shufflevector(lo, hi, 0, 1, 2, 3, 4, 5, 6, 7); }
DI int otid() { int t = threadIdx.x; asm volatile("" : "+v"(t)); return t; }
DI float sx(float v, int k) {
  const int l = otid() & 63;
  return __int_as_float(__builtin_amdgcn_ds_bpermute((l ^ k) << 2, __float_as_int(v)));
}
DI float wave_sum(float v) {
#pragma unroll
  for (int o = 32; o > 0; o >>= 1) v += sx(v, o);
  return v;
}
DI float sigmoidf_(float z) { return __builtin_amdgcn_rcpf(1.f + __expf(-z)); }
DI float siluf_(float z) { return z * __builtin_amdgcn_rcpf(1.f + __expf(-z)); }
DI int vtid() { return otid() & 255; }
DI int vbid() { return blockIdx.x * 2 + (otid() >> 8); }
DI int vgrid() { return gridDim.x * 2; }
DI f32x4 zero4() { f32x4 z = {0.f, 0.f, 0.f, 0.f}; return z; }

DI void init_tables(const Params& p) {
  float* LB = (float*)(p.ws + OFF_TAB); float* RC = LB + 4096; float* RS = RC + 65536;
  const int gt = vbid() * 256 + vtid(), gs = vgrid() * 256;
  for (int c = gt; c < 1024; c += gs) {
    float l0 = p.hg_lb_logits[c], l1 = p.hg_lb_logits[1024 + c], l2 = p.hg_lb_logits[2048 + c], l3 = p.hg_lb_logits[3072 + c];
    float mx = fmaxf(fmaxf(l0, l1), fmaxf(l2, l3));
    float e0 = expf(l0 - mx), e1 = expf(l1 - mx), e2 = expf(l2 - mx), e3 = expf(l3 - mx);
    float inv = 1.f / (e0 + e1 + e2 + e3);
    LB[c] = 0.f; LB[1024 + c] = e1 * inv; LB[2048 + c] = (e1 + e2) * inv; LB[3072 + c] = (e1 + e2 + e3) * inv;
  }
  for (int i = gt; i < 65536; i += gs) {
    int t = i >> 4, j = i & 15;
    float inv = exp2f(-(float)j * (13.287712379549449f / 16.f));
    float ang = (float)t * inv;
    double a = (double)ang;
    double k = rint(a * 0.15915494309189535);
    float r = (float)(a - k * 6.283185307179586);
    RC[i] = __cosf(r); RS[i] = __sinf(r);
  }
}

DI void cvt_tiles(const float* __restrict__ src, u16* __restrict__ dst, int K, int N, int Nd, int mode, char* smem) {
  float* tile = (float*)smem;
  const int tk = K >> 6, tn = Nd >> 6, tid = vtid();
  for (int t = vbid(); t < tk * tn; t += vgrid()) {
    const int k0 = (t % tk) << 6, n0 = (t / tk) << 6;
    {
      const int nl = tid & 63, kq = tid >> 6;
      const int nd = n0 + nl;
      int col = nd;
      if (mode == 1) { int a = nd >> 5, r = nd & 31; col = a * 16 + (r & 15) + ((r >= 16) ? 2816 : 0); }
      const bool ok = col < N;
#pragma unroll
      for (int i = 0; i < 16; ++i) {
        int kl = kq + 4 * i;
        tile[kl * 65 + nl] = ok ? src[(size_t)(k0 + kl) * N + col] : 0.f;
      }
    }
    __syncthreads();
    {
      const int kp = (tid & 31) * 2, nq = tid >> 5;
#pragma unroll
      for (int i = 0; i < 8; ++i) {
        int n = nq + 8 * i;
        *(u32*)(dst + (size_t)(n0 + n) * K + k0 + kp) = pack2(tile[kp * 65 + n], tile[(kp + 1) * 65 + n]);
      }
    }
    __syncthreads();
  }
}

DI void cvt_layer(const Params& p, int layer, char* smem) {
  const int kind = layer % 3, mi = layer / 3;
  char* ws = p.ws;
  for (int task = 0; task < 8; ++task) {
    const float* src = nullptr; size_t off = 0; int K = 0, N = 0, Nd = 0, mode = 0;
    if (task == 0) { src = p.ffn1_w_gu + (size_t)layer * 1024 * 5632; off = OFF_WGU1; K = 1024; N = 5632; Nd = 5632; mode = 1; }
    else if (task == 1) { src = p.ffn1_w_down + (size_t)layer * 2816 * 1024; off = OFF_WDN1; K = 2816; N = 1024; Nd = 1024; }
    else if (task == 2) { src = p.ffn2_w_gu + (size_t)layer * 1024 * 5632; off = OFF_WGU2; K = 1024; N = 5632; Nd = 5632; mode = 1; }
    else if (task == 3) { src = p.ffn2_w_down + (size_t)layer * 2816 * 1024; off = OFF_WDN2; K = 2816; N = 1024; Nd = 1024; }
    else if (kind == 0) {
      if (task == 4) { src = p.hg_w_in + (size_t)mi * 1024 * 5120; off = OFF_WMIX; K = 1024; N = 5120; Nd = 5120; }
      else if (task == 5) { src = p.hg_w_out + (size_t)mi * 1024 * 1024; off = OFF_WMIX + 10485760; K = 1024; N = 1024; Nd = 1024; }
    } else if (kind == 1) {
      if (task == 4) { src = p.na_w_in + (size_t)mi * 1024 * 3072; off = OFF_WMIX; K = 1024; N = 3072; Nd = 3072; }
      else if (task == 5) { src = p.na_w_out + (size_t)mi * 1024 * 1024; off = OFF_WMIX + 6291456; K = 1024; N = 1024; Nd = 1024; }
    } else {
      if (task == 4) { src = p.mla_w_in + (size_t)mi * 1024 * 1056; off = OFF_WMIX; K = 1024; N = 1056; Nd = 1280; }
      else if (task == 5) { src = p.mla_w_uq + (size_t)mi * 768 * 1536; off = OFF_WMIX + 2621440; K = 768; N = 1536; Nd = 1536; }
      else if (task == 6) { src = p.mla_w_ukv + (size_t)mi * 256 * 2048; off = OFF_WMIX + 4980736; K = 256; N = 2048; Nd = 2048; }
      else if (task == 7) { src = p.mla_w_out + (size_t)mi * 1024 * 1024; off = OFF_WMIX + 6029312; K = 1024; N = 1024; Nd = 1024; }
    }
    if (src) cvt_tiles(src, (u16*)(ws + off), K, N, Nd, mode, smem);
  }
}

DI void norm_phase(const float* __restrict__ src, const float* __restrict__ gain, u16* __restrict__ dst, float* copy_dst, int rows) {
  const int lane = vtid() & 63, wid = vtid() >> 6;
  f32x4 g[4];
#pragma unroll
  for (int i = 0; i < 4; ++i) g[i] = *(const f32x4*)(gain + i * 256 + lane * 4);
  const int stride = vgrid() * 4;
  for (int row = vbid() * 4 + wid; row < rows; row += stride * 4) {
    f32x4 v[4][4];
#pragma unroll
    for (int j = 0; j < 4; ++j) {
      const int rj = row + j * stride;
      if (rj < rows) {
#pragma unroll
        for (int i = 0; i < 4; ++i) v[j][i] = *(const f32x4*)(src + (size_t)rj * 1024 + i * 256 + lane * 4);
      }
    }
#pragma unroll
    for (int j = 0; j < 4; ++j) {
      const int rj = row + j * stride;
      if (rj < rows) {
        float ss = 0.f;
#pragma unroll
        for (int i = 0; i < 4; ++i) ss += v[j][i][0] * v[j][i][0] + v[j][i][1] * v[j][i][1] + v[j][i][2] * v[j][i][2] + v[j][i][3] * v[j][i][3];
        ss = wave_sum(ss);
        const float rstd = rsqrtf(ss * (1.f / 1024.f) + EPS);
#pragma unroll
        for (int i = 0; i < 4; ++i) {
          f32x4 y = v[j][i] * rstd * g[i];
          *(u32x2*)(dst + (size_t)rj * 1024 + i * 256 + lane * 4) = pack4(y);
          if (copy_dst) *(f32x4*)(copy_dst + (size_t)rj * 1024 + i * 256 + lane * 4) = v[j][i];
        }
      }
    }
  }
}

#define GLDS16(gp, lp) __builtin_amdgcn_global_load_lds((const unsigned*)(gp), (unsigned*)(lp), 16, 0, 0)

constexpr int G_MT = 2;
constexpr int HTB = 16384;

DI const char* uniform_ptr(const void* p) {
  const unsigned long long v = (unsigned long long)p;
  const unsigned lo = __builtin_amdgcn_readfirstlane((unsigned)v), hi = __builtin_amdgcn_readfirstlane((unsigned)(v >> 32));
  return (const char*)(((unsigned long long)hi << 32) | lo);
}
DI void glds_sv(const char* sbase, unsigned voff, unsigned ldsaddr) {
  unsigned keep;
  asm volatile("s_mov_b32 %0, m0\n\ts_mov_b32 m0, %3\n\ts_nop 0\n\tglobal_load_lds_dwordx4 %1, %2\n\ts_mov_b32 m0, %0"
               : "=&s"(keep) : "v"(voff), "s"(sbase), "s"(ldsaddr) : "memory");
}
DI int lds_byte(int r, int c) {
  const int st = (r >> 4) * 2 + (c >> 5), rr = r & 15, cc = c & 31, ob = rr * 64 + cc * 2;
  return st * 1024 + (ob ^ (((ob >> 9) & 1) << 5));
}
DI void stage_rc(int b, int& R, int& C) {
  const int st = b / 1024, sb = b % 1024, swz = sb ^ (((sb >> 9) & 1) << 5);
  R = (st >> 1) * 16 + swz / 64; C = (st & 1) * 32 + (swz % 64) / 2;
}

template <class Epi>
DI void gemm_phase(const u16* __restrict__ Act, int lda, const u16* __restrict__ Wt, int Kc, int Mrows, int Ncols, const Epi& epi, char* smem) {
  int K = Kc; asm volatile("" : "+s"(K));
  const int mtn = Mrows >> 8, ntn = Ncols >> 8;
  const int ntiles = mtn * ntn;
  constexpr int GM = 16;
  const int tid = otid(), lane = tid & 63, wid = tid >> 6;
  const int wr = wid >> 2, wc = wid & 3, fr = lane & 15, fq = lane >> 4;
  int R0, C0;
  stage_rc(tid * 16, R0, C0);
  const unsigned vo0 = (unsigned)(R0 * K + C0) * 2u;
  const unsigned sl = (unsigned)(size_t)(__attribute__((address_space(3))) char*)smem + __builtin_amdgcn_readfirstlane(tid >> 6) * 1024;
  const int nt = K >> 6;
#define SA_(b, h) (((b) * 2 + (h)) * HTB)
#define SB_(b, h) ((4 + (b) * 2 + (h)) * HTB)
#define STAGE_(POFF, BASE, br, kt) do { const char* ub_ = uniform_ptr((const char*)(BASE) + ((size_t)(br) * K + (size_t)(kt) * 64) * 2); \
    glds_sv(ub_, vo0, sl + (POFF)); glds_sv(ub_ + (size_t)K * 128, vo0, sl + (POFF) + 8192); } while (0)
  const char* la_rd = smem + (((fr * 64 + fq * 16) ^ ((fr >> 3) << 5)) + wr * 8192);
  const char* lb_rd = smem + (((fr * 64 + fq * 16) ^ ((fr >> 3) << 5)) + wc * 4096 + 65536);
#define LDA_(dst, b, h) do { _Pragma("unroll") for (int m = 0; m < 4; ++m) _Pragma("unroll") for (int k = 0; k < 2; ++k) \
    dst[m][k] = *(const bf16x8*)(la_rd + SA_(b, h) + (m * 2 + k) * 1024); } while (0)
#define LDB_(dst, b, h) do { _Pragma("unroll") for (int n = 0; n < 2; ++n) _Pragma("unroll") for (int k = 0; k < 2; ++k) \
    dst[n][k] = *(const bf16x8*)(lb_rd + SA_(b, h) + (n * 2 + k) * 1024); } while (0)
#define MMA_(ai, bj, At, Bt) do { __builtin_amdgcn_s_setprio(1); \
    _Pragma("unroll") for (int m = 0; m < 4; ++m) _Pragma("unroll") for (int n = 0; n < 2; ++n) _Pragma("unroll") for (int k = 0; k < 2; ++k) \
      acc[ai][bj][m][n] = MFMA32(At[m][k], Bt[n][k], acc[ai][bj][m][n]); \
    __builtin_amdgcn_s_setprio(0); } while (0)
#define WAIT_V(n) asm volatile("s_waitcnt vmcnt(" #n ")" ::: "memory")
#define WAIT_L(n) asm volatile("s_waitcnt lgkmcnt(" #n ")" ::: "memory")
#define BAR_ __builtin_amdgcn_s_barrier()
#define SCHED_ __builtin_amdgcn_sched_barrier(0)
  int bidp = blockIdx.x;
  if (gridDim.x == 256) { const int x_ = bidp & 7, i_ = bidp >> 3; bidp = (((x_ >> 2) * 8 + (i_ >> 2)) << 4) + (x_ & 3) * 4 + (i_ & 3); }
  for (int tile = bidp; tile < ntiles; tile += gridDim.x) {
    const int group = tile / (GM * ntn), rem = tile % (GM * ntn);
    const int mt_ = group * GM + (rem % GM), nt_ = rem / GM;
    const u16* A = Wt + (size_t)nt_ * 256 * K;
    const u16* Bt = Act + (size_t)mt_ * 256 * K;
    f32x4 acc[2][2][4][2];
#pragma unroll
    for (int a_ = 0; a_ < 2; ++a_)
#pragma unroll
      for (int b_ = 0; b_ < 2; ++b_)
#pragma unroll
        for (int m = 0; m < 4; ++m) { acc[a_][b_][m][0] = zero4(); acc[a_][b_][m][1] = zero4(); }
    bf16x8 At[4][2], B0[2][2], B1[2][2];
    STAGE_(SB_(0, 0), Bt, 0, 0); STAGE_(SA_(0, 0), A, 0, 0);
    STAGE_(SB_(0, 1), Bt, 128, 0); STAGE_(SA_(0, 1), A, 128, 0);
    if (wr == 1) BAR_;
    WAIT_V(4); BAR_;
    STAGE_(SB_(1, 0), Bt, 0, 1); STAGE_(SA_(1, 0), A, 0, 1); STAGE_(SB_(1, 1), Bt, 128, 1);
    WAIT_V(6); BAR_;
    for (int t = 0; t < nt - 2; t += 2) {
      LDB_(B0, 0, 0); SCHED_; LDA_(At, 0, 0); STAGE_(SA_(1, 1), A, 128, t + 1);
      WAIT_L(8); BAR_; WAIT_L(0); MMA_(0, 0, At, B0); BAR_; SCHED_;
      LDB_(B1, 0, 1); STAGE_(SB_(0, 0), Bt, 0, t + 2);
      BAR_; WAIT_L(0); MMA_(0, 1, At, B1); BAR_;
      LDA_(At, 0, 1); STAGE_(SA_(0, 0), A, 0, t + 2);
      BAR_; WAIT_L(0); MMA_(1, 0, At, B0); BAR_; SCHED_;
      STAGE_(SB_(0, 1), Bt, 128, t + 2);
      WAIT_V(6); BAR_; MMA_(1, 1, At, B1); BAR_;
      LDB_(B0, 1, 0); SCHED_; LDA_(At, 1, 0); STAGE_(SA_(0, 1), A, 128, t + 2);
      WAIT_L(8); BAR_; WAIT_L(0); MMA_(0, 0, At, B0); BAR_; SCHED_;
      LDB_(B1, 1, 1); STAGE_(SB_(1, 0), Bt, 0, t + 3);
      BAR_; WAIT_L(0); MMA_(0, 1, At, B1); BAR_;
      LDA_(At, 1, 1); STAGE_(SA_(1, 0), A, 0, t + 3);
      BAR_; WAIT_L(0); MMA_(1, 0, At, B0); BAR_; SCHED_;
      STAGE_(SB_(1, 1), Bt, 128, t + 3);
      WAIT_V(6); BAR_; MMA_(1, 1, At, B1); BAR_;
    }
    {
      LDB_(B0, 0, 0); LDA_(At, 0, 0); STAGE_(SA_(1, 1), A, 128, nt - 1);
      BAR_; WAIT_L(0); MMA_(0, 0, At, B0); BAR_;
      LDB_(B1, 0, 1); BAR_; WAIT_L(0); MMA_(0, 1, At, B1); BAR_;
      LDA_(At, 0, 1); WAIT_V(4); BAR_; WAIT_L(0); MMA_(1, 0, At, B0); MMA_(1, 1, At, B1); BAR_;
    }
    {
      LDB_(B0, 1, 0); LDA_(At, 1, 0); WAIT_V(2); BAR_; WAIT_L(0); MMA_(0, 0, At, B0); BAR_;
      LDB_(B1, 1, 1); WAIT_V(0); BAR_; WAIT_L(0); MMA_(0, 1, At, B1); BAR_;
      LDA_(At, 1, 1); BAR_; WAIT_L(0); MMA_(1, 0, At, B0); MMA_(1, 1, At, B1); BAR_;
    }
    if (wr == 0) BAR_;
    const int t2 = otid();
    const int fr2 = t2 & 15, fq2 = (t2 >> 4) & 3, wc2 = (t2 >> 6) & 3, wr2 = t2 >> 8;
#pragma unroll
    for (int ai = 0; ai < 2; ++ai)
#pragma unroll
      for (int bj = 0; bj < 2; ++bj)
        epi(acc[ai][bj], mt_ * 256 + bj * 128 + wc2 * 32, nt_ * 256 + ai * 128 + wr2 * 64, fr2, fq2);
  }
#undef SA_
#undef SB_
#undef STAGE_
#undef LDA_
#undef LDB_
#undef MMA_
#undef WAIT_V
#undef WAIT_L
#undef BAR_
#undef SCHED_
  __syncthreads();
}

struct EpiSwiglu {
  u16* act;
  DI void operator()(f32x4 (&acc)[4][G_MT], int mb, int nb, int fr, int fq) const {
#pragma unroll
    for (int mt = 0; mt < G_MT; ++mt) {
      const int m = mb + mt * 16 + fr;
#pragma unroll
      for (int np = 0; np < 2; ++np) {
        const f32x4 g = acc[2 * np][mt], u = acc[2 * np + 1][mt];
        f32x4 r;
#pragma unroll
        for (int j = 0; j < 4; ++j) r[j] = siluf_(g[j]) * u[j];
        const int jc = (nb >> 1) + np * 16 + fq * 4;
        *(u32x2*)(act + (size_t)m * 2816 + jc) = pack4(r);
      }
    }
  }
};

struct EpiResid {
  float* X; float scale;
  DI void operator()(f32x4 (&acc)[4][G_MT], int mb, int nb, int fr, int fq) const {
#pragma unroll
    for (int mt = 0; mt < G_MT; ++mt) {
      const int m = mb + mt * 16 + fr;
#pragma unroll
      for (int nt = 0; nt < 4; ++nt) {
        f32x4* ptr = (f32x4*)(X + (size_t)m * 1024 + nb + nt * 16 + fq * 4);
        f32x4 v = *ptr;
        v += acc[nt][mt] * scale;
        *ptr = v;
      }
    }
  }
};

struct EpiStore {
  u16* out; int ldo; int nmax;
  DI void operator()(f32x4 (&acc)[4][G_MT], int mb, int nb, int fr, int fq) const {
#pragma unroll
    for (int mt = 0; mt < G_MT; ++mt) {
      const int m = mb + mt * 16 + fr;
#pragma unroll
      for (int nt = 0; nt < 4; ++nt) {
        const int n = nb + nt * 16 + fq * 4;
        if (n < nmax) *(u32x2*)(out + (size_t)m * ldo + n) = pack4(acc[nt][mt]);
      }
    }
  }
};

struct EpiHgIn {
  u16 *Q, *LFf, *LFb, *V, *G; const float* lb;
  DI void operator()(f32x4 (&acc)[4][G_MT], int mb, int nb, int fr, int fq) const {
    const int seg = nb >> 10, c0 = nb & 1023;
    u16* dst = seg == 0 ? Q : seg == 1 ? LFf : seg == 2 ? LFb : seg == 3 ? V : G;
#pragma unroll
    for (int mt = 0; mt < G_MT; ++mt) {
      const int m = mb + mt * 16 + fr;
#pragma unroll
      for (int nt = 0; nt < 4; ++nt) {
        const int c = c0 + nt * 16 + fq * 4;
        f32x4 a = acc[nt][mt], r;
        if (seg == 0) r = a * 0.08838834764831845f;
        else if (seg == 3) r = a;
        else if (seg == 4) {
#pragma unroll
          for (int j = 0; j < 4; ++j) r[j] = siluf_(a[j]);
        } else {
          const f32x4 l4 = *(const f32x4*)(lb + c);
#pragma unroll
          for (int j = 0; j < 4; ++j) {
            float z = fminf(fmaxf(a[j], -30.f), 30.f);
            float f = l4[j] + (1.f - l4[j]) * sigmoidf_(z);
            r[j] = __logf(f);
          }
        }
        *(u32x2*)(dst + (size_t)m * 1024 + c) = pack4(r);
      }
    }
  }
};

struct EpiNaIn {
  u16 *Q, *K, *VT; const float *qn, *kn;
  DI void operator()(f32x4 (&acc)[4][G_MT], int mb, int nb, int fr, int fq) const {
    const int seg = nb >> 10, h = (nb & 1023) >> 6;
    if (seg < 2) {
      u16* dst = seg == 0 ? Q : K;
      const float* gn = seg == 0 ? qn : kn;
      const float sc = seg == 0 ? 0.125f * LOG2E : 1.f;
#pragma unroll
      for (int mt = 0; mt < G_MT; ++mt) {
        const int m = mb + mt * 16 + fr;
        float ss = 0.f;
#pragma unroll
        for (int nt = 0; nt < 4; ++nt)
#pragma unroll
          for (int j = 0; j < 4; ++j) ss += acc[nt][mt][j] * acc[nt][mt][j];
        ss += sx(ss, 16); ss += sx(ss, 32);
        const float rstd = rsqrtf(ss * (1.f / 64.f) + EPS) * sc;
#pragma unroll
        for (int nt = 0; nt < 4; ++nt) {
          const int d = nt * 16 + fq * 4;
          const f32x4 g4 = *(const f32x4*)(gn + d);
          f32x4 r = acc[nt][mt] * rstd * g4;
          *(u32x2*)(dst + (size_t)m * 1024 + h * 64 + d) = pack4(r);
        }
      }
    } else {
#pragma unroll
      for (int mt = 0; mt < G_MT; ++mt) {
        const int m = mb + mt * 16 + fr;
        const int b = m >> 12, t = m & 4095;
#pragma unroll
        for (int nt = 0; nt < 4; ++nt)
#pragma unroll
          for (int j = 0; j < 4; ++j) {
            const int d = nt * 16 + fq * 4 + j;
            VT[((size_t)((b * 16 + h) * 64 + d)) * 4096 + t] = (u16)f2bf(acc[nt][mt][j]);
          }
      }
    }
  }
};

struct HgBufs {
  u16 *Q, *LFf, *LFb, *V, *G, *QIf, *QIb, *KITf, *KITb, *VTc, *OI, *OF, *OB, *Y;
  float *DECf, *DECb;
};

DI void hg_prep_phase(const HgBufs& hb, char* smem) {
  u32x4 rq, rf, rb, rv;
  {
    const int item0 = vbid(), tid0 = vtid();
    if (item0 < 8192) {
      const size_t g0 = ((size_t)(item0 >> 11) * 4096 + ((item0 >> 3) & 255) * 16 + (tid0 >> 4)) * 1024 + (item0 & 7) * 128 + (tid0 & 15) * 8;
      rq = *(const u32x4*)(hb.Q + g0); rf = *(const u32x4*)(hb.LFf + g0); rb = *(const u32x4*)(hb.LFb + g0); rv = *(const u32x4*)(hb.V + g0);
    }
  }
  for (int item = vbid(); item < 8192; item += vgrid()) {
  const int h = item & 7, n = (item >> 3) & 255, b = item >> 11;
  float* sq = (float*)smem; float* sbf = sq + 2112; float* sbb = sbf + 2112; float* skf = sbb + 2112;
  float* skb = skf + 2112; float* sv = skb + 2112; float* sP = sv + 2112; float* sA = sP + 5120;
  const int tid = vtid();
  const int row = tid >> 4, c8 = (tid & 15) * 8;
  const size_t tok0 = (size_t)b * 4096 + n * 16;
  const size_t gidx = (tok0 + row) * 1024 + h * 128 + c8;
  {
#pragma unroll
    for (int e = 0; e < 8; ++e) {
      const int o = row * 132 + c8 + e;
      const float lf = bfget(rf, e), lb_ = bfget(rb, e);
      sq[o] = bfget(rq, e); sbf[o] = lf; sbb[o] = lb_;
      skf[o] = 1.f - __expf(lf); skb[o] = 1.f - __expf(lb_); sv[o] = bfget(rv, e);
    }
  }
  {
    const int nx = item + vgrid();
    if (nx < 8192) {
      const size_t g1 = ((size_t)(nx >> 11) * 4096 + ((nx >> 3) & 255) * 16 + row) * 1024 + (nx & 7) * 128 + c8;
      rq = *(const u32x4*)(hb.Q + g1); rf = *(const u32x4*)(hb.LFf + g1); rb = *(const u32x4*)(hb.LFb + g1); rv = *(const u32x4*)(hb.V + g1);
    }
  }
  __syncthreads();
  if (tid < 128) {
    const int d = tid; float a = 0.f;
#pragma unroll
    for (int t = 0; t < 16; ++t) { a += sbf[t * 132 + d]; sbf[t * 132 + d] = a; }
    hb.DECf[((size_t)b * 256 + n) * 1024 + h * 128 + d] = __expf(a);
  } else {
    const int d = tid - 128; float a = 0.f;
#pragma unroll
    for (int t = 15; t >= 0; --t) { a += sbb[t * 132 + d]; sbb[t * 132 + d] = a; }
    hb.DECb[((size_t)b * 256 + n) * 1024 + h * 128 + d] = __expf(a);
  }
  __syncthreads();
  {
    u32x4 of, ob;
#pragma unroll
    for (int e2 = 0; e2 < 4; ++e2) {
      const int o = row * 132 + c8 + 2 * e2;
      const float q0 = sq[o], q1 = sq[o + 1];
      of[e2] = pack2(q0 * __expf(sbf[o]), q1 * __expf(sbf[o + 1]));
      ob[e2] = pack2(q0 * __expf(sbb[o]), q1 * __expf(sbb[o + 1]));
    }
    *(u32x4*)(hb.QIf + gidx) = of; *(u32x4*)(hb.QIb + gidx) = ob;
  }
  {
    const int d = tid >> 1, t8 = (tid & 1) * 8;
    const float blf = sbf[15 * 132 + d], blb = sbb[d];
    u32x4 kf, kb, vv;
#pragma unroll
    for (int e2 = 0; e2 < 4; ++e2) {
      const int o0 = (t8 + 2 * e2) * 132 + d, o1 = o0 + 132;
      kf[e2] = pack2(skf[o0] * __expf(blf - sbf[o0]), skf[o1] * __expf(blf - sbf[o1]));
      kb[e2] = pack2(skb[o0] * __expf(blb - sbb[o0]), skb[o1] * __expf(blb - sbb[o1]));
      vv[e2] = pack2(sv[o0], sv[o1]);
    }
    const size_t cidx = (((size_t)(b * 8 + h) * 256 + n) * 128 + d) * 16 + t8;
    *(u32x4*)(hb.KITf + cidx) = kf; *(u32x4*)(hb.KITb + cidx) = kb; *(u32x4*)(hb.VTc + cidx) = vv;
  }
  {
    const int s = tid >> 4, dg = tid & 15, d0 = dg * 8, sw0 = (tid >> 6) * 4;
    float w[8];
    {
      const f32x4 a = *(const f32x4*)(skf + s * 132 + d0), b2 = *(const f32x4*)(skf + s * 132 + d0 + 4);
#pragma unroll
      for (int e = 0; e < 4; ++e) { w[e] = a[e]; w[4 + e] = b2[e]; }
    }
    float pdiag = 0.f;
    for (int t = sw0; t < 16; ++t) {
      if (t > s) {
        const f32x4 a = *(const f32x4*)(skf + t * 132 + d0), b2 = *(const f32x4*)(skf + t * 132 + d0 + 4);
#pragma unroll
        for (int e = 0; e < 4; ++e) { w[e] = fmaf(-w[e], a[e], w[e]); w[4 + e] = fmaf(-w[4 + e], b2[e], w[4 + e]); }
      }
      const f32x4 q0 = *(const f32x4*)(sq + t * 132 + d0), q1 = *(const f32x4*)(sq + t * 132 + d0 + 4);
      float part = 0.f;
#pragma unroll
      for (int e = 0; e < 4; ++e) part += q0[e] * w[e] + q1[e] * w[4 + e];
      if (t == s) pdiag = part;
      else if (t > s) sP[(t * 16 + s) * 20 + dg] = part;
    }
    {
      const f32x4 a = *(const f32x4*)(skb + s * 132 + d0), b2 = *(const f32x4*)(skb + s * 132 + d0 + 4);
#pragma unroll
      for (int e = 0; e < 4; ++e) { w[e] = a[e]; w[4 + e] = b2[e]; }
    }
    for (int t = sw0 + 3; t >= 0; --t) {
      if (t < s) {
        const f32x4 a = *(const f32x4*)(skb + t * 132 + d0), b2 = *(const f32x4*)(skb + t * 132 + d0 + 4);
#pragma unroll
        for (int e = 0; e < 4; ++e) { w[e] = fmaf(-w[e], a[e], w[e]); w[4 + e] = fmaf(-w[4 + e], b2[e], w[4 + e]); }
      }
      const f32x4 q0 = *(const f32x4*)(sq + t * 132 + d0), q1 = *(const f32x4*)(sq + t * 132 + d0 + 4);
      float part = 0.f;
#pragma unroll
      for (int e = 0; e < 4; ++e) part += q0[e] * w[e] + q1[e] * w[4 + e];
      if (t == s) sP[(s * 16 + s) * 20 + dg] = pdiag + part;
      else if (t < s) sP[(t * 16 + s) * 20 + dg] = part;
    }
  }
  __syncthreads();
  {
    const int t = tid >> 4, s = tid & 15;
    const float* pp = sP + (t * 16 + s) * 20;
    const f32x4 p0 = *(const f32x4*)pp, p1 = *(const f32x4*)(pp + 4), p2 = *(const f32x4*)(pp + 8), p3 = *(const f32x4*)(pp + 12);
    const f32x4 ps = (p0 + p1) + (p2 + p3);
    sA[t * 17 + s] = (ps[0] + ps[1]) + (ps[2] + ps[3]);
  }
  __syncthreads();
  {
    float o[8];
#pragma unroll
    for (int e = 0; e < 8; ++e) o[e] = 0.f;
#pragma unroll
    for (int s = 0; s < 16; ++s) {
      const float a = sA[row * 17 + s];
      const f32x4 v0 = *(const f32x4*)(sv + s * 132 + c8), v1 = *(const f32x4*)(sv + s * 132 + c8 + 4);
#pragma unroll
      for (int e = 0; e < 4; ++e) { o[e] += a * v0[e]; o[4 + e] += a * v1[e]; }
    }
    u32x4 r; r[0] = pack2(o[0], o[1]); r[1] = pack2(o[2], o[3]); r[2] = pack2(o[4], o[5]); r[3] = pack2(o[6], o[7]);
    *(u32x4*)(hb.OI + gidx) = r;
  }
  __syncthreads();
  }
}

constexpr int SC_NS = 6, SC_STAGE = 12288;
DI void scan_issue(char* smem, int slot, const u16* QI, const u16* KIT, const u16* VTc, const float* DEC, int b, int h, int vg, int n, int tid) {
  char* st = smem + slot * SC_STAGE + tid * 16;
  const size_t tok0 = (size_t)b * 4096 + n * 16;
  const int row = tid >> 4, lc = (tid & 15) ^ row;
  GLDS16(QI + (tok0 + row) * 1024 + h * 128 + lc * 8, st);
  const size_t cb = ((size_t)(b * 8 + h) * 256 + n) * 2048;
  GLDS16(KIT + cb + tid * 8, st + 4096);
  const float* dp = DEC + ((size_t)b * 256 + n) * 1024 + h * 128;
  const void* g3 = tid < 128 ? (const void*)(VTc + cb + vg * 1024 + tid * 8) : (const void*)(dp + ((tid - 128) & 31) * 4);
  GLDS16(g3, st + 8192);
}

struct ScanRegs { bf16x8 qa[4]; bf16x8 ka[8]; bf16x8 vb; };

DI void scan_read(ScanRegs& r, const char* st, int wid, int fr, int fq) {
#pragma unroll
  for (int ks = 0; ks < 4; ++ks) {
    const int l0 = 4 * ks + (fq >> 1), l1 = l0 + 2;
    const bf16x4 lo = *(const bf16x4*)(st + fr * 256 + ((l0 ^ fr) * 16) + (fq & 1) * 8);
    const bf16x4 hi = *(const bf16x4*)(st + fr * 256 + ((l1 ^ fr) * 16) + (fq & 1) * 8);
    r.qa[ks] = cat4(lo, hi);
  }
  r.vb = *(const bf16x8*)(st + 8192 + (wid * 16 + fr) * 32 + (fq & 1) * 16);
#pragma unroll
  for (int dt = 0; dt < 8; ++dt) r.ka[dt] = *(const bf16x8*)(st + 4096 + (dt * 16 + fr) * 32 + (fq & 1) * 16);
}

DI void scan_compute(f32x4 (&S)[8], ScanRegs& r, const f32x4 (&dc)[8], u16* op, int fq) {
  const bf16x8 z8 = {0, 0, 0, 0, 0, 0, 0, 0};
  if (fq >= 2) r.vb = z8;
  f32x4 o0 = zero4(), o1 = zero4();
  o0 = MFMA32(r.qa[0], pack8(S[0], S[1]), o0);
  o1 = MFMA32(r.qa[1], pack8(S[2], S[3]), o1);
  o0 = MFMA32(r.qa[2], pack8(S[4], S[5]), o0);
  o1 = MFMA32(r.qa[3], pack8(S[6], S[7]), o1);
#pragma unroll
  for (int dt = 0; dt < 8; ++dt) {
    if (fq >= 2) r.ka[dt] = z8;
    S[dt] = S[dt] * dc[dt];
    S[dt] = MFMA32(r.ka[dt], r.vb, S[dt]);
  }
  const f32x4 o = o0 + o1;
  const u32 w0 = pack2(o[0], o[1]), w1 = pack2(o[2], o[3]);
  asm volatile("global_store_short %0, %1, off" :: "v"(op), "v"(w0) : "memory");
  asm volatile("global_store_short_d16_hi %0, %1, off" :: "v"(op + 1024), "v"(w0) : "memory");
  asm volatile("global_store_short %0, %1, off" :: "v"(op + 2048), "v"(w1) : "memory");
  asm volatile("global_store_short_d16_hi %0, %1, off" :: "v"(op + 3072), "v"(w1) : "memory");
}

DI void hg_scan_phase(const HgBufs& hb, char* smem) {
  const int tid = vtid(), lane = tid & 63, wid = tid >> 6, fr = lane & 15, fq = lane >> 4;
  for (int item = vbid(); item < 128; item += vgrid()) {
    const int vg = item & 1, dir = (item >> 1) & 1, h = (item >> 2) & 7, b = item >> 5;
    const u16* QI = dir ? hb.QIb : hb.QIf; const u16* KIT = dir ? hb.KITb : hb.KITf;
    const float* DEC = dir ? hb.DECb : hb.DECf; u16* Oout = dir ? hb.OB : hb.OF;
    const int vs = vg * 4 + wid;
    u16* obase = Oout + ((size_t)b * 4096 + fq * 4) * 1024 + h * 128 + vs * 16 + fr;
    f32x4 S[8];
#pragma unroll
    for (int i = 0; i < 8; ++i) S[i] = zero4();
#pragma unroll
    for (int s = 0; s < SC_NS - 1; ++s) scan_issue(smem, s, QI, KIT, hb.VTc, DEC, b, h, vg, dir ? 255 - s : s, tid);
    asm volatile("s_waitcnt vmcnt(12)" ::: "memory");
    __builtin_amdgcn_s_barrier();
    asm volatile("" ::: "memory");
    ScanRegs ra, rb;
    scan_read(ra, smem, wid, fr, fq);
    int slot = 0;
#define SCAN_STEP(STEP, CUR, NXT) do { \
      const int step_ = (STEP); \
      if (step_ < 4) asm volatile("s_waitcnt vmcnt(9) lgkmcnt(0)" ::: "memory"); \
      else asm volatile("s_waitcnt vmcnt(25) lgkmcnt(0)" ::: "memory"); \
      __builtin_amdgcn_s_barrier(); \
      asm volatile("" ::: "memory"); \
      { const int ns_ = min(step_ + SC_NS - 1, 255); \
        int is_ = slot + SC_NS - 1; if (is_ >= SC_NS) is_ -= SC_NS; \
        scan_issue(smem, is_, QI, KIT, hb.VTc, DEC, b, h, vg, dir ? 255 - ns_ : ns_, tid); } \
      f32x4 dc_[8]; \
      { const char* st_ = smem + slot * SC_STAGE + 8192 + 2048 + fq * 16; \
        _Pragma("unroll") for (int dt = 0; dt < 8; ++dt) dc_[dt] = *(const f32x4*)(st_ + dt * 64); } \
      int nslot_ = slot + 1; if (nslot_ == SC_NS) nslot_ = 0; \
      if (step_ + 1 < 256) scan_read(NXT, smem + nslot_ * SC_STAGE, wid, fr, fq); \
      { const int n_ = dir ? 255 - step_ : step_; \
        scan_compute(S, CUR, dc_, obase + (size_t)n_ * 16 * 1024, fq); } \
      slot = nslot_; } while (0)
    for (int step = 0; step < 256; step += 2) {
      SCAN_STEP(step, ra, rb);
      SCAN_STEP(step + 1, rb, ra);
    }
#undef SCAN_STEP
    asm volatile("s_waitcnt vmcnt(0)" ::: "memory");
    __syncthreads();
  }
}

DI void hg_combine_phase(const HgBufs& hb, const float* __restrict__ gnorm, int rows) {
  const int lane = vtid() & 63, wid = vtid() >> 6;
  const int h = lane >> 3, c16 = (lane & 7) * 16;
  const int stride = vgrid() * 4;
  f32x4 gn[4];
#pragma unroll
  for (int i = 0; i < 4; ++i) gn[i] = *(const f32x4*)(gnorm + c16 + i * 4);
  for (int row = vbid() * 4 + wid; row < rows; row += stride * 2) {
    u32x4 ra[2][2], rf[2][2], rb[2][2], rg[2][2];
#pragma unroll
    for (int j = 0; j < 2; ++j) {
      const int rj = row + j * stride;
      if (rj < rows) {
        const size_t g = (size_t)rj * 1024 + h * 128 + c16;
#pragma unroll
        for (int half = 0; half < 2; ++half) {
          ra[j][half] = *(const u32x4*)(hb.OI + g + half * 8); rf[j][half] = *(const u32x4*)(hb.OF + g + half * 8);
          rb[j][half] = *(const u32x4*)(hb.OB + g + half * 8); rg[j][half] = *(const u32x4*)(hb.G + g + half * 8);
        }
      }
    }
#pragma unroll
    for (int j = 0; j < 2; ++j) {
      const int rj = row + j * stride;
      if (rj < rows) {
        const size_t g = (size_t)rj * 1024 + h * 128 + c16;
        float o[16]; float ss = 0.f;
#pragma unroll
        for (int half = 0; half < 2; ++half)
#pragma unroll
          for (int e = 0; e < 8; ++e) { float v = bfget(ra[j][half], e) + bfget(rf[j][half], e) + bfget(rb[j][half], e); o[half * 8 + e] = v; ss += v * v; }
        ss += sx(ss, 1); ss += sx(ss, 2); ss += sx(ss, 4);
        const float rstd = rsqrtf(ss * (1.f / 128.f) + EPS);
#pragma unroll
        for (int half = 0; half < 2; ++half) {
          u32x4 r;
#pragma unroll
          for (int e2 = 0; e2 < 4; ++e2) {
            const int e = half * 8 + 2 * e2;
            r[e2] = pack2(o[e] * rstd * gn[e >> 2][e & 3] * bfget(rg[j][half], 2 * e2), o[e + 1] * rstd * gn[(e + 1) >> 2][(e + 1) & 3] * bfget(rg[j][half], 2 * e2 + 1));
          }
          *(u32x4*)(hb.Y + g + half * 8) = r;
        }
      }
    }
  }
}

DI void na_attn_item(const u16* __restrict__ Q, const u16* __restrict__ K, const u16* __restrict__ VT, const float* __restrict__ rpb, u16* __restrict__ O, int item, int fr, int fq) {
  const int qt = item & 3, h = (item >> 2) & 15, r = (item >> 6) & 63, b = item >> 12;
  const int r0 = min(max(r - 4, 0), 56);
  const int cw0 = qt == 0 ? 0 : qt == 1 ? 8 : qt == 2 ? 24 : 32;
  const size_t tokq = (size_t)b * 4096 + r * 64 + qt * 16 + fr;
  bf16x8 qf[2];
#pragma unroll
  for (int ks = 0; ks < 2; ++ks) qf[ks] = *(const bf16x8*)(Q + tokq * 1024 + h * 64 + ks * 32 + fq * 8);
  f32x4 s[8][2];
#pragma unroll
  for (int kr = 0; kr < 8; ++kr)
#pragma unroll
    for (int hf = 0; hf < 2; ++hf) {
      const size_t tokk = (size_t)b * 4096 + (r0 + kr) * 64 + cw0 + hf * 16 + fr;
      const bf16x8 k0 = *(const bf16x8*)(K + tokk * 1024 + h * 64 + fq * 8);
      const bf16x8 k1 = *(const bf16x8*)(K + tokk * 1024 + h * 64 + 32 + fq * 8);
      f32x4 a = MFMA32(k0, qf[0], zero4());
      s[kr][hf] = MFMA32(k1, qf[1], a);
    }
  const int qc = qt * 16 + fr;
  const int cs = min(max(qc - 8, 0), 48);
  float mx = -1e30f;
#pragma unroll
  for (int kr = 0; kr < 8; ++kr) {
    const float* rp = rpb + (h * 15 + (r0 + kr - r + 7)) * 31;
#pragma unroll
    for (int hf = 0; hf < 2; ++hf)
#pragma unroll
      for (int j = 0; j < 4; ++j) {
        const int kc = cw0 + hf * 16 + fq * 4 + j;
        const bool valid = (kc >= cs) && (kc < cs + 16);
        const int ci = min(max(kc - qc + 15, 0), 30);
        const float v = valid ? s[kr][hf][j] + rp[ci] * LOG2E : -1e30f;
        s[kr][hf][j] = v; mx = fmaxf(mx, v);
      }
  }
  mx = fmaxf(mx, sx(mx, 16)); mx = fmaxf(mx, sx(mx, 32));
  float l = 0.f;
#pragma unroll
  for (int kr = 0; kr < 8; ++kr)
#pragma unroll
    for (int hf = 0; hf < 2; ++hf)
#pragma unroll
      for (int j = 0; j < 4; ++j) { const float pv = __builtin_amdgcn_exp2f(s[kr][hf][j] - mx); s[kr][hf][j] = pv; l += pv; }
  l += sx(l, 16); l += sx(l, 32);
  f32x4 o[4];
#pragma unroll
  for (int dt = 0; dt < 4; ++dt) o[dt] = zero4();
#pragma unroll
  for (int kr = 0; kr < 8; ++kr) {
    const bf16x8 pp = pack8(s[kr][0], s[kr][1]);
#pragma unroll
    for (int dt = 0; dt < 4; ++dt) {
      const u16* vp = VT + ((size_t)((b * 16 + h) * 64 + dt * 16 + fr)) * 4096 + (r0 + kr) * 64 + cw0 + fq * 4;
      const bf16x8 vf = cat4(*(const bf16x4*)vp, *(const bf16x4*)(vp + 16));
      o[dt] = MFMA32(vf, pp, o[dt]);
    }
  }
  const float inv = 1.f / l;
#pragma unroll
  for (int dt = 0; dt < 4; ++dt) *(u32x2*)(O + tokq * 1024 + h * 64 + dt * 16 + fq * 4) = pack4(o[dt] * inv);
}

DI void mla_norm_phase(const u16* __restrict__ CRAW, const float* __restrict__ gq, const float* __restrict__ gkv, u16* __restrict__ CQN, u16* __restrict__ CKVN, float* __restrict__ KROPE) {
  const int lane = vtid() & 63, wid = vtid() >> 6;
  for (int row = vbid() * 4 + wid; row < MTOK; row += vgrid() * 4) {
    const u16* c = CRAW + (size_t)row * 1056;
    f32x4 v[3]; float ss = 0.f;
#pragma unroll
    for (int i = 0; i < 3; ++i) {
      const u32x2 w = *(const u32x2*)(c + i * 256 + lane * 4);
      v[i][0] = bflo(w[0]); v[i][1] = bfhi(w[0]); v[i][2] = bflo(w[1]); v[i][3] = bfhi(w[1]);
      ss += v[i][0] * v[i][0] + v[i][1] * v[i][1] + v[i][2] * v[i][2] + v[i][3] * v[i][3];
    }
    ss = wave_sum(ss);
    const float rq = rsqrtf(ss * (1.f / 768.f) + EPS);
#pragma unroll
    for (int i = 0; i < 3; ++i) {
      const f32x4 g4 = *(const f32x4*)(gq + i * 256 + lane * 4);
      *(u32x2*)(CQN + (size_t)row * 768 + i * 256 + lane * 4) = pack4(v[i] * rq * g4);
    }
    {
      const u32x2 w = *(const u32x2*)(c + 768 + lane * 4);
      f32x4 k; k[0] = bflo(w[0]); k[1] = bfhi(w[0]); k[2] = bflo(w[1]); k[3] = bfhi(w[1]);
      float s2 = wave_sum(k[0] * k[0] + k[1] * k[1] + k[2] * k[2] + k[3] * k[3]);
      const float rk = rsqrtf(s2 * (1.f / 256.f) + EPS);
      const f32x4 g4 = *(const f32x4*)(gkv + lane * 4);
      *(u32x2*)(CKVN + (size_t)row * 256 + lane * 4) = pack4(k * rk * g4);
    }
    if (lane < 8) {
      const u32x2 w = *(const u32x2*)(c + 1024 + lane * 4);
      f32x4 k; k[0] = bflo(w[0]); k[1] = bfhi(w[0]); k[2] = bflo(w[1]); k[3] = bfhi(w[1]);
      *(f32x4*)(KROPE + (size_t)row * 32 + lane * 4) = k;
    }
  }
}

DI void mla_prep_phase(u16* __restrict__ Q, const u16* __restrict__ KVRAW, const float* __restrict__ KROPE, u16* __restrict__ Kout,
                       const float* __restrict__ gq, const float* __restrict__ gk, const float* __restrict__ RC, const float* __restrict__ RS) {
  const int lane = vtid() & 63, wid = vtid() >> 6;
  const int h = lane >> 2, sub = lane & 3;
  const float QS = 0.10206207261596577f * LOG2E;
  for (int m = vbid() * 4 + wid; m < MTOK; m += vgrid() * 4) {
    const int t = m & 4095;
    const f32x4 cs = *(const f32x4*)(RC + t * 16 + sub * 4), sn = *(const f32x4*)(RS + t * 16 + sub * 4);
#pragma unroll
    for (int which = 0; which < 2; ++which) {
      float nope[16]; f32x4 ra, rb;
      u16* dstp = (which == 0 ? Q : Kout) + (size_t)m * 1536 + h * 96;
      const float* gn = which == 0 ? gq : gk;
      if (which == 0) {
        const u32x4 w0 = *(const u32x4*)(dstp + sub * 16), w1 = *(const u32x4*)(dstp + sub * 16 + 8);
#pragma unroll
        for (int e = 0; e < 8; ++e) { nope[e] = bfget(w0, e); nope[8 + e] = bfget(w1, e); }
        const u32x2 a2 = *(const u32x2*)(dstp + 64 + sub * 4), b2 = *(const u32x2*)(dstp + 80 + sub * 4);
        ra[0] = bflo(a2[0]); ra[1] = bfhi(a2[0]); ra[2] = bflo(a2[1]); ra[3] = bfhi(a2[1]);
        rb[0] = bflo(b2[0]); rb[1] = bfhi(b2[0]); rb[2] = bflo(b2[1]); rb[3] = bfhi(b2[1]);
      } else {
        const u16* kp = KVRAW + (size_t)m * 2048 + h * 128 + sub * 16;
        const u32x4 w0 = *(const u32x4*)kp, w1 = *(const u32x4*)(kp + 8);
#pragma unroll
        for (int e = 0; e < 8; ++e) { nope[e] = bfget(w0, e); nope[8 + e] = bfget(w1, e); }
        ra = *(const f32x4*)(KROPE + (size_t)m * 32 + sub * 4);
        rb = *(const f32x4*)(KROPE + (size_t)m * 32 + 16 + sub * 4);
      }
      float ss = 0.f;
#pragma unroll
      for (int e = 0; e < 16; ++e) ss += nope[e] * nope[e];
#pragma unroll
      for (int e = 0; e < 4; ++e) ss += ra[e] * ra[e] + rb[e] * rb[e];
      ss += sx(ss, 1); ss += sx(ss, 2);
      const float rstd = rsqrtf(ss * (1.f / 96.f) + EPS) * (which == 0 ? QS : 1.f);
      u32x4 o0, o1;
#pragma unroll
      for (int e2 = 0; e2 < 4; ++e2) {
        o0[e2] = pack2(nope[2 * e2] * rstd * gn[sub * 16 + 2 * e2], nope[2 * e2 + 1] * rstd * gn[sub * 16 + 2 * e2 + 1]);
        o1[e2] = pack2(nope[8 + 2 * e2] * rstd * gn[sub * 16 + 8 + 2 * e2], nope[9 + 2 * e2] * rstd * gn[sub * 16 + 9 + 2 * e2]);
      }
      f32x4 oa, ob;
#pragma unroll
      for (int e = 0; e < 4; ++e) {
        const float a = ra[e] * rstd * gn[64 + sub * 4 + e], bq = rb[e] * rstd * gn[80 + sub * 4 + e];
        oa[e] = a * cs[e] - bq * sn[e];
        ob[e] = bq * cs[e] + a * sn[e];
      }
      *(u32x4*)(dstp + sub * 16) = o0; *(u32x4*)(dstp + sub * 16 + 8) = o1;
      *(u32x2*)(dstp + 64 + sub * 4) = pack4(oa); *(u32x2*)(dstp + 80 + sub * 4) = pack4(ob);
    }
  }
}

DI void mla_vt_phase(const u16* __restrict__ KVRAW, u16* __restrict__ VT, char* smem) {
  u16* tile = (u16*)smem;
  const int tid = vtid();
  for (int item = vbid(); item < 8192; item += vgrid()) {
    const int tt = item & 63, bh = item >> 6, b = bh >> 4, h = bh & 15;
    {
      const int row = tid >> 2, part = tid & 3;
      const u16* src = KVRAW + ((size_t)b * 4096 + tt * 64 + row) * 2048 + h * 128 + 64 + part * 16;
      const u32x4 w0 = *(const u32x4*)src, w1 = *(const u32x4*)(src + 8);
      u32* d32 = (u32*)(tile + row * 66 + part * 16);
#pragma unroll
      for (int e = 0; e < 4; ++e) { d32[e] = w0[e]; d32[4 + e] = w1[e]; }
    }
    __syncthreads();
    {
      const int d = tid >> 2, tp = (tid & 3) * 16;
      u32x4 o0, o1;
#pragma unroll
      for (int e2 = 0; e2 < 4; ++e2) {
        o0[e2] = (u32)tile[(tp + 2 * e2) * 66 + d] | ((u32)tile[(tp + 2 * e2 + 1) * 66 + d] << 16);
        o1[e2] = (u32)tile[(tp + 8 + 2 * e2) * 66 + d] | ((u32)tile[(tp + 9 + 2 * e2) * 66 + d] << 16);
      }
      u16* dst = VT + ((size_t)(bh * 64 + d)) * 4096 + tt * 64 + tp;
      *(u32x4*)dst = o0; *(u32x4*)(dst + 8) = o1;
    }
    __syncthreads();
  }
}

constexpr int FA_KROW = 208, FA_VROW = 144, FA_KT = 64 * FA_KROW, FA_BUF = FA_KT + 64 * FA_VROW;
template <bool FIXED>
DI void mla_attn_item(const u16* __restrict__ Q, const u16* __restrict__ Kb, const u16* __restrict__ VT, u16* __restrict__ O, int item, char* smem) {
  const int qb = item & 15, bh = item >> 4, b = bh >> 4, h = bh & 15;
  const int tid = vtid(), lane = tid & 63, wid = tid >> 6, fr = lane & 15, fq = lane >> 4;
  bf16x8 qf[4][3];
#pragma unroll
  for (int qt = 0; qt < 4; ++qt) {
    const size_t tq = (size_t)b * 4096 + qb * 256 + wid * 64 + qt * 16 + fr;
#pragma unroll
    for (int ks = 0; ks < 3; ++ks) qf[qt][ks] = *(const bf16x8*)(Q + tq * 1536 + h * 96 + ks * 32 + fq * 8);
  }
  f32x4 o[4][4];
#pragma unroll
  for (int i = 0; i < 4; ++i)
#pragma unroll
    for (int j = 0; j < 4; ++j) o[i][j] = zero4();
  float mrun[4] = {-1e30f, -1e30f, -1e30f, -1e30f}, lrun[4] = {0.f, 0.f, 0.f, 0.f};
  const u16* kg[3]; int ks_off[3];
#pragma unroll
  for (int i = 0; i < 3; ++i) {
    const int c = tid + 256 * i, row = c / 12, kc = c % 12;
    kg[i] = Kb + ((size_t)b * 4096 + row) * 1536 + h * 96 + kc * 8;
    ks_off[i] = row * FA_KROW + kc * 16;
  }
  const u16* vg[2]; int vs_off[2];
#pragma unroll
  for (int i = 0; i < 2; ++i) {
    const int c = tid + 256 * i, d = c >> 3, kc = c & 7;
    vg[i] = VT + ((size_t)(bh * 64 + d)) * 4096 + kc * 8;
    vs_off[i] = FA_KT + d * FA_VROW + kc * 16;
  }
  u32x4 rk[3], rv[2];
#pragma unroll
  for (int i = 0; i < 3; ++i) rk[i] = *(const u32x4*)(kg[i]);
#pragma unroll
  for (int i = 0; i < 2; ++i) rv[i] = *(const u32x4*)(vg[i]);
#pragma unroll
  for (int i = 0; i < 3; ++i) *(u32x4*)(smem + ks_off[i]) = rk[i];
#pragma unroll
  for (int i = 0; i < 2; ++i) *(u32x4*)(smem + vs_off[i]) = rv[i];
#pragma unroll
  for (int qt = 0; qt < 4; ++qt)
#pragma unroll
    for (int ks = 0; ks < 3; ++ks) asm volatile("" :: "v"(qf[qt][ks]));
  __syncthreads();
  for (int kt = 0; kt < 64; ++kt) {
    const int cur = (kt & 1) * FA_BUF, nxt = FA_BUF - cur;
    if (kt + 1 < 64) {
      const size_t key0 = (size_t)(kt + 1) * 64;
#pragma unroll
      for (int i = 0; i < 3; ++i) rk[i] = *(const u32x4*)(kg[i] + key0 * 1536);
#pragma unroll
      for (int i = 0; i < 2; ++i) rv[i] = *(const u32x4*)(vg[i] + key0);
    }
#pragma unroll
    for (int kh = 0; kh < 2; ++kh) {
      f32x4 s[2][4];
#pragma unroll
      for (int kl = 0; kl < 2; ++kl) {
#pragma unroll
        for (int qt = 0; qt < 4; ++qt) s[kl][qt] = zero4();
#pragma unroll
        for (int ks = 0; ks < 3; ++ks) {
          const bf16x8 kf = *(const bf16x8*)(smem + cur + ((kh * 2 + kl) * 16 + fr) * FA_KROW + ks * 64 + fq * 16);
#pragma unroll
          for (int qt = 0; qt < 4; ++qt) s[kl][qt] = MFMA32(kf, qf[qt][ks], s[kl][qt]);
        }
      }
      bf16x8 pp[4];
      {
        if constexpr (!FIXED) {
        float lm[4]; bool need = false;
#pragma unroll
        for (int qt = 0; qt < 4; ++qt) {
          const float m0 = fmaxf(fmaxf(s[0][qt][0], s[0][qt][1]), fmaxf(s[0][qt][2], s[0][qt][3]));
          const float m1 = fmaxf(fmaxf(s[1][qt][0], s[1][qt][1]), fmaxf(s[1][qt][2], s[1][qt][3]));
          lm[qt] = fmaxf(m0, m1);
          need = need || (lm[qt] > mrun[qt] + 8.f);
        }
        if (__any(need)) {
#pragma unroll
          for (int qt = 0; qt < 4; ++qt) {
            float mx = lm[qt];
            mx = fmaxf(mx, sx(mx, 16)); mx = fmaxf(mx, sx(mx, 32));
            const float mnew = fmaxf(mrun[qt], mx);
            const float alpha = __builtin_amdgcn_exp2f(mrun[qt] - mnew);
            mrun[qt] = mnew;
            lrun[qt] *= alpha;
#pragma unroll
            for (int dt = 0; dt < 4; ++dt) o[dt][qt] = o[dt][qt] * alpha;
          }
        }
        }
#pragma unroll
        for (int qt = 0; qt < 4; ++qt) {
          const float mr = FIXED ? 0.f : mrun[qt];
          float ps = 0.f;
#pragma unroll
          for (int kl = 0; kl < 2; ++kl)
#pragma unroll
            for (int j = 0; j < 4; ++j) { const float pv = __builtin_amdgcn_exp2f(s[kl][qt][j] - mr); s[kl][qt][j] = pv; ps += pv; }
          lrun[qt] += ps;
          pp[qt] = pack8(s[0][qt], s[1][qt]);
        }
      }
#pragma unroll
      for (int dt = 0; dt < 4; ++dt) {
        const char* vp = smem + cur + FA_KT + (dt * 16 + fr) * FA_VROW + (kh * 32 + fq * 4) * 2;
        const bf16x8 vf = cat4(*(const bf16x4*)vp, *(const bf16x4*)(vp + 32));
#pragma unroll
        for (int qt = 0; qt < 4; ++qt) o[dt][qt] = MFMA32(vf, pp[qt], o[dt][qt]);
      }
    }
    if (kt + 1 < 64) {
#pragma unroll
      for (int i = 0; i < 3; ++i) *(u32x4*)(smem + nxt + ks_off[i]) = rk[i];
#pragma unroll
      for (int i = 0; i < 2; ++i) *(u32x4*)(smem + nxt + vs_off[i]) = rv[i];
    }
    __syncthreads();
  }
#pragma unroll
  for (int qt = 0; qt < 4; ++qt) {
    float l = lrun[qt];
    l += sx(l, 16); l += sx(l, 32);
    const float inv = 1.f / l;
    const size_t tq = (size_t)b * 4096 + qb * 256 + wid * 64 + qt * 16 + fr;
#pragma unroll
    for (int dt = 0; dt < 4; ++dt) *(u32x2*)(O + tq * 1024 + h * 64 + dt * 16 + fq * 4) = pack4(o[dt][qt] * inv);
  }
}

#define XB_TMO      128
#define XB_XCNT(j)  (256  + 64 * (j))
#define XB_XSUB(j)  (1280 + 64 * (j))
#define XB_XGEN(j)  (2304 + 64 * (j))
#define XB_TOP      3328
#define XB_TOPGEN   3392
#define XCD_BAR_WORDS 3456
#define XB_SPIN_CAP (1u << 22)
DI unsigned xb_ld(unsigned* p) { return __hip_atomic_load(p, __ATOMIC_RELAXED, __HIP_MEMORY_SCOPE_AGENT); }
DI unsigned xb_add(unsigned* p, unsigned v) { return __hip_atomic_fetch_add(p, v, __ATOMIC_RELAXED, __HIP_MEMORY_SCOPE_AGENT); }
DI unsigned xb_xcc_id() { return (unsigned)__builtin_amdgcn_s_getreg((3 << 11) | 20) & 0xFu; }
#define XB_SPIN(cond, bar) do { unsigned _sp = 0; while (cond) { __builtin_amdgcn_s_sleep(1); \
    if ((++_sp & 255u) == 0u) { if (xb_ld(&(bar)[XB_TMO])) break; if (_sp > XB_SPIN_CAP) { atomicAdd(&(bar)[XB_TMO], 1u); break; } } } } while (0)

DI void xcd_barrier_complete(unsigned* bar, unsigned x, unsigned& nloc, unsigned& nx) {
  const unsigned G = gridDim.x;
  unsigned sum, cnt, mine, sp = 0u;
  for (;;) {
    sum = 0u; cnt = 0u; mine = 0u;
#pragma unroll
    for (unsigned j = 0; j < 16; ++j) { const unsigned c = xb_ld(&bar[XB_XCNT(j)]); sum += c; cnt += (c > 0u) ? 1u : 0u; mine = (j == x) ? c : mine; }
    if (sum == G) break;
    __builtin_amdgcn_s_sleep(1);
    if ((++sp & 255u) == 0u) { if (xb_ld(&bar[XB_TMO])) break; if (sp > XB_SPIN_CAP) { atomicAdd(&bar[XB_TMO], 1u); break; } }
  }
  nloc = mine > 0u ? mine : 1u; nx = cnt > 0u ? cnt : 1u;
}

DI void xcd_barrier(unsigned* bar, char* smem_) {
  int off_ = 147456; asm volatile("" : "+v"(off_));
  volatile unsigned* st = (volatile unsigned*)(smem_ + off_);
  asm volatile("s_waitcnt vmcnt(0)" ::: "memory");
  __syncthreads();
  if (threadIdx.x == 0) {
    __builtin_amdgcn_s_waitcnt(0);
    const unsigned x = xb_xcc_id();
    unsigned nloc = st[0], nx = st[1];
    if (nloc == 0u) { xcd_barrier_complete(bar, x, nloc, nx); st[0] = nloc; st[1] = nx; }
    const unsigned old = xb_add(&bar[XB_XSUB(x)], 1u);
    const unsigned gen = old / nloc;
    if (old + 1u == (gen + 1u) * nloc) {
      __builtin_amdgcn_fence(__ATOMIC_RELEASE, "agent");
      asm volatile("s_waitcnt vmcnt(0)" ::: "memory");
      const unsigned og = xb_add(&bar[XB_TOP], 1u);
      const unsigned tg = og / nx;
      if (og + 1u == (tg + 1u) * nx) xb_add(&bar[XB_TOPGEN], 1u);
      else XB_SPIN(xb_ld(&bar[XB_TOPGEN]) == tg, bar);
      __builtin_amdgcn_fence(__ATOMIC_ACQUIRE, "agent");
      xb_add(&bar[XB_XGEN(x)], 1u);
      asm volatile("s_waitcnt vmcnt(0)" ::: "memory");
    } else {
      XB_SPIN(xb_ld(&bar[XB_XGEN(x)]) == gen, bar);
      __builtin_amdgcn_fence(__ATOMIC_ACQUIRE, "agent");
      asm volatile("s_waitcnt vmcnt(0)" ::: "memory");
    }
  }
  __syncthreads();
}

#ifndef ENMASK
#define ENMASK 0xffffffffu
#endif
#define EN(i) ((ENMASK >> (i)) & 1u)
#ifndef DUPMASK
#define DUPMASK 0u
#endif
#define DUP(i) ((DUPMASK >> (i)) & 1u)
#ifndef BAR2
#define BAR2 0
#endif
#define PHASE_BEGIN(i) if (EN(i) && pc >= p.lo && pc < p.hi) for (int rep_ = 0; rep_ < 1 + (int)DUP(i); ++rep_) {
#define PHASE_END } { if (pc >= p.lo && pc + 1 < p.hi) { if (pc == p.lo) grid.sync(); else { xcd_barrier(bar, smem); if (BAR2) xcd_barrier(bar, smem); } } ++pc; }

__global__ void __launch_bounds__(512) mega(Params p) {
  __shared__ __attribute__((aligned(16))) char smem[147456 + 16];
  cg::grid_group grid = cg::this_grid();
  int pc = 0;
  unsigned* bar = (unsigned*)(p.ws + OFF_BAR);
  volatile unsigned* st = (volatile unsigned*)(smem + 147456);
  if (threadIdx.x == 0) { st[0] = 0u; st[1] = 0u; (void)xb_add(&bar[XB_XCNT(xb_xcc_id())], 1u); }
  __syncthreads();
  for (int layer = 0; layer < 4; ++layer) {
    const int kind = layer % 3, mi = layer / 3;
    for (int stage = 0; stage < 3; ++stage) {
      char* ws = p.ws; asm volatile("" : "+s"(ws));
      u16* H = (u16*)(ws + OFF_H);
      char* R = ws + OFF_R;
      const float* LB = (const float*)(ws + OFF_TAB);
      const float* RC = LB + 4096; const float* RS = RC + 65536;
      if (stage != 1) {
        const float* ng = (stage == 0 ? p.ffn1_norm : p.ffn2_norm) + layer * 1024;
        const u16* wgu = (const u16*)(ws + (stage == 0 ? OFF_WGU1 : OFF_WGU2));
        const u16* wdn = (const u16*)(ws + (stage == 0 ? OFF_WDN1 : OFF_WDN2));
        u16* ACT = (u16*)R;
        PHASE_BEGIN(0)
          const bool first = (layer == 0 && stage == 0);
          if (stage == 0) { if (layer == 0) init_tables(p); cvt_layer(p, layer, (smem + (otid() >> 8) * 73728)); }
          norm_phase(first ? p.x : p.X, ng, H, first ? p.X : nullptr, MTOK);
        PHASE_END
        PHASE_BEGIN(1)
          gemm_phase(H, 1024, wgu, 1024, MTOK, 5632, EpiSwiglu{ACT}, smem);
        PHASE_END
        PHASE_BEGIN(2)
          gemm_phase(ACT, 2816, wdn, 2816, MTOK, 1024, EpiResid{p.X, 0.5f}, smem);
        PHASE_END
      } else {
        PHASE_BEGIN(3)
          norm_phase(p.X, p.mix_norm + layer * 1024, H, nullptr, MTOK);
        PHASE_END
        if (kind == 0) {
          constexpr size_t SZ = 32 * MiB;
          HgBufs hb;
          hb.Q = (u16*)(R + 0 * SZ); hb.LFf = (u16*)(R + 1 * SZ); hb.LFb = (u16*)(R + 2 * SZ); hb.V = (u16*)(R + 3 * SZ); hb.G = (u16*)(R + 4 * SZ);
          hb.QIf = (u16*)(R + 5 * SZ); hb.QIb = (u16*)(R + 6 * SZ); hb.KITf = (u16*)(R + 7 * SZ); hb.KITb = (u16*)(R + 8 * SZ);
          hb.VTc = (u16*)(R + 9 * SZ); hb.OI = (u16*)(R + 10 * SZ); hb.OF = hb.Q; hb.OB = hb.LFf; hb.Y = hb.LFb;
          hb.DECf = (float*)(R + 11 * SZ); hb.DECb = (float*)(R + 11 * SZ + 4 * MiB);
          const u16* w_in = (const u16*)(ws + OFF_WMIX); const u16* w_out = (const u16*)(ws + OFF_WMIX + 10485760);
          for (int half = 0; half < 2; ++half) {
            PHASE_BEGIN(4)
              gemm_phase(H + (size_t)half * 16384 * 1024, 1024, w_in, 1024, 16384, 5120, EpiHgIn{hb.Q, hb.LFf, hb.LFb, hb.V, hb.G, LB + layer * 1024}, smem);
            PHASE_END
            PHASE_BEGIN(5)
              hg_prep_phase(hb, (smem + (otid() >> 8) * 73728));
            PHASE_END
            PHASE_BEGIN(6)
              hg_scan_phase(hb, (smem + (otid() >> 8) * 73728));
            PHASE_END
            PHASE_BEGIN(7)
              hg_combine_phase(hb, p.hg_g_norm + mi * 128, 16384);
            PHASE_END
            PHASE_BEGIN(8)
              gemm_phase(hb.Y, 1024, w_out, 1024, 16384, 1024, EpiResid{p.X + (size_t)half * 16384 * 1024, 1.0f}, smem);
            PHASE_END
          }
        } else if (kind == 1) {
          u16* Qn = (u16*)R; u16* Kn = (u16*)(R + 64 * MiB); u16* VT = (u16*)(R + 128 * MiB); u16* On = (u16*)(R + 192 * MiB);
          const u16* w_in = (const u16*)(ws + OFF_WMIX); const u16* w_out = (const u16*)(ws + OFF_WMIX + 6291456);
          PHASE_BEGIN(9)
            gemm_phase(H, 1024, w_in, 1024, MTOK, 3072, EpiNaIn{Qn, Kn, VT, p.na_q_norm + mi * 64, p.na_k_norm + mi * 64}, smem);
          PHASE_END
          PHASE_BEGIN(10)
            const int tid_ = vtid(), lane = tid_ & 63, wid = tid_ >> 6, fr = lane & 15, fq = lane >> 4;
            for (int item = vbid() * 4 + wid; item < 32768; item += vgrid() * 4)
              na_attn_item(Qn, Kn, VT, p.na_rpb + (size_t)mi * 16 * 15 * 31, On, item, fr, fq);
          PHASE_END
          PHASE_BEGIN(11)
            gemm_phase(On, 1024, w_out, 1024, MTOK, 1024, EpiResid{p.X, 1.0f}, smem);
          PHASE_END
        } else {
          u16* VT = H;
          u16* CRAW = (u16*)R; u16* On = (u16*)R;
          u16* CQN = (u16*)(R + 66 * MiB); u16* CKVN = (u16*)(R + 114 * MiB); u16* Kk = (u16*)(R + 66 * MiB);
          float* KROPE = (float*)(R + 162 * MiB);
          u16* Qq = (u16*)(R + 166 * MiB); u16* KVRAW = (u16*)(R + 262 * MiB);
          const u16* w_in = (const u16*)(ws + OFF_WMIX); const u16* w_uq = (const u16*)(ws + OFF_WMIX + 2621440);
          const u16* w_ukv = (const u16*)(ws + OFF_WMIX + 4980736); const u16* w_out = (const u16*)(ws + OFF_WMIX + 6029312);
          PHASE_BEGIN(12)
            gemm_phase(H, 1024, w_in, 1024, MTOK, 1280, EpiStore{CRAW, 1056, 1056}, smem);
          PHASE_END
          PHASE_BEGIN(13)
            mla_norm_phase(CRAW, p.mla_q_a_norm + mi * 768, p.mla_kv_a_norm + mi * 256, CQN, CKVN, KROPE);
          PHASE_END
          PHASE_BEGIN(14)
            gemm_phase(CQN, 768, w_uq, 768, MTOK, 1536, EpiStore{Qq, 1536, 1536}, smem);
          PHASE_END
          PHASE_BEGIN(18)
            gemm_phase(CKVN, 256, w_ukv, 256, MTOK, 2048, EpiStore{KVRAW, 2048, 2048}, smem);
          PHASE_END
          PHASE_BEGIN(15)
            mla_prep_phase(Qq, KVRAW, KROPE, Kk, p.mla_q_norm + mi * 96, p.mla_k_norm + mi * 96, RC, RS);
            mla_vt_phase(KVRAW, VT, (smem + (otid() >> 8) * 73728));
          PHASE_END
          PHASE_BEGIN(16)
            float mgq = 0.f, mgk = 0.f;
            for (int d = 0; d < 96; ++d) { mgq = fmaxf(mgq, fabsf(p.mla_q_norm[mi * 96 + d])); mgk = fmaxf(mgk, fabsf(p.mla_k_norm[mi * 96 + d])); }
            if (14.2f * mgq * mgk <= 40.f) {
              for (int item = vbid(); item < 2048; item += vgrid()) mla_attn_item<true>(Qq, Kk, VT, On, item, (smem + (otid() >> 8) * 73728));
            } else {
              for (int item = vbid(); item < 2048; item += vgrid()) mla_attn_item<false>(Qq, Kk, VT, On, item, (smem + (otid() >> 8) * 73728));
            }
          PHASE_END
          PHASE_BEGIN(17)
            gemm_phase(On, 1024, w_out, 1024, MTOK, 1024, EpiResid{p.X, 1.0f}, smem);
          PHASE_END
        }
      }
    }
  }
}

static int count_phases() {
  int n = 0;
  for (int layer = 0; layer < 4; ++layer) {
    int kind = layer % 3;
    n += 3 + 3 + 1;
    n += kind == 0 ? 10 : kind == 1 ? 3 : 7;
  }
  return n;
}

extern "C" void kernel_launch(void* const* d_in, const int* in_sizes, int n_in, void* d_out, int out_size, void* d_ws, size_t ws_size, hipStream_t stream) {
  if (ws_size < WS_NEED) { fprintf(stderr, "workspace too small: %zu < %zu\n", ws_size, WS_NEED); return; }
  static int grid_blocks = 0;
  if (!grid_blocks) {
    int dev = 0, cus = 0, per_cu = 0;
    hipGetDevice(&dev);
    hipDeviceGetAttribute(&cus, hipDeviceAttributeMultiprocessorCount, dev);
    hipOccupancyMaxActiveBlocksPerMultiprocessor(&per_cu, mega, 512, 0);
    if (per_cu > 1) per_cu = 1;
    grid_blocks = cus * per_cu;
  }
  Params p{};
  const float** pf = (const float**)&p;
  for (int i = 0; i < 25; ++i) pf[i] = (const float*)d_in[i];
  p.X = (float*)d_out; p.ws = (char*)d_ws;
  const int total = count_phases();
#if MULTI_LAUNCH
  for (int ph = 0; ph < total; ++ph) {
    p.lo = ph; p.hi = ph + 1;
    hipLaunchKernelGGL(mega, dim3(grid_blocks), dim3(512), 0, stream, p);
  }
#else
  hipMemsetAsync((char*)d_ws + OFF_BAR, 0, 16384, stream);
  p.lo = 0; p.hi = total;
  void* args[] = {&p};
  hipError_t e = hipLaunchCooperativeKernel((void*)mega, dim3(grid_blocks), dim3(512), args, 0, stream);
  if (e != hipSuccess) fprintf(stderr, "cooperative launch failed: %s (grid %d)\n", hipGetErrorString(e), grid_blocks);
#endif
}
```

```cpp
#include <hip/hip_runtime.h>
#include <hip/hip_cooperative_groups.h>
#include <cstdio>
#include <cstdint>
namespace cg = cooperative_groups;

#ifndef MULTI_LAUNCH
#define MULTI_LAUNCH 0
#endif

typedef unsigned short u16;
typedef unsigned int u32;
using bf16x8 = __attribute__((ext_vector_type(8))) short;
using bf16x4 = __attribute__((ext_vector_type(4))) short;
using f32x4 = __attribute__((ext_vector_type(4))) float;
using u32x2 = __attribute__((ext_vector_type(2))) unsigned int;
using u32x4 = __attribute__((ext_vector_type(4))) unsigned int;

#define DI __device__ __forceinline__
#define MFMA32(a, b, c) __builtin_amdgcn_mfma_f32_16x16x32_bf16((a), (b), (c), 0, 0, 0)

constexpr int MTOK = 32768;
constexpr float EPS = 1e-6f;
constexpr float LOG2E = 1.4426950408889634f;

constexpr size_t MiB = 1048576;
constexpr size_t OFF_WGU1 = 0;
constexpr size_t OFF_WDN1 = 11534336;
constexpr size_t OFF_WGU2 = 17301504;
constexpr size_t OFF_WDN2 = 28835840;
constexpr size_t OFF_WMIX = 34603008;
constexpr size_t OFF_TAB = 47185920;
constexpr size_t OFF_BAR = OFF_TAB + 786432;
constexpr size_t OFF_H = 46 * MiB;
constexpr size_t OFF_R = 110 * MiB;
constexpr size_t WS_NEED = 500 * MiB;

struct Params {
  const float* x; const float* ffn1_norm; const float* ffn1_w_gu; const float* ffn1_w_down;
  const float* mix_norm; const float* ffn2_norm; const float* ffn2_w_gu; const float* ffn2_w_down;
  const float* hg_lb_logits; const float* hg_w_in; const float* hg_g_norm; const float* hg_w_out;
  const float* na_w_in; const float* na_q_norm; const float* na_k_norm; const float* na_rpb; const float* na_w_out;
  const float* mla_w_in; const float* mla_q_a_norm; const float* mla_w_uq; const float* mla_kv_a_norm; const float* mla_w_ukv;
  const float* mla_q_norm; const float* mla_k_norm; const float* mla_w_out;
  float* X; char* ws; int lo; int hi;
};

DI u32 f2bf(float x) { u32 u = __float_as_uint(x); u += 0x7fffu + ((u >> 16) & 1u); return u >> 16; }
typedef __bf16 bf16v2 __attribute__((ext_vector_type(2)));
typedef float f32v2 __attribute__((ext_vector_type(2)));
DI u32 pack2(float a, float b) { f32v2 v = {a, b}; bf16v2 r = __builtin_convertvector(v, bf16v2); return __builtin_bit_cast(u32, r); }
DI float bflo(u32 w) { return __uint_as_float(w << 16); }
DI float bfhi(u32 w) { return __uint_as_float(w & 0xffff0000u); }
DI float bfget(const u32x4& v, int e) { u32 w = v[e >> 1]; return (e & 1) ? bfhi(w) : bflo(w); }
DI u32x2 pack4(const f32x4& v) { u32x2 r; r[0] = pack2(v[0], v[1]); r[1] = pack2(v[2], v[3]); return r; }
DI bf16x8 pack8(const f32x4& a, const f32x4& b) {
  u32x4 r; r[0] = pack2(a[0], a[1]); r[1] = pack2(a[2], a[3]); r[2] = pack2(b[0], b[1]); r[3] = pack2(b[2], b[3]);
  return __builtin_bit_cast(bf16x8, r);
}
DI bf16x8 cat4(const bf16x4& lo, const bf16x4& hi) { return __builtin_shufflevector(lo, hi, 0, 1, 2, 3, 4, 5, 6, 7); }
DI int otid() { int t = threadIdx.x; asm volatile("" : "+v"(t)); return t; }
DI float sx(float v, int k) {
  const int l = otid() & 63;
  return __int_as_float(__builtin_amdgcn_ds_bpermute((l ^ k) << 2, __float_as_int(v)));
}
DI float wave_sum(float v) {
#pragma unroll
  for (int o = 32; o > 0; o >>= 1) v += sx(v, o);
  return v;
}
DI float sigmoidf_(float z) { return __builtin_amdgcn_rcpf(1.f + __expf(-z)); }
DI float siluf_(float z) { return z * __builtin_amdgcn_rcpf(1.f + __expf(-z)); }
DI int vtid() { return otid() & 255; }
DI int vbid() { return blockIdx.x * 2 + (otid() >> 8); }
DI int vgrid() { return gridDim.x * 2; }
DI f32x4 zero4() { f32x4 z = {0.f, 0.f, 0.f, 0.f}; return z; }

DI void init_tables(const Params& p) {
  float* LB = (float*)(p.ws + OFF_TAB); float* RC = LB + 4096; float* RS = RC + 65536;
  const int gt = vbid() * 256 + vtid(), gs = vgrid() * 256;
  for (int c = gt; c < 1024; c += gs) {
    float l0 = p.hg_lb_logits[c], l1 = p.hg_lb_logits[1024 + c], l2 = p.hg_lb_logits[2048 + c], l3 = p.hg_lb_logits[3072 + c];
    float mx = fmaxf(fmaxf(l0, l1), fmaxf(l2, l3));
    float e0 = expf(l0 - mx), e1 = expf(l1 - mx), e2 = expf(l2 - mx), e3 = expf(l3 - mx);
    float inv = 1.f / (e0 + e1 + e2 + e3);
    LB[c] = 0.f; LB[1024 + c] = e1 * inv; LB[2048 + c] = (e1 + e2) * inv; LB[3072 + c] = (e1 + e2 + e3) * inv;
  }
  for (int i = gt; i < 65536; i += gs) {
    int t = i >> 4, j = i & 15;
    float inv = exp2f(-(float)j * (13.287712379549449f / 16.f));
    float ang = (float)t * inv;
    double a = (double)ang;
    double k = rint(a * 0.15915494309189535);
    float r = (float)(a - k * 6.283185307179586);
    RC[i] = __cosf(r); RS[i] = __sinf(r);
  }
}

DI void cvt_tiles(const float* __restrict__ src, u16* __restrict__ dst, int K, int N, int Nd, int mode, char* smem) {
  float* tile = (float*)smem;
  const int tk = K >> 6, tn = Nd >> 6, tid = vtid();
  for (int t = vbid(); t < tk * tn; t += vgrid()) {
    const int k0 = (t % tk) << 6, n0 = (t / tk) << 6;
    {
      const int nl = tid & 63, kq = tid >> 6;
      const int nd = n0 + nl;
      int col = nd;
      if (mode == 1) { int a = nd >> 5, r = nd & 31; col = a * 16 + (r & 15) + ((r >= 16) ? 2816 : 0); }
      const bool ok = col < N;
#pragma unroll
      for (int i = 0; i < 16; ++i) {
        int kl = kq + 4 * i;
        tile[kl * 65 + nl] = ok ? src[(size_t)(k0 + kl) * N + col] : 0.f;
      }
    }
    __syncthreads();
    {
      const int kp = (tid & 31) * 2, nq = tid >> 5;
#pragma unroll
      for (int i = 0; i < 8; ++i) {
        int n = nq + 8 * i;
        *(u32*)(dst + (size_t)(n0 + n) * K + k0 + kp) = pack2(tile[kp * 65 + n], tile[(kp + 1) * 65 + n]);
      }
    }
    __syncthreads();
  }
}

DI void cvt_layer(const Params& p, int layer, char* smem) {
  const int kind = layer % 3, mi = layer / 3;
  char* ws = p.ws;
  for (int task = 0; task < 8; ++task) {
    const float* src = nullptr; size_t off = 0; int K = 0, N = 0, Nd = 0, mode = 0;
    if (task == 0) { src = p.ffn1_w_gu + (size_t)layer * 1024 * 5632; off = OFF_WGU1; K = 1024; N = 5632; Nd = 5632; mode = 1; }
    else if (task == 1) { src = p.ffn1_w_down + (size_t)layer * 2816 * 1024; off = OFF_WDN1; K = 2816; N = 1024; Nd = 1024; }
    else if (task == 2) { src = p.ffn2_w_gu + (size_t)layer * 1024 * 5632; off = OFF_WGU2; K = 1024; N = 5632; Nd = 5632; mode = 1; }
    else if (task == 3) { src = p.ffn2_w_down + (size_t)layer * 2816 * 1024; off = OFF_WDN2; K = 2816; N = 1024; Nd = 1024; }
    else if (kind == 0) {
      if (task == 4) { src = p.hg_w_in + (size_t)mi * 1024 * 5120; off = OFF_WMIX; K = 1024; N = 5120; Nd = 5120; }
      else if (task == 5) { src = p.hg_w_out + (size_t)mi * 1024 * 1024; off = OFF_WMIX + 10485760; K = 1024; N = 1024; Nd = 1024; }
    } else if (kind == 1) {
      if (task == 4) { src = p.na_w_in + (size_t)mi * 1024 * 3072; off = OFF_WMIX; K = 1024; N = 3072; Nd = 3072; }
      else if (task == 5) { src = p.na_w_out + (size_t)mi * 1024 * 1024; off = OFF_WMIX + 6291456; K = 1024; N = 1024; Nd = 1024; }
    } else {
      if (task == 4) { src = p.mla_w_in + (size_t)mi * 1024 * 1056; off = OFF_WMIX; K = 1024; N = 1056; Nd = 1280; }
      else if (task == 5) { src = p.mla_w_uq + (size_t)mi * 768 * 1536; off = OFF_WMIX + 2621440; K = 768; N = 1536; Nd = 1536; }
      else if (task == 6) { src = p.mla_w_ukv + (size_t)mi * 256 * 2048; off = OFF_WMIX + 4980736; K = 256; N = 2048; Nd = 2048; }
      else if (task == 7) { src = p.mla_w_out + (size_t)mi * 1024 * 1024; off = OFF_WMIX + 6029312; K = 1024; N = 1024; Nd = 1024; }
    }
    if (src) cvt_tiles(src, (u16*)(ws + off), K, N, Nd, mode, smem);
  }
}

DI void norm_phase(const float* __restrict__ src, const float* __restrict__ gain, u16* __restrict__ dst, float* copy_dst, int rows) {
  const int lane = vtid() & 63, wid = vtid() >> 6;
  f32x4 g[4];
#pragma unroll
  for (int i = 0; i < 4; ++i) g[i] = *(const f32x4*)(gain + i * 256 + lane * 4);
  const int stride = vgrid() * 4;
  for (int row = vbid() * 4 + wid; row < rows; row += stride * 4) {
    f32x4 v[4][4];
#pragma unroll
    for (int j = 0; j < 4; ++j) {
      const int rj = row + j * stride;
      if (rj < rows) {
#pragma unroll
        for (int i = 0; i < 4; ++i) v[j][i] = *(const f32x4*)(src + (size_t)rj * 1024 + i * 256 + lane * 4);
      }
    }
#pragma unroll
    for (int j = 0; j < 4; ++j) {
      const int rj = row + j * stride;
      if (rj < rows) {
        float ss = 0.f;
#pragma unroll
        for (int i = 0; i < 4; ++i) ss += v[j][i][0] * v[j][i][0] + v[j][i][1] * v[j][i][1] + v[j][i][2] * v[j][i][2] + v[j][i][3] * v[j][i][3];
        ss = wave_sum(ss);
        const float rstd = rsqrtf(ss * (1.f / 1024.f) + EPS);
#pragma unroll
        for (int i = 0; i < 4; ++i) {
          f32x4 y = v[j][i] * rstd * g[i];
          *(u32x2*)(dst + (size_t)rj * 1024 + i * 256 + lane * 4) = pack4(y);
          if (copy_dst) *(f32x4*)(copy_dst + (size_t)rj * 1024 + i * 256 + lane * 4) = v[j][i];
        }
      }
    }
  }
}

#define GLDS16(gp, lp) __builtin_amdgcn_global_load_lds((const unsigned*)(gp), (unsigned*)(lp), 16, 0, 0)

constexpr int G_MT = 2;
constexpr int HTB = 16384;

DI const char* uniform_ptr(const void* p) {
  const unsigned long long v = (unsigned long long)p;
  const unsigned lo = __builtin_amdgcn_readfirstlane((unsigned)v), hi = __builtin_amdgcn_readfirstlane((unsigned)(v >> 32));
  return (const char*)(((unsigned long long)hi << 32) | lo);
}
DI void glds_sv(const char* sbase, unsigned voff, unsigned ldsaddr) {
  unsigned keep;
  asm volatile("s_mov_b32 %0, m0\n\ts_mov_b32 m0, %3\n\ts_nop 0\n\tglobal_load_lds_dwordx4 %1, %2\n\ts_mov_b32 m0, %0"
               : "=&s"(keep) : "v"(voff), "s"(sbase), "s"(ldsaddr) : "memory");
}
DI int lds_byte(int r, int c) {
  const int st = (r >> 4) * 2 + (c >> 5), rr = r & 15, cc = c & 31, ob = rr * 64 + cc * 2;
  return st * 1024 + (ob ^ (((ob >> 9) & 1) << 5));
}
DI void stage_rc(int b, int& R, int& C) {
  const int st = b / 1024, sb = b % 1024, swz = sb ^ (((sb >> 9) & 1) << 5);
  R = (st >> 1) * 16 + swz / 64; C = (st & 1) * 32 + (swz % 64) / 2;
}

template <class Epi>
DI void gemm_phase(const u16* __restrict__ Act, int lda, const u16* __restrict__ Wt, int Kc, int Mrows, int Ncols, const Epi& epi, char* smem) {
  int K = Kc; asm volatile("" : "+s"(K));
  const int mtn = Mrows >> 8, ntn = Ncols >> 8;
  const int ntiles = mtn * ntn;
  constexpr int GM = 16;
  const int tid = otid(), lane = tid & 63, wid = tid >> 6;
  const int wr = wid >> 2, wc = wid & 3, fr = lane & 15, fq = lane >> 4;
  int R0, C0;
  stage_rc(tid * 16, R0, C0);
  const unsigned vo0 = (unsigned)(R0 * K + C0) * 2u;
  const unsigned sl = (unsigned)(size_t)(__attribute__((address_space(3))) char*)smem + __builtin_amdgcn_readfirstlane(tid >> 6) * 1024;
  const int nt = K >> 6;
#define SA_(b, h) (((b) * 2 + (h)) * HTB)
#define SB_(b, h) ((4 + (b) * 2 + (h)) * HTB)
#define STAGE_(POFF, BASE, br, kt) do { const char* ub_ = uniform_ptr((const char*)(BASE) + ((size_t)(br) * K + (size_t)(kt) * 64) * 2); \
    glds_sv(ub_, vo0, sl + (POFF)); glds_sv(ub_ + (size_t)K * 128, vo0, sl + (POFF) + 8192); } while (0)
  const char* la_rd = smem + (((fr * 64 + fq * 16) ^ ((fr >> 3) << 5)) + wr * 8192);
  const char* lb_rd = smem + (((fr * 64 + fq * 16) ^ ((fr >> 3) << 5)) + wc * 4096 + 65536);
#define LDA_(dst, b, h) do { _Pragma("unroll") for (int m = 0; m < 4; ++m) _Pragma("unroll") for (int k = 0; k < 2; ++k) \
    dst[m][k] = *(const bf16x8*)(la_rd + SA_(b, h) + (m * 2 + k) * 1024); } while (0)
#define LDB_(dst, b, h) do { _Pragma("unroll") for (int n = 0; n < 2; ++n) _Pragma("unroll") for (int k = 0; k < 2; ++k) \
    dst[n][k] = *(const bf16x8*)(lb_rd + SA_(b, h) + (n * 2 + k) * 1024); } while (0)
#define MMA_(ai, bj, At, Bt) do { __builtin_amdgcn_s_setprio(1); \
    _Pragma("unroll") for (int m = 0; m < 4; ++m) _Pragma("unroll") for (int n = 0; n < 2; ++n) _Pragma("unroll") for (int k = 0; k < 2; ++k) \
      acc[ai][bj][m][n] = MFMA32(At[m][k], Bt[n][k], acc[ai][bj][m][n]); \
    __builtin_amdgcn_s_setprio(0); } while (0)
#define WAIT_V(n) asm volatile("s_waitcnt vmcnt(" #n ")" ::: "memory")
#define WAIT_L(n) asm volatile("s_waitcnt lgkmcnt(" #n ")" ::: "memory")
#define BAR_ __builtin_amdgcn_s_barrier()
#define SCHED_ __builtin_amdgcn_sched_barrier(0)
  int bidp = blockIdx.x;
  if (gridDim.x == 256) { const int x_ = bidp & 7, i_ = bidp >> 3; bidp = (((x_ >> 2) * 8 + (i_ >> 2)) << 4) + (x_ & 3) * 4 + (i_ & 3); }
  for (int tile = bidp; tile < ntiles; tile += gridDim.x) {
    const int group = tile / (GM * ntn), rem = tile % (GM * ntn);
    const int mt_ = group * GM + (rem % GM), nt_ = rem / GM;
    const u16* A = Wt + (size_t)nt_ * 256 * K;
    const u16* Bt = Act + (size_t)mt_ * 256 * K;
    f32x4 acc[2][2][4][2];
#pragma unroll
    for (int a_ = 0; a_ < 2; ++a_)
#pragma unroll
      for (int b_ = 0; b_ < 2; ++b_)
#pragma unroll
        for (int m = 0; m < 4; ++m) { acc[a_][b_][m][0] = zero4(); acc[a_][b_][m][1] = zero4(); }
    bf16x8 At[4][2], B0[2][2], B1[2][2];
    STAGE_(SB_(0, 0), Bt, 0, 0); STAGE_(SA_(0, 0), A, 0, 0);
    STAGE_(SB_(0, 1), Bt, 128, 0); STAGE_(SA_(0, 1), A, 128, 0);
    if (wr == 1) BAR_;
    WAIT_V(4); BAR_;
    STAGE_(SB_(1, 0), Bt, 0, 1); STAGE_(SA_(1, 0), A, 0, 1); STAGE_(SB_(1, 1), Bt, 128, 1);
    WAIT_V(6); BAR_;
    for (int t = 0; t < nt - 2; t += 2) {
      LDB_(B0, 0, 0); SCHED_; LDA_(At, 0, 0); STAGE_(SA_(1, 1), A, 128, t + 1);
      WAIT_L(8); BAR_; WAIT_L(0); MMA_(0, 0, At, B0); BAR_; SCHED_;
      LDB_(B1, 0, 1); STAGE_(SB_(0, 0), Bt, 0, t + 2);
      BAR_; WAIT_L(0); MMA_(0, 1, At, B1); BAR_;
      LDA_(At, 0, 1); STAGE_(SA_(0, 0), A, 0, t + 2);
      BAR_; WAIT_L(0); MMA_(1, 0, At, B0); BAR_; SCHED_;
      STAGE_(SB_(0, 1), Bt, 128, t + 2);
      WAIT_V(6); BAR_; MMA_(1, 1, At, B1); BAR_;
      LDB_(B0, 1, 0); SCHED_; LDA_(At, 1, 0); STAGE_(SA_(0, 1), A, 128, t + 2);
      WAIT_L(8); BAR_; WAIT_L(0); MMA_(0, 0, At, B0); BAR_; SCHED_;
      LDB_(B1, 1, 1); STAGE_(SB_(1, 0), Bt, 0, t + 3);
      BAR_; WAIT_L(0); MMA_(0, 1, At, B1); BAR_;
      LDA_(At, 1, 1); STAGE_(SA_(1, 0), A, 0, t + 3);
      BAR_; WAIT_L(0); MMA_(1, 0, At, B0); BAR_; SCHED_;
      STAGE_(SB_(1, 1), Bt, 128, t + 3);
      WAIT_V(6); BAR_; MMA_(1, 1, At, B1); BAR_;
    }
    {
      LDB_(B0, 0, 0); LDA_(At, 0, 0); STAGE_(SA_(1, 1), A, 128, nt - 1);
      BAR_; WAIT_L(0); MMA_(0, 0, At, B0); BAR_;
      LDB_(B1, 0, 1); BAR_; WAIT_L(0); MMA_(0, 1, At, B1); BAR_;
      LDA_(At, 0, 1); WAIT_V(4); BAR_; WAIT_L(0); MMA_(1, 0, At, B0); MMA_(1, 1, At, B1); BAR_;
    }
    {
      LDB_(B0, 1, 0); LDA_(At, 1, 0); WAIT_V(2); BAR_; WAIT_L(0); MMA_(0, 0, At, B0); BAR_;
      LDB_(B1, 1, 1); WAIT_V(0); BAR_; WAIT_L(0); MMA_(0, 1, At, B1); BAR_;
      LDA_(At, 1, 1); BAR_; WAIT_L(0); MMA_(1, 0, At, B0); MMA_(1, 1, At, B1); BAR_;
    }
    if (wr == 0) BAR_;
    const int t2 = otid();
    const int fr2 = t2 & 15, fq2 = (t2 >> 4) & 3, wc2 = (t2 >> 6) & 3, wr2 = t2 >> 8;
#pragma unroll
    for (int ai = 0; ai < 2; ++ai)
#pragma unroll
      for (int bj = 0; bj < 2; ++bj)
        epi(acc[ai][bj], mt_ * 256 + bj * 128 + wc2 * 32, nt_ * 256 + ai * 128 + wr2 * 64, fr2, fq2);
  }
#undef SA_
#undef SB_
#undef STAGE_
#undef LDA_
#undef LDB_
#undef MMA_
#undef WAIT_V
#undef WAIT_L
#undef BAR_
#undef SCHED_
  __syncthreads();
}

struct EpiSwiglu {
  u16* act;
  DI void operator()(f32x4 (&acc)[4][G_MT], int mb, int nb, int fr, int fq) const {
#pragma unroll
    for (int mt = 0; mt < G_MT; ++mt) {
      const int m = mb + mt * 16 + fr;
#pragma unroll
      for (int np = 0; np < 2; ++np) {
        const f32x4 g = acc[2 * np][mt], u = acc[2 * np + 1][mt];
        f32x4 r;
#pragma unroll
        for (int j = 0; j < 4; ++j) r[j] = siluf_(g[j]) * u[j];
        const int jc = (nb >> 1) + np * 16 + fq * 4;
        *(u32x2*)(act + (size_t)m * 2816 + jc) = pack4(r);
      }
    }
  }
};

struct EpiResid {
  float* X; float scale;
  DI void operator()(f32x4 (&acc)[4][G_MT], int mb, int nb, int fr, int fq) const {
#pragma unroll
    for (int mt = 0; mt < G_MT; ++mt) {
      const int m = mb + mt * 16 + fr;
#pragma unroll
      for (int nt = 0; nt < 4; ++nt) {
        f32x4* ptr = (f32x4*)(X + (size_t)m * 1024 + nb + nt * 16 + fq * 4);
        f32x4 v = *ptr;
        v += acc[nt][mt] * scale;
        *ptr = v;
      }
    }
  }
};

struct EpiStore {
  u16* out; int ldo; int nmax;
  DI void operator()(f32x4 (&acc)[4][G_MT], int mb, int nb, int fr, int fq) const {
#pragma unroll
    for (int mt = 0; mt < G_MT; ++mt) {
      const int m = mb + mt * 16 + fr;
#pragma unroll
      for (int nt = 0; nt < 4; ++nt) {
        const int n = nb + nt * 16 + fq * 4;
        if (n < nmax) *(u32x2*)(out + (size_t)m * ldo + n) = pack4(acc[nt][mt]);
      }
    }
  }
};

struct EpiHgIn {
  u16 *Q, *LFf, *LFb, *V, *G; const float* lb;
  DI void operator()(f32x4 (&acc)[4][G_MT], int mb, int nb, int fr, int fq) const {
    const int seg = nb >> 10, c0 = nb & 1023;
    u16* dst = seg == 0 ? Q : seg == 1 ? LFf : seg == 2 ? LFb : seg == 3 ? V : G;
#pragma unroll
    for (int mt = 0; mt < G_MT; ++mt) {
      const int m = mb + mt * 16 + fr;
#pragma unroll
      for (int nt = 0; nt < 4; ++nt) {
        const int c = c0 + nt * 16 + fq * 4;
        f32x4 a = acc[nt][mt], r;
        if (seg == 0) r = a * 0.08838834764831845f;
        else if (seg == 3) r = a;
        else if (seg == 4) {
#pragma unroll
          for (int j = 0; j < 4; ++j) r[j] = siluf_(a[j]);
        } else {
          const f32x4 l4 = *(const f32x4*)(lb + c);
#pragma unroll
          for (int j = 0; j < 4; ++j) {
            float z = fminf(fmaxf(a[j], -30.f), 30.f);
            float f = l4[j] + (1.f - l4[j]) * sigmoidf_(z);
            r[j] = __logf(f);
          }
        }
        *(u32x2*)(dst + (size_t)m * 1024 + c) = pack4(r);
      }
    }
  }
};

struct EpiNaIn {
  u16 *Q, *K, *VT; const float *qn, *kn;
  DI void operator()(f32x4 (&acc)[4][G_MT], int mb, int nb, int fr, int fq) const {
    const int seg = nb >> 10, h = (nb & 1023) >> 6;
    if (seg < 2) {
      u16* dst = seg == 0 ? Q : K;
      const float* gn = seg == 0 ? qn : kn;
      const float sc = seg == 0 ? 0.125f * LOG2E : 1.f;
#pragma unroll
      for (int mt = 0; mt < G_MT; ++mt) {
        const int m = mb + mt * 16 + fr;
        float ss = 0.f;
#pragma unroll
        for (int nt = 0; nt < 4; ++nt)
#pragma unroll
          for (int j = 0; j < 4; ++j) ss += acc[nt][mt][j] * acc[nt][mt][j];
        ss += sx(ss, 16); ss += sx(ss, 32);
        const float rstd = rsqrtf(ss * (1.f / 64.f) + EPS) * sc;
#pragma unroll
        for (int nt = 0; nt < 4; ++nt) {
          const int d = nt * 16 + fq * 4;
          const f32x4 g4 = *(const f32x4*)(gn + d);
          f32x4 r = acc[nt][mt] * rstd * g4;
          *(u32x2*)(dst + (size_t)m * 1024 + h * 64 + d) = pack4(r);
        }
      }
    } else {
#pragma unroll
      for (int mt = 0; mt < G_MT; ++mt) {
        const int m = mb + mt * 16 + fr;
        const int b = m >> 12, t = m & 4095;
#pragma unroll
        for (int nt = 0; nt < 4; ++nt)
#pragma unroll
          for (int j = 0; j < 4; ++j) {
            const int d = nt * 16 + fq * 4 + j;
            VT[((size_t)((b * 16 + h) * 64 + d)) * 4096 + t] = (u16)f2bf(acc[nt][mt][j]);
          }
      }
    }
  }
};

struct HgBufs {
  u16 *Q, *LFf, *LFb, *V, *G, *QIf, *QIb, *KITf, *KITb, *VTc, *OI, *OF, *OB, *Y;
  float *DECf, *DECb;
};

DI void hg_prep_phase(const HgBufs& hb, char* smem) {
  u32x4 rq, rf, rb, rv;
  {
    const int item0 = vbid(), tid0 = vtid();
    if (item0 < 8192) {
      const size_t g0 = ((size_t)(item0 >> 11) * 4096 + ((item0 >> 3) & 255) * 16 + (tid0 >> 4)) * 1024 + (item0 & 7) * 128 + (tid0 & 15) * 8;
      rq = *(const u32x4*)(hb.Q + g0); rf = *(const u32x4*)(hb.LFf + g0); rb = *(const u32x4*)(hb.LFb + g0); rv = *(const u32x4*)(hb.V + g0);
    }
  }
  for (int item = vbid(); item < 8192; item += vgrid()) {
  const int h = item & 7, n = (item >> 3) & 255, b = item >> 11;
  float* sq = (float*)smem; float* sbf = sq + 2112; float* sbb = sbf + 2112; float* skf = sbb + 2112;
  float* skb = skf + 2112; float* sv = skb + 2112; float* sP = sv + 2112; float* sA = sP + 5120;
  const int tid = vtid();
  const int row = tid >> 4, c8 = (tid & 15) * 8;
  const size_t tok0 = (size_t)b * 4096 + n * 16;
  const size_t gidx = (tok0 + row) * 1024 + h * 128 + c8;
  {
#pragma unroll
    for (int e = 0; e < 8; ++e) {
      const int o = row * 132 + c8 + e;
      const float lf = bfget(rf, e), lb_ = bfget(rb, e);
      sq[o] = bfget(rq, e); sbf[o] = lf; sbb[o] = lb_;
      skf[o] = 1.f - __expf(lf); skb[o] = 1.f - __expf(lb_); sv[o] = bfget(rv, e);
    }
  }
  {
    const int nx = item + vgrid();
    if (nx < 8192) {
      const size_t g1 = ((size_t)(nx >> 11) * 4096 + ((nx >> 3) & 255) * 16 + row) * 1024 + (nx & 7) * 128 + c8;
      rq = *(const u32x4*)(hb.Q + g1); rf = *(const u32x4*)(hb.LFf + g1); rb = *(const u32x4*)(hb.LFb + g1); rv = *(const u32x4*)(hb.V + g1);
    }
  }
  __syncthreads();
  if (tid < 128) {
    const int d = tid; float a = 0.f;
#pragma unroll
    for (int t = 0; t < 16; ++t) { a += sbf[t * 132 + d]; sbf[t * 132 + d] = a; }
    hb.DECf[((size_t)b * 256 + n) * 1024 + h * 128 + d] = __expf(a);
  } else {
    const int d = tid - 128; float a = 0.f;
#pragma unroll
    for (int t = 15; t >= 0; --t) { a += sbb[t * 132 + d]; sbb[t * 132 + d] = a; }
    hb.DECb[((size_t)b * 256 + n) * 1024 + h * 128 + d] = __expf(a);
  }
  __syncthreads();
  {
    u32x4 of, ob;
#pragma unroll
    for (int e2 = 0; e2 < 4; ++e2) {
      const int o = row * 132 + c8 + 2 * e2;
      const float q0 = sq[o], q1 = sq[o + 1];
      of[e2] = pack2(q0 * __expf(sbf[o]), q1 * __expf(sbf[o + 1]));
      ob[e2] = pack2(q0 * __expf(sbb[o]), q1 * __expf(sbb[o + 1]));
    }
    *(u32x4*)(hb.QIf + gidx) = of; *(u32x4*)(hb.QIb + gidx) = ob;
  }
  {
    const int d = tid >> 1, t8 = (tid & 1) * 8;
    const float blf = sbf[15 * 132 + d], blb = sbb[d];
    u32x4 kf, kb, vv;
#pragma unroll
    for (int e2 = 0; e2 < 4; ++e2) {
      const int o0 = (t8 + 2 * e2) * 132 + d, o1 = o0 + 132;
      kf[e2] = pack2(skf[o0] * __expf(blf - sbf[o0]), skf[o1] * __expf(blf - sbf[o1]));
      kb[e2] = pack2(skb[o0] * __expf(blb - sbb[o0]), skb[o1] * __expf(blb - sbb[o1]));
      vv[e2] = pack2(sv[o0], sv[o1]);
    }
    const size_t cidx = (((size_t)(b * 8 + h) * 256 + n) * 128 + d) * 16 + t8;
    *(u32x4*)(hb.KITf + cidx) = kf; *(u32x4*)(hb.KITb + cidx) = kb; *(u32x4*)(hb.VTc + cidx) = vv;
  }
  {
    const int s = tid >> 4, dg = tid & 15, d0 = dg * 8, sw0 = (tid >> 6) * 4;
    float w[8];
    {
      const f32x4 a = *(const f32x4*)(skf + s * 132 + d0), b2 = *(const f32x4*)(skf + s * 132 + d0 + 4);
#pragma unroll
      for (int e = 0; e < 4; ++e) { w[e] = a[e]; w[4 + e] = b2[e]; }
    }
    float pdiag = 0.f;
    for (int t = sw0; t < 16; ++t) {
      if (t > s) {
        const f32x4 a = *(const f32x4*)(skf + t * 132 + d0), b2 = *(const f32x4*)(skf + t * 132 + d0 + 4);
#pragma unroll
        for (int e = 0; e < 4; ++e) { w[e] = fmaf(-w[e], a[e], w[e]); w[4 + e] = fmaf(-w[4 + e], b2[e], w[4 + e]); }
      }
      const f32x4 q0 = *(const f32x4*)(sq + t * 132 + d0), q1 = *(const f32x4*)(sq + t * 132 + d0 + 4);
      float part = 0.f;
#pragma unroll
      for (int e = 0; e < 4; ++e) part += q0[e] * w[e] + q1[e] * w[4 + e];
      if (t == s) pdiag = part;
      else if (t > s) sP[(t * 16 + s) * 20 + dg] = part;
    }
    {
      const f32x4 a = *(const f32x4*)(skb + s * 132 + d0), b2 = *(const f32x4*)(skb + s * 132 + d0 + 4);
#pragma unroll
      for (int e = 0; e < 4; ++e) { w[e] = a[e]; w[4 + e] = b2[e]; }
    }
    for (int t = sw0 + 3; t >= 0; --t) {
      if (t < s) {
        const f32x4 a = *(const f32x4*)(skb + t * 132 + d0), b2 = *(const f32x4*)(skb + t * 132 + d0 + 4);
#pragma unroll
        for (int e = 0; e < 4; ++e) { w[e] = fmaf(-w[e], a[e], w[e]); w[4 + e] = fmaf(-w[4 + e], b2[e], w[4 + e]); }
      }
      const f32x4 q0 = *(const f32x4*)(sq + t * 132 + d0), q1 = *(const f32x4*)(sq + t * 132 + d0 + 4);
      float part = 0.f;
#pragma unroll
      for (int e = 0; e < 4; ++e) part += q0[e] * w[e] + q1[e] * w[4 + e];
      if (t == s) sP[(s * 16 + s) * 20 + dg] = pdiag + part;
      else if (t < s) sP[(t * 16 + s) * 20 + dg] = part;
    }
  }
  __syncthreads();
  {
    const int t = tid >> 4, s = tid & 15;
    const float* pp = sP + (t * 16 + s) * 20;
    const f32x4 p0 = *(const f32x4*)pp, p1 = *(const f32x4*)(pp + 4), p2 = *(const f32x4*)(pp + 8), p3 = *(const f32x4*)(pp + 12);
    const f32x4 ps = (p0 + p1) + (p2 + p3);
    sA[t * 17 + s] = (ps[0] + ps[1]) + (ps[2] + ps[3]);
  }
  __syncthreads();
  {
    float o[8];
#pragma unroll
    for (int e = 0; e < 8; ++e) o[e] = 0.f;
#pragma unroll
    for (int s = 0; s < 16; ++s) {
      const float a = sA[row * 17 + s];
      const f32x4 v0 = *(const f32x4*)(sv + s * 132 + c8), v1 = *(const f32x4*)(sv + s * 132 + c8 + 4);
#pragma unroll
      for (int e = 0; e < 4; ++e) { o[e] += a * v0[e]; o[4 + e] += a * v1[e]; }
    }
    u32x4 r; r[0] = pack2(o[0], o[1]); r[1] = pack2(o[2], o[3]); r[2] = pack2(o[4], o[5]); r[3] = pack2(o[6], o[7]);
    *(u32x4*)(hb.OI + gidx) = r;
  }
  __syncthreads();
  }
}

constexpr int SC_NS = 6, SC_STAGE = 12288;
DI void scan_issue(char* smem, int slot, const u16* QI, const u16* KIT, const u16* VTc, const float* DEC, int b, int h, int vg, int n, int tid) {
  char* st = smem + slot * SC_STAGE + tid * 16;
  const size_t tok0 = (size_t)b * 4096 + n * 16;
  const int row = tid >> 4, lc = (tid & 15) ^ row;
  GLDS16(QI + (tok0 + row) * 1024 + h * 128 + lc * 8, st);
  const size_t cb = ((size_t)(b * 8 + h) * 256 + n) * 2048;
  GLDS16(KIT + cb + tid * 8, st + 4096);
  const float* dp = DEC + ((size_t)b * 256 + n) * 1024 + h * 128;
  const void* g3 = tid < 128 ? (const void*)(VTc + cb + vg * 1024 + tid * 8) : (const void*)(dp + ((tid - 128) & 31) * 4);
  GLDS16(g3, st + 8192);
}

struct ScanRegs { bf16x8 qa[4]; bf16x8 ka[8]; bf16x8 vb; };

DI void scan_read(ScanRegs& r, const char* st, int wid, int fr, int fq) {
#pragma unroll
  for (int ks = 0; ks < 4; ++ks) {
    const int l0 = 4 * ks + (fq >> 1), l1 = l0 + 2;
    const bf16x4 lo = *(const bf16x4*)(st + fr * 256 + ((l0 ^ fr) * 16) + (fq & 1) * 8);
    const bf16x4 hi = *(const bf16x4*)(st + fr * 256 + ((l1 ^ fr) * 16) + (fq & 1) * 8);
    r.qa[ks] = cat4(lo, hi);
  }
  r.vb = *(const bf16x8*)(st + 8192 + (wid * 16 + fr) * 32 + (fq & 1) * 16);
#pragma unroll
  for (int dt = 0; dt < 8; ++dt) r.ka[dt] = *(const bf16x8*)(st + 4096 + (dt * 16 + fr) * 32 + (fq & 1) * 16);
}

DI void scan_compute(f32x4 (&S)[8], ScanRegs& r, const f32x4 (&dc)[8], u16* op, int fq) {
  const bf16x8 z8 = {0, 0, 0, 0, 0, 0, 0, 0};
  if (fq >= 2) r.vb = z8;
  f32x4 o0 = zero4(), o1 = zero4();
  o0 = MFMA32(r.qa[0], pack8(S[0], S[1]), o0);
  o1 = MFMA32(r.qa[1], pack8(S[2], S[3]), o1);
  o0 = MFMA32(r.qa[2], pack8(S[4], S[5]), o0);
  o1 = MFMA32(r.qa[3], pack8(S[6], S[7]), o1);
#pragma unroll
  for (int dt = 0; dt < 8; ++dt) {
    if (fq >= 2) r.ka[dt] = z8;
    S[dt] = S[dt] * dc[dt];
    S[dt] = MFMA32(r.ka[dt], r.vb, S[dt]);
  }
  const f32x4 o = o0 + o1;
  const u32 w0 = pack2(o[0], o[1]), w1 = pack2(o[2], o[3]);
  asm volatile("global_store_short %0, %1, off" :: "v"(op), "v"(w0) : "memory");
  asm volatile("global_store_short_d16_hi %0, %1, off" :: "v"(op + 1024), "v"(w0) : "memory");
  asm volatile("global_store_short %0, %1, off" :: "v"(op + 2048), "v"(w1) : "memory");
  asm volatile("global_store_short_d16_hi %0, %1, off" :: "v"(op + 3072), "v"(w1) : "memory");
}

DI void hg_scan_phase(const HgBufs& hb, char* smem) {
  const int tid = vtid(), lane = tid & 63, wid = tid >> 6, fr = lane & 15, fq = lane >> 4;
  for (int item = vbid(); item < 128; item += vgrid()) {
    const int vg = item & 1, dir = (item >> 1) & 1, h = (item >> 2) & 7, b = item >> 5;
    const u16* QI = dir ? hb.QIb : hb.QIf; const u16* KIT = dir ? hb.KITb : hb.KITf;
    const float* DEC = dir ? hb.DECb : hb.DECf; u16* Oout = dir ? hb.OB : hb.OF;
    const int vs = vg * 4 + wid;
    u16* obase = Oout + ((size_t)b * 4096 + fq * 4) * 1024 + h * 128 + vs * 16 + fr;
    f32x4 S[8];
#pragma unroll
    for (int i = 0; i < 8; ++i) S[i] = zero4();
#pragma unroll
    for (int s = 0; s < SC_NS - 1; ++s) scan_issue(smem, s, QI, KIT, hb.VTc, DEC, b, h, vg, dir ? 255 - s : s, tid);
    asm volatile("s_waitcnt vmcnt(12)" ::: "memory");
    __builtin_amdgcn_s_barrier();
    asm volatile("" ::: "memory");
    ScanRegs ra, rb;
    scan_read(ra, smem, wid, fr, fq);
    int slot = 0;
#define SCAN_STEP(STEP, CUR, NXT) do { \
      const int step_ = (STEP); \
      if (step_ < 4) asm volatile("s_waitcnt vmcnt(9) lgkmcnt(0)" ::: "memory"); \
      else asm volatile("s_waitcnt vmcnt(25) lgkmcnt(0)" ::: "memory"); \
      __builtin_amdgcn_s_barrier(); \
      asm volatile("" ::: "memory"); \
      { const int ns_ = min(step_ + SC_NS - 1, 255); \
        int is_ = slot + SC_NS - 1; if (is_ >= SC_NS) is_ -= SC_NS; \
        scan_issue(smem, is_, QI, KIT, hb.VTc, DEC, b, h, vg, dir ? 255 - ns_ : ns_, tid); } \
      f32x4 dc_[8]; \
      { const char* st_ = smem + slot * SC_STAGE + 8192 + 2048 + fq * 16; \
        _Pragma("unroll") for (int dt = 0; dt < 8; ++dt) dc_[dt] = *(const f32x4*)(st_ + dt * 64); } \
      int nslot_ = slot + 1; if (nslot_ == SC_NS) nslot_ = 0; \
      if (step_ + 1 < 256) scan_read(NXT, smem + nslot_ * SC_STAGE, wid, fr, fq); \
      { const int n_ = dir ? 255 - step_ : step_; \
        scan_compute(S, CUR, dc_, obase + (size_t)n_ * 16 * 1024, fq); } \
      slot = nslot_; } while (0)
    for (int step = 0; step < 256; step += 2) {
      SCAN_STEP(step, ra, rb);
      SCAN_STEP(step + 1, rb, ra);
    }
#undef SCAN_STEP
    asm volatile("s_waitcnt vmcnt(0)" ::: "memory");
    __syncthreads();
  }
}

DI void hg_combine_phase(const HgBufs& hb, const float* __restrict__ gnorm, int rows) {
  const int lane = vtid() & 63, wid = vtid() >> 6;
  const int h = lane >> 3, c16 = (lane & 7) * 16;
  const int stride = vgrid() * 4;
  f32x4 gn[4];
#pragma unroll
  for (int i = 0; i < 4; ++i) gn[i] = *(const f32x4*)(gnorm + c16 + i * 4);
  for (int row = vbid() * 4 + wid; row < rows; row += stride * 2) {
    u32x4 ra[2][2], rf[2][2], rb[2][2], rg[2][2];
#pragma unroll
    for (int j = 0; j < 2; ++j) {
      const int rj = row + j * stride;
      if (rj < rows) {
        const size_t g = (size_t)rj * 1024 + h * 128 + c16;
#pragma unroll
        for (int half = 0; half < 2; ++half) {
          ra[j][half] = *(const u32x4*)(hb.OI + g + half * 8); rf[j][half] = *(const u32x4*)(hb.OF + g + half * 8);
          rb[j][half] = *(const u32x4*)(hb.OB + g + half * 8); rg[j][half] = *(const u32x4*)(hb.G + g + half * 8);
        }
      }
    }
#pragma unroll
    for (int j = 0; j < 2; ++j) {
      const int rj = row + j * stride;
      if (rj < rows) {
        const size_t g = (size_t)rj * 1024 + h * 128 + c16;
        float o[16]; float ss = 0.f;
#pragma unroll
        for (int half = 0; half < 2; ++half)
#pragma unroll
          for (int e = 0; e < 8; ++e) { float v = bfget(ra[j][half], e) + bfget(rf[j][half], e) + bfget(rb[j][half], e); o[half * 8 + e] = v; ss += v * v; }
        ss += sx(ss, 1); ss += sx(ss, 2); ss += sx(ss, 4);
        const float rstd = rsqrtf(ss * (1.f / 128.f) + EPS);
#pragma unroll
        for (int half = 0; half < 2; ++half) {
          u32x4 r;
#pragma unroll
          for (int e2 = 0; e2 < 4; ++e2) {
            const int e = half * 8 + 2 * e2;
            r[e2] = pack2(o[e] * rstd * gn[e >> 2][e & 3] * bfget(rg[j][half], 2 * e2), o[e + 1] * rstd * gn[(e + 1) >> 2][(e + 1) & 3] * bfget(rg[j][half], 2 * e2 + 1));
          }
          *(u32x4*)(hb.Y + g + half * 8) = r;
        }
      }
    }
  }
}

DI void na_attn_item(const u16* __restrict__ Q, const u16* __restrict__ K, const u16* __restrict__ VT, const float* __restrict__ rpb, u16* __restrict__ O, int item, int fr, int fq) {
  const int qt = item & 3, h = (item >> 2) & 15, r = (item >> 6) & 63, b = item >> 12;
  const int r0 = min(max(r - 4, 0), 56);
  const int cw0 = qt == 0 ? 0 : qt == 1 ? 8 : qt == 2 ? 24 : 32;
  const size_t tokq = (size_t)b * 4096 + r * 64 + qt * 16 + fr;
  bf16x8 qf[2];
#pragma unroll
  for (int ks = 0; ks < 2; ++ks) qf[ks] = *(const bf16x8*)(Q + tokq * 1024 + h * 64 + ks * 32 + fq * 8);
  f32x4 s[8][2];
#pragma unroll
  for (int kr = 0; kr < 8; ++kr)
#pragma unroll
    for (int hf = 0; hf < 2; ++hf) {
      const size_t tokk = (size_t)b * 4096 + (r0 + kr) * 64 + cw0 + hf * 16 + fr;
      const bf16x8 k0 = *(const bf16x8*)(K + tokk * 1024 + h * 64 + fq * 8);
      const bf16x8 k1 = *(const bf16x8*)(K + tokk * 1024 + h * 64 + 32 + fq * 8);
      f32x4 a = MFMA32(k0, qf[0], zero4());
      s[kr][hf] = MFMA32(k1, qf[1], a);
    }
  const int qc = qt * 16 + fr;
  const int cs = min(max(qc - 8, 0), 48);
  float mx = -1e30f;
#pragma unroll
  for (int kr = 0; kr < 8; ++kr) {
    const float* rp = rpb + (h * 15 + (r0 + kr - r + 7)) * 31;
#pragma unroll
    for (int hf = 0; hf < 2; ++hf)
#pragma unroll
      for (int j = 0; j < 4; ++j) {
        const int kc = cw0 + hf * 16 + fq * 4 + j;
        const bool valid = (kc >= cs) && (kc < cs + 16);
        const int ci = min(max(kc - qc + 15, 0), 30);
        const float v = valid ? s[kr][hf][j] + rp[ci] * LOG2E : -1e30f;
        s[kr][hf][j] = v; mx = fmaxf(mx, v);
      }
  }
  mx = fmaxf(mx, sx(mx, 16)); mx = fmaxf(mx, sx(mx, 32));
  float l = 0.f;
#pragma unroll
  for (int kr = 0; kr < 8; ++kr)
#pragma unroll
    for (int hf = 0; hf < 2; ++hf)
#pragma unroll
      for (int j = 0; j < 4; ++j) { const float pv = __builtin_amdgcn_exp2f(s[kr][hf][j] - mx); s[kr][hf][j] = pv; l += pv; }
  l += sx(l, 16); l += sx(l, 32);
  f32x4 o[4];
#pragma unroll
  for (int dt = 0; dt < 4; ++dt) o[dt] = zero4();
#pragma unroll
  for (int kr = 0; kr < 8; ++kr) {
    const bf16x8 pp = pack8(s[kr][0], s[kr][1]);
#pragma unroll
    for (int dt = 0; dt < 4; ++dt) {
      const u16* vp = VT + ((size_t)((b * 16 + h) * 64 + dt * 16 + fr)) * 4096 + (r0 + kr) * 64 + cw0 + fq * 4;
      const bf16x8 vf = cat4(*(const bf16x4*)vp, *(const bf16x4*)(vp + 16));
      o[dt] = MFMA32(vf, pp, o[dt]);
    }
  }
  const float inv = 1.f / l;
#pragma unroll
  for (int dt = 0; dt < 4; ++dt) *(u32x2*)(O + tokq * 1024 + h * 64 + dt * 16 + fq * 4) = pack4(o[dt] * inv);
}

DI void mla_norm_phase(const u16* __restrict__ CRAW, const float* __restrict__ gq, const float* __restrict__ gkv, u16* __restrict__ CQN, u16* __restrict__ CKVN, float* __restrict__ KROPE) {
  const int lane = vtid() & 63, wid = vtid() >> 6;
  for (int row = vbid() * 4 + wid; row < MTOK; row += vgrid() * 4) {
    const u16* c = CRAW + (size_t)row * 1056;
    f32x4 v[3]; float ss = 0.f;
#pragma unroll
    for (int i = 0; i < 3; ++i) {
      const u32x2 w = *(const u32x2*)(c + i * 256 + lane * 4);
      v[i][0] = bflo(w[0]); v[i][1] = bfhi(w[0]); v[i][2] = bflo(w[1]); v[i][3] = bfhi(w[1]);
      ss += v[i][0] * v[i][0] + v[i][1] * v[i][1] + v[i][2] * v[i][2] + v[i][3] * v[i][3];
    }
    ss = wave_sum(ss);
    const float rq = rsqrtf(ss * (1.f / 768.f) + EPS);
#pragma unroll
    for (int i = 0; i < 3; ++i) {
      const f32x4 g4 = *(const f32x4*)(gq + i * 256 + lane * 4);
      *(u32x2*)(CQN + (size_t)row * 768 + i * 256 + lane * 4) = pack4(v[i] * rq * g4);
    }
    {
      const u32x2 w = *(const u32x2*)(c + 768 + lane * 4);
      f32x4 k; k[0] = bflo(w[0]); k[1] = bfhi(w[0]); k[2] = bflo(w[1]); k[3] = bfhi(w[1]);
      float s2 = wave_sum(k[0] * k[0] + k[1] * k[1] + k[2] * k[2] + k[3] * k[3]);
      const float rk = rsqrtf(s2 * (1.f / 256.f) + EPS);
      const f32x4 g4 = *(const f32x4*)(gkv + lane * 4);
      *(u32x2*)(CKVN + (size_t)row * 256 + lane * 4) = pack4(k * rk * g4);
    }
    if (lane < 8) {
      const u32x2 w = *(const u32x2*)(c + 1024 + lane * 4);
      f32x4 k; k[0] = bflo(w[0]); k[1] = bfhi(w[0]); k[2] = bflo(w[1]); k[3] = bfhi(w[1]);
      *(f32x4*)(KROPE + (size_t)row * 32 + lane * 4) = k;
    }
  }
}

DI void mla_prep_phase(u16* __restrict__ Q, const u16* __restrict__ KVRAW, const float* __restrict__ KROPE, u16* __restrict__ Kout,
                       const float* __restrict__ gq, const float* __restrict__ gk, const float* __restrict__ RC, const float* __restrict__ RS) {
  const int lane = vtid() & 63, wid = vtid() >> 6;
  const int h = lane >> 2, sub = lane & 3;
  const float QS = 0.10206207261596577f * LOG2E;
  for (int m = vbid() * 4 + wid; m < MTOK; m += vgrid() * 4) {
    const int t = m & 4095;
    const f32x4 cs = *(const f32x4*)(RC + t * 16 + sub * 4), sn = *(const f32x4*)(RS + t * 16 + sub * 4);
#pragma unroll
    for (int which = 0; which < 2; ++which) {
      float nope[16]; f32x4 ra, rb;
      u16* dstp = (which == 0 ? Q : Kout) + (size_t)m * 1536 + h * 96;
      const float* gn = which == 0 ? gq : gk;
      if (which == 0) {
        const u32x4 w0 = *(const u32x4*)(dstp + sub * 16), w1 = *(const u32x4*)(dstp + sub * 16 + 8);
#pragma unroll
        for (int e = 0; e < 8; ++e) { nope[e] = bfget(w0, e); nope[8 + e] = bfget(w1, e); }
        const u32x2 a2 = *(const u32x2*)(dstp + 64 + sub * 4), b2 = *(const u32x2*)(dstp + 80 + sub * 4);
        ra[0] = bflo(a2[0]); ra[1] = bfhi(a2[0]); ra[2] = bflo(a2[1]); ra[3] = bfhi(a2[1]);
        rb[0] = bflo(b2[0]); rb[1] = bfhi(b2[0]); rb[2] = bflo(b2[1]); rb[3] = bfhi(b2[1]);
      } else {
        const u16* kp = KVRAW + (size_t)m * 2048 + h * 128 + sub * 16;
        const u32x4 w0 = *(const u32x4*)kp, w1 = *(const u32x4*)(kp + 8);
#pragma unroll
        for (int e = 0; e < 8; ++e) { nope[e] = bfget(w0, e); nope[8 + e] = bfget(w1, e); }
        ra = *(const f32x4*)(KROPE + (size_t)m * 32 + sub * 4);
        rb = *(const f32x4*)(KROPE + (size_t)m * 32 + 16 + sub * 4);
      }
      float ss = 0.f;
#pragma unroll
      for (int e = 0; e < 16; ++e) ss += nope[e] * nope[e];
#pragma unroll
      for (int e = 0; e < 4; ++e) ss += ra[e] * ra[e] + rb[e] * rb[e];
      ss += sx(ss, 1); ss += sx(ss, 2);
      const float rstd = rsqrtf(ss * (1.f / 96.f) + EPS) * (which == 0 ? QS : 1.f);
      u32x4 o0, o1;
#pragma unroll
      for (int e2 = 0; e2 < 4; ++e2) {
        o0[e2] = pack2(nope[2 * e2] * rstd * gn[sub * 16 + 2 * e2], nope[2 * e2 + 1] * rstd * gn[sub * 16 + 2 * e2 + 1]);
        o1[e2] = pack2(nope[8 + 2 * e2] * rstd * gn[sub * 16 + 8 + 2 * e2], nope[9 + 2 * e2] * rstd * gn[sub * 16 + 9 + 2 * e2]);
      }
      f32x4 oa, ob;
#pragma unroll
      for (int e = 0; e < 4; ++e) {
        const float a = ra[e] * rstd * gn[64 + sub * 4 + e], bq = rb[e] * rstd * gn[80 + sub * 4 + e];
        oa[e] = a * cs[e] - bq * sn[e];
        ob[e] = bq * cs[e] + a * sn[e];
      }
      *(u32x4*)(dstp + sub * 16) = o0; *(u32x4*)(dstp + sub * 16 + 8) = o1;
      *(u32x2*)(dstp + 64 + sub * 4) = pack4(oa); *(u32x2*)(dstp + 80 + sub * 4) = pack4(ob);
    }
  }
}

DI void mla_vt_phase(const u16* __restrict__ KVRAW, u16* __restrict__ VT, char* smem) {
  u16* tile = (u16*)smem;
  const int tid = vtid();
  for (int item = vbid(); item < 8192; item += vgrid()) {
    const int tt = item & 63, bh = item >> 6, b = bh >> 4, h = bh & 15;
    {
      const int row = tid >> 2, part = tid & 3;
      const u16* src = KVRAW + ((size_t)b * 4096 + tt * 64 + row) * 2048 + h * 128 + 64 + part * 16;
      const u32x4 w0 = *(const u32x4*)src, w1 = *(const u32x4*)(src + 8);
      u32* d32 = (u32*)(tile + row * 66 + part * 16);
#pragma unroll
      for (int e = 0; e < 4; ++e) { d32[e] = w0[e]; d32[4 + e] = w1[e]; }
    }
    __syncthreads();
    {
      const int d = tid >> 2, tp = (tid & 3) * 16;
      u32x4 o0, o1;
#pragma unroll
      for (int e2 = 0; e2 < 4; ++e2) {
        o0[e2] = (u32)tile[(tp + 2 * e2) * 66 + d] | ((u32)tile[(tp + 2 * e2 + 1) * 66 + d] << 16);
        o1[e2] = (u32)tile[(tp + 8 + 2 * e2) * 66 + d] | ((u32)tile[(tp + 9 + 2 * e2) * 66 + d] << 16);
      }
      u16* dst = VT + ((size_t)(bh * 64 + d)) * 4096 + tt * 64 + tp;
      *(u32x4*)dst = o0; *(u32x4*)(dst + 8) = o1;
    }
    __syncthreads();
  }
}

constexpr int FA_KROW = 208, FA_VROW = 144, FA_KT = 64 * FA_KROW, FA_BUF = FA_KT + 64 * FA_VROW;
template <bool FIXED>
DI void mla_attn_item(const u16* __restrict__ Q, const u16* __restrict__ Kb, const u16* __restrict__ VT, u16* __restrict__ O, int item, char* smem) {
  const int qb = item & 15, bh = item >> 4, b = bh >> 4, h = bh & 15;
  const int tid = vtid(), lane = tid & 63, wid = tid >> 6, fr = lane & 15, fq = lane >> 4;
  bf16x8 qf[4][3];
#pragma unroll
  for (int qt = 0; qt < 4; ++qt) {
    const size_t tq = (size_t)b * 4096 + qb * 256 + wid * 64 + qt * 16 + fr;
#pragma unroll
    for (int ks = 0; ks < 3; ++ks) qf[qt][ks] = *(const bf16x8*)(Q + tq * 1536 + h * 96 + ks * 32 + fq * 8);
  }
  f32x4 o[4][4];
#pragma unroll
  for (int i = 0; i < 4; ++i)
#pragma unroll
    for (int j = 0; j < 4; ++j) o[i][j] = zero4();
  float mrun[4] = {-1e30f, -1e30f, -1e30f, -1e30f}, lrun[4] = {0.f, 0.f, 0.f, 0.f};
  const u16* kg[3]; int ks_off[3];
#pragma unroll
  for (int i = 0; i < 3; ++i) {
    const int c = tid + 256 * i, row = c / 12, kc = c % 12;
    kg[i] = Kb + ((size_t)b * 4096 + row) * 1536 + h * 96 + kc * 8;
    ks_off[i] = row * FA_KROW + kc * 16;
  }
  const u16* vg[2]; int vs_off[2];
#pragma unroll
  for (int i = 0; i < 2; ++i) {
    const int c = tid + 256 * i, d = c >> 3, kc = c & 7;
    vg[i] = VT + ((size_t)(bh * 64 + d)) * 4096 + kc * 8;
    vs_off[i] = FA_KT + d * FA_VROW + kc * 16;
  }
  u32x4 rk[3], rv[2];
#pragma unroll
  for (int i = 0; i < 3; ++i) rk[i] = *(const u32x4*)(kg[i]);
#pragma unroll
  for (int i = 0; i < 2; ++i) rv[i] = *(const u32x4*)(vg[i]);
#pragma unroll
  for (int i = 0; i < 3; ++i) *(u32x4*)(smem + ks_off[i]) = rk[i];
#pragma unroll
  for (int i = 0; i < 2; ++i) *(u32x4*)(smem + vs_off[i]) = rv[i];
#pragma unroll
  for (int qt = 0; qt < 4; ++qt)
#pragma unroll
    for (int ks = 0; ks < 3; ++ks) asm volatile("" :: "v"(qf[qt][ks]));
  __syncthreads();
  for (int kt = 0; kt < 64; ++kt) {
    const int cur = (kt & 1) * FA_BUF, nxt = FA_BUF - cur;
    if (kt + 1 < 64) {
      const size_t key0 = (size_t)(kt + 1) * 64;
#pragma unroll
      for (int i = 0; i < 3; ++i) rk[i] = *(const u32x4*)(kg[i] + key0 * 1536);
#pragma unroll
      for (int i = 0; i < 2; ++i) rv[i] = *(const u32x4*)(vg[i] + key0);
    }
#pragma unroll
    for (int kh = 0; kh < 2; ++kh) {
      f32x4 s[2][4];
      __builtin_amdgcn_s_setprio(2);
#pragma unroll
      for (int kl = 0; kl < 2; ++kl) {
#pragma unroll
        for (int qt = 0; qt < 4; ++qt) s[kl][qt] = zero4();
#pragma unroll
        for (int ks = 0; ks < 3; ++ks) {
          const bf16x8 kf = *(const bf16x8*)(smem + cur + ((kh * 2 + kl) * 16 + fr) * FA_KROW + ks * 64 + fq * 16);
#pragma unroll
          for (int qt = 0; qt < 4; ++qt) s[kl][qt] = MFMA32(kf, qf[qt][ks], s[kl][qt]);
        }
      }
      __builtin_amdgcn_s_setprio(0);
      bf16x8 pp[4];
      {
        if constexpr (!FIXED) {
        float lm[4]; bool need = false;
#pragma unroll
        for (int qt = 0; qt < 4; ++qt) {
          const float m0 = fmaxf(fmaxf(s[0][qt][0], s[0][qt][1]), fmaxf(s[0][qt][2], s[0][qt][3]));
          const float m1 = fmaxf(fmaxf(s[1][qt][0], s[1][qt][1]), fmaxf(s[1][qt][2], s[1][qt][3]));
          lm[qt] = fmaxf(m0, m1);
          need = need || (lm[qt] > mrun[qt] + 8.f);
        }
        if (__any(need)) {
#pragma unroll
          for (int qt = 0; qt < 4; ++qt) {
            float mx = lm[qt];
            mx = fmaxf(mx, sx(mx, 16)); mx = fmaxf(mx, sx(mx, 32));
            const float mnew = fmaxf(mrun[qt], mx);
            const float alpha = __builtin_amdgcn_exp2f(mrun[qt] - mnew);
            mrun[qt] = mnew;
            lrun[qt] *= alpha;
#pragma unroll
            for (int dt = 0; dt < 4; ++dt) o[dt][qt] = o[dt][qt] * alpha;
          }
        }
        }
#pragma unroll
        for (int qt = 0; qt < 4; ++qt) {
          const float mr = FIXED ? 0.f : mrun[qt];
          float ps = 0.f;
#pragma unroll
          for (int kl = 0; kl < 2; ++kl)
#pragma unroll
            for (int j = 0; j < 4; ++j) { const float pv = __builtin_amdgcn_exp2f(s[kl][qt][j] - mr); s[kl][qt][j] = pv; ps += pv; }
          lrun[qt] += ps;
          pp[qt] = pack8(s[0][qt], s[1][qt]);
        }
      }
#pragma unroll
      for (int dt = 0; dt < 4; ++dt) {
        const char* vp = smem + cur + FA_KT + (dt * 16 + fr) * FA_VROW + (kh * 32 + fq * 4) * 2;
        const bf16x8 vf = cat4(*(const bf16x4*)vp, *(const bf16x4*)(vp + 32));
#pragma unroll
        for (int qt = 0; qt < 4; ++qt) o[dt][qt] = MFMA32(vf, pp[qt], o[dt][qt]);
      }
    }
    if (kt + 1 < 64) {
#pragma unroll
      for (int i = 0; i < 3; ++i) *(u32x4*)(smem + nxt + ks_off[i]) = rk[i];
#pragma unroll
      for (int i = 0; i < 2; ++i) *(u32x4*)(smem + nxt + vs_off[i]) = rv[i];
    }
    __syncthreads();
  }
#pragma unroll
  for (int qt = 0; qt < 4; ++qt) {
    float l = lrun[qt];
    l += sx(l, 16); l += sx(l, 32);
    const float inv = 1.f / l;
    const size_t tq = (size_t)b * 4096 + qb * 256 + wid * 64 + qt * 16 + fr;
#pragma unroll
    for (int dt = 0; dt < 4; ++dt) *(u32x2*)(O + tq * 1024 + h * 64 + dt * 16 + fq * 4) = pack4(o[dt][qt] * inv);
  }
}

#define XB_TMO      128
#define XB_XCNT(j)  (256  + 64 * (j))
#define XB_XSUB(j)  (1280 + 64 * (j))
#define XB_XGEN(j)  (2304 + 64 * (j))
#define XB_TOP      3328
#define XB_TOPGEN   3392
#define XCD_BAR_WORDS 3456
#define XB_SPIN_CAP (1u << 22)
DI unsigned xb_ld(unsigned* p) { return __hip_atomic_load(p, __ATOMIC_RELAXED, __HIP_MEMORY_SCOPE_AGENT); }
DI unsigned xb_add(unsigned* p, unsigned v) { return __hip_atomic_fetch_add(p, v, __ATOMIC_RELAXED, __HIP_MEMORY_SCOPE_AGENT); }
DI unsigned xb_xcc_id() { return (unsigned)__builtin_amdgcn_s_getreg((3 << 11) | 20) & 0xFu; }
#define XB_SPIN(cond, bar) do { unsigned _sp = 0; while (cond) { __builtin_amdgcn_s_sleep(1); \
    if ((++_sp & 255u) == 0u) { if (xb_ld(&(bar)[XB_TMO])) break; if (_sp > XB_SPIN_CAP) { atomicAdd(&(bar)[XB_TMO], 1u); break; } } } } while (0)

DI void xcd_barrier_complete(unsigned* bar, unsigned x, unsigned& nloc, unsigned& nx) {
  const unsigned G = gridDim.x;
  unsigned sum, cnt, mine, sp = 0u;
  for (;;) {
    sum = 0u; cnt = 0u; mine = 0u;
#pragma unroll
    for (unsigned j = 0; j < 16; ++j) { const unsigned c = xb_ld(&bar[XB_XCNT(j)]); sum += c; cnt += (c > 0u) ? 1u : 0u; mine = (j == x) ? c : mine; }
    if (sum == G) break;
    __builtin_amdgcn_s_sleep(1);
    if ((++sp & 255u) == 0u) { if (xb_ld(&bar[XB_TMO])) break; if (sp > XB_SPIN_CAP) { atomicAdd(&bar[XB_TMO], 1u); break; } }
  }
  nloc = mine > 0u ? mine : 1u; nx = cnt > 0u ? cnt : 1u;
}

DI void xcd_barrier(unsigned* bar, char* smem_) {
  int off_ = 147456; asm volatile("" : "+v"(off_));
  volatile unsigned* st = (volatile unsigned*)(smem_ + off_);
  asm volatile("s_waitcnt vmcnt(0)" ::: "memory");
  __syncthreads();
  if (threadIdx.x == 0) {
    __builtin_amdgcn_s_waitcnt(0);
    const unsigned x = xb_xcc_id();
    unsigned nloc = st[0], nx = st[1];
    if (nloc == 0u) { xcd_barrier_complete(bar, x, nloc, nx); st[0] = nloc; st[1] = nx; }
    const unsigned old = xb_add(&bar[XB_XSUB(x)], 1u);
    const unsigned gen = old / nloc;
    if (old + 1u == (gen + 1u) * nloc) {
      __builtin_amdgcn_fence(__ATOMIC_RELEASE, "agent");
      asm volatile("s_waitcnt vmcnt(0)" ::: "memory");
      const unsigned og = xb_add(&bar[XB_TOP], 1u);
      const unsigned tg = og / nx;
      if (og + 1u == (tg + 1u) * nx) xb_add(&bar[XB_TOPGEN], 1u);
      else XB_SPIN(xb_ld(&bar[XB_TOPGEN]) == tg, bar);
      __builtin_amdgcn_fence(__ATOMIC_ACQUIRE, "agent");
      xb_add(&bar[XB_XGEN(x)], 1u);
      asm volatile("s_waitcnt vmcnt(0)" ::: "memory");
    } else {
      XB_SPIN(xb_ld(&bar[XB_XGEN(x)]) == gen, bar);
      __builtin_amdgcn_fence(__ATOMIC_ACQUIRE, "agent");
      asm volatile("s_waitcnt vmcnt(0)" ::: "memory");
    }
  }
  __syncthreads();
}

#ifndef ENMASK
#define ENMASK 0xffffffffu
#endif
#define EN(i) ((ENMASK >> (i)) & 1u)
#ifndef DUPMASK
#define DUPMASK 0u
#endif
#define DUP(i) ((DUPMASK >> (i)) & 1u)
#ifndef BAR2
#define BAR2 0
#endif
#define PHASE_BEGIN(i) if (EN(i) && pc >= p.lo && pc < p.hi) for (int rep_ = 0; rep_ < 1 + (int)DUP(i); ++rep_) {
#define PHASE_END } { if (pc >= p.lo && pc + 1 < p.hi) { if (pc == p.lo) grid.sync(); else { xcd_barrier(bar, smem); if (BAR2) xcd_barrier(bar, smem); } } ++pc; }

__global__ void __launch_bounds__(512) mega(Params p) {
  __shared__ __attribute__((aligned(16))) char smem[147456 + 16];
  cg::grid_group grid = cg::this_grid();
  int pc = 0;
  unsigned* bar = (unsigned*)(p.ws + OFF_BAR);
  volatile unsigned* st = (volatile unsigned*)(smem + 147456);
  if (threadIdx.x == 0) { st[0] = 0u; st[1] = 0u; (void)xb_add(&bar[XB_XCNT(xb_xcc_id())], 1u); }
  __syncthreads();
  for (int layer = 0; layer < 4; ++layer) {
    const int kind = layer % 3, mi = layer / 3;
    for (int stage = 0; stage < 3; ++stage) {
      char* ws = p.ws; asm volatile("" : "+s"(ws));
      u16* H = (u16*)(ws + OFF_H);
      char* R = ws + OFF_R;
      const float* LB = (const float*)(ws + OFF_TAB);
      const float* RC = LB + 4096; const float* RS = RC + 65536;
      if (stage != 1) {
        const float* ng = (stage == 0 ? p.ffn1_norm : p.ffn2_norm) + layer * 1024;
        const u16* wgu = (const u16*)(ws + (stage == 0 ? OFF_WGU1 : OFF_WGU2));
        const u16* wdn = (const u16*)(ws + (stage == 0 ? OFF_WDN1 : OFF_WDN2));
        u16* ACT = (u16*)R;
        PHASE_BEGIN(0)
          const bool first = (layer == 0 && stage == 0);
          if (stage == 0) { if (layer == 0) init_tables(p); cvt_layer(p, layer, (smem + (otid() >> 8) * 73728)); }
          norm_phase(first ? p.x : p.X, ng, H, first ? p.X : nullptr, MTOK);
        PHASE_END
        PHASE_BEGIN(1)
          gemm_phase(H, 1024, wgu, 1024, MTOK, 5632, EpiSwiglu{ACT}, smem);
        PHASE_END
        PHASE_BEGIN(2)
          gemm_phase(ACT, 2816, wdn, 2816, MTOK, 1024, EpiResid{p.X, 0.5f}, smem);
        PHASE_END
      } else {
        PHASE_BEGIN(3)
          norm_phase(p.X, p.mix_norm + layer * 1024, H, nullptr, MTOK);
        PHASE_END
        if (kind == 0) {
          constexpr size_t SZ = 32 * MiB;
          HgBufs hb;
          hb.Q = (u16*)(R + 0 * SZ); hb.LFf = (u16*)(R + 1 * SZ); hb.LFb = (u16*)(R + 2 * SZ); hb.V = (u16*)(R + 3 * SZ); hb.G = (u16*)(R + 4 * SZ);
          hb.QIf = (u16*)(R + 5 * SZ); hb.QIb = (u16*)(R + 6 * SZ); hb.KITf = (u16*)(R + 7 * SZ); hb.KITb = (u16*)(R + 8 * SZ);
          hb.VTc = (u16*)(R + 9 * SZ); hb.OI = (u16*)(R + 10 * SZ); hb.OF = hb.Q; hb.OB = hb.LFf; hb.Y = hb.LFb;
          hb.DECf = (float*)(R + 11 * SZ); hb.DECb = (float*)(R + 11 * SZ + 4 * MiB);
          const u16* w_in = (const u16*)(ws + OFF_WMIX); const u16* w_out = (const u16*)(ws + OFF_WMIX + 10485760);
          for (int half = 0; half < 2; ++half) {
            PHASE_BEGIN(4)
              gemm_phase(H + (size_t)half * 16384 * 1024, 1024, w_in, 1024, 16384, 5120, EpiHgIn{hb.Q, hb.LFf, hb.LFb, hb.V, hb.G, LB + layer * 1024}, smem);
            PHASE_END
            PHASE_BEGIN(5)
              hg_prep_phase(hb, (smem + (otid() >> 8) * 73728));
            PHASE_END
            PHASE_BEGIN(6)
              hg_scan_phase(hb, (smem + (otid() >> 8) * 73728));
            PHASE_END
            PHASE_BEGIN(7)
              hg_combine_phase(hb, p.hg_g_norm + mi * 128, 16384);
            PHASE_END
            PHASE_BEGIN(8)
              gemm_phase(hb.Y, 1024, w_out, 1024, 16384, 1024, EpiResid{p.X + (size_t)half * 16384 * 1024, 1.0f}, smem);
            PHASE_END
          }
        } else if (kind == 1) {
          u16* Qn = (u16*)R; u16* Kn = (u16*)(R + 64 * MiB); u16* VT = (u16*)(R + 128 * MiB); u16* On = (u16*)(R + 192 * MiB);
          const u16* w_in = (const u16*)(ws + OFF_WMIX); const u16* w_out = (const u16*)(ws + OFF_WMIX + 6291456);
          PHASE_BEGIN(9)
            gemm_phase(H, 1024, w_in, 1024, MTOK, 3072, EpiNaIn{Qn, Kn, VT, p.na_q_norm + mi * 64, p.na_k_norm + mi * 64}, smem);
          PHASE_END
          PHASE_BEGIN(10)
            const int tid_ = vtid(), lane = tid_ & 63, wid = tid_ >> 6, fr = lane & 15, fq = lane >> 4;
            for (int item = vbid() * 4 + wid; item < 32768; item += vgrid() * 4)
              na_attn_item(Qn, Kn, VT, p.na_rpb + (size_t)mi * 16 * 15 * 31, On, item, fr, fq);
          PHASE_END
          PHASE_BEGIN(11)
            gemm_phase(On, 1024, w_out, 1024, MTOK, 1024, EpiResid{p.X, 1.0f}, smem);
          PHASE_END
        } else {
          u16* VT = H;
          u16* CRAW = (u16*)R; u16* On = (u16*)R;
          u16* CQN = (u16*)(R + 66 * MiB); u16* CKVN = (u16*)(R + 114 * MiB); u16* Kk = (u16*)(R + 66 * MiB);
          float* KROPE = (float*)(R + 162 * MiB);
          u16* Qq = (u16*)(R + 166 * MiB); u16* KVRAW = (u16*)(R + 262 * MiB);
          const u16* w_in = (const u16*)(ws + OFF_WMIX); const u16* w_uq = (const u16*)(ws + OFF_WMIX + 2621440);
          const u16* w_ukv = (const u16*)(ws + OFF_WMIX + 4980736); const u16* w_out = (const u16*)(ws + OFF_WMIX + 6029312);
          PHASE_BEGIN(12)
            gemm_phase(H, 1024, w_in, 1024, MTOK, 1280, EpiStore{CRAW, 1056, 1056}, smem);
          PHASE_END
          PHASE_BEGIN(13)
            mla_norm_phase(CRAW, p.mla_q_a_norm + mi * 768, p.mla_kv_a_norm + mi * 256, CQN, CKVN, KROPE);
          PHASE_END
          PHASE_BEGIN(14)
            gemm_phase(CQN, 768, w_uq, 768, MTOK, 1536, EpiStore{Qq, 1536, 1536}, smem);
          PHASE_END
          PHASE_BEGIN(18)
            gemm_phase(CKVN, 256, w_ukv, 256, MTOK, 2048, EpiStore{KVRAW, 2048, 2048}, smem);
          PHASE_END
          PHASE_BEGIN(15)
            mla_prep_phase(Qq, KVRAW, KROPE, Kk, p.mla_q_norm + mi * 96, p.mla_k_norm + mi * 96, RC, RS);
            mla_vt_phase(KVRAW, VT, (smem + (otid() >> 8) * 73728));
          PHASE_END
          PHASE_BEGIN(16)
            float mgq = 0.f, mgk = 0.f;
            for (int d = 0; d < 96; ++d) { mgq = fmaxf(mgq, fabsf(p.mla_q_norm[mi * 96 + d])); mgk = fmaxf(mgk, fabsf(p.mla_k_norm[mi * 96 + d])); }
            if (14.2f * mgq * mgk <= 40.f) {
              for (int item = vbid(); item < 2048; item += vgrid()) mla_attn_item<true>(Qq, Kk, VT, On, item, (smem + (otid() >> 8) * 73728));
            } else {
              for (int item = vbid(); item < 2048; item += vgrid()) mla_attn_item<false>(Qq, Kk, VT, On, item, (smem + (otid() >> 8) * 73728));
            }
          PHASE_END
          PHASE_BEGIN(17)
            gemm_phase(On, 1024, w_out, 1024, MTOK, 1024, EpiResid{p.X, 1.0f}, smem);
          PHASE_END
        }
      }
    }
  }
}

static int count_phases() {
  int n = 0;
  for (int layer = 0; layer < 4; ++layer) {
    int kind = layer % 3;
    n += 3 + 3 + 1;
    n += kind == 0 ? 10 : kind == 1 ? 3 : 7;
  }
  return n;
}

extern "C" void kernel_launch(void* const* d_in, const int* in_sizes, int n_in, void* d_out, int out_size, void* d_ws, size_t ws_size, hipStream_t stream) {
  if (ws_size < WS_NEED) { fprintf(stderr, "workspace too small: %zu < %zu\n", ws_size, WS_NEED); return; }
  static int grid_blocks = 0;
  if (!grid_blocks) {
    int dev = 0, cus = 0, per_cu = 0;
    hipGetDevice(&dev);
    hipDeviceGetAttribute(&cus, hipDeviceAttributeMultiprocessorCount, dev);
    hipOccupancyMaxActiveBlocksPerMultiprocessor(&per_cu, mega, 512, 0);
    if (per_cu > 1) per_cu = 1;
    grid_blocks = cus * per_cu;
  }
  Params p{};
  const float** pf = (const float**)&p;
  for (int i = 0; i < 25; ++i) pf[i] = (const float*)d_in[i];
  p.X = (float*)d_out; p.ws = (char*)d_ws;
  const int total = count_phases();
#if MULTI_LAUNCH
  for (int ph = 0; ph < total; ++ph) {
    p.lo = ph; p.hi = ph + 1;
    hipLaunchKernelGGL(mega, dim3(grid_blocks), dim3(512), 0, stream, p);
  }
#else
  hipMemsetAsync((char*)d_ws + OFF_BAR, 0, 16384, stream);
  p.lo = 0; p.hi = total;
  void* args[] = {&p};
  hipError_t e = hipLaunchCooperativeKernel((void*)mega, dim3(grid_blocks), dim3(512), args, 0, stream);
  if (e != hipSuccess) fprintf(stderr, "cooperative launch failed: %s (grid %d)\n", hipGetErrorString(e), grid_blocks);
#endif
}
```
